# Optimizing an MI355X kernel written in HIP

```python
import math
import jax, jax.numpy as jnp
from jax import lax
import numpy as np

D_MODEL = 2048
BATCH = 2
SEQ = 16384
DEPTH = 1

MEM_LEN = 256
EPS = 1e-6
DA_HEADS = 8
DA_DK = 128
DA_DV = 256
Q_BLOCK = 128
ML_HEADS = 4
ML_D = 256
ML_CHUNK = 64
CONV_W = 4
XA_HEADS = 4
XA_D = 256
N_BRANCH = 3
N_GROUPS = 4
EXPERTS_PER_GROUP = 8
N_EXPERTS = N_GROUPS * EXPERTS_PER_GROUP
TOP_K = 2
D_EXPERT = 704
MOE_BLOCK = 128

SPLIT_SIZES = (
    DA_HEADS * 2 * DA_DK,
    DA_HEADS * 2 * DA_DK,
    DA_HEADS * DA_DV,
    2 * ML_HEADS * ML_D,
    ML_HEADS * ML_D,
    ML_HEADS * ML_D,
    2 * ML_HEADS,
    XA_HEADS * XA_D,
    N_BRANCH * D_MODEL,
)
D_IN = sum(SPLIT_SIZES)

kernel_name = "hybrid_diffattn_mlstm_memxattn_hmoe"


def rms_norm(x, g):
    x32 = x.astype(jnp.float32)
    y = x32 * lax.rsqrt(jnp.mean(x32 * x32, axis=-1, keepdims=True) + EPS)
    return (y * g.astype(jnp.float32)).astype(x.dtype)


def causal_conv(x, w, b):
    S = x.shape[1]
    xp = jnp.pad(x, ((0, 0), (CONV_W - 1, 0), (0, 0)))
    return sum(xp[:, j:j + S] * w[j] for j in range(CONV_W)) + b


def diff_attention(q, k, v, lam, slopes):
    B, S, H = q.shape[:3]
    q = jnp.transpose(q, (0, 2, 3, 1, 4)).astype(jnp.float32)
    k = jnp.transpose(k, (0, 2, 3, 1, 4)).astype(jnp.float32)
    v = jnp.transpose(v, (0, 2, 1, 3)).astype(jnp.float32)
    nb = S // Q_BLOCK
    qb = jnp.moveaxis(q.reshape(B, H, 2, nb, Q_BLOCK, DA_DK), 3, 0)
    key_pos = jnp.arange(S)
    scale = DA_DK ** -0.5

    def block(args):
        qi, i = args
        s = jnp.einsum('bhmqd,bhmkd->bhmqk', qi, k) * scale
        q_pos = i * Q_BLOCK + jnp.arange(Q_BLOCK)
        dist = q_pos[:, None] - key_pos[None, :]
        bias = -slopes[None, :, None, None, None] * dist.astype(jnp.float32)
        s = jnp.where(dist >= 0, s + bias, -jnp.inf)
        p = jax.nn.softmax(s, axis=-1)
        a = p[:, :, 0] - lam * p[:, :, 1]
        return jnp.einsum('bhqk,bhkd->bhqd', a, v)

    o = lax.map(block, (qb, jnp.arange(nb)))
    return jnp.transpose(o, (1, 0, 3, 2, 4)).reshape(B, S, H, DA_DV)


def mlstm_chunkwise(q, k, v, ig, lf):
    B, S, H, d = q.shape
    nc = S // ML_CHUNK

    def chunks(t):
        t = t.astype(jnp.float32).reshape((B, nc, ML_CHUNK, H) + t.shape[3:])
        return jnp.moveaxis(jnp.moveaxis(t, 1, 0), 3, 2)

    causal = jnp.tril(jnp.ones((ML_CHUNK, ML_CHUNK), dtype=bool))

    def step(carry, xs):
        C, n, m = carry
        qc, kc, vc, ic, fc = xs
        b = jnp.cumsum(fc, axis=-1)
        log_d = jnp.where(causal, b[..., :, None] - b[..., None, :] + ic[..., None, :], -jnp.inf)
        m_inter = b + m[..., None]
        m_t = jnp.maximum(m_inter, jnp.max(log_d, axis=-1))
        dmat = jnp.exp(log_d - m_t[..., None])
        inter = jnp.exp(m_inter - m_t)
        w = jnp.einsum('bhtd,bhsd->bhts', qc, kc) * dmat
        num = jnp.einsum('bhts,bhsd->bhtd', w, vc) + inter[..., None] * jnp.einsum('bhtd,bhde->bhte', qc, C)
        nq = jnp.sum(w, axis=-1) + inter * jnp.einsum('bhtd,bhd->bht', qc, n)
        h = num / jnp.maximum(jnp.abs(nq), jnp.exp(-m_t))[..., None]
        b_last = b[..., -1]
        a = b_last[..., None] - b + ic
        m_new = jnp.maximum(b_last + m, jnp.max(a, axis=-1))
        decay = jnp.exp(b_last + m - m_new)
        wa = jnp.exp(a - m_new[..., None])
        C_new = decay[..., None, None] * C + jnp.einsum('bhs,bhsd,bhse->bhde', wa, kc, vc)
        n_new = decay[..., None] * n + jnp.einsum('bhs,bhsd->bhd', wa, kc)
        return (C_new, n_new, m_new), h

    init = (jnp.zeros((B, H, d, d), jnp.float32), jnp.zeros((B, H, d), jnp.float32),
            jnp.zeros((B, H), jnp.float32))
    _, h = lax.scan(step, init, (chunks(q), chunks(k), chunks(v), chunks(ig), chunks(lf)))
    return jnp.transpose(h, (1, 0, 3, 2, 4)).reshape(B, S, H, d)


def memory_cross_attention(q, mk, mv):
    s = jnp.einsum('bshd,bmhd->bhsm', q.astype(jnp.float32), mk.astype(jnp.float32)) * (XA_D ** -0.5)
    p = jax.nn.softmax(s, axis=-1)
    return jnp.einsum('bhsm,bmhd->bshd', p, mv.astype(jnp.float32))


def hierarchical_moe(h, w_router_group, b_router_group, w_router_expert, b_router_expert,
                     w_expert_gate, w_expert_up, w_expert_down):
    B, S, D = h.shape
    T = B * S
    hf = h.reshape(T, D)
    g_logits = (hf @ w_router_group).astype(jnp.float32) + b_router_group.astype(jnp.float32)
    g_prob = jax.nn.softmax(g_logits, axis=-1)
    grp = jnp.argmax(g_logits, axis=-1)
    p_grp = jnp.take_along_axis(g_prob, grp[:, None], axis=-1)
    e_logits = ((hf @ w_router_expert).astype(jnp.float32)
                + b_router_expert.astype(jnp.float32)).reshape(T, N_GROUPS, EXPERTS_PER_GROUP)
    e_in = jnp.take_along_axis(e_logits, grp[:, None, None], axis=1)[:, 0]
    top_v, top_i = lax.top_k(e_in, TOP_K)
    wts = jax.nn.softmax(top_v, axis=-1) * p_grp
    eid = (grp[:, None] * EXPERTS_PER_GROUP + top_i).reshape(-1).astype(jnp.int32)
    tok = jnp.repeat(jnp.arange(T, dtype=jnp.int32), TOP_K)
    wflat = wts.reshape(-1)
    n_assign = T * TOP_K
    order = jnp.argsort(eid)
    eid_s, tok_s, w_s = eid[order], tok[order], wflat[order]
    counts = jax.ops.segment_sum(jnp.ones_like(eid), eid, num_segments=N_EXPERTS)
    start = jnp.cumsum(counts) - counts
    padded = (counts + MOE_BLOCK - 1) // MOE_BLOCK * MOE_BLOCK
    pad_end = jnp.cumsum(padded)
    pad_start = pad_end - padded
    dest = pad_start[eid_s] + (jnp.arange(n_assign, dtype=jnp.int32) - start[eid_s])
    nb = (n_assign + MOE_BLOCK - 1) // MOE_BLOCK + N_EXPERTS
    P = nb * MOE_BLOCK
    buf_tok = jnp.zeros((P,), jnp.int32).at[dest].set(tok_s)
    buf_w = jnp.zeros((P,), jnp.float32).at[dest].set(w_s)
    blk_e = jnp.minimum(jnp.searchsorted(pad_end, jnp.arange(nb, dtype=jnp.int32) * MOE_BLOCK, side='right'),
                        N_EXPERTS - 1)

    def expert_block(args):
        tk, wk, e = args
        xb = hf[tk]
        a = xb @ w_expert_gate[e]
        u = xb @ w_expert_up[e]
        return ((jax.nn.silu(a) * u) @ w_expert_down[e]) * wk[:, None].astype(xb.dtype)

    out = lax.map(expert_block, (buf_tok.reshape(nb, MOE_BLOCK), buf_w.reshape(nb, MOE_BLOCK), blk_e))
    y = jnp.zeros_like(hf).at[buf_tok].add(out.reshape(P, D))
    return y.reshape(B, S, D)


def hybrid_layer(x, mem, layer_idx, g_mix, w_in, conv_w, conv_b, b_igate, b_fgate,
                 lam_q1, lam_k1, lam_q2, lam_k2, g_diff_head, g_mlstm_head, g_mem, w_mem_kv,
                 w_branch_diff, w_branch_mlstm, w_branch_cross, b_gate, w_out, g_ffn,
                 w_router_group, b_router_group, w_router_expert, b_router_expert,
                 w_expert_gate, w_expert_up, w_expert_down):
    B, S, _ = x.shape
    h = rms_norm(x, g_mix)
    proj = h @ w_in
    points = np.cumsum(SPLIT_SIZES)[:-1].tolist()
    da_q, da_k, da_v, ml_qk, ml_v, ml_o, ml_g, xa_q, gate_pre = jnp.split(proj, points, axis=-1)

    lam_init = 0.8 - 0.6 * math.exp(-0.3 * layer_idx)
    lam = (jnp.exp(jnp.dot(lam_q1.astype(jnp.float32), lam_k1.astype(jnp.float32)))
           - jnp.exp(jnp.dot(lam_q2.astype(jnp.float32), lam_k2.astype(jnp.float32))) + lam_init)
    slopes = 2.0 ** (-8.0 * jnp.arange(1, DA_HEADS + 1, dtype=jnp.float32) / DA_HEADS)
    da = diff_attention(da_q.reshape(B, S, DA_HEADS, 2, DA_DK), da_k.reshape(B, S, DA_HEADS, 2, DA_DK),
                        da_v.reshape(B, S, DA_HEADS, DA_DV), lam, slopes)
    da = (rms_norm(da, g_diff_head) * (1.0 - lam_init)).reshape(B, S, DA_HEADS * DA_DV).astype(x.dtype)

    qk = jax.nn.silu(causal_conv(ml_qk, conv_w, conv_b))
    ml_q, ml_k = jnp.split(qk, 2, axis=-1)
    ig = ml_g[..., :ML_HEADS] + b_igate
    lf = jax.nn.log_sigmoid((ml_g[..., ML_HEADS:] + b_fgate).astype(jnp.float32))
    hm = mlstm_chunkwise(ml_q.reshape(B, S, ML_HEADS, ML_D), ml_k.reshape(B, S, ML_HEADS, ML_D) * (ML_D ** -0.5),
                         ml_v.reshape(B, S, ML_HEADS, ML_D), ig, lf)
    hm = (jax.nn.sigmoid(ml_o) * rms_norm(hm, g_mlstm_head).reshape(B, S, ML_HEADS * ML_D)).astype(x.dtype)

    mem_kv = rms_norm(mem, g_mem) @ w_mem_kv
    mk, mv = jnp.split(mem_kv, 2, axis=-1)
    M = mem.shape[1]
    xa = memory_cross_attention(xa_q.reshape(B, S, XA_HEADS, XA_D), mk.reshape(B, M, XA_HEADS, XA_D),
                                mv.reshape(B, M, XA_HEADS, XA_D))
    xa = xa.reshape(B, S, XA_HEADS * XA_D).astype(x.dtype)

    gates = jax.nn.sigmoid(gate_pre + b_gate).reshape(B, S, N_BRANCH, D_MODEL)
    merged = (gates[..., 0, :] * (da @ w_branch_diff) + gates[..., 1, :] * (hm @ w_branch_mlstm)
              + gates[..., 2, :] * (xa @ w_branch_cross))
    x = x + merged @ w_out

    x = x + hierarchical_moe(rms_norm(x, g_ffn), w_router_group, b_router_group, w_router_expert,
                             b_router_expert, w_expert_gate, w_expert_up, w_expert_down)
    return x


def setup_inputs(seed: int = 0) -> dict:
    key = jax.random.key(seed)
    ks = jax.random.split(key, 32)
    L, D = DEPTH, D_MODEL
    f32 = jnp.float32

    def nrm(k, shape, scale):
        return jax.random.normal(k, shape, f32) * scale

    def gain(k, shape):
        return 1.0 + 0.02 * jax.random.normal(k, shape, f32)

    f_bias_base = jnp.linspace(3.0, 6.0, ML_HEADS, dtype=f32)
    return {
        "x": nrm(ks[0], (BATCH, SEQ, D), 1.0),
        "mem": nrm(ks[1], (BATCH, MEM_LEN, D), 1.0),
        "g_mix": gain(ks[2], (L, D)),
        "w_in": nrm(ks[3], (L, D, D_IN), D ** -0.5),
        "conv_w": nrm(ks[4], (L, CONV_W, 2 * ML_HEADS * ML_D), CONV_W ** -0.5),
        "conv_b": nrm(ks[5], (L, 2 * ML_HEADS * ML_D), 0.02),
        "b_igate": nrm(ks[6], (L, ML_HEADS), 0.1),
        "b_fgate": f_bias_base + nrm(ks[7], (L, ML_HEADS), 0.1),
        "lam_q1": nrm(ks[8], (L, DA_DK), 0.1),
        "lam_k1": nrm(ks[9], (L, DA_DK), 0.1),
        "lam_q2": nrm(ks[10], (L, DA_DK), 0.1),
        "lam_k2": nrm(ks[11], (L, DA_DK), 0.1),
        "g_diff_head": gain(ks[12], (L, DA_HEADS, DA_DV)),
        "g_mlstm_head": gain(ks[13], (L, ML_HEADS, ML_D)),
        "g_mem": gain(ks[14], (L, D)),
        "w_mem_kv": nrm(ks[15], (L, D, 2 * XA_HEADS * XA_D), D ** -0.5),
        "w_branch_diff": nrm(ks[16], (L, DA_HEADS * DA_DV, D), (DA_HEADS * DA_DV) ** -0.5),
        "w_branch_mlstm": nrm(ks[17], (L, ML_HEADS * ML_D, D), (ML_HEADS * ML_D) ** -0.5),
        "w_branch_cross": nrm(ks[18], (L, XA_HEADS * XA_D, D), (XA_HEADS * XA_D) ** -0.5),
        "b_gate": nrm(ks[19], (L, N_BRANCH * D), 0.02),
        "w_out": nrm(ks[20], (L, D, D), D ** -0.5),
        "g_ffn": gain(ks[21], (L, D)),
        "w_router_group": nrm(ks[22], (L, D, N_GROUPS), D ** -0.5),
        "b_router_group": nrm(ks[23], (L, N_GROUPS), 0.01),
        "w_router_expert": nrm(ks[24], (L, D, N_EXPERTS), D ** -0.5),
        "b_router_expert": nrm(ks[25], (L, N_EXPERTS), 0.01),
        "w_expert_gate": nrm(ks[26], (L, N_EXPERTS, D, D_EXPERT), D ** -0.5),
        "w_expert_up": nrm(ks[27], (L, N_EXPERTS, D, D_EXPERT), D ** -0.5),
        "w_expert_down": nrm(ks[28], (L, N_EXPERTS, D_EXPERT, D), D_EXPERT ** -0.5),
        "g_final": gain(ks[29], (D,)),
    }


def reference(x, mem, g_mix, w_in, conv_w, conv_b, b_igate, b_fgate, lam_q1, lam_k1, lam_q2, lam_k2,
              g_diff_head, g_mlstm_head, g_mem, w_mem_kv, w_branch_diff, w_branch_mlstm, w_branch_cross,
              b_gate, w_out, g_ffn, w_router_group, b_router_group, w_router_expert, b_router_expert,
              w_expert_gate, w_expert_up, w_expert_down, g_final):
    for l in range(DEPTH):
        x = hybrid_layer(x, mem, l, g_mix[l], w_in[l], conv_w[l], conv_b[l], b_igate[l], b_fgate[l],
                         lam_q1[l], lam_k1[l], lam_q2[l], lam_k2[l], g_diff_head[l], g_mlstm_head[l],
                         g_mem[l], w_mem_kv[l], w_branch_diff[l], w_branch_mlstm[l], w_branch_cross[l],
                         b_gate[l], w_out[l], g_ffn[l], w_router_group[l], b_router_group[l],
                         w_router_expert[l], b_router_expert[l], w_expert_gate[l], w_expert_up[l],
                         w_expert_down[l])
    return rms_norm(x, g_final)
```

```cpp
#include <hip/hip_runtime.h>
#include <hip/hip_bf16.h>
#include <cstdio>
#include <cstdint>

#define LAS __attribute__((address_space(3)))
#define GAS __attribute__((address_space(1)))
typedef unsigned short bf16_t;
typedef short bf16x8 __attribute__((ext_vector_type(8)));
typedef short s16x4 __attribute__((ext_vector_type(4)));
typedef float f32x2 __attribute__((ext_vector_type(2)));
typedef float f32x4 __attribute__((ext_vector_type(4)));
typedef float f32x16 __attribute__((ext_vector_type(16)));
typedef unsigned u32x2 __attribute__((ext_vector_type(2)));
typedef unsigned u32x4 __attribute__((ext_vector_type(4)));

constexpr int NB = 2, SEQ = 16384, TT = NB * SEQ, DM = 2048, MEML = 256;
constexpr int DIN = 17416;
constexpr float EPS = 1e-6f;
constexpr int NEXP = 32, DEXP = 704, DEXP_P = 768, GU_N = 1536;
constexpr int MAX_RT = 288;

constexpr size_t MiB = 1u << 20;
constexpr size_t WS_CTL = 0, CTL_ZERO_BYTES = 1 * MiB;
constexpr size_t WS_MLG = 1 * MiB;
constexpr size_t WS_SCKW = 2 * MiB, WS_SCRS = 2 * MiB + 512 * 1024, WS_SCIT = 3 * MiB, WS_SCED = 3 * MiB + 512 * 1024;
constexpr size_t WS_HDEN = 4 * MiB;
constexpr size_t WS_KN = 13 * MiB;
constexpr size_t WS_NP = 5 * MiB + 512 * 1024;
constexpr size_t WS_DEC = 6 * MiB;
constexpr size_t WS_MEMN = 7 * MiB;
constexpr size_t WS_MK = 9 * MiB;
constexpr size_t WS_MVT = 10 * MiB;
constexpr size_t WS_TOKE = 11 * MiB;
constexpr size_t WS_TOKW = 11 * MiB + 256 * 1024;
constexpr size_t WS_POS = 11 * MiB + 512 * 1024;
constexpr size_t WS_WROW = 12 * MiB;
constexpr size_t WS_TILEE = 12 * MiB + 512 * 1024;
constexpr size_t WS_RT = 12 * MiB + 768 * 1024;
constexpr size_t WS_WINT = 16 * MiB;
constexpr size_t WS_WMEMT = 84 * MiB;
constexpr size_t WS_WBDT = 92 * MiB;
constexpr size_t WS_WBMT = 100 * MiB;
constexpr size_t WS_WBCT = 104 * MiB;
constexpr size_t WS_WOUTT = 108 * MiB;
constexpr size_t WS_WRT = 116 * MiB;
constexpr size_t WS_MQK = 120 * MiB;
constexpr size_t WS_U = 120 * MiB;
constexpr size_t WS_XQ = 312 * MiB;
constexpr size_t WS_XP = 312 * MiB;
constexpr size_t WS_VC = 376 * MiB;
constexpr size_t WS_Q = 504 * MiB;
constexpr size_t WS_WQ = 568 * MiB;
constexpr size_t WS_KW = 696 * MiB;
constexpr size_t WS_KWT = 760 * MiB;
constexpr size_t WS_XS = 824 * MiB;
constexpr size_t WS_MLO = 952 * MiB;
constexpr size_t WS_DQ = 120 * MiB, WS_DK = 248 * MiB, WS_DV = 376 * MiB;
constexpr size_t WS_O = 504 * MiB;
constexpr size_t WS_DA = 760 * MiB;
constexpr size_t WS_WGU = 120 * MiB;
constexpr size_t WS_WD = 216 * MiB;
constexpr size_t WS_HBF8 = 264 * MiB;
constexpr size_t WS_GT0 = 408 * MiB, WS_GT1 = 536 * MiB;
constexpr size_t WS_MERGED = 888 * MiB;
constexpr size_t WS_X1B = 264 * MiB;
constexpr size_t WS_RSS = 1016 * MiB;
constexpr size_t WS_LG = 536 * MiB;
constexpr size_t WS_XSORT = 568 * MiB;
constexpr size_t WS_HD = 856 * MiB;
constexpr size_t WS_YS = 568 * MiB;
constexpr size_t WS_END = 1024 * MiB;
constexpr size_t DO_HBF = 0, DO_HR = 128 * MiB, DO_XA = 192 * MiB;

constexpr int CW_BAR = 4096;
constexpr int CW_AHEAD = 8192;
constexpr int CW_QKMAX = 8256;
constexpr int CW_KMX = 8272;
constexpr int CW_QB2 = 16384;
constexpr int CW_ND = 16384 + 2048;
constexpr int CW_ECNT = 8320;
constexpr int CW_ECUR = 8384;
constexpr int CW_LAM = 8448;
constexpr int CW_NRT = 8449;

constexpr int RING_BYTES = 131072;
constexpr int MISC_OFF = RING_BYTES + 320;
constexpr int LDS_BYTES = 147456;

#define LDS_WAIT() asm volatile("s_waitcnt lgkmcnt(0)" ::: "memory")
#define VM_WAIT() asm volatile("s_waitcnt vmcnt(0)" ::: "memory")
#define RLX_AGENT __ATOMIC_RELAXED, __HIP_MEMORY_SCOPE_AGENT

__device__ __forceinline__ unsigned cvtpk(float lo, float hi) { unsigned r; asm volatile("v_cvt_pk_bf16_f32 %0, %1, %2" : "=v"(r) : "v"(lo), "v"(hi)); return r; }
__device__ __forceinline__ unsigned pk4_fp8(float a, float b, float c, float d) { int w = 0; w = __builtin_amdgcn_cvt_pk_fp8_f32(a, b, w, false); w = __builtin_amdgcn_cvt_pk_fp8_f32(c, d, w, true); return (unsigned)w; }
__device__ __forceinline__ float bf2f(unsigned short b) { return __uint_as_float(((unsigned)b) << 16); }
__device__ __forceinline__ float bflo(unsigned w) { return __uint_as_float(w << 16); }
__device__ __forceinline__ float bfhi(unsigned w) { return __uint_as_float(w & 0xffff0000u); }
__device__ __forceinline__ float wave_sum(float v) {
#pragma unroll
    for (int o = 1; o < 64; o <<= 1) v += __shfl_xor(v, o);
    return v;
}
__device__ __forceinline__ float wave_max(float v) {
#pragma unroll
    for (int o = 1; o < 64; o <<= 1) v = fmaxf(v, __shfl_xor(v, o));
    return v;
}
__device__ __forceinline__ float sigmoidf_(float x) { return 1.0f / (1.0f + __expf(-x)); }

#define XB_TMO      128
#define XB_XCNT(j)  (256  + 64 * (j))
#define XB_XSUB(j)  (1280 + 64 * (j))
#define XB_XGEN(j)  (2304 + 64 * (j))
#define XB_TOP      3328
#define XB_TOPGEN   3392
#define XCD_BAR_WORDS 3456
#define XB_SPIN_CAP (1u << 18)

__device__ __forceinline__ unsigned xb_ld(unsigned* p)              { return __hip_atomic_load(p, __ATOMIC_RELAXED, __HIP_MEMORY_SCOPE_AGENT); }
__device__ __forceinline__ unsigned xb_add(unsigned* p, unsigned v) { return __hip_atomic_fetch_add(p, v, __ATOMIC_RELAXED, __HIP_MEMORY_SCOPE_AGENT); }
__device__ __forceinline__ unsigned xb_xcc_id() { return (unsigned)__builtin_amdgcn_s_getreg((3 << 11) | 20) & 0xFu; }
#define XB_SPIN(cond, bar) do { unsigned _sp = 0; while (cond) { __builtin_amdgcn_s_sleep(1); \
    if ((++_sp & 255u) == 0u) { if (xb_ld(&(bar)[XB_TMO])) break; if (_sp > XB_SPIN_CAP) { atomicAdd(&(bar)[XB_TMO], 1u); break; } } } } while (0)

struct XcdBarrier { unsigned* bar; unsigned x; volatile LAS unsigned* st; };

__device__ __forceinline__ XcdBarrier xcd_barrier_post(unsigned* bar, volatile LAS unsigned* st, const int tid) {
    XcdBarrier b; b.bar = bar; b.x = xb_xcc_id(); b.st = st;
    if (tid == 0) (void)xb_add(&bar[XB_XCNT(b.x)], 1u);
    return b;
}
__device__ __forceinline__ void xcd_barrier_complete(unsigned* bar, unsigned x, unsigned& nloc, unsigned& nx) {
    const unsigned G = gridDim.x * gridDim.y * gridDim.z;
    unsigned sum, cnt, mine, sp = 0u;
    for (;;) {
        sum = 0u; cnt = 0u; mine = 0u;
#pragma unroll
        for (unsigned j = 0; j < 16; ++j) { const unsigned c = xb_ld(&bar[XB_XCNT(j)]); sum += c; cnt += (c > 0u) ? 1u : 0u; mine = (j == x) ? c : mine; }
        if (sum == G) break;
        __builtin_amdgcn_s_sleep(1);
        if ((++sp & 255u) == 0u) { if (xb_ld(&bar[XB_TMO])) break; if (sp > XB_SPIN_CAP) { atomicAdd(&bar[XB_TMO], 1u); break; } }
    }
    nloc = mine > 0u ? mine : 1u; nx = cnt > 0u ? cnt : 1u;
}
__device__ __forceinline__ void xcd_barrier(const XcdBarrier& b, const int tid) {
    asm volatile("s_waitcnt vmcnt(0)" ::: "memory");
    __syncthreads();
    if (tid == 0) {
        unsigned* bar = b.bar;
        __builtin_amdgcn_s_waitcnt(0);
        unsigned nloc = b.st[0], nx = b.st[1];
        if (nloc == 0u) { xcd_barrier_complete(bar, b.x, nloc, nx); b.st[0] = nloc; b.st[1] = nx; }
        const unsigned old = xb_add(&bar[XB_XSUB(b.x)], 1u);
        const unsigned gen = old / nloc;
        if (old + 1u == (gen + 1u) * nloc) {
            __builtin_amdgcn_fence(__ATOMIC_RELEASE, "agent");
            asm volatile("s_waitcnt vmcnt(0)" ::: "memory");
            const unsigned og = xb_add(&bar[XB_TOP], 1u);
            const unsigned tg = og / nx;
            if (og + 1u == (tg + 1u) * nx) xb_add(&bar[XB_TOPGEN], 1u);
            else XB_SPIN(xb_ld(&bar[XB_TOPGEN]) == tg, bar);
            __builtin_amdgcn_fence(__ATOMIC_ACQUIRE, "agent");
            xb_add(&bar[XB_XGEN(b.x)], 1u);
            asm volatile("s_waitcnt vmcnt(0)" ::: "memory");
        } else {
            XB_SPIN(xb_ld(&bar[XB_XGEN(b.x)]) == gen, bar);
            __builtin_amdgcn_fence(__ATOMIC_ACQUIRE, "agent");
            asm volatile("s_waitcnt vmcnt(0)" ::: "memory");
        }
    }
    __syncthreads();
}

namespace pg8 {
constexpr int BM = 256, BK = 64, HALF = 128, HTB = HALF * BK * 2, STAGE_BYTES = 8 * HTB, NXCD = 8, WGM = 8;
__host__ __device__ __forceinline__ int lds_byte(int r, int c) { const int st = (r >> 4) * 2 + (c >> 5), rr = r & 15, cc = c & 31, ob = rr * 64 + cc * 2; return st * 1024 + (ob ^ (((ob >> 9) & 1) << 5)); }
__host__ __device__ __forceinline__ void stage_rc(int b, int& R, int& C) { const int st = b / 1024, sb = b % 1024, swz = sb ^ (((sb >> 9) & 1) << 5); R = (st >> 1) * 16 + swz / 64; C = (st & 1) * 32 + (swz % 64) / 2; }
__host__ __device__ __forceinline__ int perm32(int rho) { const int n = rho >> 4, i = rho & 15; return 8 * (i >> 2) + 4 * n + (i & 3); }

struct Unit { const bf16_t* A; const bf16_t* B; int pm, pn, aux; };

__device__ __forceinline__ void tile_order(int L, int nM, int nN, int& pm, int& pn) {
    const int nwg = nM * nN; int wgid = L;
    { const int q = nwg / NXCD, r = nwg % NXCD, xcd = wgid % NXCD, off = wgid / NXCD; wgid = (xcd < r ? xcd * (q + 1) : r * (q + 1) + (xcd - r) * q) + off; }
    const int nig = WGM * nN, gid = wgid / nig, fm = gid * WGM, gsz = (nM - fm) < WGM ? (nM - fm) : WGM;
    pm = fm + ((wgid % nig) % gsz); pn = (wgid % nig) / gsz;
}

typedef int i32x4 __attribute__((ext_vector_type(4)));
typedef int i32x8 __attribute__((ext_vector_type(8)));
__device__ __forceinline__ i32x8 cat8(const bf16x8 a, const bf16x8 b) { const i32x4 x = __builtin_bit_cast(i32x4, a), y = __builtin_bit_cast(i32x4, b); return __builtin_shufflevector(x, y, 0, 1, 2, 3, 4, 5, 6, 7); }
template <class Epi, class Sched, bool F8 = false>
__device__ __forceinline__ void gemm_phase(LAS unsigned char* lds, const int lda, const int ldb, const int K, const Sched& S, const Epi& E, const int tid) {
    const int wid = __builtin_amdgcn_readfirstlane(tid >> 6), lane = tid & 63, wr = wid >> 2, wc = wid & 3, fr = lane & 15, fq = lane >> 4;
    const int nt = K / BK;
    unsigned voffA[2], voffB[2];
#pragma unroll
    for (int i = 0; i < 2; ++i) { int R, C; stage_rc(tid * 16 + i * 8192, R, C); const int Rb = Epi::PERM ? ((R & ~31) + perm32(R & 31)) : R;
        voffA[i] = (unsigned)(R * lda + C) * 2u; voffB[i] = (unsigned)(Rb * ldb + C) * 2u; }
    const size_t kstep = (size_t)(BK * 2);
    const size_t hstepA = (size_t)HALF * lda * 2, hstepB = (size_t)HALF * ldb * 2;
    const unsigned ldsw = (unsigned)wid * 1024u;
    const int aoff = lds_byte(wr * 64 + fr, fq * 8), boff = lds_byte(wc * 32 + fr, fq * 8);
#define PG8_SA(b, h) (((b) * 2 + (h)) * HTB)
#define PG8_SB(b, h) ((4 + (b) * 2 + (h)) * HTB)
#define PG8_STAGE(bufoff, gbase, voff) do { _Pragma("unroll") for (int _i = 0; _i < 2; ++_i) \
        __builtin_amdgcn_global_load_lds((const unsigned*)((const char*)(gbase) + (voff)[_i]), (LAS unsigned*)(lds + (bufoff) + ldsw + _i * 8192), 16, 0, 0); } while (0)
#define PG8_LDA(dst, b, h) do { _Pragma("unroll") for (int m = 0; m < 4; ++m) { \
        if constexpr (F8) { const i32x4 lo_ = *(const LAS i32x4*)(lds + PG8_SA(b, h) + aoff + m * 2048), hi_ = *(const LAS i32x4*)(lds + PG8_SA(b, h) + aoff + m * 2048 + 1024); dst##8[m] = __builtin_shufflevector(lo_, hi_, 0, 1, 2, 3, 4, 5, 6, 7); } \
        else { _Pragma("unroll") for (int k = 0; k < 2; ++k) dst[m][k] = *(const LAS bf16x8*)(lds + PG8_SA(b, h) + aoff + m * 2048 + k * 1024); } } } while (0)
#define PG8_LDB(dst, b, h) do { _Pragma("unroll") for (int n = 0; n < 2; ++n) { \
        if constexpr (F8) { const i32x4 lo_ = *(const LAS i32x4*)(lds + PG8_SB(b, h) + boff + n * 2048), hi_ = *(const LAS i32x4*)(lds + PG8_SB(b, h) + boff + n * 2048 + 1024); dst##8[n] = __builtin_shufflevector(lo_, hi_, 0, 1, 2, 3, 4, 5, 6, 7); } \
        else { _Pragma("unroll") for (int k = 0; k < 2; ++k) dst[n][k] = *(const LAS bf16x8*)(lds + PG8_SB(b, h) + boff + n * 2048 + k * 1024); } } } while (0)
#define PG8_MMA(ai, bj, At, Bt) do { __builtin_amdgcn_s_setprio(1); _Pragma("unroll") for (int m = 0; m < 4; ++m) _Pragma("unroll") for (int n = 0; n < 2; ++n) { \
        if constexpr (F8) asm volatile("v_mfma_f32_16x16x128_f8f6f4 %0, %1, %2, %0" : "+v"(acc[ai][bj][m][n]) : "v"(Bt##8[n]), "v"(At##8[m])); \
        else { _Pragma("unroll") for (int k = 0; k < 2; ++k) acc[ai][bj][m][n] = __builtin_amdgcn_mfma_f32_16x16x32_bf16(Bt[n][k], At[m][k], acc[ai][bj][m][n], 0, 0, 0); } } \
        __builtin_amdgcn_s_setprio(0); } while (0)
#define PG8_WAIT_V(n) asm volatile("s_waitcnt vmcnt(" #n ")" ::: "memory")
#define PG8_WAIT_L(n) asm volatile("s_waitcnt lgkmcnt(" #n ")" ::: "memory")
#define PG8_BAR __builtin_amdgcn_s_barrier()
#define PG8_SCHED __builtin_amdgcn_sched_barrier(0)
    Unit cur, nxt; int ui = 0;
    if (!S.next(0, cur)) return;
    f32x4 acc[2][2][4][2];
#pragma unroll
    for (int a = 0; a < 2; ++a)
#pragma unroll
        for (int b = 0; b < 2; ++b)
#pragma unroll
            for (int m = 0; m < 4; ++m)
#pragma unroll
                for (int n = 0; n < 2; ++n) acc[a][b][m][n] = (f32x4){0.f, 0.f, 0.f, 0.f};
    bf16x8 At[4][2], B0[2][2], B1[2][2]; i32x8 At8[4], B08[2], B18[2];
    const char* cA = (const char*)cur.A; const char* cB = (const char*)cur.B;
    PG8_STAGE(PG8_SB(0, 0), cB, voffB); PG8_STAGE(PG8_SA(0, 0), cA, voffA); PG8_STAGE(PG8_SB(0, 1), cB + hstepB, voffB); PG8_STAGE(PG8_SA(0, 1), cA + hstepA, voffA);
    if (wr == 1) PG8_BAR;
    PG8_WAIT_V(4); PG8_BAR;
    PG8_STAGE(PG8_SB(1, 0), cB + kstep, voffB); PG8_STAGE(PG8_SA(1, 0), cA + kstep, voffA); PG8_STAGE(PG8_SB(1, 1), cB + hstepB + kstep, voffB);
    PG8_WAIT_V(6); PG8_BAR;
    for (;;) {
        const bool has_next = S.next(ui + 1, nxt);
        const char* nA = has_next ? (const char*)nxt.A : cA; const char* nB = has_next ? (const char*)nxt.B : cB;
#pragma nounroll
        for (int t = 0; t < nt; t += 2) {
            const bool last = (t == nt - 2);
            const char* a1 = cA + (size_t)(t + 1) * kstep;
            const char* a2 = last ? nA : cA + (size_t)(t + 2) * kstep; const char* b2 = last ? nB : cB + (size_t)(t + 2) * kstep;
            const char* a3 = a2 + kstep; const char* b3 = b2 + kstep;
            PG8_LDB(B0, 0, 0); PG8_SCHED; PG8_LDA(At, 0, 0); PG8_STAGE(PG8_SA(1, 1), a1 + hstepA, voffA);
            PG8_WAIT_L(8); PG8_BAR; PG8_WAIT_L(0); PG8_MMA(0, 0, At, B0); PG8_BAR; PG8_SCHED;
            PG8_LDB(B1, 0, 1); PG8_STAGE(PG8_SB(0, 0), b2, voffB);
            PG8_BAR; PG8_WAIT_L(0); PG8_MMA(0, 1, At, B1); PG8_BAR;
            PG8_LDA(At, 0, 1); PG8_STAGE(PG8_SA(0, 0), a2, voffA);
            PG8_BAR; PG8_WAIT_L(0); PG8_MMA(1, 0, At, B0); PG8_BAR; PG8_SCHED;
            PG8_STAGE(PG8_SB(0, 1), b2 + hstepB, voffB);
            PG8_WAIT_V(6); PG8_BAR; PG8_MMA(1, 1, At, B1); PG8_BAR;
            PG8_LDB(B0, 1, 0); PG8_SCHED; PG8_LDA(At, 1, 0); PG8_STAGE(PG8_SA(0, 1), a2 + hstepA, voffA);
            PG8_WAIT_L(8); PG8_BAR; PG8_WAIT_L(0); PG8_MMA(0, 0, At, B0); PG8_BAR; PG8_SCHED;
            PG8_LDB(B1, 1, 1); PG8_STAGE(PG8_SB(1, 0), b3, voffB);
            PG8_BAR; PG8_WAIT_L(0); PG8_MMA(0, 1, At, B1); PG8_BAR;
            PG8_LDA(At, 1, 1); PG8_STAGE(PG8_SA(1, 0), a3, voffA);
            PG8_BAR; PG8_WAIT_L(0); PG8_MMA(1, 0, At, B0); PG8_BAR; PG8_SCHED;
            PG8_STAGE(PG8_SB(1, 1), b3 + hstepB, voffB);
            PG8_WAIT_V(6); PG8_BAR; PG8_MMA(1, 1, At, B1); PG8_BAR;
        }
        if constexpr (F8) asm volatile("s_nop 15\n\ts_nop 15" ::: "memory");
        { int l_e = (int)__builtin_amdgcn_mbcnt_hi(~0u, __builtin_amdgcn_mbcnt_lo(~0u, 0u)); asm volatile("" : "+v"(l_e)); int fr_e = l_e & 15, fq_e = l_e >> 4;
          E(acc, cur, wr, wc, fr_e, fq_e); }
        if (!has_next) break;
#pragma unroll
        for (int a = 0; a < 2; ++a)
#pragma unroll
            for (int b = 0; b < 2; ++b)
#pragma unroll
                for (int m = 0; m < 4; ++m)
#pragma unroll
                    for (int n = 0; n < 2; ++n) acc[a][b][m][n] = (f32x4){0.f, 0.f, 0.f, 0.f};
        cur = nxt; cA = nA; cB = nB; ++ui;
    }
    PG8_WAIT_V(0);
    if (wr == 0) PG8_BAR;
    PG8_BAR;
#undef PG8_SA
#undef PG8_SB
#undef PG8_STAGE
#undef PG8_LDA
#undef PG8_LDB
#undef PG8_MMA
#undef PG8_WAIT_V
#undef PG8_WAIT_L
#undef PG8_BAR
#undef PG8_SCHED
}
}
namespace pg8 {
typedef f32x4 Acc[2][2][4][2];
__device__ __forceinline__ void st_bf16x8(bf16_t* p, f32x4 v0, f32x4 v1) {
    u32x4 w; w.x = cvtpk(v0[0], v0[1]); w.y = cvtpk(v0[2], v0[3]); w.z = cvtpk(v1[0], v1[1]); w.w = cvtpk(v1[2], v1[3]);
    *(u32x4*)p = w;
}
#define EPI_BF16_LOOP(...) \
    _Pragma("unroll") for (int ai = 0; ai < 2; ++ai) \
    _Pragma("unroll") for (int m = 0; m < 4; ++m) { int r = ai * 128 + wr * 64 + m * 16 + fr; asm volatile("" : "+v"(r)); \
    _Pragma("unroll") for (int bj = 0; bj < 2; ++bj) { f32x4 v0 = acc[ai][bj][m][0], v1 = acc[ai][bj][m][1]; const int colh = wc * 32 + 8 * fq; (void)colh; __VA_ARGS__ } }
#define EPI_F32_LOOP(...) \
    _Pragma("unroll") for (int ai = 0; ai < 2; ++ai) \
    _Pragma("unroll") for (int m = 0; m < 4; ++m) { int r = ai * 128 + wr * 64 + m * 16 + fr; asm volatile("" : "+v"(r)); \
    _Pragma("unroll") for (int bj = 0; bj < 2; ++bj) \
    _Pragma("unroll") for (int n = 0; n < 2; ++n) { f32x4 v = acc[ai][bj][m][n]; const int col = bj * 128 + wc * 32 + n * 16 + 4 * fq; (void)col; __VA_ARGS__ } }

struct EpiPA {
    static constexpr bool PERM = true;
    bf16_t *MQK, *MLO, *XQ, *VC;
    __device__ __forceinline__ void operator()(const Acc& acc, const Unit& u, int wr, int wc, int fr, int fq) const {
        bf16_t* base; size_t ldc;
        if (u.aux == 0) {
            if (u.pn < 8)       { base = MQK + (size_t)u.pm * 256 * 2048 + u.pn * 256; ldc = 2048; }
            else if (u.pn < 12) { base = MLO + (size_t)u.pm * 256 * 1024 + (u.pn - 8) * 256; ldc = 1024; }
            else                { base = XQ + ((size_t)(u.pn - 12) * TT + (size_t)u.pm * 256) * 256; ldc = 256; }
        } else                  { base = VC + ((size_t)(u.pm * 128 + u.pn) * 256) * 512; ldc = 512; }
        EPI_BF16_LOOP( st_bf16x8(base + (size_t)r * ldc + bj * 128 + colh, v0, v1); )
    }
};
struct EpiMem {
    static constexpr bool PERM = true;
    bf16_t *MK, *MVT;
    __device__ __forceinline__ void operator()(const Acc& acc, const Unit& u, int wr, int wc, int fr, int fq) const {
        bf16_t* base = (u.aux == 0) ? MK + (size_t)(u.pm * 4 + u.pn) * 65536 : MVT + (size_t)(u.pn * 4 + u.pm) * 65536;
        EPI_BF16_LOOP( st_bf16x8(base + (size_t)r * 256 + bj * 128 + colh, v0, v1); )
    }
};
struct EpiPB {
    static constexpr bool PERM = true;
    bf16_t *DQ, *DK, *DV;
    __device__ __forceinline__ void operator()(const Acc& acc, const Unit& u, int wr, int wc, int fr, int fq) const {
        const int which = u.pn >> 3, c0 = (u.pn & 7) * 2;
        bf16_t* buf = DQ + (size_t)which * ((WS_DK - WS_DQ) / 2);
        EPI_BF16_LOOP( st_bf16x8(buf + ((size_t)(c0 + bj) * TT + (size_t)u.pm * 256 + r) * 128 + colh, v0, v1); )
    }
};
struct EpiF32Tile {
    static constexpr bool PERM = false;
    float* C; size_t off_pm, off_pn, off_aux; int ldc;
    __device__ __forceinline__ void operator()(const Acc& acc, const Unit& u, int wr, int wc, int fr, int fq) const {
        float* base = C + (size_t)u.pm * off_pm + (size_t)u.pn * off_pn + (size_t)u.aux * off_aux;
        EPI_F32_LOOP( *(f32x4*)(base + (size_t)r * ldc + col) = v; )
    }
};
struct EpiB16Tile {
    static constexpr bool PERM = true;
    bf16_t* C; size_t off_pm, off_pn, off_aux; int ldc; float sc;
    __device__ __forceinline__ void operator()(const Acc& acc, const Unit& u, int wr, int wc, int fr, int fq) const {
        bf16_t* base = C + (size_t)u.pm * off_pm + (size_t)u.pn * off_pn + (size_t)u.aux * off_aux;
        EPI_BF16_LOOP( v0 *= sc; v1 *= sc; st_bf16x8(base + (size_t)r * ldc + bj * 128 + colh, v0, v1); )
    }
};
struct EpiW {
    static constexpr bool PERM = true;
    bf16_t* WQ; const float* RS;
    __device__ __forceinline__ void operator()(const Acc& acc, const Unit& u, int wr, int wc, int fr, int fq) const {
        const size_t trow = (size_t)u.aux * TT + (size_t)u.pm * 256;
        const int colh = wc * 32 + 8 * fq;
#pragma unroll
        for (int ai = 0; ai < 2; ++ai)
#pragma unroll
            for (int m = 0; m < 4; ++m) { int r = ai * 128 + wr * 64 + m * 16 + fr; asm volatile("" : "+v"(r)); const float rs = RS[trow + r];
#pragma unroll
                for (int bj = 0; bj < 2; ++bj) { f32x4 v0 = acc[ai][bj][m][0], v1 = acc[ai][bj][m][1]; const int c = bj * 128 + colh; const float fl = (float)(r - c + 1);
#pragma unroll
                    for (int j = 0; j < 4; ++j) { v0[j] = v0[j] * (rs * __saturatef(fl - (float)j)); v1[j] = v1[j] * (rs * __saturatef(fl - (float)(4 + j))); }
                    st_bf16x8(WQ + (trow + r) * 512 + c, v0, v1);
                    } }
    }
};
struct EpiH {
    static constexpr bool PERM = true;
    bf16_t* HR; const float* HDEN;
    __device__ __forceinline__ void operator()(const Acc& acc, const Unit& u, int wr, int wc, int fr, int fq) const {
        const size_t t0 = (size_t)u.pm * 256;
        EPI_BF16_LOOP( const float inv = 1.0f / HDEN[(size_t)u.aux * TT + t0 + r];
            v0 *= inv; v1 *= inv; st_bf16x8(HR + (t0 + r) * 1024 + u.aux * 256 + bj * 128 + colh, v0, v1); )
    }
};
struct EpiXA {
    static constexpr bool PERM = true;
    bf16_t* XA;
    __device__ __forceinline__ void operator()(const Acc& acc, const Unit& u, int wr, int wc, int fr, int fq) const {
        const size_t t0 = (size_t)u.pm * 256;
        EPI_BF16_LOOP( st_bf16x8(XA + (t0 + r) * 1024 + u.aux * 256 + bj * 128 + colh, v0, v1); )
    }
};
struct EpiGate {
    static constexpr bool PERM = true;
    bf16_t* GT; const float* bg; float dsc;
    __device__ __forceinline__ void operator()(const Acc& acc, const Unit& u, int wr, int wc, int fr, int fq) const {
        const size_t t0 = (size_t)u.pm * 256;
        EPI_BF16_LOOP( const int c = u.pn * 256 + bj * 128 + colh; const f32x4 b0 = *(const f32x4*)(bg + c), b1 = *(const f32x4*)(bg + c + 4);
            _Pragma("unroll") for (int j = 0; j < 4; ++j) { v0[j] = sigmoidf_(v0[j] * dsc + b0[j]); v1[j] = sigmoidf_(v1[j] * dsc + b1[j]); }
            st_bf16x8(GT + (t0 + r) * 2048 + c, v0, v1); )
    }
};
template <bool FIRST> struct EpiBranch {
    static constexpr bool PERM = true;
    const bf16_t* GT; bf16_t* MG;
    __device__ __forceinline__ void operator()(const Acc& acc, const Unit& u, int wr, int wc, int fr, int fq) const {
        const size_t t0 = (size_t)u.pm * 256;
        EPI_BF16_LOOP( const size_t o = (t0 + r) * 2048 + u.pn * 256 + bj * 128 + colh; const u32x4 g = *(const u32x4*)(GT + o);
            v0[0] *= bflo(g.x); v0[1] *= bfhi(g.x); v0[2] *= bflo(g.y); v0[3] *= bfhi(g.y); v1[0] *= bflo(g.z); v1[1] *= bfhi(g.z); v1[2] *= bflo(g.w); v1[3] *= bfhi(g.w);
            if (!FIRST) { const u32x4 p = *(const u32x4*)(MG + o);
                v0[0] += bflo(p.x); v0[1] += bfhi(p.x); v0[2] += bflo(p.y); v0[3] += bfhi(p.y); v1[0] += bflo(p.z); v1[1] += bfhi(p.z); v1[2] += bflo(p.w); v1[3] += bfhi(p.w); }
            st_bf16x8(MG + o, v0, v1); )
    }
};
struct EpiOut {
    static constexpr bool PERM = true;
    const float* X; bf16_t* X1B; float* RSS;
    __device__ __forceinline__ void operator()(const Acc& acc, const Unit& u, int wr, int wc, int fr, int fq) const {
        const size_t t0 = (size_t)u.pm * 256; const int colh = wc * 32 + 8 * fq;
#pragma unroll
        for (int ai = 0; ai < 2; ++ai)
#pragma unroll
            for (int m = 0; m < 4; ++m) { int r = ai * 128 + wr * 64 + m * 16 + fr; asm volatile("" : "+v"(r)); float ss = 0.f;
#pragma unroll
                for (int bj = 0; bj < 2; ++bj) { const size_t o = (t0 + r) * 2048 + u.pn * 256 + bj * 128 + colh;
                    const f32x4 v0 = acc[ai][bj][m][0] + *(const f32x4*)(X + o), v1 = acc[ai][bj][m][1] + *(const f32x4*)(X + o + 4);
                    u32x4 w; w.x = cvtpk(v0[0], v0[1]); w.y = cvtpk(v0[2], v0[3]); w.z = cvtpk(v1[0], v1[1]); w.w = cvtpk(v1[2], v1[3]);
                    *(u32x4*)(X1B + o) = w;
                    ss += ((bflo(w.x) * bflo(w.x) + bfhi(w.x) * bfhi(w.x)) + (bflo(w.y) * bflo(w.y) + bfhi(w.y) * bfhi(w.y))) + ((bflo(w.z) * bflo(w.z) + bfhi(w.z) * bfhi(w.z)) + (bflo(w.w) * bflo(w.w) + bfhi(w.w) * bfhi(w.w))); }
                ss += __shfl_xor(ss, 16); ss += __shfl_xor(ss, 32);
                if (fq == 0) RSS[(t0 + r) * 32 + u.pn * 4 + wc] = ss; }
    }
};
struct EpiGU {
    static constexpr bool PERM = true;
    unsigned char* HD;
    __device__ __forceinline__ void operator()(const Acc& acc, const Unit& u, int wr, int wc, int fr, int fq) const {
        const size_t t0 = (size_t)u.pm * 256; const int colh = wc * 32 + 8 * fq;
#pragma unroll
        for (int ai = 0; ai < 2; ++ai)
#pragma unroll
            for (int m = 0; m < 4; ++m) { int r = ai * 128 + wr * 64 + m * 16 + fr; asm volatile("" : "+v"(r));
                f32x4 g0 = acc[ai][0][m][0], g1 = acc[ai][0][m][1]; const f32x4 u0 = acc[ai][1][m][0], u1 = acc[ai][1][m][1];
#pragma unroll
                for (int j = 0; j < 4; ++j) { const float a0 = g0[j] * (1.0f / 32.0f), a1 = g1[j] * (1.0f / 32.0f); g0[j] = a0 * sigmoidf_(a0) * (u0[j] * 0.25f); g1[j] = a1 * sigmoidf_(a1) * (u1[j] * 0.25f); }
                u32x2 w; w.x = pk4_fp8(g0[0], g0[1], g0[2], g0[3]); w.y = pk4_fp8(g1[0], g1[1], g1[2], g1[3]);
                *(u32x2*)(HD + (t0 + r) * DEXP_P + u.pn * 128 + colh) = w; }
    }
};
struct EpiDown {
    static constexpr bool PERM = true;
    bf16_t* YS; const float* WROW;
    __device__ __forceinline__ void operator()(const Acc& acc, const Unit& u, int wr, int wc, int fr, int fq) const {
        const size_t t0 = (size_t)u.pm * 256;
        EPI_BF16_LOOP( const float w = WROW[t0 + r] * (1.0f / 128.0f); v0 *= w; v1 *= w;      st_bf16x8(YS + (t0 + r) * 2048 + u.pn * 256 + bj * 128 + colh, v0, v1); )
    }
};

struct SchedDense {
    const bf16_t* A0; const bf16_t* B0; int lda, ldb, nM, nN, G, c;
    __device__ __forceinline__ bool next(int i, Unit& u) const {
        const int L = i * G + c; if (L >= nM * nN) return false;
        tile_order(L, nM, nN, u.pm, u.pn); u.aux = 0;
        u.A = A0 + (size_t)u.pm * 256 * lda; u.B = B0 + (size_t)u.pn * 256 * ldb; return true;
    }
};
struct SchedPA {
    const bf16_t* HBF; const bf16_t* WINT; int G, c;
    __device__ __forceinline__ bool next(int i, Unit& u) const {
        const int L = i * G + c;
        if (L < 2048) { tile_order(L, 128, 16, u.pm, u.pn); u.aux = 0; u.A = HBF + (size_t)u.pm * 256 * 2048; u.B = WINT + (size_t)(6144 + u.pn * 256) * 2048; return true; }
        if (L < 2560) { const int q = L - 2048; u.pm = q & 3; u.pn = q >> 2; u.aux = 1; u.A = WINT + (size_t)(10240 + u.pm * 256) * 2048; u.B = HBF + (size_t)u.pn * 256 * 2048; return true; }
        return false;
    }
};
struct SchedMem {
    const bf16_t* MEMN; const bf16_t* WMEMT; int G, c;
    __device__ __forceinline__ bool next(int i, Unit& u) const {
        const int L = i * G + c; if (L >= 16) return false;
        if (L < 8) { u.aux = 0; u.pm = L >> 2; u.pn = L & 3; u.A = MEMN + (size_t)u.pm * 256 * 2048; u.B = WMEMT + (size_t)u.pn * 256 * 2048; }
        else { const int q = L - 8; u.aux = 1; u.pm = q & 3; u.pn = q >> 2; u.A = WMEMT + (size_t)(1024 + u.pm * 256) * 2048; u.B = MEMN + (size_t)u.pn * 256 * 2048; }
        return true;
    }
};
struct SchedHG {
    const bf16_t* A0; const bf16_t* B0; size_t sa_h, sa_g, sb_h, sb_g; int G, c;
    __device__ __forceinline__ bool next(int i, Unit& u) const {
        const int L = i * G + c; if (L >= 512) return false;
        const int hh = L >> 7, g = L & 127; u.aux = hh; u.pm = g; u.pn = 0;
        u.A = A0 + (size_t)hh * sa_h + (size_t)g * sa_g; u.B = B0 + (size_t)hh * sb_h + (size_t)g * sb_g; return true;
    }
};
struct SchedXA {
    const bf16_t* A0; const bf16_t* B0; int G, c;
    __device__ __forceinline__ bool next(int i, Unit& u) const {
        const int L = i * G + c; if (L >= 512) return false;
        const int hh = L >> 7, pm = L & 127; u.aux = hh; u.pm = pm; u.pn = 0;
        u.A = A0 + ((size_t)hh * TT + (size_t)pm * 256) * 256; u.B = B0 + (size_t)((pm >> 6) * 4 + hh) * 65536; return true;
    }
};
struct SchedMoE {
    const bf16_t* A0; const bf16_t* B0; const int* tile_e; int nrt, NT, lda; size_t eb_stride, nb_stride; int G, c;
    __device__ __forceinline__ bool next(int i, Unit& u) const {
        const int L = i * G + c; if (L >= nrt * NT) return false;
        const int rt = L / NT, pn = L - rt * NT; const int e = __builtin_amdgcn_readfirstlane(tile_e[rt]);
        u.pm = rt; u.pn = pn; u.aux = e; u.A = A0 + (size_t)rt * 256 * lda; u.B = B0 + (size_t)e * eb_stride + (size_t)pn * nb_stride; return true;
    }
};
}
namespace attn {
constexpr int D = 128;
constexpr float THR = 8.f;
constexpr float SCALE = 0.08838834764831845f;
constexpr int NW = 8, QBLK = 32, KVBLK = 64, QB = NW * QBLK;
constexpr int SHM_V = KVBLK * D * 2, SHM_K = KVBLK * D * 2;
constexpr int LDS_BYTES = 2 * SHM_V + 2 * SHM_K + NW * 64 * 4;
typedef bf16_t bf16;

#define KSWZ(row, colB) ((row) * 256 + ((colB) ^ (((row) & 7) << 4)))
#define SBAR() __builtin_amdgcn_sched_barrier(0)
__device__ __forceinline__ int v_st(int k, int c) { const int kk = (k & ~0xC) | ((k & 4) << 1) | ((k & 8) >> 1); return ((kk >> 3) * 4 + (c >> 5)) * 512 + ((kk & 7) * 32 + (c & 31)) * 2; }
__device__ __forceinline__ int v_rd_base(int lane) { return ((lane & 3) << 3) | (((lane >> 2) & 3) << 6) | (((lane >> 4) & 1) << 5) | (((lane >> 5) & 1) << 8); }
constexpr int v_rd_off(int d0, int ks, int half) { return d0 * 512 + ks * 4096 + half * 2048; }
__device__ __forceinline__ int crow(int r, int hi) { return (r & 3) + 8 * (r >> 2) + 4 * hi; }
__device__ __forceinline__ bf16x8 load8(const bf16* p) { return *reinterpret_cast<const bf16x8*>(p); }

__device__ __forceinline__ void mask_tile(f32x16& p0, f32x16& p1, int dq, unsigned W) {
    const float NEG = -__builtin_inff();
#pragma unroll
    for (int r = 0; r < 16; ++r) {
        const int c = (r & 3) + 8 * (r >> 2);
        if ((unsigned)(dq - c) >= W) p0[r] = NEG;
        if ((unsigned)(dq - c - 32) >= W) p1[r] = NEG;
    }
}
__device__ __forceinline__ void partialSM(f32x16& p0, f32x16& p1, float& m_reg, float& mn, float& alpha) {
    float pmax = p0[0]; for (int r = 1; r < 16; ++r) pmax = fmaxf(pmax, p0[r]); for (int r = 0; r < 16; ++r) pmax = fmaxf(pmax, p1[r]);
    { auto rr = __builtin_amdgcn_permlane32_swap(__float_as_uint(pmax), __float_as_uint(pmax), false, false);
      pmax = fmaxf(__uint_as_float(rr[0]), __uint_as_float(rr[1])); }
    constexpr float C2 = 1.4426950408889634f * SCALE;
    if (__builtin_expect(__all((pmax - m_reg) * SCALE <= THR), 1)) { mn = m_reg; alpha = 1.f; }
    else { mn = fmaxf(m_reg, pmax); alpha = __builtin_amdgcn_exp2f((m_reg - mn) * C2); m_reg = mn; }
    const float mnL = -mn * C2;
    for (int r = 0; r < 16; ++r) p0[r] = fmaf(p0[r], C2, mnL); for (int r = 0; r < 16; ++r) p1[r] = fmaf(p1[r], C2, mnL);
    for (int r = 0; r < 16; ++r) p0[r] = __builtin_amdgcn_exp2f(p0[r]);
}
__device__ __forceinline__ void finishSM(f32x16& p0, f32x16& p1, float alpha, float& l_reg, bf16x8& pa0, bf16x8& pa1, bf16x8& pa2, bf16x8& pa3) {
    for (int r = 0; r < 16; ++r) p1[r] = __builtin_amdgcn_exp2f(p1[r]);
    float ps = 0; for (int r = 0; r < 16; ++r) ps += p0[r]; for (int r = 0; r < 16; ++r) ps += p1[r];
    { auto rr = __builtin_amdgcn_permlane32_swap(__float_as_uint(ps), __float_as_uint(ps), false, false);
      ps = __uint_as_float(rr[0]) + __uint_as_float(rr[1]); }
    l_reg = l_reg * alpha + ps;
#define PK4(P, B_, OUT) do { unsigned a0 = cvtpk(P[B_+0], P[B_+1]), a1 = cvtpk(P[B_+2], P[B_+3]);                          \
        unsigned b0 = cvtpk(P[B_+4], P[B_+5]), b1 = cvtpk(P[B_+6], P[B_+7]);                                             \
        auto r0 = __builtin_amdgcn_permlane32_swap(a0, b0, false, false); auto r1 = __builtin_amdgcn_permlane32_swap(a1, b1, false, false); \
        u32x4 w = {r0[0], r1[0], r0[1], r1[1]}; OUT = *reinterpret_cast<bf16x8*>(&w); } while (0)
    PK4(p0, 0, pa0); PK4(p0, 8, pa1); PK4(p1, 0, pa2); PK4(p1, 8, pa3);
#undef PK4
}
template <int KB>
__device__ __forceinline__ void qkt(f32x16& p0, f32x16& p1, const char* K_lds, int r32, int hi, const bf16x8* qr, float sl, int dq) {
    const float sl8 = 8.f * sl, sl32 = 32.f * sl;
    p0[0] = -sl * (float)dq; p0[1] = p0[0] + sl; p0[2] = p0[1] + sl; p0[3] = p0[2] + sl;
#pragma unroll
    for (int r = 4; r < 16; ++r) p0[r] = p0[r - 4] + sl8;
#pragma unroll
    for (int r = 0; r < 16; ++r) p1[r] = p0[r] + sl32;
    const char* kb[4];
#pragma unroll
    for (int dd = 0; dd < 4; ++dd) kb[dd] = K_lds + KB * SHM_K + KSWZ(r32, (dd * 16 + hi * 8) * 2);
#pragma unroll
    for (int d0 = 0; d0 < 8; ++d0) { const char* a = kb[d0 & 3] + (d0 >> 2) * 128;
        bf16x8 b0_ = *reinterpret_cast<const bf16x8*>(a);
        bf16x8 b1_ = *reinterpret_cast<const bf16x8*>(a + 32 * 256);
        p0 = __builtin_amdgcn_mfma_f32_32x32x16_bf16(b0_, qr[d0], p0, 0, 0, 0);
        p1 = __builtin_amdgcn_mfma_f32_32x32x16_bf16(b1_, qr[d0], p1, 0, 0, 0); }
}
template <int VB>
__device__ __forceinline__ void pv_tile(f32x16* o, int vb0, bf16x8 pa0, bf16x8 pa1, bf16x8 pa2, bf16x8 pa3) {
#define TRRD(dst, off) asm volatile("ds_read_b64_tr_b16 %0, %1 offset:%2" : "=&v"(dst) : "v"(vb0), "i"(off) : "memory")
#define PV_D0(d0) do { s16x4 l0, l1, l2, l3, h0, h1, h2, h3; constexpr int b_ = VB * SHM_V + v_rd_off(d0, 0, 0); \
        TRRD(l0, b_); TRRD(h0, b_ + 2048); TRRD(l1, b_ + 4096); TRRD(h1, b_ + 6144); TRRD(l2, b_ + 8192); TRRD(h2, b_ + 10240); TRRD(l3, b_ + 12288); TRRD(h3, b_ + 14336); \
        asm volatile("s_waitcnt lgkmcnt(0)" ::: "memory"); SBAR();   \
        o[d0] = __builtin_amdgcn_mfma_f32_32x32x16_bf16(pa0, (bf16x8){l0[0], l0[1], l0[2], l0[3], h0[0], h0[1], h0[2], h0[3]}, o[d0], 0, 0, 0);   \
        o[d0] = __builtin_amdgcn_mfma_f32_32x32x16_bf16(pa1, (bf16x8){l1[0], l1[1], l1[2], l1[3], h1[0], h1[1], h1[2], h1[3]}, o[d0], 0, 0, 0);   \
        o[d0] = __builtin_amdgcn_mfma_f32_32x32x16_bf16(pa2, (bf16x8){l2[0], l2[1], l2[2], l2[3], h2[0], h2[1], h2[2], h2[3]}, o[d0], 0, 0, 0);   \
        o[d0] = __builtin_amdgcn_mfma_f32_32x32x16_bf16(pa3, (bf16x8){l3[0], l3[1], l3[2], l3[3], h3[0], h3[1], h3[2], h3[3]}, o[d0], 0, 0, 0); } while (0)
    PV_D0(0); PV_D0(1); PV_D0(2); PV_D0(3);
#undef PV_D0
#undef TRRD
}

struct BlockRef { const bf16* Q; const bf16* K; const bf16* V; bf16* O; int P0; };
struct Seam { bf16x8 qr[8]; bf16x8 st_v0, st_v1, st_k0, st_k1; };
__device__ __forceinline__ int swa_jlo(int P0, int W) { const int lowk = P0 - W + 1; return lowk > 0 ? lowk / KVBLK : 0; }
#define ROW(p, k0, rr) ((p) + (size_t)((k0) + (rr)) * D + sc)
#define VMW() asm volatile("s_waitcnt vmcnt(0)" ::: "memory")
#define VMWN(n) asm volatile("s_waitcnt vmcnt(%0)" :: "i"(n) : "memory")
#define SLOAD_H(Kp, Vp, k0) do { S.st_v0 = load8(ROW(Vp, k0, sr)); S.st_v1 = load8(ROW(Vp, k0, 32 + sr));              \
                         S.st_k0 = load8(ROW(Kp, k0, sr)); S.st_k1 = load8(ROW(Kp, k0, 32 + sr)); } while (0)
#define SWRITE_HK(bf) do { *(bf16x8*)(K_lds + (bf) * SHM_K + kws) = S.st_k0; *(bf16x8*)(K_lds + (bf) * SHM_K + kws + 32 * 256) = S.st_k1; } while (0)
#define SWRITE_HV(bf) do { *(bf16x8*)(V_lds + (bf) * SHM_V + vst0) = S.st_v0; *(bf16x8*)(V_lds + (bf) * SHM_V + vst1) = S.st_v1; } while (0)
#define SWRITE_H(bf) do { SWRITE_HV(bf); SWRITE_HK(bf); } while (0)

__device__ __forceinline__ void causal_swa_prime(const BlockRef& cur, int W, char* lds, Seam& S, const int tid) {
    const int wid = __builtin_amdgcn_readfirstlane(tid >> 6), lane = tid & 63, r32 = lane & 31, hi = lane >> 5;
    const int sr = tid >> 4, sc = (tid & 15) * 8, kws = KSWZ(sr, sc * 2); char* K_lds = lds + 2 * SHM_V;
    const int kb0 = swa_jlo(cur.P0, W) * KVBLK;
    for (int d0 = 0; d0 < 8; ++d0) S.qr[d0] = load8(cur.Q + (size_t)(wid * QBLK + r32) * D + d0 * 16 + hi * 8);
    SLOAD_H(cur.K, cur.V, kb0); VMW(); SWRITE_HK(0);
    __syncthreads();
}
__device__ __forceinline__ void causal_swa_block(const BlockRef& cur, const BlockRef& nxt, int skv, int W, int Wn, float sl, char* lds, Seam& S, const int tid) {
    const int wid = __builtin_amdgcn_readfirstlane(tid >> 6), lane = tid & 63, r32 = lane & 31, hi = lane >> 5;
    const int j_lo = swa_jlo(cur.P0, W);
    int j_hi = (cur.P0 + QB - 1) / KVBLK + 1; if (j_hi > skv / KVBLK) j_hi = skv / KVBLK;
    const int NT = j_hi - j_lo;
    const int kbn = swa_jlo(nxt.P0, Wn) * KVBLK;
    const int qlo = cur.P0 + wid * QBLK, qm = qlo + r32 - 4 * hi;
    char* V_lds = lds; char* K_lds = lds + 2 * SHM_V;
    float* ws = (float*)(lds + 2 * SHM_V + 2 * SHM_K) + wid * 64; float* li_l = ws, * al_l = ws + 32;
    float m_reg = -1e30f, l_reg = 0; f32x16 o[4] = {};
    const int sr = tid >> 4, sc = (tid & 15) * 8, vst0 = v_st(sr, sc), vst1 = v_st(32 + sr, sc), kws = KSWZ(sr, sc * 2);
    const int vb0 = (int)(uintptr_t)V_lds + v_rd_base(lane);
    const bf16* Kh = cur.K; const bf16* Vh = cur.V;
#define RESC(a) do { if (__any((a) < 1.f)) { if (hi == 0) al_l[r32] = (a); asm volatile("s_waitcnt lgkmcnt(0)" ::: "memory");              \
                     for (int d_ = 0; d_ < 4; ++d_) for (int r = 0; r < 16; ++r) o[d_][r] *= al_l[crow(r, hi)]; } } while (0)
#define KBASE(t) ((j_lo + (t)) * KVBLK)
#define MASKT(P0_, P1_, t) do { const int kb_ = KBASE(t); if (kb_ + KVBLK - 1 > qlo || kb_ <= qlo + QBLK - 1 - W) mask_tile(P0_, P1_, qm - kb_, (unsigned)W); } while (0)
    constexpr int NQL = 8;
#define SEAM_K0() do { VMWN(NQL); SWRITE_HK(0); SBAR(); } while (0)
    f32x16 pA0, pA1, pB0, pB1; float mnA, mnB, alA, alB; bf16x8 pa0, pa1, pa2, pa3;
    SWRITE_HV(0); SBAR();
    if (NT > 1) { SLOAD_H(Kh, Vh, KBASE(1)); }
    SBAR(); qkt<0>(pA0, pA1, K_lds, r32, hi, S.qr, sl, qm - KBASE(0));
    MASKT(pA0, pA1, 0); partialSM(pA0, pA1, m_reg, mnA, alA);
    if (NT > 1) { VMW(); SWRITE_H(1); }
    __syncthreads();
#define HALF_STEP(PX0, PX1, mnX, alX, PY0, PY1, alY, t, KB, VB, SB) do {                                                      \
        SBAR(); qkt<KB>(PX0, PX1, K_lds, r32, hi, S.qr, sl, qm - KBASE(t));                                                   \
        finishSM(PY0, PY1, alY, l_reg, pa0, pa1, pa2, pa3); SBAR();                                                           \
        if ((t) + 1 < NT) { SLOAD_H(Kh, Vh, KBASE((t) + 1)); SBAR(); }                                                        \
        pv_tile<VB>(o, vb0, pa0, pa1, pa2, pa3); MASKT(PX0, PX1, (t)); partialSM(PX0, PX1, m_reg, mnX, alX);                  \
        __syncthreads();                                                                                                      \
        if ((t) + 1 < NT) { VMW(); SWRITE_H(SB); }                                                                            \
        RESC(alX); __syncthreads(); } while (0)
    for (int t = 1; t + 1 < NT; t += 2) {
        HALF_STEP(pB0, pB1, mnB, alB, pA0, pA1, alA, t, 1, 0, 0);
        HALF_STEP(pA0, pA1, mnA, alA, pB0, pB1, alB, t + 1, 0, 1, 1);
    }
    const bool even = (NT & 1) == 0;
    if (even) { SBAR(); qkt<1>(pB0, pB1, K_lds, r32, hi, S.qr, sl, qm - KBASE(NT - 1)); SBAR(); }
    SLOAD_H(nxt.K, nxt.V, kbn); SBAR();
#pragma unroll
    for (int d0 = 0; d0 < 8; ++d0) S.qr[d0] = load8(nxt.Q + (size_t)(wid * QBLK + r32) * D + d0 * 16 + hi * 8);
    SBAR();
    finishSM(pA0, pA1, alA, l_reg, pa0, pa1, pa2, pa3); SBAR();
    pv_tile<0>(o, vb0, pa0, pa1, pa2, pa3);
    if (even) { MASKT(pB0, pB1, NT - 1); partialSM(pB0, pB1, m_reg, mnB, alB); __syncthreads(); RESC(alB);
        finishSM(pB0, pB1, alB, l_reg, pa0, pa1, pa2, pa3); SBAR(); pv_tile<1>(o, vb0, pa0, pa1, pa2, pa3); }
    SBAR(); SEAM_K0();
    if (hi == 0) li_l[r32] = l_reg; asm volatile("s_waitcnt lgkmcnt(0)" ::: "memory");
    float rli[16];
#pragma unroll
    for (int r = 0; r < 16; ++r) rli[r] = __builtin_amdgcn_rcpf(li_l[crow(r, hi)]);
    bf16* Ow = cur.O + (size_t)(wid * QBLK) * D;
    int zo = 0; asm volatile("" : "+v"(zo));
    const unsigned ob = (unsigned)(4 * hi * D + r32 + zo);
#pragma unroll
    for (int r = 0; r < 16; ++r) { const unsigned off = ob + (unsigned)(((r & 3) + 8 * (r >> 2)) * D);
#pragma unroll
        for (int d0 = 0; d0 < 4; ++d0) { const float v = o[d0][r] * rli[r];
            const float vn = __shfl_xor(v, 1);
            if ((r32 & 1) == 0) *(unsigned*)(Ow + off + d0 * 32) = cvtpk(v, vn); } }
    __syncthreads();
#undef RESC
#undef KBASE
#undef MASKT
#undef SEAM_K0
#undef HALF_STEP
}
#undef ROW
#undef VMW
#undef VMWN
#undef SLOAD_H
#undef SWRITE_HK
#undef SWRITE_HV
#undef SWRITE_H
}
namespace attn4 {
using attn::bf16; using attn::KVBLK; using attn::QBLK; using attn::SHM_K;
constexpr int QB = 128, D = 128;
constexpr int V_OFF = 0, K_OFF = 65536, PX_OFF = 98304;
constexpr int AL_OFF = RING_BYTES + 1024;
struct Item { const bf16* Q; const bf16* K; const bf16* V0; const bf16* V1; bf16* O; int P0, W; float sl; };

template <int OFF>
__device__ __forceinline__ void pv_half(f32x16* o, int vb0, bf16x8 pa0, bf16x8 pa1, bf16x8 pa2, bf16x8 pa3) {
#define TRRD(dst, off) asm volatile("ds_read_b64_tr_b16 %0, %1 offset:%2" : "=&v"(dst) : "v"(vb0), "i"(off) : "memory")
#define PV_D0(d0) do { s16x4 l0, l1, l2, l3, h0, h1, h2, h3; constexpr int b_ = OFF + attn::v_rd_off(d0, 0, 0); \
        TRRD(l0, b_); TRRD(h0, b_ + 2048); TRRD(l1, b_ + 4096); TRRD(h1, b_ + 6144); TRRD(l2, b_ + 8192); TRRD(h2, b_ + 10240); TRRD(l3, b_ + 12288); TRRD(h3, b_ + 14336); \
        asm volatile("s_waitcnt lgkmcnt(0)" ::: "memory"); SBAR();   \
        o[d0] = __builtin_amdgcn_mfma_f32_32x32x16_bf16(pa0, (bf16x8){l0[0], l0[1], l0[2], l0[3], h0[0], h0[1], h0[2], h0[3]}, o[d0], 0, 0, 0);   \
        o[d0] = __builtin_amdgcn_mfma_f32_32x32x16_bf16(pa1, (bf16x8){l1[0], l1[1], l1[2], l1[3], h1[0], h1[1], h1[2], h1[3]}, o[d0], 0, 0, 0);   \
        o[d0] = __builtin_amdgcn_mfma_f32_32x32x16_bf16(pa2, (bf16x8){l2[0], l2[1], l2[2], l2[3], h2[0], h2[1], h2[2], h2[3]}, o[d0], 0, 0, 0);   \
        o[d0] = __builtin_amdgcn_mfma_f32_32x32x16_bf16(pa3, (bf16x8){l3[0], l3[1], l3[2], l3[3], h3[0], h3[1], h3[2], h3[3]}, o[d0], 0, 0, 0); } while (0)
    PV_D0(0); PV_D0(1); PV_D0(2); PV_D0(3);
#undef PV_D0
#undef TRRD
}

__device__ __forceinline__ void item(const Item& it, char* lds, LAS unsigned char* ldsL, const int tid) {
    const int wid = __builtin_amdgcn_readfirstlane(tid >> 6), lane = tid & 63, r32 = lane & 31, hi = lane >> 5, role = wid >> 2, g = wid & 3;
    const int j_lo = attn::swa_jlo(it.P0, it.W);
    const int j_hi = (it.P0 + QB - 1) / KVBLK + 1;
    const int NT = j_hi - j_lo;
    const int W = it.W; const float sl = it.sl;
    const int qlo = it.P0 + g * QBLK, qm = qlo + r32 - 4 * hi;
    const int sr = tid >> 4, sc = (tid & 15) * 8, vst0 = attn::v_st(sr, sc), vst1 = attn::v_st(32 + sr, sc), kws = KSWZ(sr, sc * 2);
    float* AL = (float*)(lds + AL_OFF); int* FLG = (int*)(lds + AL_OFF + 1024); float* LL = (float*)(lds + AL_OFF + 1088);
    unsigned soff[6]; int pkind[6], pldso[6];
#pragma unroll
    for (int i = 0; i < 6; ++i) { const int q = wid * 6 + i;
        if (q < 16) { const int row = 4 * q + (lane >> 4), c = (lane & 15) ^ (row & 7); soff[i] = (unsigned)(row * D + c * 8); pkind[i] = 0; pldso[i] = q * 1024; }
        else { const int j = (q - 16) & 15, eh = (q - 16) >> 4, sidx = 2 * j + (lane >> 5), kk = (sidx >> 2) * 8 + ((lane & 31) >> 2), k = (kk & ~0xC) | ((kk & 4) << 1) | ((kk & 8) >> 1), col = (sidx & 3) * 32 + (lane & 3) * 8;
            soff[i] = (unsigned)(k * D + col); pkind[i] = 1 + eh; pldso[i] = eh * 16384 + j * 1024; } }
#define KBASE(t) ((j_lo + (t)) * KVBLK)
#define A4_DMA(src, ldsbyte) __builtin_amdgcn_global_load_lds((const unsigned*)(src), (LAS unsigned*)((LAS unsigned char*)ldsL + (ldsbyte)), 16, 0, 0)
#define A4_STAGE(t, PAR) do { _Pragma("unroll") for (int i = 0; i < 6; ++i) { \
            if (pkind[i] == 0) { if ((t) + 1 < NT) A4_DMA(it.K + (size_t)KBASE((t) + 1) * D + soff[i], K_OFF + ((PAR) ^ 1) * SHM_K + pldso[i]); } \
            else if ((t) < NT) A4_DMA((pkind[i] == 1 ? it.V0 : it.V1) + (size_t)KBASE(t) * D + soff[i], V_OFF + (PAR) * 32768 + pldso[i]); } } while (0)
#define A4_SYNC() do { asm volatile("s_waitcnt vmcnt(0) lgkmcnt(0)" ::: "memory"); __builtin_amdgcn_s_barrier(); asm volatile("" ::: "memory"); } while (0)
#define A4_PROLOGUE() do { _Pragma("unroll") for (int i = 0; i < 6; ++i) if (pkind[i] == 0) A4_DMA(it.K + (size_t)KBASE(0) * D + soff[i], K_OFF + pldso[i]); A4_SYNC(); } while (0)
    char* K_lds = lds + K_OFF;
    if (role == 0) {
        bf16x8 qr[8];
#pragma unroll
        for (int d0 = 0; d0 < 8; ++d0) qr[d0] = attn::load8(it.Q + (size_t)(g * QBLK + r32) * D + d0 * 16 + hi * 8);
        asm volatile("s_waitcnt vmcnt(0)" ::: "memory");
        A4_PROLOGUE();
        float m_reg = -1e30f, l_reg = 0.f;
#define A2_QK_STEP(t, PAR) do { A4_STAGE(t, PAR); \
            if ((t) < NT) { f32x16 p0, p1; float mn, alpha; bf16x8 pa0, pa1, pa2, pa3; \
                attn::qkt<PAR>(p0, p1, K_lds, r32, hi, qr, sl, qm - KBASE(t)); \
                { const int kb_ = KBASE(t); if (kb_ + KVBLK - 1 > qlo || kb_ <= qlo + QBLK - 1 - W) attn::mask_tile(p0, p1, qm - kb_, (unsigned)W); } \
                attn::partialSM(p0, p1, m_reg, mn, alpha); attn::finishSM(p0, p1, alpha, l_reg, pa0, pa1, pa2, pa3); \
                char* px = lds + PX_OFF + (PAR) * 16384 + g * 4096 + lane * 16; \
                *(bf16x8*)px = pa0; *(bf16x8*)(px + 1024) = pa1; *(bf16x8*)(px + 2048) = pa2; *(bf16x8*)(px + 3072) = pa3; \
                if (hi == 0) AL[(PAR) * 128 + g * 32 + r32] = alpha; \
                const int anyr = __any(alpha < 1.f) ? 1 : 0; if (lane == 0) FLG[(PAR) * 4 + g] = anyr; } \
            A4_SYNC(); } while (0)
        for (int t = 0; t <= NT; t += 2) { A2_QK_STEP(t, 0); if (t + 1 <= NT) A2_QK_STEP(t + 1, 1); }
        if (hi == 0) LL[g * 32 + r32] = l_reg;
        __syncthreads();
        __syncthreads();
#undef A2_QK_STEP
    } else {
        A4_PROLOGUE();
        f32x16 o[8] = {};
        const int vb0 = (int)(uintptr_t)(lds + V_OFF) + attn::v_rd_base(lane);
#define A2_PV_STEP(t, PAR) do { A4_STAGE(t, PAR); \
            if ((t) >= 1) { constexpr int PB = (PAR) ^ 1; \
                const int flag = __builtin_amdgcn_readfirstlane(FLG[PB * 4 + g]); \
                if (flag) { _Pragma("unroll") for (int r = 0; r < 16; ++r) { const float a = AL[PB * 128 + g * 32 + attn::crow(r, hi)]; \
                        _Pragma("unroll") for (int d_ = 0; d_ < 8; ++d_) o[d_][r] *= a; } } \
                const char* px = lds + PX_OFF + PB * 16384 + g * 4096 + lane * 16; \
                const bf16x8 pa0 = *(const bf16x8*)px, pa1 = *(const bf16x8*)(px + 1024), pa2 = *(const bf16x8*)(px + 2048), pa3 = *(const bf16x8*)(px + 3072); \
                pv_half<PB * 32768>(o, vb0, pa0, pa1, pa2, pa3); pv_half<PB * 32768 + 16384>(o + 4, vb0, pa0, pa1, pa2, pa3); } \
            A4_SYNC(); } while (0)
        for (int t = 0; t <= NT; t += 2) { A2_PV_STEP(t, 0); if (t + 1 <= NT) A2_PV_STEP(t + 1, 1); }
        __syncthreads();
        float rli[16];
#pragma unroll
        for (int r = 0; r < 16; ++r) rli[r] = __builtin_amdgcn_rcpf(LL[g * 32 + attn::crow(r, hi)]);
        bf16* Ow = it.O + (size_t)(g * QBLK) * 256;
        int zo = 0; asm volatile("" : "+v"(zo));
        const unsigned ob = (unsigned)(4 * hi * 256 + r32 + zo);
#pragma unroll
        for (int r = 0; r < 16; ++r) { const unsigned off = ob + (unsigned)(((r & 3) + 8 * (r >> 2)) * 256);
#pragma unroll
            for (int d0 = 0; d0 < 8; ++d0) { const float v = o[d0][r] * rli[r];
                const float vn = __shfl_xor(v, 1);
                if ((r32 & 1) == 0) *(unsigned*)(Ow + off + d0 * 32) = cvtpk(v, vn); } }
        __syncthreads();
#undef A2_PV_STEP
    }
#undef KBASE
#undef A4_DMA
#undef A4_STAGE
#undef A4_SYNC
#undef A4_PROLOGUE
}
}
struct Frame {
    LAS unsigned char* lds; unsigned char* lds_g;
    volatile LAS unsigned* MISC;
    unsigned* ctl; unsigned char* ws; unsigned char* dout;
    int tid, lane, wave, G, bid, gw, NGW;
};

__device__ __forceinline__ void tr_item(const float* W, int ldw, int c0, bf16_t* WT, int ldt, int r0, int kb, int nb, LAS float* scr, int lane) {
    const int k0 = 64 * kb, n0 = 32 * nb;
#pragma unroll 8
    for (int i = 0; i < 32; ++i) { const int kk = 2 * i + (lane >> 5); scr[kk * 33 + (lane & 31)] = W[(size_t)(k0 + kk) * ldw + c0 + n0 + (lane & 31)]; }
    LDS_WAIT(); asm volatile("" ::: "memory");
    const int c = lane & 7;
#pragma unroll
    for (int j = 0; j < 4; ++j) { const int n = (lane >> 3) + 8 * j; const LAS float* s = scr + (8 * c) * 33 + n;
        u32x4 o; o.x = cvtpk(s[0 * 33], s[1 * 33]); o.y = cvtpk(s[2 * 33], s[3 * 33]); o.z = cvtpk(s[4 * 33], s[5 * 33]); o.w = cvtpk(s[6 * 33], s[7 * 33]);
        *(u32x4*)(WT + (size_t)(r0 + n0 + n) * ldt + k0 + 8 * c) = o; }
    LDS_WAIT(); asm volatile("" ::: "memory");
}
__device__ __forceinline__ void tr_item8(const float* W, int ldw, int c0, unsigned char* WT, int ldt, int r0, int kb, int nb, float sc, LAS float* scr, int lane) {
    const int k0 = 64 * kb, n0 = 32 * nb;
#pragma unroll 8
    for (int i = 0; i < 32; ++i) { const int kk = 2 * i + (lane >> 5); scr[kk * 33 + (lane & 31)] = W[(size_t)(k0 + kk) * ldw + c0 + n0 + (lane & 31)]; }
    LDS_WAIT(); asm volatile("" ::: "memory");
    const int c = lane & 7;
#pragma unroll
    for (int j = 0; j < 4; ++j) { const int n = (lane >> 3) + 8 * j; const LAS float* s = scr + (8 * c) * 33 + n;
        u32x2 o; o.x = pk4_fp8(s[0 * 33] * sc, s[1 * 33] * sc, s[2 * 33] * sc, s[3 * 33] * sc); o.y = pk4_fp8(s[4 * 33] * sc, s[5 * 33] * sc, s[6 * 33] * sc, s[7 * 33] * sc);
        *(u32x2*)(WT + (size_t)(r0 + n0 + n) * ldt + k0 + 8 * c) = o; }
    LDS_WAIT(); asm volatile("" ::: "memory");
}
__device__ __forceinline__ void rms_row2048(const float* xrow, const float* g, f32x4 (&v)[8], int lane) {
    const f32x4* xr = (const f32x4*)xrow + lane; float ss = 0.f;
#pragma unroll
    for (int j = 0; j < 8; ++j) { v[j] = xr[64 * j]; ss += (v[j].x * v[j].x + v[j].y * v[j].y) + (v[j].z * v[j].z + v[j].w * v[j].w); }
    ss = wave_sum(ss); const float r = rsqrtf(ss * (1.0f / 2048.0f) + EPS);
#pragma unroll
    for (int j = 0; j < 8; ++j) { const f32x4 gg = ((const f32x4*)g)[lane + 64 * j]; v[j] = v[j] * r * gg; }
}
__device__ __forceinline__ void store_row_bf16(bf16_t* orow, const f32x4 (&v)[8], int lane) {
#pragma unroll
    for (int j = 0; j < 8; ++j) { u32x2 w; w.x = cvtpk(v[j].x, v[j].y); w.y = cvtpk(v[j].z, v[j].w); *(u32x2*)(orow + 4 * lane + 256 * j) = w; }
}

__device__ __forceinline__ void p0_prologue(Frame& F, const float* const* in) {
    LAS float* scr = (LAS float*)(F.lds + F.wave * 16384);
    const float* w_in = in[3];
    bf16_t* WINT = (bf16_t*)(F.ws + WS_WINT);
    constexpr int I0 = 8192, I1 = 1024, I2 = 1024, I3 = 1024, I4 = 6144, I5 = 2048, I6 = 2048, I7 = 1024, I8 = 1024, I9 = 2048;
    constexpr int NITEMS = I0 + I1 + I2 + I3 + I4 + I5 + I6 + I7 + I8 + I9;
    for (int it = F.gw; it < NITEMS; it += F.NGW) {
        int r = it;
        if (r < I0) { tr_item(w_in, DIN, 0, WINT, 2048, 0, r / 256, r % 256, scr, F.lane); continue; } r -= I0;
        if (r < I1) { tr_item(w_in, DIN, 9216, WINT, 2048, 8192, r / 32, r % 32, scr, F.lane); continue; } r -= I1;
        if (r < I2) { tr_item(w_in, DIN, 10248, WINT, 2048, 9216, r / 32, r % 32, scr, F.lane); continue; } r -= I2;
        if (r < I3) { tr_item(w_in, DIN, 8192, WINT, 2048, 10240, r / 32, r % 32, scr, F.lane); continue; } r -= I3;
        if (r < I4) { tr_item8(w_in, DIN, 11272, (unsigned char*)(WINT + (size_t)11264 * 2048), 2048, 0, r / 192, r % 192, 32.0f, scr, F.lane); continue; } r -= I4;
        if (r < I5) { tr_item(in[15], 2048, 0, (bf16_t*)(F.ws + WS_WMEMT), 2048, 0, r / 64, r % 64, scr, F.lane); continue; } r -= I5;
        if (r < I6) { tr_item(in[16], 2048, 0, (bf16_t*)(F.ws + WS_WBDT), 2048, 0, r / 64, r % 64, scr, F.lane); continue; } r -= I6;
        if (r < I7) { tr_item(in[17], 2048, 0, (bf16_t*)(F.ws + WS_WBMT), 1024, 0, r / 64, r % 64, scr, F.lane); continue; } r -= I7;
        if (r < I8) { tr_item(in[18], 2048, 0, (bf16_t*)(F.ws + WS_WBCT), 1024, 0, r / 64, r % 64, scr, F.lane); continue; } r -= I8;
        tr_item(in[20], 2048, 0, (bf16_t*)(F.ws + WS_WOUTT), 2048, 0, r / 64, r % 64, scr, F.lane);
    }
    { bf16_t* WRT = (bf16_t*)(F.ws + WS_WRT); const float* wrg = in[22]; const float* wre = in[24];
      for (int idx = F.bid * 512 + F.tid; idx < 256 * 2048; idx += F.G * 512) { const int n = idx >> 11, k = idx & 2047;
          const float v = (n < 4 ? wrg[k * 4 + n] : (n < 36 ? wre[k * 32 + (n - 4)] : 0.f)) * in[21][k]; WRT[idx] = (bf16_t)(cvtpk(v, 0.f) & 0xffffu); } }
    __syncthreads();
    LAS float* wg = (LAS float*)F.lds;
    for (int idx = F.tid; idx < 16384; idx += 512) { const int k = idx >> 3, j = idx & 7; wg[j * 2048 + k] = w_in[(size_t)k * DIN + 10240 + j]; }
    __syncthreads();
    const float* x = in[0]; bf16_t* HBF = (bf16_t*)(F.dout + DO_HBF); float* MLG = (float*)(F.ws + WS_MLG);
    for (int m = F.gw; m < TT; m += F.NGW) {
        f32x4 v[8]; rms_row2048(x + (size_t)m * 2048, in[2], v, F.lane);
        store_row_bf16(HBF + (size_t)m * 2048, v, F.lane);
        float res = 0.f;
#pragma unroll
        for (int jj = 0; jj < 8; ++jj) { float a = 0.f;
#pragma unroll
            for (int j = 0; j < 8; ++j) { const f32x4 w = *(const LAS f32x4*)(wg + jj * 2048 + 4 * F.lane + 256 * j); a += (v[j].x * w.x + v[j].y * w.y) + (v[j].z * w.z + v[j].w * w.w); }
            a = wave_sum(a); if (F.lane == jj) res = a; }
        if (F.lane < 8) MLG[(size_t)m * 8 + F.lane] = res;
    }
    { const float* mem = in[1]; bf16_t* MEMN = (bf16_t*)(F.ws + WS_MEMN);
      for (int m = F.gw; m < NB * MEML; m += F.NGW) { f32x4 v[8]; rms_row2048(mem + (size_t)m * 2048, in[14], v, F.lane); store_row_bf16(MEMN + (size_t)m * 2048, v, F.lane); } }
    if (F.bid == 0 && F.wave == 0) {
        const float* q1 = in[8]; const float* k1 = in[9]; const float* q2 = in[10]; const float* k2 = in[11];
        float d1 = q1[F.lane] * k1[F.lane] + q1[F.lane + 64] * k1[F.lane + 64], d2 = q2[F.lane] * k2[F.lane] + q2[F.lane + 64] * k2[F.lane + 64];
        d1 = wave_sum(d1); d2 = wave_sum(d2);
        if (F.lane == 0) F.ctl[CW_LAM] = __float_as_uint(expf(d1) - expf(d2) + 0.2f);
    }
    __syncthreads();
}

__device__ __forceinline__ void ml0_seq(Frame& F, const float* const* in, int s) {
    const int b = s >> 2, hh = s & 3;
    const float* MLG = (const float*)(F.ws + WS_MLG);
    float* KW = (float*)(F.ws + WS_SCKW); float* RS = (float*)(F.ws + WS_SCRS); float* IT = (float*)(F.ws + WS_SCIT); float* ED = (float*)(F.ws + WS_SCED); float* DEC = (float*)(F.ws + WS_DEC);
    LAS float* sm_bl = (LAS float*)F.lds; LAS float* sm_cm = sm_bl + 64; LAS float* sm_mp = sm_bl + 128; LAS float* sm_R = sm_bl + 192;
    const float big = in[6][hh], bfg = in[7][hh];
    float bl[8][4], gh[8][4], cm[8][4];
#pragma unroll
    for (int rd = 0; rd < 8; ++rd) {
        const int c = rd * 8 + F.wave; const size_t t0 = (size_t)b * SEQ + (size_t)c * 256 + 4 * F.lane;
        float lf[4], ig[4];
#pragma unroll
        for (int i = 0; i < 4; ++i) { const float fg = MLG[(t0 + i) * 8 + 4 + hh] + bfg; lf[i] = fminf(fg, 0.f) - log1pf(expf(-fabsf(fg))); ig[i] = MLG[(t0 + i) * 8 + hh] + big; }
        float p[4]; p[0] = lf[0]; p[1] = p[0] + lf[1]; p[2] = p[1] + lf[2]; p[3] = p[2] + lf[3];
        float incl = p[3];
#pragma unroll
        for (int o = 1; o < 64; o <<= 1) { const float y = __shfl_up(incl, o); if (F.lane >= o) incl += y; }
        const float excl = incl - p[3];
#pragma unroll
        for (int i = 0; i < 4; ++i) { bl[rd][i] = excl + p[i]; gh[rd][i] = ig[i] - bl[rd][i]; }
        float q[4]; q[0] = gh[rd][0]; q[1] = fmaxf(q[0], gh[rd][1]); q[2] = fmaxf(q[1], gh[rd][2]); q[3] = fmaxf(q[2], gh[rd][3]);
        float im = q[3];
#pragma unroll
        for (int o = 1; o < 64; o <<= 1) { const float y = __shfl_up(im, o); if (F.lane >= o) im = fmaxf(im, y); }
        float em = __shfl_up(im, 1); if (F.lane == 0) em = -__builtin_inff();
#pragma unroll
        for (int i = 0; i < 4; ++i) cm[rd][i] = fmaxf(em, q[i]);
        if (F.lane == 63) { sm_bl[c] = bl[rd][3]; sm_cm[c] = cm[rd][3]; }
    }
    __syncthreads();
    if (F.tid == 0) { float M = 0.f; for (int c = 0; c < 64; ++c) { sm_mp[c] = M; const float R = fmaxf(M, sm_cm[c]); sm_R[c] = R; M = sm_bl[c] + R; } }
    __syncthreads();
#pragma unroll
    for (int rd = 0; rd < 8; ++rd) {
        const int c = rd * 8 + F.wave; const size_t idx = (size_t)hh * TT + (size_t)b * SEQ + (size_t)c * 256 + 4 * F.lane;
        const float Mp = sm_mp[c], R = sm_R[c];
        f32x4 kw, rs, it, ed;
#pragma unroll
        for (int i = 0; i < 4; ++i) { const float Gt = fmaxf(Mp, cm[rd][i]); kw[i] = expf(gh[rd][i] - R); rs[i] = expf(R - Gt); it[i] = expf(Mp - Gt); ed[i] = expf(-(bl[rd][i] + Gt)); }
        *(f32x4*)(KW + idx) = kw; *(f32x4*)(RS + idx) = rs; *(f32x4*)(IT + idx) = it; *(f32x4*)(ED + idx) = ed;
        if (F.lane == 0) DEC[s * 64 + c] = expf(Mp - R);
    }
    __syncthreads();
}

__device__ __forceinline__ void unpack8(const u32x4 r, float (&x)[8]) { x[0] = bflo(r.x); x[1] = bfhi(r.x); x[2] = bflo(r.y); x[3] = bfhi(r.y); x[4] = bflo(r.z); x[5] = bfhi(r.z); x[6] = bflo(r.w); x[7] = bfhi(r.w); }
__device__ __forceinline__ void ml1_conv(Frame& F, const float* const* in) {
    const bf16_t* MQK = (const bf16_t*)(F.ws + WS_MQK);
    bf16_t* Q = (bf16_t*)(F.ws + WS_Q); bf16_t* WQ = (bf16_t*)(F.ws + WS_WQ); bf16_t* KWB = (bf16_t*)(F.ws + WS_KW); bf16_t* KWT = (bf16_t*)(F.ws + WS_KWT);
    const float* KWS = (const float*)(F.ws + WS_SCKW); const float* ITS = (const float*)(F.ws + WS_SCIT); float* KN4 = (float*)(F.ws + WS_KN);
    const float* cw = in[4]; const float* cbp = in[5];
    for (int id = F.gw; id < 2048; id += F.NGW) {
        const int cg = id & 3, sc = id >> 2, kind = cg >> 1, hh = (cg & 1) * 2 + (F.lane >> 5), d0 = (F.lane & 31) * 8, col = cg * 512 + F.lane * 8;
        const size_t t0 = (size_t)sc * 64, hrow = (size_t)hh * TT + t0;
        float w[4][8], cb[8], h3[8], h2[8], h1[8], cs[8];
#pragma unroll
        for (int j = 0; j < 4; ++j) { const f32x4 a = *(const f32x4*)(cw + j * 2048 + col), b = *(const f32x4*)(cw + j * 2048 + col + 4);
            w[j][0] = a.x; w[j][1] = a.y; w[j][2] = a.z; w[j][3] = a.w; w[j][4] = b.x; w[j][5] = b.y; w[j][6] = b.z; w[j][7] = b.w; }
        { const f32x4 a = *(const f32x4*)(cbp + col), b = *(const f32x4*)(cbp + col + 4); cb[0] = a.x; cb[1] = a.y; cb[2] = a.z; cb[3] = a.w; cb[4] = b.x; cb[5] = b.y; cb[6] = b.z; cb[7] = b.w; }
#pragma unroll
        for (int c = 0; c < 8; ++c) { h3[c] = 0.f; h2[c] = 0.f; h1[c] = 0.f; cs[c] = 0.f; }
        if ((t0 & (size_t)(SEQ - 1)) != 0) {
            unpack8(*(const u32x4*)(MQK + (t0 - 3) * 2048 + col), h3); unpack8(*(const u32x4*)(MQK + (t0 - 2) * 2048 + col), h2); unpack8(*(const u32x4*)(MQK + (t0 - 1) * 2048 + col), h1); }
        u32x4 xn[8];
#pragma unroll
        for (int i = 0; i < 8; ++i) xn[i] = *(const u32x4*)(MQK + (t0 + i) * 2048 + col);
        for (int tb = 0; tb < 8; ++tb) {
            u32x4 xr[8]; unsigned pk[8][4];
#pragma unroll
            for (int i = 0; i < 8; ++i) xr[i] = xn[i];
            { const int tn = tb < 7 ? tb + 1 : 7;
#pragma unroll
              for (int i = 0; i < 8; ++i) xn[i] = *(const u32x4*)(MQK + (t0 + tn * 8 + i) * 2048 + col); }
#pragma unroll
            for (int i = 0; i < 8; ++i) {
                float xv[8], sv[8]; unpack8(xr[i], xv);
#pragma unroll
                for (int c = 0; c < 8; ++c) { const float y = w[0][c] * h3[c] + w[1][c] * h2[c] + w[2][c] * h1[c] + w[3][c] * xv[c] + cb[c]; sv[c] = y * sigmoidf_(y); h3[c] = h2[c]; h2[c] = h1[c]; h1[c] = xv[c]; }
                const size_t tr = hrow + tb * 8 + i;
                if (kind == 0) { const float itv = ITS[tr];
                    u32x4 o; o.x = cvtpk(sv[0], sv[1]); o.y = cvtpk(sv[2], sv[3]); o.z = cvtpk(sv[4], sv[5]); o.w = cvtpk(sv[6], sv[7]); *(u32x4*)(Q + tr * 256 + d0) = o;
                    u32x4 p; p.x = cvtpk(sv[0] * itv, sv[1] * itv); p.y = cvtpk(sv[2] * itv, sv[3] * itv); p.z = cvtpk(sv[4] * itv, sv[5] * itv); p.w = cvtpk(sv[6] * itv, sv[7] * itv); *(u32x4*)(WQ + tr * 512 + 256 + d0) = p;
                } else { const float kwv = KWS[tr] * 0.0625f;
                    u32x4 o; o.x = cvtpk(sv[0] * kwv, sv[1] * kwv); o.y = cvtpk(sv[2] * kwv, sv[3] * kwv); o.z = cvtpk(sv[4] * kwv, sv[5] * kwv); o.w = cvtpk(sv[6] * kwv, sv[7] * kwv); *(u32x4*)(KWB + tr * 256 + d0) = o;
                    pk[i][0] = o.x; pk[i][1] = o.y; pk[i][2] = o.z; pk[i][3] = o.w;
                    cs[0] += bflo(o.x); cs[1] += bfhi(o.x); cs[2] += bflo(o.y); cs[3] += bfhi(o.y); cs[4] += bflo(o.z); cs[5] += bfhi(o.z); cs[6] += bflo(o.w); cs[7] += bfhi(o.w); }
            }
            if (kind == 1) {
#pragma unroll
                for (int c = 0; c < 8; ++c) { u32x4 o;
                    unsigned wj[4];
#pragma unroll
                    for (int j = 0; j < 4; ++j) { const unsigned a = pk[2 * j][c >> 1], b = pk[2 * j + 1][c >> 1];
                        wj[j] = (c & 1) ? ((a >> 16) | (b & 0xffff0000u)) : ((a & 0xffffu) | (b << 16)); }
                    o.x = wj[0]; o.y = wj[1]; o.z = wj[2]; o.w = wj[3];
                    *(u32x4*)(KWT + (((size_t)hh * 128 + (sc >> 2)) * 256 + d0 + c) * 256 + (sc & 3) * 64 + tb * 8) = o; }
            }
        }
        if (kind == 1) { float* kn = KN4 + (((size_t)hh * 128 + (sc >> 2)) * 4 + (sc & 3)) * 256 + d0;
            *(f32x4*)kn = (f32x4){cs[0], cs[1], cs[2], cs[3]}; *(f32x4*)(kn + 4) = (f32x4){cs[4], cs[5], cs[6], cs[7]}; }
    }
}

__device__ __forceinline__ void nscan_seq(Frame& F, int s) {
    if (F.tid < 256) { const int hh = s & 3, b = s >> 2; const float* KN4 = (const float*)(F.ws + WS_KN); const float* DEC = (const float*)(F.ws + WS_DEC); float* NP = (float*)(F.ws + WS_NP);
        float n = 0.f;
        for (int c0 = 0; c0 < 64; c0 += 8) { float kn[8], dc[8];
#pragma unroll
            for (int i = 0; i < 8; ++i) { const float* p = KN4 + ((size_t)hh * 128 + b * 64 + c0 + i) * 1024 + F.tid; kn[i] = (p[0] + p[256]) + (p[512] + p[768]); dc[i] = DEC[s * 64 + c0 + i]; }
#pragma unroll
            for (int i = 0; i < 8; ++i) { NP[((size_t)s * 64 + c0 + i) * 256 + F.tid] = n; n = dc[i] * n + kn[i]; } }
    }
}
__device__ __forceinline__ void xsoftmax(Frame& F) {
    const bf16_t* XS = (const bf16_t*)(F.ws + WS_XS); bf16_t* XP = (bf16_t*)(F.ws + WS_XP);
    const int sub = F.lane >> 5, d8 = (F.lane & 31) * 8;
    for (int row0 = F.gw * 8; row0 < 4 * TT; row0 += F.NGW * 8) {
        u32x4 v[4];
#pragma unroll
        for (int i = 0; i < 4; ++i) v[i] = *(const u32x4*)(XS + (size_t)(row0 + 2 * i + sub) * 256 + d8);
#pragma unroll
        for (int i = 0; i < 4; ++i) { float x[8]; unpack8(v[i], x);
            float m = fmaxf(fmaxf(fmaxf(x[0], x[1]), fmaxf(x[2], x[3])), fmaxf(fmaxf(x[4], x[5]), fmaxf(x[6], x[7])));
#pragma unroll
            for (int o = 1; o < 32; o <<= 1) m = fmaxf(m, __shfl_xor(m, o));
            float s = 0.f;
#pragma unroll
            for (int c = 0; c < 8; ++c) { x[c] = __expf(x[c] - m); s += x[c]; }
#pragma unroll
            for (int o = 1; o < 32; o <<= 1) s += __shfl_xor(s, o);
            const float inv = 1.0f / s;
            u32x4 w; w.x = cvtpk(x[0] * inv, x[1] * inv); w.y = cvtpk(x[2] * inv, x[3] * inv); w.z = cvtpk(x[4] * inv, x[5] * inv); w.w = cvtpk(x[6] * inv, x[7] * inv);
            *(u32x4*)(XP + (size_t)(row0 + 2 * i + sub) * 256 + d8) = w; }
    }
}
__device__ __forceinline__ void cscan(Frame& F) {
    const bf16_t* U = (const bf16_t*)(F.ws + WS_U); bf16_t* VC = (bf16_t*)(F.ws + WS_VC); const float* DEC = (const float*)(F.ws + WS_DEC);
    for (int gid = F.bid * 512 + F.tid; gid < 131072; gid += F.G * 512) {
        const int s = gid >> 14, rem = gid & 16383, dv = rem >> 6, dk4 = (rem & 63) * 4, hh = s & 3, b = s >> 2;
        f32x4 C = {0.f, 0.f, 0.f, 0.f};
        for (int c0 = 0; c0 < 64; c0 += 8) { const size_t g0 = (size_t)hh * 128 + b * 64 + c0;
            f32x4 u[8]; float dc[8];
#pragma unroll
            for (int i = 0; i < 8; ++i) { const u32x2 w = *(const u32x2*)(U + (g0 + i) * 65536 + (size_t)dv * 256 + dk4); u[i] = (f32x4){bflo(w.x), bfhi(w.x), bflo(w.y), bfhi(w.y)}; dc[i] = DEC[s * 64 + c0 + i]; }
#pragma unroll
            for (int i = 0; i < 8; ++i) { u32x2 w; w.x = cvtpk(C.x, C.y); w.y = cvtpk(C.z, C.w); *(u32x2*)(VC + ((g0 + i) * 256 + dv) * 512 + 256 + dk4) = w; C = C * dc[i] + u[i]; } }
    }
}
__device__ __forceinline__ void denpass(Frame& F) {
    const bf16_t* WQ = (const bf16_t*)(F.ws + WS_WQ); const float* NP = (const float*)(F.ws + WS_NP); const float* ED = (const float*)(F.ws + WS_SCED); float* HDEN = (float*)(F.ws + WS_HDEN);
    for (int row0 = F.gw * 4; row0 < 4 * TT; row0 += F.NGW * 4) {
        const int hh = row0 / TT, t = row0 - hh * TT, b = t / SEQ, c = (t - b * SEQ) >> 8;
        u32x4 w[4]; f32x4 n0 = {0.f, 0.f, 0.f, 0.f}, n1 = {0.f, 0.f, 0.f, 0.f};
#pragma unroll
        for (int i = 0; i < 4; ++i) w[i] = *(const u32x4*)(WQ + (size_t)(row0 + i) * 512 + 8 * F.lane);
        if (F.lane >= 32) { const float* np = NP + ((size_t)(b * 4 + hh) * 64 + c) * 256 + 8 * (F.lane - 32); n0 = *(const f32x4*)np; n1 = *(const f32x4*)(np + 4); }
        else { n0 = (f32x4){1.f, 1.f, 1.f, 1.f}; n1 = n0; }
        const float edv = ED[row0 + (F.lane & 3)];
#pragma unroll
        for (int i = 0; i < 4; ++i) {
            const float part = ((bflo(w[i].x) * n0.x + bfhi(w[i].x) * n0.y) + (bflo(w[i].y) * n0.z + bfhi(w[i].y) * n0.w)) + ((bflo(w[i].z) * n1.x + bfhi(w[i].z) * n1.y) + (bflo(w[i].w) * n1.z + bfhi(w[i].w) * n1.w));
            const float den = wave_sum(part);
            if (F.lane == i) HDEN[row0 + i] = fmaxf(fabsf(den), edv); }
    }
}
__device__ __forceinline__ void hmnorm(Frame& F, const float* const* in) {
    bf16_t* HR = (bf16_t*)(F.dout + DO_HR); const bf16_t* MLO = (const bf16_t*)(F.ws + WS_MLO); const float* g = in[13];
    const int sub = F.lane >> 5, d8 = (F.lane & 31) * 8;
    for (int row0 = F.gw * 8; row0 < 4 * TT; row0 += F.NGW * 8) {
        u32x4 xw[4], ow[4];
#pragma unroll
        for (int i = 0; i < 4; ++i) { const int row = row0 + 2 * i + sub; const size_t o = (size_t)(row >> 2) * 1024 + (row & 3) * 256 + d8; xw[i] = *(const u32x4*)(HR + o); ow[i] = *(const u32x4*)(MLO + o); }
#pragma unroll
        for (int i = 0; i < 4; ++i) { const int row = row0 + 2 * i + sub, hh = row & 3; const size_t o = (size_t)(row >> 2) * 1024 + hh * 256 + d8;
            float x[8], og[8]; unpack8(xw[i], x); unpack8(ow[i], og);
            float ss = ((x[0] * x[0] + x[1] * x[1]) + (x[2] * x[2] + x[3] * x[3])) + ((x[4] * x[4] + x[5] * x[5]) + (x[6] * x[6] + x[7] * x[7]));
            ss += __shfl_xor(ss, 1); ss += __shfl_xor(ss, 2); ss += __shfl_xor(ss, 4); ss += __shfl_xor(ss, 8); ss += __shfl_xor(ss, 16);
            const float r = rsqrtf(ss * (1.0f / 256.0f) + EPS);
            const f32x4 g0 = *(const f32x4*)(g + hh * 256 + d8), g1 = *(const f32x4*)(g + hh * 256 + d8 + 4);
            u32x4 w; w.x = cvtpk(sigmoidf_(og[0]) * x[0] * r * g0.x, sigmoidf_(og[1]) * x[1] * r * g0.y); w.y = cvtpk(sigmoidf_(og[2]) * x[2] * r * g0.z, sigmoidf_(og[3]) * x[3] * r * g0.w);
            w.z = cvtpk(sigmoidf_(og[4]) * x[4] * r * g1.x, sigmoidf_(og[5]) * x[5] * r * g1.y); w.w = cvtpk(sigmoidf_(og[6]) * x[6] * r * g1.z, sigmoidf_(og[7]) * x[7] * r * g1.w);
            *(u32x4*)(HR + o) = w; }
    }
}
__device__ __forceinline__ unsigned fkey(float f) { const unsigned u = __float_as_uint(f); return (u & 0x80000000u) ? ~u : (u | 0x80000000u); }
__device__ __forceinline__ float fkey_inv(unsigned k) { return __uint_as_float((k & 0x80000000u) ? (k & 0x7fffffffu) : ~k); }
__device__ __forceinline__ float dot8(const u32x4 a, const u32x4 b) {
    return ((bflo(a.x) * bflo(b.x) + bfhi(a.x) * bfhi(b.x)) + (bflo(a.y) * bflo(b.y) + bfhi(a.y) * bfhi(b.y))) + ((bflo(a.z) * bflo(b.z) + bfhi(a.z) * bfhi(b.z)) + (bflo(a.w) * bflo(b.w) + bfhi(a.w) * bfhi(b.w))); }
__device__ __forceinline__ void normmax(Frame& F) {
    LAS float* red = (LAS float*)F.lds;
    const bf16_t* DQ = (const bf16_t*)(F.ws + WS_DQ); const bf16_t* DK = (const bf16_t*)(F.ws + WS_DK);
    const size_t row0 = (size_t)F.gw * 16 + (F.lane >> 4), coff = (F.lane & 15) * 8;
    u32x4 q[4], k[4];
#pragma unroll
    for (int i = 0; i < 4; ++i) { q[i] = *(const u32x4*)(DQ + (row0 + 4 * i) * 128 + coff); k[i] = *(const u32x4*)(DK + (row0 + 4 * i) * 128 + coff); }
    for (int c16 = 0; c16 < 16; ++c16) {
        u32x4 qn[4], kn[4];
        const int cn = c16 < 15 ? c16 + 1 : 15;
#pragma unroll
        for (int i = 0; i < 4; ++i) { qn[i] = *(const u32x4*)(DQ + ((size_t)cn * TT + row0 + 4 * i) * 128 + coff); kn[i] = *(const u32x4*)(DK + ((size_t)cn * TT + row0 + 4 * i) * 128 + coff); }
        float q2 = 0.f, k2 = 0.f, nd = -__builtin_inff();
#pragma unroll
        for (int i = 0; i < 4; ++i) { float a = dot8(q[i], q[i]), b = dot8(k[i], k[i]), c = dot8(q[i], k[i]);
#pragma unroll
            for (int o = 1; o < 16; o <<= 1) { a += __shfl_xor(a, o); b += __shfl_xor(b, o); c += __shfl_xor(c, o); }
            q2 = fmaxf(q2, a); k2 = fmaxf(k2, b); nd = fmaxf(nd, -c); }
        q2 = wave_max(q2); k2 = wave_max(k2); nd = wave_max(nd);
        if (F.lane == 0) { red[F.wave] = q2; red[8 + F.wave] = k2; red[16 + F.wave] = nd; }
        __syncthreads();
        if (F.tid < 2) {
            const int blk = F.bid >> 1, b = (F.bid * 128) / SEQ;
            if (F.tid == 0) { float a = red[0], bb = red[8];
#pragma unroll
                for (int w = 1; w < 8; ++w) { a = fmaxf(a, red[w]); bb = fmaxf(bb, red[8 + w]); }
                atomicMax(F.ctl + CW_QB2 + c16 * 128 + blk, __float_as_uint(a)); atomicMax(F.ctl + CW_KMX + c16 * 2 + b, __float_as_uint(bb)); }
            else { float a = red[16];
#pragma unroll
                for (int w = 1; w < 8; ++w) a = fmaxf(a, red[16 + w]);
                atomicMax(F.ctl + CW_ND + c16 * 128 + blk, fkey(a)); }
        }
        __syncthreads();
#pragma unroll
        for (int i = 0; i < 4; ++i) { q[i] = qn[i]; k[i] = kn[i]; }
    }
}
__device__ __forceinline__ attn4::Item attn_item(Frame& F, int qx, int id) {
    const int b = qx >> 2, m = (qx >> 1) & 1, x = id, h = 7 - (x >> 6), qb = 2 * (63 - (x & 63)) + (qx & 1);
    const bf16_t* DQ = (const bf16_t*)(F.ws + WS_DQ); const bf16_t* DK = (const bf16_t*)(F.ws + WS_DK); const bf16_t* DV = (const bf16_t*)(F.ws + WS_DV); bf16_t* O = (bf16_t*)(F.ws + WS_O);
    attn4::Item it; const size_t srow = (size_t)b * SEQ;
    it.Q = DQ + ((size_t)(h * 2 + m) * TT + srow + (size_t)qb * 128) * 128;
    it.K = DK + ((size_t)(h * 2 + m) * TT + srow) * 128;
    it.V0 = DV + ((size_t)(h * 2 + 0) * TT + srow) * 128;
    it.V1 = DV + ((size_t)(h * 2 + 1) * TT + srow) * 128;
    it.O = O + ((size_t)(h * 2 + m) * TT + srow + (size_t)qb * 128) * 256;
    it.P0 = qb * 128;
    const int c16 = h * 2 + m, blk = b * 64 + (qb >> 1);
    const float q2 = __uint_as_float(F.ctl[CW_QB2 + c16 * 128 + blk]), k2 = __uint_as_float(F.ctl[CW_KMX + c16 * 2 + b]), ndg = fkey_inv(F.ctl[CW_ND + c16 * 128 + blk]);
    const float slope = exp2f(-(float)(h + 1));
    const float bnd = (sqrtf(q2) * sqrtf(k2) + ndg) * attn::SCALE + 32.02f;
    float wf = ceilf(bnd / slope) + 1.0f; if (!(wf < (float)SEQ)) wf = (float)SEQ; if (!(wf >= 1.0f)) wf = 1.0f;
    it.W = (int)wf; it.sl = slope / attn::SCALE;
    return it;
}
__device__ __forceinline__ int attn_ticket(Frame& F, int rep, int& myq) {
    if (F.tid == 0) { int res = -1;
        for (int k = 0; k < 8; ++k) { const int q = (myq + k) & 7; const unsigned t = atomicAdd(F.ctl + CW_AHEAD + rep * 64 + q * 8, 1u); if (t < 512u) { res = q * 512 + (int)t; break; } }
        F.MISC[0] = (unsigned)res; }
    __syncthreads();
    const int v = __builtin_amdgcn_readfirstlane((int)F.MISC[0]);
    __syncthreads();
    if (v >= 0) myq = v >> 9;
    return v;
}
__device__ __forceinline__ void attn_phase(Frame& F, int rep) {
    const int tid = F.tid; int myq = F.bid & 7;
    for (;;) {
        const int id = attn_ticket(F, rep, myq);
        if (id < 0) break;
        const attn4::Item it = attn_item(F, id >> 9, id & 511);
        attn4::item(it, (char*)F.lds_g, F.lds, tid);
    }
    VM_WAIT(); __syncthreads();
}
__device__ __forceinline__ void dacombine(Frame& F, const float* const* in) {
    const bf16_t* O = (const bf16_t*)(F.ws + WS_O); bf16_t* DA = (bf16_t*)(F.ws + WS_DA); const float* g = in[12];
    const float lam = __uint_as_float(F.ctl[CW_LAM]);
    const int sub = F.lane >> 5, d8 = (F.lane & 31) * 8;
    for (int row0 = F.gw * 8; row0 < 8 * TT; row0 += F.NGW * 8) {
        u32x4 a[4], bq[4];
#pragma unroll
        for (int i = 0; i < 4; ++i) { const int row = row0 + 2 * i + sub, t = row >> 3, h = row & 7;
            a[i] = *(const u32x4*)(O + ((size_t)(h * 2 + 0) * TT + t) * 256 + d8); bq[i] = *(const u32x4*)(O + ((size_t)(h * 2 + 1) * TT + t) * 256 + d8); }
#pragma unroll
        for (int i = 0; i < 4; ++i) { const int row = row0 + 2 * i + sub, t = row >> 3, h = row & 7;
            float x[8], y[8]; unpack8(a[i], x); unpack8(bq[i], y);
#pragma unroll
            for (int c = 0; c < 8; ++c) x[c] -= lam * y[c];
            float ss = ((x[0] * x[0] + x[1] * x[1]) + (x[2] * x[2] + x[3] * x[3])) + ((x[4] * x[4] + x[5] * x[5]) + (x[6] * x[6] + x[7] * x[7]));
            ss += __shfl_xor(ss, 1); ss += __shfl_xor(ss, 2); ss += __shfl_xor(ss, 4); ss += __shfl_xor(ss, 8); ss += __shfl_xor(ss, 16);
            const float r = rsqrtf(ss * (1.0f / 256.0f) + EPS) * 0.8f;
            const f32x4 g0 = *(const f32x4*)(g + h * 256 + d8), g1 = *(const f32x4*)(g + h * 256 + d8 + 4);
            u32x4 w; w.x = cvtpk(x[0] * r * g0.x, x[1] * r * g0.y); w.y = cvtpk(x[2] * r * g0.z, x[3] * r * g0.w); w.z = cvtpk(x[4] * r * g1.x, x[5] * r * g1.y); w.w = cvtpk(x[6] * r * g1.z, x[7] * r * g1.w);
            *(u32x4*)(DA + (size_t)t * 2048 + h * 256 + d8) = w; }
    }
}
__device__ __forceinline__ void expert_convert(Frame& F, const float* const* in) {
    LAS float* scr = (LAS float*)(F.lds + F.wave * 16384);
    unsigned char* WGU = F.ws + WS_WGU; unsigned char* WD = F.ws + WS_WD;
    constexpr int PER = 22528;
    for (int it = F.gw; it < 3 * PER; it += F.NGW) {
        const int kind = it / PER, r = it - kind * PER, e = r / 704, r2 = r - e * 704;
        if (kind < 2) { const int kb = r2 / 22, nb = r2 - kb * 22, pn = nb >> 2;
            tr_item8((kind == 0 ? in[26] : in[27]) + (size_t)e * 2048 * DEXP, DEXP, 0, WGU, 2048, e * GU_N + pn * 128 + kind * 128, kb, nb, 32.0f, scr, F.lane); }
        else { const int kb = r2 >> 6, nb = r2 & 63;
            tr_item8(in[28] + (size_t)e * DEXP * 2048, 2048, 0, WD + (size_t)e * 2048 * DEXP_P, DEXP_P, 0, kb, nb, 16.0f, scr, F.lane); }
    }
    const u32x4 z = {0u, 0u, 0u, 0u};
    for (int idx = F.bid * 512 + F.tid; idx < 32 * 2 * 64 * 128; idx += F.G * 512) { const int e = idx >> 14, rem = idx & 16383, blk = rem >> 13, row = (rem >> 7) & 63, c16 = rem & 127;
        *(u32x4*)(WGU + ((size_t)e * GU_N + 1280 + blk * 128 + 64 + row) * 2048 + c16 * 16) = z; }
    for (int idx = F.bid * 512 + F.tid; idx < 32 * 2048 * 4; idx += F.G * 512) { const int en = idx >> 2, j = idx & 3;
        *(u32x4*)(WD + (size_t)en * DEXP_P + DEXP + j * 16) = z; }
    { const bf16_t* HBF = (const bf16_t*)(F.dout + DO_HBF); unsigned char* H8 = F.ws + WS_HBF8;
      for (size_t g8 = (size_t)(F.gw * 64 + F.lane) * 4; g8 < (size_t)TT * 256; g8 += (size_t)F.NGW * 64 * 4) {
          u32x4 a[4];
#pragma unroll
          for (int i = 0; i < 4; ++i) a[i] = *(const u32x4*)(HBF + (g8 + i) * 8);
          u32x4 o0, o1;
          o0.x = pk4_fp8(bflo(a[0].x), bfhi(a[0].x), bflo(a[0].y), bfhi(a[0].y)); o0.y = pk4_fp8(bflo(a[0].z), bfhi(a[0].z), bflo(a[0].w), bfhi(a[0].w));
          o0.z = pk4_fp8(bflo(a[1].x), bfhi(a[1].x), bflo(a[1].y), bfhi(a[1].y)); o0.w = pk4_fp8(bflo(a[1].z), bfhi(a[1].z), bflo(a[1].w), bfhi(a[1].w));
          o1.x = pk4_fp8(bflo(a[2].x), bfhi(a[2].x), bflo(a[2].y), bfhi(a[2].y)); o1.y = pk4_fp8(bflo(a[2].z), bfhi(a[2].z), bflo(a[2].w), bfhi(a[2].w));
          o1.z = pk4_fp8(bflo(a[3].x), bfhi(a[3].x), bflo(a[3].y), bfhi(a[3].y)); o1.w = pk4_fp8(bflo(a[3].z), bfhi(a[3].z), bflo(a[3].w), bfhi(a[3].w));
          *(u32x4*)(H8 + g8 * 8) = o0; *(u32x4*)(H8 + g8 * 8 + 16) = o1; } }
    __syncthreads();
}
__device__ __forceinline__ void topk_pass(Frame& F, const float* const* in) {
    const float* LG = (const float*)(F.ws + WS_LG); int* TOKE = (int*)(F.ws + WS_TOKE); float* TOKW = (float*)(F.ws + WS_TOKW); const float* RSS = (const float*)(F.ws + WS_RSS); float* RT = (float*)(F.ws + WS_RT);
    LAS unsigned* hist = (LAS unsigned*)F.lds;
    if (F.tid < 32) hist[F.tid] = 0u;
    __syncthreads();
    const float* brg = in[23]; const float* bre = in[25];
    for (int t = F.bid * 512 + F.tid; t < TT; t += F.G * 512) {
        const float* lp = LG + (size_t)t * 256;
        float rt; { const f32x4* rs = (const f32x4*)(RSS + (size_t)t * 32); f32x4 a = rs[0];
#pragma unroll
            for (int j = 1; j < 8; ++j) a += rs[j];
            rt = rsqrtf(((a.x + a.y) + (a.z + a.w)) * (1.0f / 2048.0f) + EPS); RT[t] = rt; }
        const f32x4 g4 = *(const f32x4*)lp * rt;
        const float g0 = g4.x + brg[0], g1 = g4.y + brg[1], g2 = g4.z + brg[2], g3 = g4.w + brg[3];
        int grp = 0; float gm = g0; if (g1 > gm) { gm = g1; grp = 1; } if (g2 > gm) { gm = g2; grp = 2; } if (g3 > gm) { gm = g3; grp = 3; }
        const float pg = 1.0f / (expf(g0 - gm) + expf(g1 - gm) + expf(g2 - gm) + expf(g3 - gm));
        const f32x4 ea = *(const f32x4*)(lp + 4 + grp * 8) * rt, eb = *(const f32x4*)(lp + 8 + grp * 8) * rt;
        const f32x4 ba = *(const f32x4*)(bre + grp * 8), bb = *(const f32x4*)(bre + grp * 8 + 4);
        float ev[8] = {ea.x + ba.x, ea.y + ba.y, ea.z + ba.z, ea.w + ba.w, eb.x + bb.x, eb.y + bb.y, eb.z + bb.z, eb.w + bb.w};
        int i1 = 0; float v1 = ev[0];
#pragma unroll
        for (int j = 1; j < 8; ++j) if (ev[j] > v1) { v1 = ev[j]; i1 = j; }
        int i2 = -1; float v2 = -__builtin_inff();
#pragma unroll
        for (int j = 0; j < 8; ++j) if (j != i1 && ev[j] > v2) { v2 = ev[j]; i2 = j; }
        const float ex = expf(v2 - v1), inv = 1.0f / (1.0f + ex);
        const int e1 = grp * 8 + i1, e2 = grp * 8 + i2;
        TOKE[t * 2] = e1; TOKE[t * 2 + 1] = e2; TOKW[t * 2] = inv * pg; TOKW[t * 2 + 1] = ex * inv * pg;
        __hip_atomic_fetch_add(&hist[e1], 1u, __ATOMIC_RELAXED, __HIP_MEMORY_SCOPE_WORKGROUP); __hip_atomic_fetch_add(&hist[e2], 1u, __ATOMIC_RELAXED, __HIP_MEMORY_SCOPE_WORKGROUP);
    }
    __syncthreads();
    if (F.tid < 32 && hist[F.tid]) atomicAdd(F.ctl + CW_ECNT + F.tid, hist[F.tid]);
    __syncthreads();
}
__device__ __forceinline__ void gather_pass(Frame& F, const float* const* in) {
    const int* TOKE = (const int*)(F.ws + WS_TOKE); const float* TOKW = (const float*)(F.ws + WS_TOKW); int* POS = (int*)(F.ws + WS_POS); float* WROW = (float*)(F.ws + WS_WROW); int* TILEE = (int*)(F.ws + WS_TILEE);
    const bf16_t* X1B = (const bf16_t*)(F.ws + WS_X1B); const float* RT = (const float*)(F.ws + WS_RT); unsigned char* XSORT = F.ws + WS_XSORT;
    float gf[32];
#pragma unroll
    for (int j = 0; j < 8; ++j) { const f32x4 g = *(const f32x4*)(in[21] + 32 * F.lane + 4 * j); gf[4 * j] = g.x; gf[4 * j + 1] = g.y; gf[4 * j + 2] = g.z; gf[4 * j + 3] = g.w; }
    LAS unsigned* pstart = (LAS unsigned*)F.lds; LAS unsigned* hist = pstart + 32; LAS unsigned* base = pstart + 64; LAS unsigned* lcur = pstart + 96; LAS int* apos = (LAS int*)(pstart + 128); LAS int* atok = apos + 512;
    if (F.tid == 0) { unsigned acc = 0; for (int e = 0; e < 32; ++e) { pstart[e] = acc; const unsigned c = F.ctl[CW_ECNT + e]; const unsigned pc = (c + 255u) & ~255u;
            if (F.bid == 0) for (unsigned rt = acc >> 8; rt < (acc + pc) >> 8; ++rt) TILEE[rt] = e;
            acc += pc; }
        if (F.bid == 0) F.ctl[CW_NRT] = acc >> 8; }
    const int per = (TT + F.G - 1) / F.G;
    const int tbeg = F.bid * per, tend = (tbeg + per < TT) ? tbeg + per : TT;
    for (int ts = tbeg; ts < tend; ts += 256) {
        const int nasg = 2 * ((tend - ts < 256) ? tend - ts : 256);
        if (F.tid < 32) { hist[F.tid] = 0u; lcur[F.tid] = 0u; }
        __syncthreads();
        int e = 0; const int a = F.tid;
        if (a < nasg) { e = TOKE[ts * 2 + a]; __hip_atomic_fetch_add(&hist[e], 1u, __ATOMIC_RELAXED, __HIP_MEMORY_SCOPE_WORKGROUP); }
        __syncthreads();
        if (F.tid < 32) base[F.tid] = pstart[F.tid] + (hist[F.tid] ? atomicAdd(F.ctl + CW_ECUR + F.tid, hist[F.tid]) : 0u);
        __syncthreads();
        if (a < nasg) { const unsigned p = base[e] + __hip_atomic_fetch_add(&lcur[e], 1u, __ATOMIC_RELAXED, __HIP_MEMORY_SCOPE_WORKGROUP); POS[ts * 2 + a] = (int)p; WROW[p] = TOKW[ts * 2 + a]; apos[a] = (int)p; atok[a] = ts + (a >> 1); }
        __syncthreads();
        for (int i = F.wave; i < nasg; i += 8) { const int tok = atok[i]; const u32x4* src = (const u32x4*)(X1B + (size_t)tok * 2048) + 4 * F.lane; u32x4* dst = (u32x4*)(XSORT + (size_t)apos[i] * 2048) + 2 * F.lane;
            u32x4 a[4]; const float rt = RT[tok];
#pragma unroll
            for (int j = 0; j < 4; ++j) a[j] = src[j];
            unsigned o[8];
#pragma unroll
            for (int j = 0; j < 4; ++j) {
                o[2 * j]     = pk4_fp8(bflo(a[j].x) * rt * gf[8 * j],     bfhi(a[j].x) * rt * gf[8 * j + 1], bflo(a[j].y) * rt * gf[8 * j + 2], bfhi(a[j].y) * rt * gf[8 * j + 3]);
                o[2 * j + 1] = pk4_fp8(bflo(a[j].z) * rt * gf[8 * j + 4], bfhi(a[j].z) * rt * gf[8 * j + 5], bflo(a[j].w) * rt * gf[8 * j + 6], bfhi(a[j].w) * rt * gf[8 * j + 7]); }
            u32x4 o0, o1; o0.x = o[0]; o0.y = o[1]; o0.z = o[2]; o0.w = o[3]; o1.x = o[4]; o1.y = o[5]; o1.z = o[6]; o1.w = o[7];
            dst[0] = o0; dst[1] = o1; }
        __syncthreads();
    }
}
__device__ __forceinline__ void final_pass(Frame& F, const float* const* in) {
    const bf16_t* X1B = (const bf16_t*)(F.ws + WS_X1B); float* OUT = (float*)F.dout; const bf16_t* YS = (const bf16_t*)(F.ws + WS_YS); const int* POS = (const int*)(F.ws + WS_POS); const float* g = in[29];
    for (int m0 = F.gw * 2; m0 < TT; m0 += F.NGW * 2) {
        u32x4 x[2][4], a[2][4], bq[2][4];
#pragma unroll
        for (int rr = 0; rr < 2; ++rr) { const int m = m0 + rr; const int p0 = POS[m * 2], p1 = POS[m * 2 + 1];
#pragma unroll
            for (int j = 0; j < 4; ++j) { const size_t c = 8 * F.lane + 512 * j;
                x[rr][j] = *(const u32x4*)(X1B + (size_t)m * 2048 + c); a[rr][j] = *(const u32x4*)(YS + (size_t)p0 * 2048 + c); bq[rr][j] = *(const u32x4*)(YS + (size_t)p1 * 2048 + c); } }
#pragma unroll
        for (int rr = 0; rr < 2; ++rr) { const int m = m0 + rr; float v[4][8]; float ss = 0.f;
#pragma unroll
            for (int j = 0; j < 4; ++j) { float xa[8], ya[8], yb[8]; unpack8(x[rr][j], xa); unpack8(a[rr][j], ya); unpack8(bq[rr][j], yb);
#pragma unroll
                for (int c = 0; c < 8; ++c) { v[j][c] = xa[c] + (ya[c] + yb[c]); ss += v[j][c] * v[j][c]; } }
            ss = wave_sum(ss); const float r = rsqrtf(ss * (1.0f / 2048.0f) + EPS);
#pragma unroll
            for (int j = 0; j < 4; ++j) { const size_t c = 8 * F.lane + 512 * j; const f32x4 g0 = *(const f32x4*)(g + c), g1 = *(const f32x4*)(g + c + 4);
                *(f32x4*)(OUT + (size_t)m * 2048 + c) = (f32x4){v[j][0] * r * g0.x, v[j][1] * r * g0.y, v[j][2] * r * g0.z, v[j][3] * r * g0.w};
                *(f32x4*)(OUT + (size_t)m * 2048 + c + 4) = (f32x4){v[j][4] * r * g1.x, v[j][5] * r * g1.y, v[j][6] * r * g1.z, v[j][7] * r * g1.w}; } }
    }
}
constexpr int NPHASE = 21;
struct Args { const float* in[30]; float* out; unsigned char* ws; int ph_lo, ph_hi; };

__device__ __forceinline__ bool fresh_lane(Frame& F) { int l = (int)__builtin_amdgcn_mbcnt_hi(~0u, __builtin_amdgcn_mbcnt_lo(~0u, 0u)); asm volatile("" : "+v"(l)); F.lane = l; F.tid = (F.wave << 6) | l; return true; }
__global__ void __launch_bounds__(512, 2) mk_fwd(Args args) {
    extern __shared__ __attribute__((aligned(16))) unsigned char lds_raw[];
    Frame F;
    F.lds = (LAS unsigned char*)lds_raw; F.lds_g = lds_raw;
    F.MISC = (volatile LAS unsigned*)(F.lds + MISC_OFF);
    F.tid = threadIdx.x; F.lane = F.tid & 63; F.wave = __builtin_amdgcn_readfirstlane(F.tid >> 6);
    F.G = gridDim.x; F.bid = blockIdx.x; F.gw = F.bid * 8 + F.wave; F.NGW = F.G * 8;
    F.ws = args.ws; F.dout = (unsigned char*)args.out; F.ctl = (unsigned*)(args.ws + WS_CTL);
    const float* const* in = args.in;
    for (int u = F.tid; u < (LDS_BYTES - RING_BYTES) / 4; u += 512) ((LAS unsigned*)(F.lds + RING_BYTES))[u] = 0u;
    __syncthreads();
    const int lo = args.ph_lo, hi = args.ph_hi;
    const bool fused = (hi - lo) > 1;
    XcdBarrier bar; bar.bar = F.ctl + CW_BAR; bar.x = 0; bar.st = nullptr;
    if (fused) bar = xcd_barrier_post(F.ctl + CW_BAR, F.MISC + 8, F.tid);
#ifndef ONLY_PHASE
#define ONLY_PHASE -1
#endif
#define IN(k) ((ONLY_PHASE < 0 || ONLY_PHASE == (k)) && lo <= (k) && (k) < hi && fresh_lane(F))
#ifndef DUP_MASK
#define DUP_MASK 0
#endif
#define DUP_BEGIN(k) _Pragma("unroll") for (int rep_ = 0; rep_ < 1 + ((DUP_MASK >> (k)) & 1); ++rep_) { if (rep_) { xcd_barrier(bar, F.tid); fresh_lane(F); }
#define DUP_END }
#define SEAM(k) do { if ((ONLY_PHASE < 0 || ONLY_PHASE == (k) + 1) && lo <= (k) + 1 && (k) + 1 < hi) xcd_barrier(bar, F.tid); } while (0)
    const int G = F.G, c = F.bid;
    bf16_t* const HBF = (bf16_t*)(F.dout + DO_HBF);
    bf16_t* const WINT = (bf16_t*)(F.ws + WS_WINT);
    const bf16_t* const HBF8 = (const bf16_t*)(F.ws + WS_HBF8);
    const bf16_t* const WG8 = (const bf16_t*)(WINT + (size_t)11264 * 2048);

    if (IN(0)) { DUP_BEGIN(0) p0_prologue(F, in); DUP_END SEAM(0); }

    if (IN(1)) { DUP_BEGIN(1)
        if (F.bid < 8) ml0_seq(F, in, F.bid);
        pg8::SchedPA S{HBF, WINT, G, c};
        pg8::EpiPA E{(bf16_t*)(F.ws + WS_MQK), (bf16_t*)(F.ws + WS_MLO), (bf16_t*)(F.ws + WS_XQ), (bf16_t*)(F.ws + WS_VC)};
        pg8::gemm_phase(F.lds, 2048, 2048, 2048, S, E, F.tid);
        DUP_END SEAM(1);
    }
    if (IN(2)) { DUP_BEGIN(2)
        pg8::SchedMem S{(const bf16_t*)(F.ws + WS_MEMN), (const bf16_t*)(F.ws + WS_WMEMT), G, c};
        pg8::EpiMem E{(bf16_t*)(F.ws + WS_MK), (bf16_t*)(F.ws + WS_MVT)};
        pg8::gemm_phase(F.lds, 2048, 2048, 2048, S, E, F.tid);
        ml1_conv(F, in);
        DUP_END SEAM(2);
    }
    if (IN(3)) { DUP_BEGIN(3)
#ifndef SUB
#define SUB 7
#endif
        if (SUB & 1) { pg8::SchedHG S{(const bf16_t*)(F.ws + WS_Q), (const bf16_t*)(F.ws + WS_KW), (size_t)TT * 256, 65536, (size_t)TT * 256, 65536, G, c};
          pg8::EpiW E{(bf16_t*)(F.ws + WS_WQ), (const float*)(F.ws + WS_SCRS)};
          pg8::gemm_phase(F.lds, 256, 256, 256, S, E, F.tid); }
        if (SUB & 2) { pg8::SchedHG S{(const bf16_t*)(F.ws + WS_VC), (const bf16_t*)(F.ws + WS_KWT), (size_t)128 * 256 * 512, (size_t)256 * 512, (size_t)128 * 65536, 65536, G, c};
          pg8::EpiB16Tile E{(bf16_t*)(F.ws + WS_U), 65536, 0, (size_t)128 * 65536, 256, 1.0f};
          pg8::gemm_phase(F.lds, 512, 256, 256, S, E, F.tid); }
        if (SUB & 4) { pg8::SchedXA S{(const bf16_t*)(F.ws + WS_XQ), (const bf16_t*)(F.ws + WS_MK), G, c};
          pg8::EpiB16Tile E{(bf16_t*)(F.ws + WS_XS), 65536, 0, (size_t)TT * 256, 256, 0.0625f};
          pg8::gemm_phase(F.lds, 256, 256, 256, S, E, F.tid); }
        if (F.bid < 8) nscan_seq(F, F.bid);
        DUP_END SEAM(3);
    }
    if (IN(4)) { DUP_BEGIN(4) cscan(F); denpass(F); xsoftmax(F); DUP_END SEAM(4); }
    if (IN(5)) { DUP_BEGIN(5)
        { pg8::SchedHG S{(const bf16_t*)(F.ws + WS_WQ), (const bf16_t*)(F.ws + WS_VC), (size_t)TT * 512, (size_t)256 * 512, (size_t)128 * 256 * 512, (size_t)256 * 512, G, c};
          pg8::EpiH E{(bf16_t*)(F.dout + DO_HR), (const float*)(F.ws + WS_HDEN)};
          pg8::gemm_phase(F.lds, 512, 512, 512, S, E, F.tid); }
        { pg8::SchedXA S{(const bf16_t*)(F.ws + WS_XP), (const bf16_t*)(F.ws + WS_MVT), G, c};
          pg8::EpiXA E{(bf16_t*)(F.dout + DO_XA)};
          pg8::gemm_phase(F.lds, 256, 256, 256, S, E, F.tid); }
        DUP_END SEAM(5);
    }
    if (IN(6)) { DUP_BEGIN(6)
        pg8::SchedDense S{HBF, WINT, 2048, 2048, 128, 24, G, c};
        pg8::EpiPB E{(bf16_t*)(F.ws + WS_DQ), (bf16_t*)(F.ws + WS_DK), (bf16_t*)(F.ws + WS_DV)};
        pg8::gemm_phase(F.lds, 2048, 2048, 2048, S, E, F.tid);
        hmnorm(F, in);
        DUP_END SEAM(6);
    }
    if (IN(7)) { DUP_BEGIN(7) normmax(F); DUP_END SEAM(7); }
    if (IN(8)) { DUP_BEGIN(8) attn_phase(F, rep_); DUP_END SEAM(8); }
    if (IN(9)) { DUP_BEGIN(9) dacombine(F, in); expert_convert(F, in); DUP_END SEAM(9); }
    if (IN(10)) { DUP_BEGIN(10)
        pg8::SchedDense S{HBF8, WG8, 1024, 1024, 128, 8, G, c};
        pg8::EpiGate E{(bf16_t*)(F.ws + WS_GT0), in[19], 1.0f / 32.0f};
        pg8::gemm_phase<pg8::EpiGate, pg8::SchedDense, true>(F.lds, 1024, 1024, 1024, S, E, F.tid);
        DUP_END SEAM(10);
    }
    if (IN(11)) { DUP_BEGIN(11)
        { pg8::SchedDense S{(const bf16_t*)(F.ws + WS_DA), (const bf16_t*)(F.ws + WS_WBDT), 2048, 2048, 128, 8, G, c};
          pg8::EpiBranch<true> E{(const bf16_t*)(F.ws + WS_GT0), (bf16_t*)(F.ws + WS_MERGED)};
          pg8::gemm_phase(F.lds, 2048, 2048, 2048, S, E, F.tid); }
        { pg8::SchedDense S{HBF8, WG8 + (size_t)2048 * 1024, 1024, 1024, 128, 8, G, c};
          pg8::EpiGate E{(bf16_t*)(F.ws + WS_GT1), in[19] + 2048, 1.0f / 32.0f};
          pg8::gemm_phase<pg8::EpiGate, pg8::SchedDense, true>(F.lds, 1024, 1024, 1024, S, E, F.tid); }
        DUP_END SEAM(11);
    }
    if (IN(12)) { DUP_BEGIN(12)
        { pg8::SchedDense S{(const bf16_t*)(F.dout + DO_HR), (const bf16_t*)(F.ws + WS_WBMT), 1024, 1024, 128, 8, G, c};
          pg8::EpiBranch<false> E{(const bf16_t*)(F.ws + WS_GT1), (bf16_t*)(F.ws + WS_MERGED)};
          pg8::gemm_phase(F.lds, 1024, 1024, 1024, S, E, F.tid); }
        { pg8::SchedDense S{HBF8, WG8 + (size_t)4096 * 1024, 1024, 1024, 128, 8, G, c};
          pg8::EpiGate E{(bf16_t*)(F.ws + WS_GT0), in[19] + 4096, 1.0f / 32.0f};
          pg8::gemm_phase<pg8::EpiGate, pg8::SchedDense, true>(F.lds, 1024, 1024, 1024, S, E, F.tid); }
        DUP_END SEAM(12);
    }
    if (IN(13)) { DUP_BEGIN(13)
        pg8::SchedDense S{(const bf16_t*)(F.dout + DO_XA), (const bf16_t*)(F.ws + WS_WBCT), 1024, 1024, 128, 8, G, c};
        pg8::EpiBranch<false> E{(const bf16_t*)(F.ws + WS_GT0), (bf16_t*)(F.ws + WS_MERGED)};
        pg8::gemm_phase(F.lds, 1024, 1024, 1024, S, E, F.tid);
        DUP_END SEAM(13);
    }
    if (IN(14)) { DUP_BEGIN(14)
        pg8::SchedDense S{(const bf16_t*)(F.ws + WS_MERGED), (const bf16_t*)(F.ws + WS_WOUTT), 2048, 2048, 128, 8, G, c};
        pg8::EpiOut E{in[0], (bf16_t*)(F.ws + WS_X1B), (float*)(F.ws + WS_RSS)};
        pg8::gemm_phase(F.lds, 2048, 2048, 2048, S, E, F.tid);
        DUP_END SEAM(14);
    }
    if (IN(15)) { DUP_BEGIN(15)
        pg8::SchedDense S{(const bf16_t*)(F.ws + WS_X1B), (const bf16_t*)(F.ws + WS_WRT), 2048, 2048, 128, 1, G, c};
        pg8::EpiF32Tile E{(float*)(F.ws + WS_LG), 65536, 0, 0, 256};
        pg8::gemm_phase(F.lds, 2048, 2048, 2048, S, E, F.tid);
        DUP_END SEAM(15);
    }
    if (IN(16)) { DUP_BEGIN(16) topk_pass(F, in); DUP_END SEAM(16); }
    if (IN(17)) { DUP_BEGIN(17) gather_pass(F, in); DUP_END SEAM(17); }
    if (IN(18)) { DUP_BEGIN(18)
        const int nrt = (int)__builtin_amdgcn_readfirstlane(F.ctl[CW_NRT]);
        pg8::SchedMoE S{(const bf16_t*)(F.ws + WS_XSORT), (const bf16_t*)(F.ws + WS_WGU), (const int*)(F.ws + WS_TILEE), nrt, 6, 1024, (size_t)GU_N * 1024, (size_t)256 * 1024, G, c};
        pg8::EpiGU E{F.ws + WS_HD};
        pg8::gemm_phase<pg8::EpiGU, pg8::SchedMoE, true>(F.lds, 1024, 1024, 1024, S, E, F.tid);
        DUP_END SEAM(18);
    }
    if (IN(19)) { DUP_BEGIN(19)
        const int nrt = (int)__builtin_amdgcn_readfirstlane(F.ctl[CW_NRT]);
        pg8::SchedMoE S{(const bf16_t*)(F.ws + WS_HD), (const bf16_t*)(F.ws + WS_WD), (const int*)(F.ws + WS_TILEE), nrt, 8, DEXP_P / 2, (size_t)2048 * (DEXP_P / 2), (size_t)256 * (DEXP_P / 2), G, c};
        pg8::EpiDown E{(bf16_t*)(F.ws + WS_YS), (const float*)(F.ws + WS_WROW)};
        pg8::gemm_phase<pg8::EpiDown, pg8::SchedMoE, true>(F.lds, DEXP_P / 2, DEXP_P / 2, DEXP_P / 2, S, E, F.tid);
        DUP_END SEAM(19);
    }
    if (IN(20)) { DUP_BEGIN(20) final_pass(F, in); DUP_END }
#undef IN
#undef SEAM
}

#ifndef MK_FUSED
#define MK_FUSED 1
#endif
extern "C" void kernel_launch(void* const* d_in, const int* in_sizes, int n_in, void* d_out, int out_size, void* d_ws, size_t ws_size, hipStream_t stream) {
    static int grid = 0;
    if (grid == 0) {
        if (n_in != 30 || out_size != TT * DM || ws_size < WS_END) { fprintf(stderr, "kernel_launch: unexpected shapes (n_in %d out %d ws %zu)\n", n_in, out_size, ws_size); grid = -1; return; }
        int dev = 0, cus = 0, per_cu = 0;
        if (hipGetDevice(&dev) != hipSuccess || hipDeviceGetAttribute(&cus, hipDeviceAttributeMultiprocessorCount, dev) != hipSuccess) { grid = -1; return; }
        if (hipFuncSetAttribute((const void*)mk_fwd, hipFuncAttributeMaxDynamicSharedMemorySize, LDS_BYTES) != hipSuccess) { fprintf(stderr, "kernel_launch: hipFuncSetAttribute failed\n"); grid = -1; return; }
        if (hipOccupancyMaxActiveBlocksPerMultiprocessor(&per_cu, (const void*)mk_fwd, 512, LDS_BYTES) != hipSuccess || per_cu < 1) fprintf(stderr, "kernel_launch: occupancy query says %d\n", per_cu);
        (void)hipGetLastError();
        grid = cus;
    }
    if (grid < 0) return;
    (void)hipMemsetAsync((char*)d_ws + WS_CTL, 0, CTL_ZERO_BYTES, stream);
    Args a{};
    for (int i = 0; i < 30; ++i) a.in[i] = (const float*)d_in[i];
    a.out = (float*)d_out; a.ws = (unsigned char*)d_ws;
#if MK_FUSED
    a.ph_lo = 0; a.ph_hi = NPHASE;
    hipLaunchKernelGGL(mk_fwd, dim3(grid), dim3(512), LDS_BYTES, stream, a);
#else
#ifndef PROBE_DUP
#define PROBE_DUP 0u
#endif
    for (int p = 0; p < NPHASE; ++p) { a.ph_lo = p; a.ph_hi = p + 1; hipLaunchKernelGGL(mk_fwd, dim3(grid), dim3(512), LDS_BYTES, stream, a);
        if ((PROBE_DUP >> p) & 1u) {
            if (p == 8) (void)hipMemsetAsync((char*)d_ws + WS_CTL + CW_AHEAD * 4, 0, 256, stream);
            hipLaunchKernelGGL(mk_fwd, dim3(grid), dim3(512), LDS_BYTES, stream, a); } }
#endif
}
```

```cpp
#include <hip/hip_runtime.h>
#include <hip/hip_bf16.h>
#include <cstdio>
#include <cstdint>

#define LAS __attribute__((address_space(3)))
#define GAS __attribute__((address_space(1)))
typedef unsigned short bf16_t;
typedef short bf16x8 __attribute__((ext_vector_type(8)));
typedef short s16x4 __attribute__((ext_vector_type(4)));
typedef float f32x2 __attribute__((ext_vector_type(2)));
typedef float f32x4 __attribute__((ext_vector_type(4)));
typedef float f32x16 __attribute__((ext_vector_type(16)));
typedef unsigned u32x2 __attribute__((ext_vector_type(2)));
typedef unsigned u32x4 __attribute__((ext_vector_type(4)));

constexpr int NB = 2, SEQ = 16384, TT = NB * SEQ, DM = 2048, MEML = 256;
constexpr int DIN = 17416;
constexpr float EPS = 1e-6f;
constexpr int NEXP = 32, DEXP = 704, DEXP_P = 768, GU_N = 1536;
constexpr int MAX_RT = 288;

constexpr size_t MiB = 1u << 20;
constexpr size_t WS_CTL = 0, CTL_ZERO_BYTES = 1 * MiB;
constexpr size_t WS_MLG = 1 * MiB;
constexpr size_t WS_SCKW = 2 * MiB, WS_SCRS = 2 * MiB + 512 * 1024, WS_SCIT = 3 * MiB, WS_SCED = 3 * MiB + 512 * 1024;
constexpr size_t WS_HDEN = 4 * MiB;
constexpr size_t WS_KN = 13 * MiB;
constexpr size_t WS_NP = 5 * MiB + 512 * 1024;
constexpr size_t WS_DEC = 6 * MiB;
constexpr size_t WS_MEMN = 7 * MiB;
constexpr size_t WS_MK = 9 * MiB;
constexpr size_t WS_MVT = 10 * MiB;
constexpr size_t WS_TOKE = 11 * MiB;
constexpr size_t WS_TOKW = 11 * MiB + 256 * 1024;
constexpr size_t WS_POS = 11 * MiB + 512 * 1024;
constexpr size_t WS_WROW = 12 * MiB;
constexpr size_t WS_TILEE = 12 * MiB + 512 * 1024;
constexpr size_t WS_RT = 12 * MiB + 768 * 1024;
constexpr size_t WS_WINT = 16 * MiB;
constexpr size_t WS_WMEMT = 84 * MiB;
constexpr size_t WS_WBDT = 92 * MiB;
constexpr size_t WS_WBMT = 100 * MiB;
constexpr size_t WS_WBCT = 104 * MiB;
constexpr size_t WS_WOUTT = 108 * MiB;
constexpr size_t WS_WRT = 116 * MiB;
constexpr size_t WS_MQK = 120 * MiB;
constexpr size_t WS_U = 120 * MiB;
constexpr size_t WS_XQ = 312 * MiB;
constexpr size_t WS_XP = 312 * MiB;
constexpr size_t WS_VC = 376 * MiB;
constexpr size_t WS_Q = 504 * MiB;
constexpr size_t WS_WQ = 568 * MiB;
constexpr size_t WS_KW = 696 * MiB;
constexpr size_t WS_KWT = 760 * MiB;
constexpr size_t WS_XP2 = 824 * MiB;
constexpr size_t WS_XS = 824 * MiB;
constexpr size_t WS_MLO = 952 * MiB;
constexpr size_t WS_DQ = 120 * MiB, WS_DK = 248 * MiB, WS_DV = 376 * MiB;
constexpr size_t WS_O = 504 * MiB;
constexpr size_t WS_DA = 760 * MiB;
constexpr size_t WS_WGU = 120 * MiB;
constexpr size_t WS_WD = 216 * MiB;
constexpr size_t WS_HBF8 = 264 * MiB;
constexpr size_t WS_GT0 = 408 * MiB, WS_GT1 = 536 * MiB;
constexpr size_t WS_MERGED = 888 * MiB;
constexpr size_t WS_X1B = 264 * MiB;
constexpr size_t WS_RSS = 1016 * MiB;
constexpr size_t WS_LG = 536 * MiB;
constexpr size_t WS_XSORT = 568 * MiB;
constexpr size_t WS_HD = 856 * MiB;
constexpr size_t WS_YS = 568 * MiB;
constexpr size_t WS_END = 1024 * MiB;
constexpr size_t DO_HBF = 0, DO_HR = 128 * MiB, DO_XA = 192 * MiB;

constexpr int CW_BAR = 4096;
constexpr int CW_AHEAD = 8192;
constexpr int CW_QKMAX = 8256;
constexpr int CW_KMX = 8272;
constexpr int CW_QB2 = 16384;
constexpr int CW_ND = 16384 + 2048;
constexpr int CW_ECNT = 8320;
constexpr int CW_ECUR = 8384;
constexpr int CW_LAM = 8448;
constexpr int CW_NRT = 8449;

constexpr int RING_BYTES = 131072;
constexpr int MISC_OFF = RING_BYTES + 320;
constexpr int LDS_BYTES = 147456;

#define LDS_WAIT() asm volatile("s_waitcnt lgkmcnt(0)" ::: "memory")
#define VM_WAIT() asm volatile("s_waitcnt vmcnt(0)" ::: "memory")
#define RLX_AGENT __ATOMIC_RELAXED, __HIP_MEMORY_SCOPE_AGENT

__device__ __forceinline__ unsigned cvtpk(float lo, float hi) { unsigned r; asm volatile("v_cvt_pk_bf16_f32 %0, %1, %2" : "=v"(r) : "v"(lo), "v"(hi)); return r; }
__device__ __forceinline__ unsigned pk4_fp8(float a, float b, float c, float d) { int w = 0; w = __builtin_amdgcn_cvt_pk_fp8_f32(a, b, w, false); w = __builtin_amdgcn_cvt_pk_fp8_f32(c, d, w, true); return (unsigned)w; }
__device__ __forceinline__ float bf2f(unsigned short b) { return __uint_as_float(((unsigned)b) << 16); }
__device__ __forceinline__ float bflo(unsigned w) { return __uint_as_float(w << 16); }
__device__ __forceinline__ float bfhi(unsigned w) { return __uint_as_float(w & 0xffff0000u); }
__device__ __forceinline__ float wave_sum(float v) {
#pragma unroll
    for (int o = 1; o < 64; o <<= 1) v += __shfl_xor(v, o);
    return v;
}
__device__ __forceinline__ float wave_max(float v) {
#pragma unroll
    for (int o = 1; o < 64; o <<= 1) v = fmaxf(v, __shfl_xor(v, o));
    return v;
}
__device__ __forceinline__ float sigmoidf_(float x) { return 1.0f / (1.0f + __expf(-x)); }

#define XB_TMO      128
#define XB_XCNT(j)  (256  + 64 * (j))
#define XB_XSUB(j)  (1280 + 64 * (j))
#define XB_XGEN(j)  (2304 + 64 * (j))
#define XB_TOP      3328
#define XB_TOPGEN   3392
#define XCD_BAR_WORDS 3456
#define XB_SPIN_CAP (1u << 18)

__device__ __forceinline__ unsigned xb_ld(unsigned* p)              { return __hip_atomic_load(p, __ATOMIC_RELAXED, __HIP_MEMORY_SCOPE_AGENT); }
__device__ __forceinline__ unsigned xb_add(unsigned* p, unsigned v) { return __hip_atomic_fetch_add(p, v, __ATOMIC_RELAXED, __HIP_MEMORY_SCOPE_AGENT); }
__device__ __forceinline__ unsigned xb_xcc_id() { return (unsigned)__builtin_amdgcn_s_getreg((3 << 11) | 20) & 0xFu; }
#define XB_SPIN(cond, bar) do { unsigned _sp = 0; while (cond) { __builtin_amdgcn_s_sleep(1); \
    if ((++_sp & 255u) == 0u) { if (xb_ld(&(bar)[XB_TMO])) break; if (_sp > XB_SPIN_CAP) { atomicAdd(&(bar)[XB_TMO], 1u); break; } } } } while (0)

struct XcdBarrier { unsigned* bar; unsigned x; volatile LAS unsigned* st; };

__device__ __forceinline__ XcdBarrier xcd_barrier_post(unsigned* bar, volatile LAS unsigned* st, const int tid) {
    XcdBarrier b; b.bar = bar; b.x = xb_xcc_id(); b.st = st;
    if (tid == 0) (void)xb_add(&bar[XB_XCNT(b.x)], 1u);
    return b;
}
__device__ __forceinline__ void xcd_barrier_complete(unsigned* bar, unsigned x, unsigned& nloc, unsigned& nx) {
    const unsigned G = gridDim.x * gridDim.y * gridDim.z;
    unsigned sum, cnt, mine, sp = 0u;
    for (;;) {
        sum = 0u; cnt = 0u; mine = 0u;
#pragma unroll
        for (unsigned j = 0; j < 16; ++j) { const unsigned c = xb_ld(&bar[XB_XCNT(j)]); sum += c; cnt += (c > 0u) ? 1u : 0u; mine = (j == x) ? c : mine; }
        if (sum == G) break;
        __builtin_amdgcn_s_sleep(1);
        if ((++sp & 255u) == 0u) { if (xb_ld(&bar[XB_TMO])) break; if (sp > XB_SPIN_CAP) { atomicAdd(&bar[XB_TMO], 1u); break; } }
    }
    nloc = mine > 0u ? mine : 1u; nx = cnt > 0u ? cnt : 1u;
}
__device__ __forceinline__ void xcd_barrier(const XcdBarrier& b, const int tid) {
    asm volatile("s_waitcnt vmcnt(0)" ::: "memory");
    __syncthreads();
    if (tid == 0) {
        unsigned* bar = b.bar;
        __builtin_amdgcn_s_waitcnt(0);
        unsigned nloc = b.st[0], nx = b.st[1];
        if (nloc == 0u) { xcd_barrier_complete(bar, b.x, nloc, nx); b.st[0] = nloc; b.st[1] = nx; }
        const unsigned old = xb_add(&bar[XB_XSUB(b.x)], 1u);
        const unsigned gen = old / nloc;
        if (old + 1u == (gen + 1u) * nloc) {
            __builtin_amdgcn_fence(__ATOMIC_RELEASE, "agent");
            asm volatile("s_waitcnt vmcnt(0)" ::: "memory");
            const unsigned og = xb_add(&bar[XB_TOP], 1u);
            const unsigned tg = og / nx;
            if (og + 1u == (tg + 1u) * nx) xb_add(&bar[XB_TOPGEN], 1u);
            else XB_SPIN(xb_ld(&bar[XB_TOPGEN]) == tg, bar);
            __builtin_amdgcn_fence(__ATOMIC_ACQUIRE, "agent");
            xb_add(&bar[XB_XGEN(b.x)], 1u);
            asm volatile("s_waitcnt vmcnt(0)" ::: "memory");
        } else {
            XB_SPIN(xb_ld(&bar[XB_XGEN(b.x)]) == gen, bar);
            __builtin_amdgcn_fence(__ATOMIC_ACQUIRE, "agent");
            asm volatile("s_waitcnt vmcnt(0)" ::: "memory");
        }
    }
    __syncthreads();
}

namespace pg8 {
constexpr int BM = 256, BK = 64, HALF = 128, HTB = HALF * BK * 2, STAGE_BYTES = 8 * HTB, NXCD = 8, WGM = 8;
__host__ __device__ __forceinline__ int lds_byte(int r, int c) { const int st = (r >> 4) * 2 + (c >> 5), rr = r & 15, cc = c & 31, ob = rr * 64 + cc * 2; return st * 1024 + (ob ^ (((ob >> 9) & 1) << 5)); }
__host__ __device__ __forceinline__ void stage_rc(int b, int& R, int& C) { const int st = b / 1024, sb = b % 1024, swz = sb ^ (((sb >> 9) & 1) << 5); R = (st >> 1) * 16 + swz / 64; C = (st & 1) * 32 + (swz % 64) / 2; }
__host__ __device__ __forceinline__ int perm32(int rho) { const int n = rho >> 4, i = rho & 15; return 8 * (i >> 2) + 4 * n + (i & 3); }

struct Unit { const bf16_t* A; const bf16_t* B; int pm, pn, aux; };

__device__ __forceinline__ void tile_order(int L, int nM, int nN, int& pm, int& pn) {
    const int nwg = nM * nN; int wgid = L;
    { const int q = nwg / NXCD, r = nwg % NXCD, xcd = wgid % NXCD, off = wgid / NXCD; wgid = (xcd < r ? xcd * (q + 1) : r * (q + 1) + (xcd - r) * q) + off; }
    const int nig = WGM * nN, gid = wgid / nig, fm = gid * WGM, gsz = (nM - fm) < WGM ? (nM - fm) : WGM;
    pm = fm + ((wgid % nig) % gsz); pn = (wgid % nig) / gsz;
}

typedef int i32x4 __attribute__((ext_vector_type(4)));
typedef int i32x8 __attribute__((ext_vector_type(8)));
__device__ __forceinline__ i32x8 cat8(const bf16x8 a, const bf16x8 b) { const i32x4 x = __builtin_bit_cast(i32x4, a), y = __builtin_bit_cast(i32x4, b); return __builtin_shufflevector(x, y, 0, 1, 2, 3, 4, 5, 6, 7); }
template <class Epi, class Sched, bool F8 = false>
__device__ __forceinline__ void gemm_phase(LAS unsigned char* lds, const int lda, const int ldb, const int K, const Sched& S, const Epi& E, const int tid) {
    const int wid = __builtin_amdgcn_readfirstlane(tid >> 6), lane = tid & 63, wr = wid >> 2, wc = wid & 3, fr = lane & 15, fq = lane >> 4;
    const int nt = K / BK;
    unsigned voffA[2], voffB[2];
#pragma unroll
    for (int i = 0; i < 2; ++i) { int R, C; stage_rc(tid * 16 + i * 8192, R, C); const int Rb = Epi::PERM ? ((R & ~31) + perm32(R & 31)) : R;
        voffA[i] = (unsigned)(R * lda + C) * 2u; voffB[i] = (unsigned)(Rb * ldb + C) * 2u; }
    const size_t kstep = (size_t)(BK * 2);
    const size_t hstepA = (size_t)HALF * lda * 2, hstepB = (size_t)HALF * ldb * 2;
    const unsigned ldsw = (unsigned)wid * 1024u;
    const int aoff = lds_byte(wr * 64 + fr, fq * 8), boff = lds_byte(wc * 32 + fr, fq * 8);
#define PG8_SA(b, h) (((b) * 2 + (h)) * HTB)
#define PG8_SB(b, h) ((4 + (b) * 2 + (h)) * HTB)
#define PG8_STAGE(bufoff, gbase, voff) do { _Pragma("unroll") for (int _i = 0; _i < 2; ++_i) \
        __builtin_amdgcn_global_load_lds((const unsigned*)((const char*)(gbase) + (voff)[_i]), (LAS unsigned*)(lds + (bufoff) + ldsw + _i * 8192), 16, 0, 0); } while (0)
#define PG8_LDA(dst, b, h) do { _Pragma("unroll") for (int m = 0; m < 4; ++m) { \
        if constexpr (F8) { const i32x4 lo_ = *(const LAS i32x4*)(lds + PG8_SA(b, h) + aoff + m * 2048), hi_ = *(const LAS i32x4*)(lds + PG8_SA(b, h) + aoff + m * 2048 + 1024); dst##8[m] = __builtin_shufflevector(lo_, hi_, 0, 1, 2, 3, 4, 5, 6, 7); } \
        else { _Pragma("unroll") for (int k = 0; k < 2; ++k) dst[m][k] = *(const LAS bf16x8*)(lds + PG8_SA(b, h) + aoff + m * 2048 + k * 1024); } } } while (0)
#define PG8_LDB(dst, b, h) do { _Pragma("unroll") for (int n = 0; n < 2; ++n) { \
        if constexpr (F8) { const i32x4 lo_ = *(const LAS i32x4*)(lds + PG8_SB(b, h) + boff + n * 2048), hi_ = *(const LAS i32x4*)(lds + PG8_SB(b, h) + boff + n * 2048 + 1024); dst##8[n] = __builtin_shufflevector(lo_, hi_, 0, 1, 2, 3, 4, 5, 6, 7); } \
        else { _Pragma("unroll") for (int k = 0; k < 2; ++k) dst[n][k] = *(const LAS bf16x8*)(lds + PG8_SB(b, h) + boff + n * 2048 + k * 1024); } } } while (0)
#define PG8_MMA(ai, bj, At, Bt) do { __builtin_amdgcn_s_setprio(1); _Pragma("unroll") for (int m = 0; m < 4; ++m) _Pragma("unroll") for (int n = 0; n < 2; ++n) { \
        if constexpr (F8) asm volatile("v_mfma_f32_16x16x128_f8f6f4 %0, %1, %2, %0" : "+v"(acc[ai][bj][m][n]) : "v"(Bt##8[n]), "v"(At##8[m])); \
        else { _Pragma("unroll") for (int k = 0; k < 2; ++k) acc[ai][bj][m][n] = __builtin_amdgcn_mfma_f32_16x16x32_bf16(Bt[n][k], At[m][k], acc[ai][bj][m][n], 0, 0, 0); } } \
        __builtin_amdgcn_s_setprio(0); } while (0)
#define PG8_WAIT_V(n) asm volatile("s_waitcnt vmcnt(" #n ")" ::: "memory")
#define PG8_WAIT_L(n) asm volatile("s_waitcnt lgkmcnt(" #n ")" ::: "memory")
#define PG8_BAR __builtin_amdgcn_s_barrier()
#define PG8_SCHED __builtin_amdgcn_sched_barrier(0)
    Unit cur, nxt; int ui = 0;
    if (!S.next(0, cur)) return;
    f32x4 acc[2][2][4][2];
#pragma unroll
    for (int a = 0; a < 2; ++a)
#pragma unroll
        for (int b = 0; b < 2; ++b)
#pragma unroll
            for (int m = 0; m < 4; ++m)
#pragma unroll
                for (int n = 0; n < 2; ++n) acc[a][b][m][n] = (f32x4){0.f, 0.f, 0.f, 0.f};
    bf16x8 At[4][2], B0[2][2], B1[2][2]; i32x8 At8[4], B08[2], B18[2];
    const char* cA = (const char*)cur.A; const char* cB = (const char*)cur.B;
    PG8_STAGE(PG8_SB(0, 0), cB, voffB); PG8_STAGE(PG8_SA(0, 0), cA, voffA); PG8_STAGE(PG8_SB(0, 1), cB + hstepB, voffB); PG8_STAGE(PG8_SA(0, 1), cA + hstepA, voffA);
    if (wr == 1) PG8_BAR;
    PG8_WAIT_V(4); PG8_BAR;
    PG8_STAGE(PG8_SB(1, 0), cB + kstep, voffB); PG8_STAGE(PG8_SA(1, 0), cA + kstep, voffA); PG8_STAGE(PG8_SB(1, 1), cB + hstepB + kstep, voffB);
    PG8_WAIT_V(6); PG8_BAR;
    for (;;) {
        const bool has_next = S.next(ui + 1, nxt);
        const char* nA = has_next ? (const char*)nxt.A : cA; const char* nB = has_next ? (const char*)nxt.B : cB;
#pragma nounroll
        for (int t = 0; t < nt; t += 2) {
            const bool last = (t == nt - 2);
            const char* a1 = cA + (size_t)(t + 1) * kstep;
            const char* a2 = last ? nA : cA + (size_t)(t + 2) * kstep; const char* b2 = last ? nB : cB + (size_t)(t + 2) * kstep;
            const char* a3 = a2 + kstep; const char* b3 = b2 + kstep;
            PG8_LDB(B0, 0, 0); PG8_SCHED; PG8_LDA(At, 0, 0); PG8_STAGE(PG8_SA(1, 1), a1 + hstepA, voffA);
            PG8_WAIT_L(8); PG8_BAR; PG8_WAIT_L(0); PG8_MMA(0, 0, At, B0); PG8_BAR; PG8_SCHED;
            PG8_LDB(B1, 0, 1); PG8_STAGE(PG8_SB(0, 0), b2, voffB);
            PG8_BAR; PG8_WAIT_L(0); PG8_MMA(0, 1, At, B1); PG8_BAR;
            PG8_LDA(At, 0, 1); PG8_STAGE(PG8_SA(0, 0), a2, voffA);
            PG8_BAR; PG8_WAIT_L(0); PG8_MMA(1, 0, At, B0); PG8_BAR; PG8_SCHED;
            PG8_STAGE(PG8_SB(0, 1), b2 + hstepB, voffB);
            PG8_WAIT_V(6); PG8_BAR; PG8_MMA(1, 1, At, B1); PG8_BAR;
            PG8_LDB(B0, 1, 0); PG8_SCHED; PG8_LDA(At, 1, 0); PG8_STAGE(PG8_SA(0, 1), a2 + hstepA, voffA);
            PG8_WAIT_L(8); PG8_BAR; PG8_WAIT_L(0); PG8_MMA(0, 0, At, B0); PG8_BAR; PG8_SCHED;
            PG8_LDB(B1, 1, 1); PG8_STAGE(PG8_SB(1, 0), b3, voffB);
            PG8_BAR; PG8_WAIT_L(0); PG8_MMA(0, 1, At, B1); PG8_BAR;
            PG8_LDA(At, 1, 1); PG8_STAGE(PG8_SA(1, 0), a3, voffA);
            PG8_BAR; PG8_WAIT_L(0); PG8_MMA(1, 0, At, B0); PG8_BAR; PG8_SCHED;
            PG8_STAGE(PG8_SB(1, 1), b3 + hstepB, voffB);
            PG8_WAIT_V(6); PG8_BAR; PG8_MMA(1, 1, At, B1); PG8_BAR;
        }
        if constexpr (F8) asm volatile("s_nop 15\n\ts_nop 15" ::: "memory");
        { int l_e = (int)__builtin_amdgcn_mbcnt_hi(~0u, __builtin_amdgcn_mbcnt_lo(~0u, 0u)); asm volatile("" : "+v"(l_e)); int fr_e = l_e & 15, fq_e = l_e >> 4;
          E(acc, cur, wr, wc, fr_e, fq_e); }
        if (!has_next) break;
#pragma unroll
        for (int a = 0; a < 2; ++a)
#pragma unroll
            for (int b = 0; b < 2; ++b)
#pragma unroll
                for (int m = 0; m < 4; ++m)
#pragma unroll
                    for (int n = 0; n < 2; ++n) acc[a][b][m][n] = (f32x4){0.f, 0.f, 0.f, 0.f};
        cur = nxt; cA = nA; cB = nB; ++ui;
    }
    PG8_WAIT_V(0);
    if (wr == 0) PG8_BAR;
    PG8_BAR;
#undef PG8_SA
#undef PG8_SB
#undef PG8_STAGE
#undef PG8_LDA
#undef PG8_LDB
#undef PG8_MMA
#undef PG8_WAIT_V
#undef PG8_WAIT_L
#undef PG8_BAR
#undef PG8_SCHED
}
}
namespace pg8 {
typedef f32x4 Acc[2][2][4][2];
__device__ __forceinline__ void st_bf16x8(bf16_t* p, f32x4 v0, f32x4 v1) {
    u32x4 w; w.x = cvtpk(v0[0], v0[1]); w.y = cvtpk(v0[2], v0[3]); w.z = cvtpk(v1[0], v1[1]); w.w = cvtpk(v1[2], v1[3]);
    *(u32x4*)p = w;
}
#define EPI_BF16_LOOP(...) \
    _Pragma("unroll") for (int ai = 0; ai < 2; ++ai) \
    _Pragma("unroll") for (int m = 0; m < 4; ++m) { int r = ai * 128 + wr * 64 + m * 16 + fr; asm volatile("" : "+v"(r)); \
    _Pragma("unroll") for (int bj = 0; bj < 2; ++bj) { f32x4 v0 = acc[ai][bj][m][0], v1 = acc[ai][bj][m][1]; const int colh = wc * 32 + 8 * fq; (void)colh; __VA_ARGS__ } }
#define EPI_F32_LOOP(...) \
    _Pragma("unroll") for (int ai = 0; ai < 2; ++ai) \
    _Pragma("unroll") for (int m = 0; m < 4; ++m) { int r = ai * 128 + wr * 64 + m * 16 + fr; asm volatile("" : "+v"(r)); \
    _Pragma("unroll") for (int bj = 0; bj < 2; ++bj) \
    _Pragma("unroll") for (int n = 0; n < 2; ++n) { f32x4 v = acc[ai][bj][m][n]; const int col = bj * 128 + wc * 32 + n * 16 + 4 * fq; (void)col; __VA_ARGS__ } }

struct EpiPA {
    static constexpr bool PERM = true;
    bf16_t *MQK, *MLO, *XQ, *VC;
    __device__ __forceinline__ void operator()(const Acc& acc, const Unit& u, int wr, int wc, int fr, int fq) const {
        bf16_t* base; size_t ldc;
        if (u.aux == 0) {
            if (u.pn < 8)       { base = MQK + (size_t)u.pm * 256 * 2048 + u.pn * 256; ldc = 2048; }
            else if (u.pn < 12) { base = MLO + (size_t)u.pm * 256 * 1024 + (u.pn - 8) * 256; ldc = 1024; }
            else                { base = XQ + ((size_t)(u.pn - 12) * TT + (size_t)u.pm * 256) * 256; ldc = 256; }
        } else                  { base = VC + ((size_t)(u.pm * 128 + u.pn) * 256) * 512; ldc = 512; }
        EPI_BF16_LOOP( st_bf16x8(base + (size_t)r * ldc + bj * 128 + colh, v0, v1); )
    }
};
struct EpiMem {
    static constexpr bool PERM = true;
    bf16_t *MK, *MVT;
    __device__ __forceinline__ void operator()(const Acc& acc, const Unit& u, int wr, int wc, int fr, int fq) const {
        bf16_t* base = (u.aux == 0) ? MK + (size_t)(u.pm * 4 + u.pn) * 65536 : MVT + (size_t)(u.pn * 4 + u.pm) * 65536;
        EPI_BF16_LOOP( st_bf16x8(base + (size_t)r * 256 + bj * 128 + colh, v0, v1); )
    }
};
struct EpiPB {
    static constexpr bool PERM = true;
    bf16_t *DQ, *DK, *DV;
    __device__ __forceinline__ void operator()(const Acc& acc, const Unit& u, int wr, int wc, int fr, int fq) const {
        const int which = u.pn >> 3, c0 = (u.pn & 7) * 2;
        bf16_t* buf = DQ + (size_t)which * ((WS_DK - WS_DQ) / 2);
        EPI_BF16_LOOP( st_bf16x8(buf + ((size_t)(c0 + bj) * TT + (size_t)u.pm * 256 + r) * 128 + colh, v0, v1); )
    }
};
struct EpiF32Tile {
    static constexpr bool PERM = false;
    float* C; size_t off_pm, off_pn, off_aux; int ldc;
    __device__ __forceinline__ void operator()(const Acc& acc, const Unit& u, int wr, int wc, int fr, int fq) const {
        float* base = C + (size_t)u.pm * off_pm + (size_t)u.pn * off_pn + (size_t)u.aux * off_aux;
        EPI_F32_LOOP( *(f32x4*)(base + (size_t)r * ldc + col) = v; )
    }
};
struct EpiB16Tile {
    static constexpr bool PERM = true;
    bf16_t* C; size_t off_pm, off_pn, off_aux; int ldc; float sc;
    __device__ __forceinline__ void operator()(const Acc& acc, const Unit& u, int wr, int wc, int fr, int fq) const {
        bf16_t* base = C + (size_t)u.pm * off_pm + (size_t)u.pn * off_pn + (size_t)u.aux * off_aux;
        EPI_BF16_LOOP( v0 *= sc; v1 *= sc; st_bf16x8(base + (size_t)r * ldc + bj * 128 + colh, v0, v1); )
    }
};
constexpr int EPI_TBL_OFF = RING_BYTES + 4096;
#define EPI_XBAR() do { asm volatile("s_waitcnt lgkmcnt(0)" ::: "memory"); __builtin_amdgcn_s_barrier(); asm volatile("" ::: "memory"); } while (0)
struct EpiXSoft {
    static constexpr bool PERM = true;
    bf16_t* XP; LAS float* tbl;
    __device__ __forceinline__ void operator()(const Acc& acc, const Unit& u, int wr, int wc, int fr, int fq) const {
        LAS float* TM = tbl; LAS float* TS = tbl + 1024;
        const int colh = wc * 32 + 8 * fq;
        float mloc[2][4];
#pragma unroll
        for (int ai = 0; ai < 2; ++ai)
#pragma unroll
            for (int m = 0; m < 4; ++m) { const int r = ai * 128 + wr * 64 + m * 16 + fr; float mx = -__builtin_inff();
#pragma unroll
                for (int bj = 0; bj < 2; ++bj)
#pragma unroll
                    for (int n = 0; n < 2; ++n) { const f32x4 v = acc[ai][bj][m][n]; mx = fmaxf(mx, fmaxf(fmaxf(v[0], v[1]), fmaxf(v[2], v[3]))); }
                mx = fmaxf(mx, __shfl_xor(mx, 16)); mx = fmaxf(mx, __shfl_xor(mx, 32));
                if (fq == 0) TM[r * 4 + wc] = mx; mloc[ai][m] = mx; }
        EPI_XBAR();
        f32x4 ev[2][4][2][2];
#pragma unroll
        for (int ai = 0; ai < 2; ++ai)
#pragma unroll
            for (int m = 0; m < 4; ++m) { const int r = ai * 128 + wr * 64 + m * 16 + fr;
                const f32x4 t4 = *(const LAS f32x4*)(TM + r * 4); const float mx = fmaxf(fmaxf(t4[0], t4[1]), fmaxf(t4[2], t4[3])) * 0.0625f; float s = 0.f;
#pragma unroll
                for (int bj = 0; bj < 2; ++bj)
#pragma unroll
                    for (int n = 0; n < 2; ++n) { f32x4 v = acc[ai][bj][m][n];
#pragma unroll
                        for (int j = 0; j < 4; ++j) { v[j] = __expf(v[j] * 0.0625f - mx); s += v[j]; }
                        ev[ai][m][bj][n] = v; }
                s += __shfl_xor(s, 16); s += __shfl_xor(s, 32);
                if (fq == 0) TS[r * 4 + wc] = s; }
        EPI_XBAR();
        const size_t t0 = (size_t)u.aux * TT + (size_t)u.pm * 256;
#pragma unroll
        for (int ai = 0; ai < 2; ++ai)
#pragma unroll
            for (int m = 0; m < 4; ++m) { const int r = ai * 128 + wr * 64 + m * 16 + fr;
                const f32x4 t4 = *(const LAS f32x4*)(TS + r * 4); const float inv = 1.0f / ((t4[0] + t4[1]) + (t4[2] + t4[3]));
#pragma unroll
                for (int bj = 0; bj < 2; ++bj) st_bf16x8(XP + (t0 + r) * 256 + bj * 128 + colh, ev[ai][m][bj][0] * inv, ev[ai][m][bj][1] * inv); }
    }
};
struct EpiHNorm {
    static constexpr bool PERM = true;
    bf16_t* HM; const float* HDEN; const bf16_t* MLO; const float* G; LAS float* tbl;
    __device__ __forceinline__ void operator()(const Acc& acc, const Unit& u, int wr, int wc, int fr, int fq) const {
        LAS float* TQ = tbl;
        const size_t t0 = (size_t)u.pm * 256; const int colh = wc * 32 + 8 * fq;
        float inv[2][4];
#pragma unroll
        for (int ai = 0; ai < 2; ++ai)
#pragma unroll
            for (int m = 0; m < 4; ++m) { const int r = ai * 128 + wr * 64 + m * 16 + fr; const float iv = 1.0f / HDEN[(size_t)u.aux * TT + t0 + r]; inv[ai][m] = iv; float q = 0.f;
#pragma unroll
                for (int bj = 0; bj < 2; ++bj)
#pragma unroll
                    for (int n = 0; n < 2; ++n) { const f32x4 v = acc[ai][bj][m][n] * iv; q += (v[0] * v[0] + v[1] * v[1]) + (v[2] * v[2] + v[3] * v[3]); }
                q += __shfl_xor(q, 16); q += __shfl_xor(q, 32);
                if (fq == 0) TQ[r * 4 + wc] = q; }
        EPI_XBAR();
#pragma unroll
        for (int ai = 0; ai < 2; ++ai)
#pragma unroll
            for (int m = 0; m < 4; ++m) { const int r = ai * 128 + wr * 64 + m * 16 + fr;
                const f32x4 t4 = *(const LAS f32x4*)(TQ + r * 4); const float rs = rsqrtf(((t4[0] + t4[1]) + (t4[2] + t4[3])) * (1.0f / 256.0f) + EPS) * inv[ai][m];
#pragma unroll
                for (int bj = 0; bj < 2; ++bj) { const size_t o = (t0 + r) * 1024 + u.aux * 256 + bj * 128 + colh; const u32x4 og = *(const u32x4*)(MLO + o);
                    const f32x4 g0 = *(const f32x4*)(G + u.aux * 256 + bj * 128 + colh), g1 = *(const f32x4*)(G + u.aux * 256 + bj * 128 + colh + 4);
                    f32x4 v0 = acc[ai][bj][m][0] * rs, v1 = acc[ai][bj][m][1] * rs;
                    v0[0] *= sigmoidf_(bflo(og.x)) * g0[0]; v0[1] *= sigmoidf_(bfhi(og.x)) * g0[1]; v0[2] *= sigmoidf_(bflo(og.y)) * g0[2]; v0[3] *= sigmoidf_(bfhi(og.y)) * g0[3];
                    v1[0] *= sigmoidf_(bflo(og.z)) * g1[0]; v1[1] *= sigmoidf_(bfhi(og.z)) * g1[1]; v1[2] *= sigmoidf_(bflo(og.w)) * g1[2]; v1[3] *= sigmoidf_(bfhi(og.w)) * g1[3];
                    st_bf16x8(HM + o, v0, v1); } }
    }
};
struct EpiW {
    static constexpr bool PERM = true;
    bf16_t* WQ; const float* RS;
    __device__ __forceinline__ void operator()(const Acc& acc, const Unit& u, int wr, int wc, int fr, int fq) const {
        const size_t trow = (size_t)u.aux * TT + (size_t)u.pm * 256;
        const int colh = wc * 32 + 8 * fq;
#pragma unroll
        for (int ai = 0; ai < 2; ++ai)
#pragma unroll
            for (int m = 0; m < 4; ++m) { int r = ai * 128 + wr * 64 + m * 16 + fr; asm volatile("" : "+v"(r)); const float rs = RS[trow + r];
#pragma unroll
                for (int bj = 0; bj < 2; ++bj) { f32x4 v0 = acc[ai][bj][m][0], v1 = acc[ai][bj][m][1]; const int c = bj * 128 + colh; const float fl = (float)(r - c + 1);
#pragma unroll
                    for (int j = 0; j < 4; ++j) { v0[j] = v0[j] * (rs * __saturatef(fl - (float)j)); v1[j] = v1[j] * (rs * __saturatef(fl - (float)(4 + j))); }
                    st_bf16x8(WQ + (trow + r) * 512 + c, v0, v1);
                    } }
    }
};
struct EpiH {
    static constexpr bool PERM = true;
    bf16_t* HR; const float* HDEN;
    __device__ __forceinline__ void operator()(const Acc& acc, const Unit& u, int wr, int wc, int fr, int fq) const {
        const size_t t0 = (size_t)u.pm * 256;
        EPI_BF16_LOOP( const float inv = 1.0f / HDEN[(size_t)u.aux * TT + t0 + r];
            v0 *= inv; v1 *= inv; st_bf16x8(HR + (t0 + r) * 1024 + u.aux * 256 + bj * 128 + colh, v0, v1); )
    }
};
struct EpiXA {
    static constexpr bool PERM = true;
    bf16_t* XA;
    __device__ __forceinline__ void operator()(const Acc& acc, const Unit& u, int wr, int wc, int fr, int fq) const {
        const size_t t0 = (size_t)u.pm * 256;
        EPI_BF16_LOOP( st_bf16x8(XA + (t0 + r) * 1024 + u.aux * 256 + bj * 128 + colh, v0, v1); )
    }
};
struct EpiGate {
    static constexpr bool PERM = true;
    bf16_t* GT; const float* bg; float dsc;
    __device__ __forceinline__ void operator()(const Acc& acc, const Unit& u, int wr, int wc, int fr, int fq) const {
        const size_t t0 = (size_t)u.pm * 256;
        EPI_BF16_LOOP( const int c = u.pn * 256 + bj * 128 + colh; const f32x4 b0 = *(const f32x4*)(bg + c), b1 = *(const f32x4*)(bg + c + 4);
            _Pragma("unroll") for (int j = 0; j < 4; ++j) { v0[j] = sigmoidf_(v0[j] * dsc + b0[j]); v1[j] = sigmoidf_(v1[j] * dsc + b1[j]); }
            st_bf16x8(GT + (t0 + r) * 2048 + c, v0, v1); )
    }
};
template <bool FIRST> struct EpiBranch {
    static constexpr bool PERM = true;
    const bf16_t* GT; bf16_t* MG;
    __device__ __forceinline__ void operator()(const Acc& acc, const Unit& u, int wr, int wc, int fr, int fq) const {
        const size_t t0 = (size_t)u.pm * 256;
        EPI_BF16_LOOP( const size_t o = (t0 + r) * 2048 + u.pn * 256 + bj * 128 + colh; const u32x4 g = *(const u32x4*)(GT + o);
            v0[0] *= bflo(g.x); v0[1] *= bfhi(g.x); v0[2] *= bflo(g.y); v0[3] *= bfhi(g.y); v1[0] *= bflo(g.z); v1[1] *= bfhi(g.z); v1[2] *= bflo(g.w); v1[3] *= bfhi(g.w);
            if (!FIRST) { const u32x4 p = *(const u32x4*)(MG + o);
                v0[0] += bflo(p.x); v0[1] += bfhi(p.x); v0[2] += bflo(p.y); v0[3] += bfhi(p.y); v1[0] += bflo(p.z); v1[1] += bfhi(p.z); v1[2] += bflo(p.w); v1[3] += bfhi(p.w); }
            st_bf16x8(MG + o, v0, v1); )
    }
};
struct EpiOut {
    static constexpr bool PERM = true;
    const float* X; bf16_t* X1B; float* RSS;
    __device__ __forceinline__ void operator()(const Acc& acc, const Unit& u, int wr, int wc, int fr, int fq) const {
        const size_t t0 = (size_t)u.pm * 256; const int colh = wc * 32 + 8 * fq;
#pragma unroll
        for (int ai = 0; ai < 2; ++ai)
#pragma unroll
            for (int m = 0; m < 4; ++m) { int r = ai * 128 + wr * 64 + m * 16 + fr; asm volatile("" : "+v"(r)); float ss = 0.f;
#pragma unroll
                for (int bj = 0; bj < 2; ++bj) { const size_t o = (t0 + r) * 2048 + u.pn * 256 + bj * 128 + colh;
                    const f32x4 v0 = acc[ai][bj][m][0] + *(const f32x4*)(X + o), v1 = acc[ai][bj][m][1] + *(const f32x4*)(X + o + 4);
                    u32x4 w; w.x = cvtpk(v0[0], v0[1]); w.y = cvtpk(v0[2], v0[3]); w.z = cvtpk(v1[0], v1[1]); w.w = cvtpk(v1[2], v1[3]);
                    *(u32x4*)(X1B + o) = w;
                    ss += ((bflo(w.x) * bflo(w.x) + bfhi(w.x) * bfhi(w.x)) + (bflo(w.y) * bflo(w.y) + bfhi(w.y) * bfhi(w.y))) + ((bflo(w.z) * bflo(w.z) + bfhi(w.z) * bfhi(w.z)) + (bflo(w.w) * bflo(w.w) + bfhi(w.w) * bfhi(w.w))); }
                ss += __shfl_xor(ss, 16); ss += __shfl_xor(ss, 32);
                if (fq == 0) RSS[(t0 + r) * 32 + u.pn * 4 + wc] = ss; }
    }
};
struct EpiGU {
    static constexpr bool PERM = true;
    unsigned char* HD;
    __device__ __forceinline__ void operator()(const Acc& acc, const Unit& u, int wr, int wc, int fr, int fq) const {
        const size_t t0 = (size_t)u.pm * 256; const int colh = wc * 32 + 8 * fq;
#pragma unroll
        for (int ai = 0; ai < 2; ++ai)
#pragma unroll
            for (int m = 0; m < 4; ++m) { int r = ai * 128 + wr * 64 + m * 16 + fr; asm volatile("" : "+v"(r));
                f32x4 g0 = acc[ai][0][m][0], g1 = acc[ai][0][m][1]; const f32x4 u0 = acc[ai][1][m][0], u1 = acc[ai][1][m][1];
#pragma unroll
                for (int j = 0; j < 4; ++j) { const float a0 = g0[j] * (1.0f / 32.0f), a1 = g1[j] * (1.0f / 32.0f); g0[j] = a0 * sigmoidf_(a0) * (u0[j] * 0.25f); g1[j] = a1 * sigmoidf_(a1) * (u1[j] * 0.25f); }
                u32x2 w; w.x = pk4_fp8(g0[0], g0[1], g0[2], g0[3]); w.y = pk4_fp8(g1[0], g1[1], g1[2], g1[3]);
                *(u32x2*)(HD + (t0 + r) * DEXP_P + u.pn * 128 + colh) = w; }
    }
};
struct EpiDown {
    static constexpr bool PERM = true;
    bf16_t* YS; const float* WROW;
    __device__ __forceinline__ void operator()(const Acc& acc, const Unit& u, int wr, int wc, int fr, int fq) const {
        const size_t t0 = (size_t)u.pm * 256;
        EPI_BF16_LOOP( const float w = WROW[t0 + r] * (1.0f / 128.0f); v0 *= w; v1 *= w;      st_bf16x8(YS + (t0 + r) * 2048 + u.pn * 256 + bj * 128 + colh, v0, v1); )
    }
};

struct SchedDense {
    const bf16_t* A0; const bf16_t* B0; int lda, ldb, nM, nN, G, c;
    __device__ __forceinline__ bool next(int i, Unit& u) const {
        const int L = i * G + c; if (L >= nM * nN) return false;
        tile_order(L, nM, nN, u.pm, u.pn); u.aux = 0;
        u.A = A0 + (size_t)u.pm * 256 * lda; u.B = B0 + (size_t)u.pn * 256 * ldb; return true;
    }
};
struct SchedPA {
    const bf16_t* HBF; const bf16_t* WINT; int G, c;
    __device__ __forceinline__ bool next(int i, Unit& u) const {
        const int L = i * G + c;
        if (L < 2048) { tile_order(L, 128, 16, u.pm, u.pn); u.aux = 0; u.A = HBF + (size_t)u.pm * 256 * 2048; u.B = WINT + (size_t)(6144 + u.pn * 256) * 2048; return true; }
        if (L < 2560) { const int q = L - 2048; u.pm = q & 3; u.pn = q >> 2; u.aux = 1; u.A = WINT + (size_t)(10240 + u.pm * 256) * 2048; u.B = HBF + (size_t)u.pn * 256 * 2048; return true; }
        return false;
    }
};
struct SchedMem {
    const bf16_t* MEMN; const bf16_t* WMEMT; int G, c;
    __device__ __forceinline__ bool next(int i, Unit& u) const {
        const int L = i * G + c; if (L >= 16) return false;
        if (L < 8) { u.aux = 0; u.pm = L >> 2; u.pn = L & 3; u.A = MEMN + (size_t)u.pm * 256 * 2048; u.B = WMEMT + (size_t)u.pn * 256 * 2048; }
        else { const int q = L - 8; u.aux = 1; u.pm = q & 3; u.pn = q >> 2; u.A = WMEMT + (size_t)(1024 + u.pm * 256) * 2048; u.B = MEMN + (size_t)u.pn * 256 * 2048; }
        return true;
    }
};
struct SchedHG {
    const bf16_t* A0; const bf16_t* B0; size_t sa_h, sa_g, sb_h, sb_g; int G, c;
    __device__ __forceinline__ bool next(int i, Unit& u) const {
        const int L = i * G + c; if (L >= 512) return false;
        const int hh = L >> 7, g = L & 127; u.aux = hh; u.pm = g; u.pn = 0;
        u.A = A0 + (size_t)hh * sa_h + (size_t)g * sa_g; u.B = B0 + (size_t)hh * sb_h + (size_t)g * sb_g; return true;
    }
};
struct SchedXA {
    const bf16_t* A0; const bf16_t* B0; int G, c;
    __device__ __forceinline__ bool next(int i, Unit& u) const {
        const int L = i * G + c; if (L >= 512) return false;
        const int hh = L >> 7, pm = L & 127; u.aux = hh; u.pm = pm; u.pn = 0;
        u.A = A0 + ((size_t)hh * TT + (size_t)pm * 256) * 256; u.B = B0 + (size_t)((pm >> 6) * 4 + hh) * 65536; return true;
    }
};
struct SchedMoE {
    const bf16_t* A0; const bf16_t* B0; const int* tile_e; int nrt, NT, lda; size_t eb_stride, nb_stride; int G, c;
    __device__ __forceinline__ bool next(int i, Unit& u) const {
        const int L = i * G + c; if (L >= nrt * NT) return false;
        const int rt = L / NT, pn = L - rt * NT; const int e = __builtin_amdgcn_readfirstlane(tile_e[rt]);
        u.pm = rt; u.pn = pn; u.aux = e; u.A = A0 + (size_t)rt * 256 * lda; u.B = B0 + (size_t)e * eb_stride + (size_t)pn * nb_stride; return true;
    }
};
}
namespace attn {
constexpr int D = 128;
constexpr float THR = 8.f;
constexpr float SCALE = 0.08838834764831845f;
constexpr int NW = 8, QBLK = 32, KVBLK = 64, QB = NW * QBLK;
constexpr int SHM_V = KVBLK * D * 2, SHM_K = KVBLK * D * 2;
constexpr int LDS_BYTES = 2 * SHM_V + 2 * SHM_K + NW * 64 * 4;
typedef bf16_t bf16;

#define KSWZ(row, colB) ((row) * 256 + ((colB) ^ (((row) & 7) << 4)))
#define SBAR() __builtin_amdgcn_sched_barrier(0)
__device__ __forceinline__ int v_st(int k, int c) { const int kk = (k & ~0xC) | ((k & 4) << 1) | ((k & 8) >> 1); return ((kk >> 3) * 4 + (c >> 5)) * 512 + ((kk & 7) * 32 + (c & 31)) * 2; }
__device__ __forceinline__ int v_rd_base(int lane) { return ((lane & 3) << 3) | (((lane >> 2) & 3) << 6) | (((lane >> 4) & 1) << 5) | (((lane >> 5) & 1) << 8); }
constexpr int v_rd_off(int d0, int ks, int half) { return d0 * 512 + ks * 4096 + half * 2048; }
__device__ __forceinline__ int crow(int r, int hi) { return (r & 3) + 8 * (r >> 2) + 4 * hi; }
__device__ __forceinline__ bf16x8 load8(const bf16* p) { return *reinterpret_cast<const bf16x8*>(p); }

__device__ __forceinline__ void mask_tile(f32x16& p0, f32x16& p1, int dq, unsigned W) {
    const float NEG = -__builtin_inff();
#pragma unroll
    for (int r = 0; r < 16; ++r) {
        const int c = (r & 3) + 8 * (r >> 2);
        if ((unsigned)(dq - c) >= W) p0[r] = NEG;
        if ((unsigned)(dq - c - 32) >= W) p1[r] = NEG;
    }
}
__device__ __forceinline__ void partialSM(f32x16& p0, f32x16& p1, float& m_reg, float& mn, float& alpha) {
    float pmax = p0[0]; for (int r = 1; r < 16; ++r) pmax = fmaxf(pmax, p0[r]); for (int r = 0; r < 16; ++r) pmax = fmaxf(pmax, p1[r]);
    { auto rr = __builtin_amdgcn_permlane32_swap(__float_as_uint(pmax), __float_as_uint(pmax), false, false);
      pmax = fmaxf(__uint_as_float(rr[0]), __uint_as_float(rr[1])); }
    constexpr float C2 = 1.4426950408889634f * SCALE;
    if (__builtin_expect(__all((pmax - m_reg) * SCALE <= THR), 1)) { mn = m_reg; alpha = 1.f; }
    else { mn = fmaxf(m_reg, pmax); alpha = __builtin_amdgcn_exp2f((m_reg - mn) * C2); m_reg = mn; }
    const float mnL = -mn * C2;
    for (int r = 0; r < 16; ++r) p0[r] = fmaf(p0[r], C2, mnL); for (int r = 0; r < 16; ++r) p1[r] = fmaf(p1[r], C2, mnL);
    for (int r = 0; r < 16; ++r) p0[r] = __builtin_amdgcn_exp2f(p0[r]);
}
__device__ __forceinline__ void finishSM(f32x16& p0, f32x16& p1, float alpha, float& l_reg, bf16x8& pa0, bf16x8& pa1, bf16x8& pa2, bf16x8& pa3) {
    for (int r = 0; r < 16; ++r) p1[r] = __builtin_amdgcn_exp2f(p1[r]);
    float ps = 0; for (int r = 0; r < 16; ++r) ps += p0[r]; for (int r = 0; r < 16; ++r) ps += p1[r];
    { auto rr = __builtin_amdgcn_permlane32_swap(__float_as_uint(ps), __float_as_uint(ps), false, false);
      ps = __uint_as_float(rr[0]) + __uint_as_float(rr[1]); }
    l_reg = l_reg * alpha + ps;
#define PK4(P, B_, OUT) do { unsigned a0 = cvtpk(P[B_+0], P[B_+1]), a1 = cvtpk(P[B_+2], P[B_+3]);                          \
        unsigned b0 = cvtpk(P[B_+4], P[B_+5]), b1 = cvtpk(P[B_+6], P[B_+7]);                                             \
        auto r0 = __builtin_amdgcn_permlane32_swap(a0, b0, false, false); auto r1 = __builtin_amdgcn_permlane32_swap(a1, b1, false, false); \
        u32x4 w = {r0[0], r1[0], r0[1], r1[1]}; OUT = *reinterpret_cast<bf16x8*>(&w); } while (0)
    PK4(p0, 0, pa0); PK4(p0, 8, pa1); PK4(p1, 0, pa2); PK4(p1, 8, pa3);
#undef PK4
}
template <int KB>
__device__ __forceinline__ void qkt(f32x16& p0, f32x16& p1, const char* K_lds, int r32, int hi, const bf16x8* qr, float sl, int dq) {
    const float sl8 = 8.f * sl, sl32 = 32.f * sl;
    p0[0] = -sl * (float)dq; p0[1] = p0[0] + sl; p0[2] = p0[1] + sl; p0[3] = p0[2] + sl;
#pragma unroll
    for (int r = 4; r < 16; ++r) p0[r] = p0[r - 4] + sl8;
#pragma unroll
    for (int r = 0; r < 16; ++r) p1[r] = p0[r] + sl32;
    const char* kb[4];
#pragma unroll
    for (int dd = 0; dd < 4; ++dd) kb[dd] = K_lds + KB * SHM_K + KSWZ(r32, (dd * 16 + hi * 8) * 2);
#pragma unroll
    for (int d0 = 0; d0 < 8; ++d0) { const char* a = kb[d0 & 3] + (d0 >> 2) * 128;
        bf16x8 b0_ = *reinterpret_cast<const bf16x8*>(a);
        bf16x8 b1_ = *reinterpret_cast<const bf16x8*>(a + 32 * 256);
        p0 = __builtin_amdgcn_mfma_f32_32x32x16_bf16(b0_, qr[d0], p0, 0, 0, 0);
        p1 = __builtin_amdgcn_mfma_f32_32x32x16_bf16(b1_, qr[d0], p1, 0, 0, 0); }
}
template <int VB>
__device__ __forceinline__ void pv_tile(f32x16* o, int vb0, bf16x8 pa0, bf16x8 pa1, bf16x8 pa2, bf16x8 pa3) {
#define TRRD(dst, off) asm volatile("ds_read_b64_tr_b16 %0, %1 offset:%2" : "=&v"(dst) : "v"(vb0), "i"(off) : "memory")
#define PV_D0(d0) do { s16x4 l0, l1, l2, l3, h0, h1, h2, h3; constexpr int b_ = VB * SHM_V + v_rd_off(d0, 0, 0); \
        TRRD(l0, b_); TRRD(h0, b_ + 2048); TRRD(l1, b_ + 4096); TRRD(h1, b_ + 6144); TRRD(l2, b_ + 8192); TRRD(h2, b_ + 10240); TRRD(l3, b_ + 12288); TRRD(h3, b_ + 14336); \
        asm volatile("s_waitcnt lgkmcnt(0)" ::: "memory"); SBAR();   \
        o[d0] = __builtin_amdgcn_mfma_f32_32x32x16_bf16(pa0, (bf16x8){l0[0], l0[1], l0[2], l0[3], h0[0], h0[1], h0[2], h0[3]}, o[d0], 0, 0, 0);   \
        o[d0] = __builtin_amdgcn_mfma_f32_32x32x16_bf16(pa1, (bf16x8){l1[0], l1[1], l1[2], l1[3], h1[0], h1[1], h1[2], h1[3]}, o[d0], 0, 0, 0);   \
        o[d0] = __builtin_amdgcn_mfma_f32_32x32x16_bf16(pa2, (bf16x8){l2[0], l2[1], l2[2], l2[3], h2[0], h2[1], h2[2], h2[3]}, o[d0], 0, 0, 0);   \
        o[d0] = __builtin_amdgcn_mfma_f32_32x32x16_bf16(pa3, (bf16x8){l3[0], l3[1], l3[2], l3[3], h3[0], h3[1], h3[2], h3[3]}, o[d0], 0, 0, 0); } while (0)
    PV_D0(0); PV_D0(1); PV_D0(2); PV_D0(3);
#undef PV_D0
#undef TRRD
}

struct BlockRef { const bf16* Q; const bf16* K; const bf16* V; bf16* O; int P0; };
struct Seam { bf16x8 qr[8]; bf16x8 st_v0, st_v1, st_k0, st_k1; };
__device__ __forceinline__ int swa_jlo(int P0, int W) { const int lowk = P0 - W + 1; return lowk > 0 ? lowk / KVBLK : 0; }
#define ROW(p, k0, rr) ((p) + (size_t)((k0) + (rr)) * D + sc)
#define VMW() asm volatile("s_waitcnt vmcnt(0)" ::: "memory")
#define VMWN(n) asm volatile("s_waitcnt vmcnt(%0)" :: "i"(n) : "memory")
#define SLOAD_H(Kp, Vp, k0) do { S.st_v0 = load8(ROW(Vp, k0, sr)); S.st_v1 = load8(ROW(Vp, k0, 32 + sr));              \
                         S.st_k0 = load8(ROW(Kp, k0, sr)); S.st_k1 = load8(ROW(Kp, k0, 32 + sr)); } while (0)
#define SWRITE_HK(bf) do { *(bf16x8*)(K_lds + (bf) * SHM_K + kws) = S.st_k0; *(bf16x8*)(K_lds + (bf) * SHM_K + kws + 32 * 256) = S.st_k1; } while (0)
#define SWRITE_HV(bf) do { *(bf16x8*)(V_lds + (bf) * SHM_V + vst0) = S.st_v0; *(bf16x8*)(V_lds + (bf) * SHM_V + vst1) = S.st_v1; } while (0)
#define SWRITE_H(bf) do { SWRITE_HV(bf); SWRITE_HK(bf); } while (0)

__device__ __forceinline__ void causal_swa_prime(const BlockRef& cur, int W, char* lds, Seam& S, const int tid) {
    const int wid = __builtin_amdgcn_readfirstlane(tid >> 6), lane = tid & 63, r32 = lane & 31, hi = lane >> 5;
    const int sr = tid >> 4, sc = (tid & 15) * 8, kws = KSWZ(sr, sc * 2); char* K_lds = lds + 2 * SHM_V;
    const int kb0 = swa_jlo(cur.P0, W) * KVBLK;
    for (int d0 = 0; d0 < 8; ++d0) S.qr[d0] = load8(cur.Q + (size_t)(wid * QBLK + r32) * D + d0 * 16 + hi * 8);
    SLOAD_H(cur.K, cur.V, kb0); VMW(); SWRITE_HK(0);
    __syncthreads();
}
__device__ __forceinline__ void causal_swa_block(const BlockRef& cur, const BlockRef& nxt, int skv, int W, int Wn, float sl, char* lds, Seam& S, const int tid) {
    const int wid = __builtin_amdgcn_readfirstlane(tid >> 6), lane = tid & 63, r32 = lane & 31, hi = lane >> 5;
    const int j_lo = swa_jlo(cur.P0, W);
    int j_hi = (cur.P0 + QB - 1) / KVBLK + 1; if (j_hi > skv / KVBLK) j_hi = skv / KVBLK;
    const int NT = j_hi - j_lo;
    const int kbn = swa_jlo(nxt.P0, Wn) * KVBLK;
    const int qlo = cur.P0 + wid * QBLK, qm = qlo + r32 - 4 * hi;
    char* V_lds = lds; char* K_lds = lds + 2 * SHM_V;
    float* ws = (float*)(lds + 2 * SHM_V + 2 * SHM_K) + wid * 64; float* li_l = ws, * al_l = ws + 32;
    float m_reg = -1e30f, l_reg = 0; f32x16 o[4] = {};
    const int sr = tid >> 4, sc = (tid & 15) * 8, vst0 = v_st(sr, sc), vst1 = v_st(32 + sr, sc), kws = KSWZ(sr, sc * 2);
    const int vb0 = (int)(uintptr_t)V_lds + v_rd_base(lane);
    const bf16* Kh = cur.K; const bf16* Vh = cur.V;
#define RESC(a) do { if (__any((a) < 1.f)) { if (hi == 0) al_l[r32] = (a); asm volatile("s_waitcnt lgkmcnt(0)" ::: "memory");              \
                     for (int d_ = 0; d_ < 4; ++d_) for (int r = 0; r < 16; ++r) o[d_][r] *= al_l[crow(r, hi)]; } } while (0)
#define KBASE(t) ((j_lo + (t)) * KVBLK)
#define MASKT(P0_, P1_, t) do { const int kb_ = KBASE(t); if (kb_ + KVBLK - 1 > qlo || kb_ <= qlo + QBLK - 1 - W) mask_tile(P0_, P1_, qm - kb_, (unsigned)W); } while (0)
    constexpr int NQL = 8;
#define SEAM_K0() do { VMWN(NQL); SWRITE_HK(0); SBAR(); } while (0)
    f32x16 pA0, pA1, pB0, pB1; float mnA, mnB, alA, alB; bf16x8 pa0, pa1, pa2, pa3;
    SWRITE_HV(0); SBAR();
    if (NT > 1) { SLOAD_H(Kh, Vh, KBASE(1)); }
    SBAR(); qkt<0>(pA0, pA1, K_lds, r32, hi, S.qr, sl, qm - KBASE(0));
    MASKT(pA0, pA1, 0); partialSM(pA0, pA1, m_reg, mnA, alA);
    if (NT > 1) { VMW(); SWRITE_H(1); }
    __syncthreads();
#define HALF_STEP(PX0, PX1, mnX, alX, PY0, PY1, alY, t, KB, VB, SB) do {                                                      \
        SBAR(); qkt<KB>(PX0, PX1, K_lds, r32, hi, S.qr, sl, qm - KBASE(t));                                                   \
        finishSM(PY0, PY1, alY, l_reg, pa0, pa1, pa2, pa3); SBAR();                                                           \
        if ((t) + 1 < NT) { SLOAD_H(Kh, Vh, KBASE((t) + 1)); SBAR(); }                                                        \
        pv_tile<VB>(o, vb0, pa0, pa1, pa2, pa3); MASKT(PX0, PX1, (t)); partialSM(PX0, PX1, m_reg, mnX, alX);                  \
        __syncthreads();                                                                                                      \
        if ((t) + 1 < NT) { VMW(); SWRITE_H(SB); }                                                                            \
        RESC(alX); __syncthreads(); } while (0)
    for (int t = 1; t + 1 < NT; t += 2) {
        HALF_STEP(pB0, pB1, mnB, alB, pA0, pA1, alA, t, 1, 0, 0);
        HALF_STEP(pA0, pA1, mnA, alA, pB0, pB1, alB, t + 1, 0, 1, 1);
    }
    const bool even = (NT & 1) == 0;
    if (even) { SBAR(); qkt<1>(pB0, pB1, K_lds, r32, hi, S.qr, sl, qm - KBASE(NT - 1)); SBAR(); }
    SLOAD_H(nxt.K, nxt.V, kbn); SBAR();
#pragma unroll
    for (int d0 = 0; d0 < 8; ++d0) S.qr[d0] = load8(nxt.Q + (size_t)(wid * QBLK + r32) * D + d0 * 16 + hi * 8);
    SBAR();
    finishSM(pA0, pA1, alA, l_reg, pa0, pa1, pa2, pa3); SBAR();
    pv_tile<0>(o, vb0, pa0, pa1, pa2, pa3);
    if (even) { MASKT(pB0, pB1, NT - 1); partialSM(pB0, pB1, m_reg, mnB, alB); __syncthreads(); RESC(alB);
        finishSM(pB0, pB1, alB, l_reg, pa0, pa1, pa2, pa3); SBAR(); pv_tile<1>(o, vb0, pa0, pa1, pa2, pa3); }
    SBAR(); SEAM_K0();
    if (hi == 0) li_l[r32] = l_reg; asm volatile("s_waitcnt lgkmcnt(0)" ::: "memory");
    float rli[16];
#pragma unroll
    for (int r = 0; r < 16; ++r) rli[r] = __builtin_amdgcn_rcpf(li_l[crow(r, hi)]);
    bf16* Ow = cur.O + (size_t)(wid * QBLK) * D;
    int zo = 0; asm volatile("" : "+v"(zo));
    const unsigned ob = (unsigned)(4 * hi * D + r32 + zo);
#pragma unroll
    for (int r = 0; r < 16; ++r) { const unsigned off = ob + (unsigned)(((r & 3) + 8 * (r >> 2)) * D);
#pragma unroll
        for (int d0 = 0; d0 < 4; ++d0) { const float v = o[d0][r] * rli[r];
            const float vn = __shfl_xor(v, 1);
            if ((r32 & 1) == 0) *(unsigned*)(Ow + off + d0 * 32) = cvtpk(v, vn); } }
    __syncthreads();
#undef RESC
#undef KBASE
#undef MASKT
#undef SEAM_K0
#undef HALF_STEP
}
#undef ROW
#undef VMW
#undef VMWN
#undef SLOAD_H
#undef SWRITE_HK
#undef SWRITE_HV
#undef SWRITE_H
}
namespace attn4 {
using attn::bf16; using attn::KVBLK; using attn::QBLK; using attn::SHM_K;
constexpr int QB = 128, D = 128;
constexpr int V_OFF = 0, K_OFF = 65536, PX_OFF = 98304;
constexpr int AL_OFF = RING_BYTES + 1024;
struct Item { const bf16* Q; const bf16* K; const bf16* V0; const bf16* V1; bf16* O; int P0, W; float sl; };

template <int OFF>
__device__ __forceinline__ void pv_half(f32x16* o, int vb0, bf16x8 pa0, bf16x8 pa1, bf16x8 pa2, bf16x8 pa3) {
#define TRRD(dst, off) asm volatile("ds_read_b64_tr_b16 %0, %1 offset:%2" : "=&v"(dst) : "v"(vb0), "i"(off) : "memory")
#define PV_D0(d0) do { s16x4 l0, l1, l2, l3, h0, h1, h2, h3; constexpr int b_ = OFF + attn::v_rd_off(d0, 0, 0); \
        TRRD(l0, b_); TRRD(h0, b_ + 2048); TRRD(l1, b_ + 4096); TRRD(h1, b_ + 6144); TRRD(l2, b_ + 8192); TRRD(h2, b_ + 10240); TRRD(l3, b_ + 12288); TRRD(h3, b_ + 14336); \
        asm volatile("s_waitcnt lgkmcnt(0)" ::: "memory"); SBAR();   \
        o[d0] = __builtin_amdgcn_mfma_f32_32x32x16_bf16(pa0, (bf16x8){l0[0], l0[1], l0[2], l0[3], h0[0], h0[1], h0[2], h0[3]}, o[d0], 0, 0, 0);   \
        o[d0] = __builtin_amdgcn_mfma_f32_32x32x16_bf16(pa1, (bf16x8){l1[0], l1[1], l1[2], l1[3], h1[0], h1[1], h1[2], h1[3]}, o[d0], 0, 0, 0);   \
        o[d0] = __builtin_amdgcn_mfma_f32_32x32x16_bf16(pa2, (bf16x8){l2[0], l2[1], l2[2], l2[3], h2[0], h2[1], h2[2], h2[3]}, o[d0], 0, 0, 0);   \
        o[d0] = __builtin_amdgcn_mfma_f32_32x32x16_bf16(pa3, (bf16x8){l3[0], l3[1], l3[2], l3[3], h3[0], h3[1], h3[2], h3[3]}, o[d0], 0, 0, 0); } while (0)
    PV_D0(0); PV_D0(1); PV_D0(2); PV_D0(3);
#undef PV_D0
#undef TRRD
}

__device__ __forceinline__ void item(const Item& it, char* lds, LAS unsigned char* ldsL, const int tid) {
    const int wid = __builtin_amdgcn_readfirstlane(tid >> 6), lane = tid & 63, r32 = lane & 31, hi = lane >> 5, role = wid >> 2, g = wid & 3;
    const int j_lo = attn::swa_jlo(it.P0, it.W);
    const int j_hi = (it.P0 + QB - 1) / KVBLK + 1;
    const int NT = j_hi - j_lo;
    const int W = it.W; const float sl = it.sl;
    const int qlo = it.P0 + g * QBLK, qm = qlo + r32 - 4 * hi;
    const int sr = tid >> 4, sc = (tid & 15) * 8, vst0 = attn::v_st(sr, sc), vst1 = attn::v_st(32 + sr, sc), kws = KSWZ(sr, sc * 2);
    float* AL = (float*)(lds + AL_OFF); int* FLG = (int*)(lds + AL_OFF + 1024); float* LL = (float*)(lds + AL_OFF + 1088);
    unsigned soff[6]; int pkind[6], pldso[6];
#pragma unroll
    for (int i = 0; i < 6; ++i) { const int q = wid * 6 + i;
        if (q < 16) { const int row = 4 * q + (lane >> 4), c = (lane & 15) ^ (row & 7); soff[i] = (unsigned)(row * D + c * 8); pkind[i] = 0; pldso[i] = q * 1024; }
        else { const int j = (q - 16) & 15, eh = (q - 16) >> 4, sidx = 2 * j + (lane >> 5), kk = (sidx >> 2) * 8 + ((lane & 31) >> 2), k = (kk & ~0xC) | ((kk & 4) << 1) | ((kk & 8) >> 1), col = (sidx & 3) * 32 + (lane & 3) * 8;
            soff[i] = (unsigned)(k * D + col); pkind[i] = 1 + eh; pldso[i] = eh * 16384 + j * 1024; } }
#define KBASE(t) ((j_lo + (t)) * KVBLK)
#define A4_DMA(src, ldsbyte) __builtin_amdgcn_global_load_lds((const unsigned*)(src), (LAS unsigned*)((LAS unsigned char*)ldsL + (ldsbyte)), 16, 0, 0)
#define A4_STAGE(t, PAR) do { _Pragma("unroll") for (int i = 0; i < 6; ++i) { \
            if (pkind[i] == 0) { if ((t) + 1 < NT) A4_DMA(it.K + (size_t)KBASE((t) + 1) * D + soff[i], K_OFF + ((PAR) ^ 1) * SHM_K + pldso[i]); } \
            else if ((t) < NT) A4_DMA((pkind[i] == 1 ? it.V0 : it.V1) + (size_t)KBASE(t) * D + soff[i], V_OFF + (PAR) * 32768 + pldso[i]); } } while (0)
#define A4_SYNC() do { asm volatile("s_waitcnt vmcnt(0) lgkmcnt(0)" ::: "memory"); __builtin_amdgcn_s_barrier(); asm volatile("" ::: "memory"); } while (0)
#define A4_PROLOGUE() do { _Pragma("unroll") for (int i = 0; i < 6; ++i) if (pkind[i] == 0) A4_DMA(it.K + (size_t)KBASE(0) * D + soff[i], K_OFF + pldso[i]); A4_SYNC(); } while (0)
    char* K_lds = lds + K_OFF;
    if (role == 0) {
        bf16x8 qr[8];
#pragma unroll
        for (int d0 = 0; d0 < 8; ++d0) qr[d0] = attn::load8(it.Q + (size_t)(g * QBLK + r32) * D + d0 * 16 + hi * 8);
        asm volatile("s_waitcnt vmcnt(0)" ::: "memory");
        A4_PROLOGUE();
        float m_reg = -1e30f, l_reg = 0.f;
#define A2_QK_STEP(t, PAR) do { A4_STAGE(t, PAR); \
            if ((t) < NT) { f32x16 p0, p1; float mn, alpha; bf16x8 pa0, pa1, pa2, pa3; \
                attn::qkt<PAR>(p0, p1, K_lds, r32, hi, qr, sl, qm - KBASE(t)); \
                { const int kb_ = KBASE(t); if (kb_ + KVBLK - 1 > qlo || kb_ <= qlo + QBLK - 1 - W) attn::mask_tile(p0, p1, qm - kb_, (unsigned)W); } \
                attn::partialSM(p0, p1, m_reg, mn, alpha); attn::finishSM(p0, p1, alpha, l_reg, pa0, pa1, pa2, pa3); \
                char* px = lds + PX_OFF + (PAR) * 16384 + g * 4096 + lane * 16; \
                *(bf16x8*)px = pa0; *(bf16x8*)(px + 1024) = pa1; *(bf16x8*)(px + 2048) = pa2; *(bf16x8*)(px + 3072) = pa3; \
                if (hi == 0) AL[(PAR) * 128 + g * 32 + r32] = alpha; \
                const int anyr = __any(alpha < 1.f) ? 1 : 0; if (lane == 0) FLG[(PAR) * 4 + g] = anyr; } \
            A4_SYNC(); } while (0)
        for (int t = 0; t <= NT; t += 2) { A2_QK_STEP(t, 0); if (t + 1 <= NT) A2_QK_STEP(t + 1, 1); }
        if (hi == 0) LL[g * 32 + r32] = l_reg;
        __syncthreads();
        __syncthreads();
#undef A2_QK_STEP
    } else {
        A4_PROLOGUE();
        f32x16 o[8] = {};
        const int vb0 = (int)(uintptr_t)(lds + V_OFF) + attn::v_rd_base(lane);
#define A2_PV_STEP(t, PAR) do { A4_STAGE(t, PAR); \
            if ((t) >= 1) { constexpr int PB = (PAR) ^ 1; \
                const int flag = __builtin_amdgcn_readfirstlane(FLG[PB * 4 + g]); \
                if (flag) { _Pragma("unroll") for (int r = 0; r < 16; ++r) { const float a = AL[PB * 128 + g * 32 + attn::crow(r, hi)]; \
                        _Pragma("unroll") for (int d_ = 0; d_ < 8; ++d_) o[d_][r] *= a; } } \
                const char* px = lds + PX_OFF + PB * 16384 + g * 4096 + lane * 16; \
                const bf16x8 pa0 = *(const bf16x8*)px, pa1 = *(const bf16x8*)(px + 1024), pa2 = *(const bf16x8*)(px + 2048), pa3 = *(const bf16x8*)(px + 3072); \
                pv_half<PB * 32768>(o, vb0, pa0, pa1, pa2, pa3); pv_half<PB * 32768 + 16384>(o + 4, vb0, pa0, pa1, pa2, pa3); } \
            A4_SYNC(); } while (0)
        for (int t = 0; t <= NT; t += 2) { A2_PV_STEP(t, 0); if (t + 1 <= NT) A2_PV_STEP(t + 1, 1); }
        __syncthreads();
        float rli[16];
#pragma unroll
        for (int r = 0; r < 16; ++r) rli[r] = __builtin_amdgcn_rcpf(LL[g * 32 + attn::crow(r, hi)]);
        bf16* Ow = it.O + (size_t)(g * QBLK) * 256;
        int zo = 0; asm volatile("" : "+v"(zo));
        const unsigned ob = (unsigned)(4 * hi * 256 + r32 + zo);
#pragma unroll
        for (int r = 0; r < 16; ++r) { const unsigned off = ob + (unsigned)(((r & 3) + 8 * (r >> 2)) * 256);
#pragma unroll
            for (int d0 = 0; d0 < 8; ++d0) { const float v = o[d0][r] * rli[r];
                const float vn = __shfl_xor(v, 1);
                if ((r32 & 1) == 0) *(unsigned*)(Ow + off + d0 * 32) = cvtpk(v, vn); } }
        __syncthreads();
#undef A2_PV_STEP
    }
#undef KBASE
#undef A4_DMA
#undef A4_STAGE
#undef A4_SYNC
#undef A4_PROLOGUE
}
}
struct Frame {
    LAS unsigned char* lds; unsigned char* lds_g;
    volatile LAS unsigned* MISC;
    unsigned* ctl; unsigned char* ws; unsigned char* dout;
    int tid, lane, wave, G, bid, gw, NGW;
};

__device__ __forceinline__ void tr_item(const float* W, int ldw, int c0, bf16_t* WT, int ldt, int r0, int kb, int nb, LAS float* scr, int lane) {
    const int k0 = 64 * kb, n0 = 32 * nb;
#pragma unroll 8
    for (int i = 0; i < 32; ++i) { const int kk = 2 * i + (lane >> 5); scr[kk * 33 + (lane & 31)] = W[(size_t)(k0 + kk) * ldw + c0 + n0 + (lane & 31)]; }
    LDS_WAIT(); asm volatile("" ::: "memory");
    const int c = lane & 7;
#pragma unroll
    for (int j = 0; j < 4; ++j) { const int n = (lane >> 3) + 8 * j; const LAS float* s = scr + (8 * c) * 33 + n;
        u32x4 o; o.x = cvtpk(s[0 * 33], s[1 * 33]); o.y = cvtpk(s[2 * 33], s[3 * 33]); o.z = cvtpk(s[4 * 33], s[5 * 33]); o.w = cvtpk(s[6 * 33], s[7 * 33]);
        *(u32x4*)(WT + (size_t)(r0 + n0 + n) * ldt + k0 + 8 * c) = o; }
    LDS_WAIT(); asm volatile("" ::: "memory");
}
__device__ __forceinline__ void tr_item8(const float* W, int ldw, int c0, unsigned char* WT, int ldt, int r0, int kb, int nb, float sc, LAS float* scr, int lane) {
    const int k0 = 64 * kb, n0 = 32 * nb;
#pragma unroll 8
    for (int i = 0; i < 32; ++i) { const int kk = 2 * i + (lane >> 5); scr[kk * 33 + (lane & 31)] = W[(size_t)(k0 + kk) * ldw + c0 + n0 + (lane & 31)]; }
    LDS_WAIT(); asm volatile("" ::: "memory");
    const int c = lane & 7;
#pragma unroll
    for (int j = 0; j < 4; ++j) { const int n = (lane >> 3) + 8 * j; const LAS float* s = scr + (8 * c) * 33 + n;
        u32x2 o; o.x = pk4_fp8(s[0 * 33] * sc, s[1 * 33] * sc, s[2 * 33] * sc, s[3 * 33] * sc); o.y = pk4_fp8(s[4 * 33] * sc, s[5 * 33] * sc, s[6 * 33] * sc, s[7 * 33] * sc);
        *(u32x2*)(WT + (size_t)(r0 + n0 + n) * ldt + k0 + 8 * c) = o; }
    LDS_WAIT(); asm volatile("" ::: "memory");
}
__device__ __forceinline__ void rms_row2048(const float* xrow, const float* g, f32x4 (&v)[8], int lane) {
    const f32x4* xr = (const f32x4*)xrow + lane; float ss = 0.f;
#pragma unroll
    for (int j = 0; j < 8; ++j) { v[j] = xr[64 * j]; ss += (v[j].x * v[j].x + v[j].y * v[j].y) + (v[j].z * v[j].z + v[j].w * v[j].w); }
    ss = wave_sum(ss); const float r = rsqrtf(ss * (1.0f / 2048.0f) + EPS);
#pragma unroll
    for (int j = 0; j < 8; ++j) { const f32x4 gg = ((const f32x4*)g)[lane + 64 * j]; v[j] = v[j] * r * gg; }
}
__device__ __forceinline__ void store_row_bf16(bf16_t* orow, const f32x4 (&v)[8], int lane) {
#pragma unroll
    for (int j = 0; j < 8; ++j) { u32x2 w; w.x = cvtpk(v[j].x, v[j].y); w.y = cvtpk(v[j].z, v[j].w); *(u32x2*)(orow + 4 * lane + 256 * j) = w; }
}

__device__ __forceinline__ void p0_prologue(Frame& F, const float* const* in) {
    LAS float* scr = (LAS float*)(F.lds + F.wave * 16384);
    const float* w_in = in[3];
    bf16_t* WINT = (bf16_t*)(F.ws + WS_WINT);
    constexpr int I0 = 8192, I1 = 1024, I2 = 1024, I3 = 1024, I4 = 6144, I5 = 2048, I6 = 2048, I7 = 1024, I8 = 1024, I9 = 2048;
    constexpr int NITEMS = I0 + I1 + I2 + I3 + I4 + I5 + I6 + I7 + I8 + I9;
    for (int it = F.gw; it < NITEMS; it += F.NGW) {
        int r = it;
        if (r < I0) { tr_item(w_in, DIN, 0, WINT, 2048, 0, r / 256, r % 256, scr, F.lane); continue; } r -= I0;
        if (r < I1) { tr_item(w_in, DIN, 9216, WINT, 2048, 8192, r / 32, r % 32, scr, F.lane); continue; } r -= I1;
        if (r < I2) { tr_item(w_in, DIN, 10248, WINT, 2048, 9216, r / 32, r % 32, scr, F.lane); continue; } r -= I2;
        if (r < I3) { tr_item(w_in, DIN, 8192, WINT, 2048, 10240, r / 32, r % 32, scr, F.lane); continue; } r -= I3;
        if (r < I4) { tr_item8(w_in, DIN, 11272, (unsigned char*)(WINT + (size_t)11264 * 2048), 2048, 0, r / 192, r % 192, 32.0f, scr, F.lane); continue; } r -= I4;
        if (r < I5) { tr_item(in[15], 2048, 0, (bf16_t*)(F.ws + WS_WMEMT), 2048, 0, r / 64, r % 64, scr, F.lane); continue; } r -= I5;
        if (r < I6) { tr_item(in[16], 2048, 0, (bf16_t*)(F.ws + WS_WBDT), 2048, 0, r / 64, r % 64, scr, F.lane); continue; } r -= I6;
        if (r < I7) { tr_item(in[17], 2048, 0, (bf16_t*)(F.ws + WS_WBMT), 1024, 0, r / 64, r % 64, scr, F.lane); continue; } r -= I7;
        if (r < I8) { tr_item(in[18], 2048, 0, (bf16_t*)(F.ws + WS_WBCT), 1024, 0, r / 64, r % 64, scr, F.lane); continue; } r -= I8;
        tr_item(in[20], 2048, 0, (bf16_t*)(F.ws + WS_WOUTT), 2048, 0, r / 64, r % 64, scr, F.lane);
    }
    { bf16_t* WRT = (bf16_t*)(F.ws + WS_WRT); const float* wrg = in[22]; const float* wre = in[24];
      for (int idx = F.bid * 512 + F.tid; idx < 256 * 2048; idx += F.G * 512) { const int n = idx >> 11, k = idx & 2047;
          const float v = (n < 4 ? wrg[k * 4 + n] : (n < 36 ? wre[k * 32 + (n - 4)] : 0.f)) * in[21][k]; WRT[idx] = (bf16_t)(cvtpk(v, 0.f) & 0xffffu); } }
    __syncthreads();
    LAS float* wg = (LAS float*)F.lds;
    for (int idx = F.tid; idx < 16384; idx += 512) { const int k = idx >> 3, j = idx & 7; wg[j * 2048 + k] = w_in[(size_t)k * DIN + 10240 + j]; }
    __syncthreads();
    const float* x = in[0]; bf16_t* HBF = (bf16_t*)(F.dout + DO_HBF); float* MLG = (float*)(F.ws + WS_MLG);
    for (int m = F.gw; m < TT; m += F.NGW) {
        f32x4 v[8]; rms_row2048(x + (size_t)m * 2048, in[2], v, F.lane);
        store_row_bf16(HBF + (size_t)m * 2048, v, F.lane);
        float res = 0.f;
#pragma unroll
        for (int jj = 0; jj < 8; ++jj) { float a = 0.f;
#pragma unroll
            for (int j = 0; j < 8; ++j) { const f32x4 w = *(const LAS f32x4*)(wg + jj * 2048 + 4 * F.lane + 256 * j); a += (v[j].x * w.x + v[j].y * w.y) + (v[j].z * w.z + v[j].w * w.w); }
            a = wave_sum(a); if (F.lane == jj) res = a; }
        if (F.lane < 8) MLG[(size_t)m * 8 + F.lane] = res;
    }
    { const float* mem = in[1]; bf16_t* MEMN = (bf16_t*)(F.ws + WS_MEMN);
      for (int m = F.gw; m < NB * MEML; m += F.NGW) { f32x4 v[8]; rms_row2048(mem + (size_t)m * 2048, in[14], v, F.lane); store_row_bf16(MEMN + (size_t)m * 2048, v, F.lane); } }
    if (F.bid == 0 && F.wave == 0) {
        const float* q1 = in[8]; const float* k1 = in[9]; const float* q2 = in[10]; const float* k2 = in[11];
        float d1 = q1[F.lane] * k1[F.lane] + q1[F.lane + 64] * k1[F.lane + 64], d2 = q2[F.lane] * k2[F.lane] + q2[F.lane + 64] * k2[F.lane + 64];
        d1 = wave_sum(d1); d2 = wave_sum(d2);
        if (F.lane == 0) F.ctl[CW_LAM] = __float_as_uint(expf(d1) - expf(d2) + 0.2f);
    }
    __syncthreads();
}

__device__ __forceinline__ void ml0_seq(Frame& F, const float* const* in, int s) {
    const int b = s >> 2, hh = s & 3;
    const float* MLG = (const float*)(F.ws + WS_MLG);
    float* KW = (float*)(F.ws + WS_SCKW); float* RS = (float*)(F.ws + WS_SCRS); float* IT = (float*)(F.ws + WS_SCIT); float* ED = (float*)(F.ws + WS_SCED); float* DEC = (float*)(F.ws + WS_DEC);
    LAS float* sm_bl = (LAS float*)F.lds; LAS float* sm_cm = sm_bl + 64; LAS float* sm_mp = sm_bl + 128; LAS float* sm_R = sm_bl + 192;
    const float big = in[6][hh], bfg = in[7][hh];
    float bl[8][4], gh[8][4], cm[8][4];
#pragma unroll
    for (int rd = 0; rd < 8; ++rd) {
        const int c = rd * 8 + F.wave; const size_t t0 = (size_t)b * SEQ + (size_t)c * 256 + 4 * F.lane;
        float lf[4], ig[4];
#pragma unroll
        for (int i = 0; i < 4; ++i) { const float fg = MLG[(t0 + i) * 8 + 4 + hh] + bfg; lf[i] = fminf(fg, 0.f) - log1pf(expf(-fabsf(fg))); ig[i] = MLG[(t0 + i) * 8 + hh] + big; }
        float p[4]; p[0] = lf[0]; p[1] = p[0] + lf[1]; p[2] = p[1] + lf[2]; p[3] = p[2] + lf[3];
        float incl = p[3];
#pragma unroll
        for (int o = 1; o < 64; o <<= 1) { const float y = __shfl_up(incl, o); if (F.lane >= o) incl += y; }
        const float excl = incl - p[3];
#pragma unroll
        for (int i = 0; i < 4; ++i) { bl[rd][i] = excl + p[i]; gh[rd][i] = ig[i] - bl[rd][i]; }
        float q[4]; q[0] = gh[rd][0]; q[1] = fmaxf(q[0], gh[rd][1]); q[2] = fmaxf(q[1], gh[rd][2]); q[3] = fmaxf(q[2], gh[rd][3]);
        float im = q[3];
#pragma unroll
        for (int o = 1; o < 64; o <<= 1) { const float y = __shfl_up(im, o); if (F.lane >= o) im = fmaxf(im, y); }
        float em = __shfl_up(im, 1); if (F.lane == 0) em = -__builtin_inff();
#pragma unroll
        for (int i = 0; i < 4; ++i) cm[rd][i] = fmaxf(em, q[i]);
        if (F.lane == 63) { sm_bl[c] = bl[rd][3]; sm_cm[c] = cm[rd][3]; }
    }
    __syncthreads();
    if (F.tid == 0) { float M = 0.f; for (int c = 0; c < 64; ++c) { sm_mp[c] = M; const float R = fmaxf(M, sm_cm[c]); sm_R[c] = R; M = sm_bl[c] + R; } }
    __syncthreads();
#pragma unroll
    for (int rd = 0; rd < 8; ++rd) {
        const int c = rd * 8 + F.wave; const size_t idx = (size_t)hh * TT + (size_t)b * SEQ + (size_t)c * 256 + 4 * F.lane;
        const float Mp = sm_mp[c], R = sm_R[c];
        f32x4 kw, rs, it, ed;
#pragma unroll
        for (int i = 0; i < 4; ++i) { const float Gt = fmaxf(Mp, cm[rd][i]); kw[i] = expf(gh[rd][i] - R); rs[i] = expf(R - Gt); it[i] = expf(Mp - Gt); ed[i] = expf(-(bl[rd][i] + Gt)); }
        *(f32x4*)(KW + idx) = kw; *(f32x4*)(RS + idx) = rs; *(f32x4*)(IT + idx) = it; *(f32x4*)(ED + idx) = ed;
        if (F.lane == 0) DEC[s * 64 + c] = expf(Mp - R);
    }
    __syncthreads();
}

__device__ __forceinline__ void unpack8(const u32x4 r, float (&x)[8]) { x[0] = bflo(r.x); x[1] = bfhi(r.x); x[2] = bflo(r.y); x[3] = bfhi(r.y); x[4] = bflo(r.z); x[5] = bfhi(r.z); x[6] = bflo(r.w); x[7] = bfhi(r.w); }
__device__ __forceinline__ void ml1_conv(Frame& F, const float* const* in) {
    const bf16_t* MQK = (const bf16_t*)(F.ws + WS_MQK);
    bf16_t* Q = (bf16_t*)(F.ws + WS_Q); bf16_t* WQ = (bf16_t*)(F.ws + WS_WQ); bf16_t* KWB = (bf16_t*)(F.ws + WS_KW); bf16_t* KWT = (bf16_t*)(F.ws + WS_KWT);
    const float* KWS = (const float*)(F.ws + WS_SCKW); const float* ITS = (const float*)(F.ws + WS_SCIT); float* KN4 = (float*)(F.ws + WS_KN);
    const float* cw = in[4]; const float* cbp = in[5];
    for (int id = F.gw; id < 2048; id += F.NGW) {
        const int cg = id & 3, sc = id >> 2, kind = cg >> 1, hh = (cg & 1) * 2 + (F.lane >> 5), d0 = (F.lane & 31) * 8, col = cg * 512 + F.lane * 8;
        const size_t t0 = (size_t)sc * 64, hrow = (size_t)hh * TT + t0;
        float w[4][8], cb[8], h3[8], h2[8], h1[8], cs[8];
#pragma unroll
        for (int j = 0; j < 4; ++j) { const f32x4 a = *(const f32x4*)(cw + j * 2048 + col), b = *(const f32x4*)(cw + j * 2048 + col + 4);
            w[j][0] = a.x; w[j][1] = a.y; w[j][2] = a.z; w[j][3] = a.w; w[j][4] = b.x; w[j][5] = b.y; w[j][6] = b.z; w[j][7] = b.w; }
        { const f32x4 a = *(const f32x4*)(cbp + col), b = *(const f32x4*)(cbp + col + 4); cb[0] = a.x; cb[1] = a.y; cb[2] = a.z; cb[3] = a.w; cb[4] = b.x; cb[5] = b.y; cb[6] = b.z; cb[7] = b.w; }
#pragma unroll
        for (int c = 0; c < 8; ++c) { h3[c] = 0.f; h2[c] = 0.f; h1[c] = 0.f; cs[c] = 0.f; }
        if ((t0 & (size_t)(SEQ - 1)) != 0) {
            unpack8(*(const u32x4*)(MQK + (t0 - 3) * 2048 + col), h3); unpack8(*(const u32x4*)(MQK + (t0 - 2) * 2048 + col), h2); unpack8(*(const u32x4*)(MQK + (t0 - 1) * 2048 + col), h1); }
        u32x4 xn[8];
#pragma unroll
        for (int i = 0; i < 8; ++i) xn[i] = *(const u32x4*)(MQK + (t0 + i) * 2048 + col);
        for (int tb = 0; tb < 8; ++tb) {
            u32x4 xr[8]; unsigned pk[8][4];
#pragma unroll
            for (int i = 0; i < 8; ++i) xr[i] = xn[i];
            { const int tn = tb < 7 ? tb + 1 : 7;
#pragma unroll
              for (int i = 0; i < 8; ++i) xn[i] = *(const u32x4*)(MQK + (t0 + tn * 8 + i) * 2048 + col); }
#pragma unroll
            for (int i = 0; i < 8; ++i) {
                float xv[8], sv[8]; unpack8(xr[i], xv);
#pragma unroll
                for (int c = 0; c < 8; ++c) { const float y = w[0][c] * h3[c] + w[1][c] * h2[c] + w[2][c] * h1[c] + w[3][c] * xv[c] + cb[c]; sv[c] = y * sigmoidf_(y); h3[c] = h2[c]; h2[c] = h1[c]; h1[c] = xv[c]; }
                const size_t tr = hrow + tb * 8 + i;
                if (kind == 0) { const float itv = ITS[tr];
                    u32x4 o; o.x = cvtpk(sv[0], sv[1]); o.y = cvtpk(sv[2], sv[3]); o.z = cvtpk(sv[4], sv[5]); o.w = cvtpk(sv[6], sv[7]); *(u32x4*)(Q + tr * 256 + d0) = o;
                    u32x4 p; p.x = cvtpk(sv[0] * itv, sv[1] * itv); p.y = cvtpk(sv[2] * itv, sv[3] * itv); p.z = cvtpk(sv[4] * itv, sv[5] * itv); p.w = cvtpk(sv[6] * itv, sv[7] * itv); *(u32x4*)(WQ + tr * 512 + 256 + d0) = p;
                } else { const float kwv = KWS[tr] * 0.0625f;
                    u32x4 o; o.x = cvtpk(sv[0] * kwv, sv[1] * kwv); o.y = cvtpk(sv[2] * kwv, sv[3] * kwv); o.z = cvtpk(sv[4] * kwv, sv[5] * kwv); o.w = cvtpk(sv[6] * kwv, sv[7] * kwv); *(u32x4*)(KWB + tr * 256 + d0) = o;
                    pk[i][0] = o.x; pk[i][1] = o.y; pk[i][2] = o.z; pk[i][3] = o.w;
                    cs[0] += bflo(o.x); cs[1] += bfhi(o.x); cs[2] += bflo(o.y); cs[3] += bfhi(o.y); cs[4] += bflo(o.z); cs[5] += bfhi(o.z); cs[6] += bflo(o.w); cs[7] += bfhi(o.w); }
            }
            if (kind == 1) {
#pragma unroll
                for (int c = 0; c < 8; ++c) { u32x4 o;
                    unsigned wj[4];
#pragma unroll
                    for (int j = 0; j < 4; ++j) { const unsigned a = pk[2 * j][c >> 1], b = pk[2 * j + 1][c >> 1];
                        wj[j] = (c & 1) ? ((a >> 16) | (b & 0xffff0000u)) : ((a & 0xffffu) | (b << 16)); }
                    o.x = wj[0]; o.y = wj[1]; o.z = wj[2]; o.w = wj[3];
                    *(u32x4*)(KWT + (((size_t)hh * 128 + (sc >> 2)) * 256 + d0 + c) * 256 + (sc & 3) * 64 + tb * 8) = o; }
            }
        }
        if (kind == 1) { float* kn = KN4 + (((size_t)hh * 128 + (sc >> 2)) * 4 + (sc & 3)) * 256 + d0;
            *(f32x4*)kn = (f32x4){cs[0], cs[1], cs[2], cs[3]}; *(f32x4*)(kn + 4) = (f32x4){cs[4], cs[5], cs[6], cs[7]}; }
    }
}

__device__ __forceinline__ void nscan_seq(Frame& F, int s) {
    if (F.tid < 256) { const int hh = s & 3, b = s >> 2; const float* KN4 = (const float*)(F.ws + WS_KN); const float* DEC = (const float*)(F.ws + WS_DEC); float* NP = (float*)(F.ws + WS_NP);
        float n = 0.f;
        for (int c0 = 0; c0 < 64; c0 += 8) { float kn[8], dc[8];
#pragma unroll
            for (int i = 0; i < 8; ++i) { const float* p = KN4 + ((size_t)hh * 128 + b * 64 + c0 + i) * 1024 + F.tid; kn[i] = (p[0] + p[256]) + (p[512] + p[768]); dc[i] = DEC[s * 64 + c0 + i]; }
#pragma unroll
            for (int i = 0; i < 8; ++i) { NP[((size_t)s * 64 + c0 + i) * 256 + F.tid] = n; n = dc[i] * n + kn[i]; } }
    }
}
__device__ __forceinline__ void xsoftmax(Frame& F) {
    const bf16_t* XS = (const bf16_t*)(F.ws + WS_XS); bf16_t* XP = (bf16_t*)(F.ws + WS_XP);
    const int sub = F.lane >> 5, d8 = (F.lane & 31) * 8;
    for (int row0 = F.gw * 8; row0 < 4 * TT; row0 += F.NGW * 8) {
        u32x4 v[4];
#pragma unroll
        for (int i = 0; i < 4; ++i) v[i] = *(const u32x4*)(XS + (size_t)(row0 + 2 * i + sub) * 256 + d8);
#pragma unroll
        for (int i = 0; i < 4; ++i) { float x[8]; unpack8(v[i], x);
            float m = fmaxf(fmaxf(fmaxf(x[0], x[1]), fmaxf(x[2], x[3])), fmaxf(fmaxf(x[4], x[5]), fmaxf(x[6], x[7])));
#pragma unroll
            for (int o = 1; o < 32; o <<= 1) m = fmaxf(m, __shfl_xor(m, o));
            float s = 0.f;
#pragma unroll
            for (int c = 0; c < 8; ++c) { x[c] = __expf(x[c] - m); s += x[c]; }
#pragma unroll
            for (int o = 1; o < 32; o <<= 1) s += __shfl_xor(s, o);
            const float inv = 1.0f / s;
            u32x4 w; w.x = cvtpk(x[0] * inv, x[1] * inv); w.y = cvtpk(x[2] * inv, x[3] * inv); w.z = cvtpk(x[4] * inv, x[5] * inv); w.w = cvtpk(x[6] * inv, x[7] * inv);
            *(u32x4*)(XP + (size_t)(row0 + 2 * i + sub) * 256 + d8) = w; }
    }
}
__device__ __forceinline__ void cscan(Frame& F) {
    const bf16_t* U = (const bf16_t*)(F.ws + WS_U); bf16_t* VC = (bf16_t*)(F.ws + WS_VC); const float* DEC = (const float*)(F.ws + WS_DEC);
    for (int gid = F.bid * 512 + F.tid; gid < 131072; gid += F.G * 512) {
        const int s = gid >> 14, rem = gid & 16383, dv = rem >> 6, dk4 = (rem & 63) * 4, hh = s & 3, b = s >> 2;
        f32x4 C = {0.f, 0.f, 0.f, 0.f};
        for (int c0 = 0; c0 < 64; c0 += 8) { const size_t g0 = (size_t)hh * 128 + b * 64 + c0;
            f32x4 u[8]; float dc[8];
#pragma unroll
            for (int i = 0; i < 8; ++i) { const u32x2 w = *(const u32x2*)(U + (g0 + i) * 65536 + (size_t)dv * 256 + dk4); u[i] = (f32x4){bflo(w.x), bfhi(w.x), bflo(w.y), bfhi(w.y)}; dc[i] = DEC[s * 64 + c0 + i]; }
#pragma unroll
            for (int i = 0; i < 8; ++i) { u32x2 w; w.x = cvtpk(C.x, C.y); w.y = cvtpk(C.z, C.w); *(u32x2*)(VC + ((g0 + i) * 256 + dv) * 512 + 256 + dk4) = w; C = C * dc[i] + u[i]; } }
    }
}
__device__ __forceinline__ void denpass(Frame& F) {
    const bf16_t* WQ = (const bf16_t*)(F.ws + WS_WQ); const float* NP = (const float*)(F.ws + WS_NP); const float* ED = (const float*)(F.ws + WS_SCED); float* HDEN = (float*)(F.ws + WS_HDEN);
    for (int row0 = F.gw * 4; row0 < 4 * TT; row0 += F.NGW * 4) {
        const int hh = row0 / TT, t = row0 - hh * TT, b = t / SEQ, c = (t - b * SEQ) >> 8;
        u32x4 w[4]; f32x4 n0 = {0.f, 0.f, 0.f, 0.f}, n1 = {0.f, 0.f, 0.f, 0.f};
#pragma unroll
        for (int i = 0; i < 4; ++i) w[i] = *(const u32x4*)(WQ + (size_t)(row0 + i) * 512 + 8 * F.lane);
        if (F.lane >= 32) { const float* np = NP + ((size_t)(b * 4 + hh) * 64 + c) * 256 + 8 * (F.lane - 32); n0 = *(const f32x4*)np; n1 = *(const f32x4*)(np + 4); }
        else { n0 = (f32x4){1.f, 1.f, 1.f, 1.f}; n1 = n0; }
        const float edv = ED[row0 + (F.lane & 3)];
#pragma unroll
        for (int i = 0; i < 4; ++i) {
            const float part = ((bflo(w[i].x) * n0.x + bfhi(w[i].x) * n0.y) + (bflo(w[i].y) * n0.z + bfhi(w[i].y) * n0.w)) + ((bflo(w[i].z) * n1.x + bfhi(w[i].z) * n1.y) + (bflo(w[i].w) * n1.z + bfhi(w[i].w) * n1.w));
            const float den = wave_sum(part);
            if (F.lane == i) HDEN[row0 + i] = fmaxf(fabsf(den), edv); }
    }
}
__device__ __forceinline__ void hmnorm(Frame& F, const float* const* in) {
    bf16_t* HR = (bf16_t*)(F.dout + DO_HR); const bf16_t* MLO = (const bf16_t*)(F.ws + WS_MLO); const float* g = in[13];
    const int sub = F.lane >> 5, d8 = (F.lane & 31) * 8;
    for (int row0 = F.gw * 8; row0 < 4 * TT; row0 += F.NGW * 8) {
        u32x4 xw[4], ow[4];
#pragma unroll
        for (int i = 0; i < 4; ++i) { const int row = row0 + 2 * i + sub; const size_t o = (size_t)(row >> 2) * 1024 + (row & 3) * 256 + d8; xw[i] = *(const u32x4*)(HR + o); ow[i] = *(const u32x4*)(MLO + o); }
#pragma unroll
        for (int i = 0; i < 4; ++i) { const int row = row0 + 2 * i + sub, hh = row & 3; const size_t o = (size_t)(row >> 2) * 1024 + hh * 256 + d8;
            float x[8], og[8]; unpack8(xw[i], x); unpack8(ow[i], og);
            float ss = ((x[0] * x[0] + x[1] * x[1]) + (x[2] * x[2] + x[3] * x[3])) + ((x[4] * x[4] + x[5] * x[5]) + (x[6] * x[6] + x[7] * x[7]));
            ss += __shfl_xor(ss, 1); ss += __shfl_xor(ss, 2); ss += __shfl_xor(ss, 4); ss += __shfl_xor(ss, 8); ss += __shfl_xor(ss, 16);
            const float r = rsqrtf(ss * (1.0f / 256.0f) + EPS);
            const f32x4 g0 = *(const f32x4*)(g + hh * 256 + d8), g1 = *(const f32x4*)(g + hh * 256 + d8 + 4);
            u32x4 w; w.x = cvtpk(sigmoidf_(og[0]) * x[0] * r * g0.x, sigmoidf_(og[1]) * x[1] * r * g0.y); w.y = cvtpk(sigmoidf_(og[2]) * x[2] * r * g0.z, sigmoidf_(og[3]) * x[3] * r * g0.w);
            w.z = cvtpk(sigmoidf_(og[4]) * x[4] * r * g1.x, sigmoidf_(og[5]) * x[5] * r * g1.y); w.w = cvtpk(sigmoidf_(og[6]) * x[6] * r * g1.z, sigmoidf_(og[7]) * x[7] * r * g1.w);
            *(u32x4*)(HR + o) = w; }
    }
}
__device__ __forceinline__ unsigned fkey(float f) { const unsigned u = __float_as_uint(f); return (u & 0x80000000u) ? ~u : (u | 0x80000000u); }
__device__ __forceinline__ float fkey_inv(unsigned k) { return __uint_as_float((k & 0x80000000u) ? (k & 0x7fffffffu) : ~k); }
__device__ __forceinline__ float dot8(const u32x4 a, const u32x4 b) {
    return ((bflo(a.x) * bflo(b.x) + bfhi(a.x) * bfhi(b.x)) + (bflo(a.y) * bflo(b.y) + bfhi(a.y) * bfhi(b.y))) + ((bflo(a.z) * bflo(b.z) + bfhi(a.z) * bfhi(b.z)) + (bflo(a.w) * bflo(b.w) + bfhi(a.w) * bfhi(b.w))); }
__device__ __forceinline__ void normmax(Frame& F) {
    LAS float* red = (LAS float*)F.lds;
    const bf16_t* DQ = (const bf16_t*)(F.ws + WS_DQ); const bf16_t* DK = (const bf16_t*)(F.ws + WS_DK);
    const size_t row0 = (size_t)F.gw * 16 + (F.lane >> 4), coff = (F.lane & 15) * 8;
    u32x4 q[4], k[4];
#pragma unroll
    for (int i = 0; i < 4; ++i) { q[i] = *(const u32x4*)(DQ + (row0 + 4 * i) * 128 + coff); k[i] = *(const u32x4*)(DK + (row0 + 4 * i) * 128 + coff); }
    for (int c16 = 0; c16 < 16; ++c16) {
        u32x4 qn[4], kn[4];
        const int cn = c16 < 15 ? c16 + 1 : 15;
#pragma unroll
        for (int i = 0; i < 4; ++i) { qn[i] = *(const u32x4*)(DQ + ((size_t)cn * TT + row0 + 4 * i) * 128 + coff); kn[i] = *(const u32x4*)(DK + ((size_t)cn * TT + row0 + 4 * i) * 128 + coff); }
        float q2 = 0.f, k2 = 0.f, nd = -__builtin_inff();
#pragma unroll
        for (int i = 0; i < 4; ++i) { float a = dot8(q[i], q[i]), b = dot8(k[i], k[i]), c = dot8(q[i], k[i]);
#pragma unroll
            for (int o = 1; o < 16; o <<= 1) { a += __shfl_xor(a, o); b += __shfl_xor(b, o); c += __shfl_xor(c, o); }
            q2 = fmaxf(q2, a); k2 = fmaxf(k2, b); nd = fmaxf(nd, -c); }
        q2 = wave_max(q2); k2 = wave_max(k2); nd = wave_max(nd);
        if (F.lane == 0) { red[F.wave] = q2; red[8 + F.wave] = k2; red[16 + F.wave] = nd; }
        __syncthreads();
        if (F.tid < 2) {
            const int blk = F.bid >> 1, b = (F.bid * 128) / SEQ;
            if (F.tid == 0) { float a = red[0], bb = red[8];
#pragma unroll
                for (int w = 1; w < 8; ++w) { a = fmaxf(a, red[w]); bb = fmaxf(bb, red[8 + w]); }
                atomicMax(F.ctl + CW_QB2 + c16 * 128 + blk, __float_as_uint(a)); atomicMax(F.ctl + CW_KMX + c16 * 2 + b, __float_as_uint(bb)); }
            else { float a = red[16];
#pragma unroll
                for (int w = 1; w < 8; ++w) a = fmaxf(a, red[16 + w]);
                atomicMax(F.ctl + CW_ND + c16 * 128 + blk, fkey(a)); }
        }
        __syncthreads();
#pragma unroll
        for (int i = 0; i < 4; ++i) { q[i] = qn[i]; k[i] = kn[i]; }
    }
}
__device__ __forceinline__ attn4::Item attn_item(Frame& F, int qx, int id) {
    const int b = qx >> 2, m = (qx >> 1) & 1, x = id, h = 7 - (x >> 6), qb = 2 * (63 - (x & 63)) + (qx & 1);
    const bf16_t* DQ = (const bf16_t*)(F.ws + WS_DQ); const bf16_t* DK = (const bf16_t*)(F.ws + WS_DK); const bf16_t* DV = (const bf16_t*)(F.ws + WS_DV); bf16_t* O = (bf16_t*)(F.ws + WS_O);
    attn4::Item it; const size_t srow = (size_t)b * SEQ;
    it.Q = DQ + ((size_t)(h * 2 + m) * TT + srow + (size_t)qb * 128) * 128;
    it.K = DK + ((size_t)(h * 2 + m) * TT + srow) * 128;
    it.V0 = DV + ((size_t)(h * 2 + 0) * TT + srow) * 128;
    it.V1 = DV + ((size_t)(h * 2 + 1) * TT + srow) * 128;
    it.O = O + ((size_t)(h * 2 + m) * TT + srow + (size_t)qb * 128) * 256;
    it.P0 = qb * 128;
    const int c16 = h * 2 + m, blk = b * 64 + (qb >> 1);
    const float q2 = __uint_as_float(F.ctl[CW_QB2 + c16 * 128 + blk]), k2 = __uint_as_float(F.ctl[CW_KMX + c16 * 2 + b]), ndg = fkey_inv(F.ctl[CW_ND + c16 * 128 + blk]);
    const float slope = exp2f(-(float)(h + 1));
    const float bnd = (sqrtf(q2) * sqrtf(k2) + ndg) * attn::SCALE + 32.02f;
    float wf = ceilf(bnd / slope) + 1.0f; if (!(wf < (float)SEQ)) wf = (float)SEQ; if (!(wf >= 1.0f)) wf = 1.0f;
    it.W = (int)wf; it.sl = slope / attn::SCALE;
    return it;
}
__device__ __forceinline__ int attn_ticket(Frame& F, int rep, int& myq) {
    if (F.tid == 0) { int res = -1;
        for (int k = 0; k < 8; ++k) { const int q = (myq + k) & 7; const unsigned t = atomicAdd(F.ctl + CW_AHEAD + rep * 64 + q * 8, 1u); if (t < 512u) { res = q * 512 + (int)t; break; } }
        F.MISC[0] = (unsigned)res; }
    __syncthreads();
    const int v = __builtin_amdgcn_readfirstlane((int)F.MISC[0]);
    __syncthreads();
    if (v >= 0) myq = v >> 9;
    return v;
}
__device__ __forceinline__ void attn_phase(Frame& F, int rep) {
    const int tid = F.tid; int myq = F.bid & 7;
    for (;;) {
        const int id = attn_ticket(F, rep, myq);
        if (id < 0) break;
        const attn4::Item it = attn_item(F, id >> 9, id & 511);
        attn4::item(it, (char*)F.lds_g, F.lds, tid);
    }
    VM_WAIT(); __syncthreads();
}
__device__ __forceinline__ void dacombine(Frame& F, const float* const* in) {
    const bf16_t* O = (const bf16_t*)(F.ws + WS_O); bf16_t* DA = (bf16_t*)(F.ws + WS_DA); const float* g = in[12];
    const float lam = __uint_as_float(F.ctl[CW_LAM]);
    const int sub = F.lane >> 5, d8 = (F.lane & 31) * 8;
    for (int row0 = F.gw * 8; row0 < 8 * TT; row0 += F.NGW * 8) {
        u32x4 a[4], bq[4];
#pragma unroll
        for (int i = 0; i < 4; ++i) { const int row = row0 + 2 * i + sub, t = row >> 3, h = row & 7;
            a[i] = *(const u32x4*)(O + ((size_t)(h * 2 + 0) * TT + t) * 256 + d8); bq[i] = *(const u32x4*)(O + ((size_t)(h * 2 + 1) * TT + t) * 256 + d8); }
#pragma unroll
        for (int i = 0; i < 4; ++i) { const int row = row0 + 2 * i + sub, t = row >> 3, h = row & 7;
            float x[8], y[8]; unpack8(a[i], x); unpack8(bq[i], y);
#pragma unroll
            for (int c = 0; c < 8; ++c) x[c] -= lam * y[c];
            float ss = ((x[0] * x[0] + x[1] * x[1]) + (x[2] * x[2] + x[3] * x[3])) + ((x[4] * x[4] + x[5] * x[5]) + (x[6] * x[6] + x[7] * x[7]));
            ss += __shfl_xor(ss, 1); ss += __shfl_xor(ss, 2); ss += __shfl_xor(ss, 4); ss += __shfl_xor(ss, 8); ss += __shfl_xor(ss, 16);
            const float r = rsqrtf(ss * (1.0f / 256.0f) + EPS) * 0.8f;
            const f32x4 g0 = *(const f32x4*)(g + h * 256 + d8), g1 = *(const f32x4*)(g + h * 256 + d8 + 4);
            u32x4 w; w.x = cvtpk(x[0] * r * g0.x, x[1] * r * g0.y); w.y = cvtpk(x[2] * r * g0.z, x[3] * r * g0.w); w.z = cvtpk(x[4] * r * g1.x, x[5] * r * g1.y); w.w = cvtpk(x[6] * r * g1.z, x[7] * r * g1.w);
            *(u32x4*)(DA + (size_t)t * 2048 + h * 256 + d8) = w; }
    }
}
__device__ __forceinline__ void expert_convert(Frame& F, const float* const* in) {
    LAS float* scr = (LAS float*)(F.lds + F.wave * 16384);
    unsigned char* WGU = F.ws + WS_WGU; unsigned char* WD = F.ws + WS_WD;
    constexpr int PER = 22528;
    for (int it = F.gw; it < 3 * PER; it += F.NGW) {
        const int kind = it / PER, r = it - kind * PER, e = r / 704, r2 = r - e * 704;
        if (kind < 2) { const int kb = r2 / 22, nb = r2 - kb * 22, pn = nb >> 2;
            tr_item8((kind == 0 ? in[26] : in[27]) + (size_t)e * 2048 * DEXP, DEXP, 0, WGU, 2048, e * GU_N + pn * 128 + kind * 128, kb, nb, 32.0f, scr, F.lane); }
        else { const int kb = r2 >> 6, nb = r2 & 63;
            tr_item8(in[28] + (size_t)e * DEXP * 2048, 2048, 0, WD + (size_t)e * 2048 * DEXP_P, DEXP_P, 0, kb, nb, 16.0f, scr, F.lane); }
    }
    const u32x4 z = {0u, 0u, 0u, 0u};
    for (int idx = F.bid * 512 + F.tid; idx < 32 * 2 * 64 * 128; idx += F.G * 512) { const int e = idx >> 14, rem = idx & 16383, blk = rem >> 13, row = (rem >> 7) & 63, c16 = rem & 127;
        *(u32x4*)(WGU + ((size_t)e * GU_N + 1280 + blk * 128 + 64 + row) * 2048 + c16 * 16) = z; }
    for (int idx = F.bid * 512 + F.tid; idx < 32 * 2048 * 4; idx += F.G * 512) { const int en = idx >> 2, j = idx & 3;
        *(u32x4*)(WD + (size_t)en * DEXP_P + DEXP + j * 16) = z; }
    { const bf16_t* HBF = (const bf16_t*)(F.dout + DO_HBF); unsigned char* H8 = F.ws + WS_HBF8;
      for (size_t g8 = (size_t)(F.gw * 64 + F.lane) * 4; g8 < (size_t)TT * 256; g8 += (size_t)F.NGW * 64 * 4) {
          u32x4 a[4];
#pragma unroll
          for (int i = 0; i < 4; ++i) a[i] = *(const u32x4*)(HBF + (g8 + i) * 8);
          u32x4 o0, o1;
          o0.x = pk4_fp8(bflo(a[0].x), bfhi(a[0].x), bflo(a[0].y), bfhi(a[0].y)); o0.y = pk4_fp8(bflo(a[0].z), bfhi(a[0].z), bflo(a[0].w), bfhi(a[0].w));
          o0.z = pk4_fp8(bflo(a[1].x), bfhi(a[1].x), bflo(a[1].y), bfhi(a[1].y)); o0.w = pk4_fp8(bflo(a[1].z), bfhi(a[1].z), bflo(a[1].w), bfhi(a[1].w));
          o1.x = pk4_fp8(bflo(a[2].x), bfhi(a[2].x), bflo(a[2].y), bfhi(a[2].y)); o1.y = pk4_fp8(bflo(a[2].z), bfhi(a[2].z), bflo(a[2].w), bfhi(a[2].w));
          o1.z = pk4_fp8(bflo(a[3].x), bfhi(a[3].x), bflo(a[3].y), bfhi(a[3].y)); o1.w = pk4_fp8(bflo(a[3].z), bfhi(a[3].z), bflo(a[3].w), bfhi(a[3].w));
          *(u32x4*)(H8 + g8 * 8) = o0; *(u32x4*)(H8 + g8 * 8 + 16) = o1; } }
    __syncthreads();
}
__device__ __forceinline__ void topk_pass(Frame& F, const float* const* in) {
    const float* LG = (const float*)(F.ws + WS_LG); int* TOKE = (int*)(F.ws + WS_TOKE); float* TOKW = (float*)(F.ws + WS_TOKW); const float* RSS = (const float*)(F.ws + WS_RSS); float* RT = (float*)(F.ws + WS_RT);
    LAS unsigned* hist = (LAS unsigned*)F.lds;
    if (F.tid < 32) hist[F.tid] = 0u;
    __syncthreads();
    const float* brg = in[23]; const float* bre = in[25];
    for (int t = F.bid * 512 + F.tid; t < TT; t += F.G * 512) {
        const float* lp = LG + (size_t)t * 256;
        float rt; { const f32x4* rs = (const f32x4*)(RSS + (size_t)t * 32); f32x4 a = rs[0];
#pragma unroll
            for (int j = 1; j < 8; ++j) a += rs[j];
            rt = rsqrtf(((a.x + a.y) + (a.z + a.w)) * (1.0f / 2048.0f) + EPS); RT[t] = rt; }
        const f32x4 g4 = *(const f32x4*)lp * rt;
        const float g0 = g4.x + brg[0], g1 = g4.y + brg[1], g2 = g4.z + brg[2], g3 = g4.w + brg[3];
        int grp = 0; float gm = g0; if (g1 > gm) { gm = g1; grp = 1; } if (g2 > gm) { gm = g2; grp = 2; } if (g3 > gm) { gm = g3; grp = 3; }
        const float pg = 1.0f / (expf(g0 - gm) + expf(g1 - gm) + expf(g2 - gm) + expf(g3 - gm));
        const f32x4 ea = *(const f32x4*)(lp + 4 + grp * 8) * rt, eb = *(const f32x4*)(lp + 8 + grp * 8) * rt;
        const f32x4 ba = *(const f32x4*)(bre + grp * 8), bb = *(const f32x4*)(bre + grp * 8 + 4);
        float ev[8] = {ea.x + ba.x, ea.y + ba.y, ea.z + ba.z, ea.w + ba.w, eb.x + bb.x, eb.y + bb.y, eb.z + bb.z, eb.w + bb.w};
        int i1 = 0; float v1 = ev[0];
#pragma unroll
        for (int j = 1; j < 8; ++j) if (ev[j] > v1) { v1 = ev[j]; i1 = j; }
        int i2 = -1; float v2 = -__builtin_inff();
#pragma unroll
        for (int j = 0; j < 8; ++j) if (j != i1 && ev[j] > v2) { v2 = ev[j]; i2 = j; }
        const float ex = expf(v2 - v1), inv = 1.0f / (1.0f + ex);
        const int e1 = grp * 8 + i1, e2 = grp * 8 + i2;
        TOKE[t * 2] = e1; TOKE[t * 2 + 1] = e2; TOKW[t * 2] = inv * pg; TOKW[t * 2 + 1] = ex * inv * pg;
        __hip_atomic_fetch_add(&hist[e1], 1u, __ATOMIC_RELAXED, __HIP_MEMORY_SCOPE_WORKGROUP); __hip_atomic_fetch_add(&hist[e2], 1u, __ATOMIC_RELAXED, __HIP_MEMORY_SCOPE_WORKGROUP);
    }
    __syncthreads();
    if (F.tid < 32 && hist[F.tid]) atomicAdd(F.ctl + CW_ECNT + F.tid, hist[F.tid]);
    __syncthreads();
}
__device__ __forceinline__ void gather_pass(Frame& F, const float* const* in) {
    const int* TOKE = (const int*)(F.ws + WS_TOKE); const float* TOKW = (const float*)(F.ws + WS_TOKW); int* POS = (int*)(F.ws + WS_POS); float* WROW = (float*)(F.ws + WS_WROW); int* TILEE = (int*)(F.ws + WS_TILEE);
    const bf16_t* X1B = (const bf16_t*)(F.ws + WS_X1B); const float* RT = (const float*)(F.ws + WS_RT); unsigned char* XSORT = F.ws + WS_XSORT;
    float gf[32];
#pragma unroll
    for (int j = 0; j < 8; ++j) { const f32x4 g = *(const f32x4*)(in[21] + 32 * F.lane + 4 * j); gf[4 * j] = g.x; gf[4 * j + 1] = g.y; gf[4 * j + 2] = g.z; gf[4 * j + 3] = g.w; }
    LAS unsigned* pstart = (LAS unsigned*)F.lds; LAS unsigned* hist = pstart + 32; LAS unsigned* base = pstart + 64; LAS unsigned* lcur = pstart + 96; LAS int* apos = (LAS int*)(pstart + 128); LAS int* atok = apos + 512;
    if (F.tid == 0) { unsigned acc = 0; for (int e = 0; e < 32; ++e) { pstart[e] = acc; const unsigned c = F.ctl[CW_ECNT + e]; const unsigned pc = (c + 255u) & ~255u;
            if (F.bid == 0) for (unsigned rt = acc >> 8; rt < (acc + pc) >> 8; ++rt) TILEE[rt] = e;
            acc += pc; }
        if (F.bid == 0) F.ctl[CW_NRT] = acc >> 8; }
    const int per = (TT + F.G - 1) / F.G;
    const int tbeg = F.bid * per, tend = (tbeg + per < TT) ? tbeg + per : TT;
    for (int ts = tbeg; ts < tend; ts += 256) {
        const int nasg = 2 * ((tend - ts < 256) ? tend - ts : 256);
        if (F.tid < 32) { hist[F.tid] = 0u; lcur[F.tid] = 0u; }
        __syncthreads();
        int e = 0; const int a = F.tid;
        if (a < nasg) { e = TOKE[ts * 2 + a]; __hip_atomic_fetch_add(&hist[e], 1u, __ATOMIC_RELAXED, __HIP_MEMORY_SCOPE_WORKGROUP); }
        __syncthreads();
        if (F.tid < 32) base[F.tid] = pstart[F.tid] + (hist[F.tid] ? atomicAdd(F.ctl + CW_ECUR + F.tid, hist[F.tid]) : 0u);
        __syncthreads();
        if (a < nasg) { const unsigned p = base[e] + __hip_atomic_fetch_add(&lcur[e], 1u, __ATOMIC_RELAXED, __HIP_MEMORY_SCOPE_WORKGROUP); POS[ts * 2 + a] = (int)p; WROW[p] = TOKW[ts * 2 + a]; apos[a] = (int)p; atok[a] = ts + (a >> 1); }
        __syncthreads();
        for (int i = F.wave; i < nasg; i += 8) { const int tok = atok[i]; const u32x4* src = (const u32x4*)(X1B + (size_t)tok * 2048) + 4 * F.lane; u32x4* dst = (u32x4*)(XSORT + (size_t)apos[i] * 2048) + 2 * F.lane;
            u32x4 a[4]; const float rt = RT[tok];
#pragma unroll
            for (int j = 0; j < 4; ++j) a[j] = src[j];
            unsigned o[8];
#pragma unroll
            for (int j = 0; j < 4; ++j) {
                o[2 * j]     = pk4_fp8(bflo(a[j].x) * rt * gf[8 * j],     bfhi(a[j].x) * rt * gf[8 * j + 1], bflo(a[j].y) * rt * gf[8 * j + 2], bfhi(a[j].y) * rt * gf[8 * j + 3]);
                o[2 * j + 1] = pk4_fp8(bflo(a[j].z) * rt * gf[8 * j + 4], bfhi(a[j].z) * rt * gf[8 * j + 5], bflo(a[j].w) * rt * gf[8 * j + 6], bfhi(a[j].w) * rt * gf[8 * j + 7]); }
            u32x4 o0, o1; o0.x = o[0]; o0.y = o[1]; o0.z = o[2]; o0.w = o[3]; o1.x = o[4]; o1.y = o[5]; o1.z = o[6]; o1.w = o[7];
            dst[0] = o0; dst[1] = o1; }
        __syncthreads();
    }
}
__device__ __forceinline__ void final_pass(Frame& F, const float* const* in) {
    const bf16_t* X1B = (const bf16_t*)(F.ws + WS_X1B); float* OUT = (float*)F.dout; const bf16_t* YS = (const bf16_t*)(F.ws + WS_YS); const int* POS = (const int*)(F.ws + WS_POS); const float* g = in[29];
    for (int m0 = F.gw * 2; m0 < TT; m0 += F.NGW * 2) {
        u32x4 x[2][4], a[2][4], bq[2][4];
#pragma unroll
        for (int rr = 0; rr < 2; ++rr) { const int m = m0 + rr; const int p0 = POS[m * 2], p1 = POS[m * 2 + 1];
#pragma unroll
            for (int j = 0; j < 4; ++j) { const size_t c = 8 * F.lane + 512 * j;
                x[rr][j] = *(const u32x4*)(X1B + (size_t)m * 2048 + c); a[rr][j] = *(const u32x4*)(YS + (size_t)p0 * 2048 + c); bq[rr][j] = *(const u32x4*)(YS + (size_t)p1 * 2048 + c); } }
#pragma unroll
        for (int rr = 0; rr < 2; ++rr) { const int m = m0 + rr; float v[4][8]; float ss = 0.f;
#pragma unroll
            for (int j = 0; j < 4; ++j) { float xa[8], ya[8], yb[8]; unpack8(x[rr][j], xa); unpack8(a[rr][j], ya); unpack8(bq[rr][j], yb);
#pragma unroll
                for (int c = 0; c < 8; ++c) { v[j][c] = xa[c] + (ya[c] + yb[c]); ss += v[j][c] * v[j][c]; } }
            ss = wave_sum(ss); const float r = rsqrtf(ss * (1.0f / 2048.0f) + EPS);
#pragma unroll
            for (int j = 0; j < 4; ++j) { const size_t c = 8 * F.lane + 512 * j; const f32x4 g0 = *(const f32x4*)(g + c), g1 = *(const f32x4*)(g + c + 4);
                *(f32x4*)(OUT + (size_t)m * 2048 + c) = (f32x4){v[j][0] * r * g0.x, v[j][1] * r * g0.y, v[j][2] * r * g0.z, v[j][3] * r * g0.w};
                *(f32x4*)(OUT + (size_t)m * 2048 + c + 4) = (f32x4){v[j][4] * r * g1.x, v[j][5] * r * g1.y, v[j][6] * r * g1.z, v[j][7] * r * g1.w}; } }
    }
}
constexpr int NPHASE = 21;
struct Args { const float* in[30]; float* out; unsigned char* ws; int ph_lo, ph_hi; };

__device__ __forceinline__ bool fresh_lane(Frame& F) { int l = (int)__builtin_amdgcn_mbcnt_hi(~0u, __builtin_amdgcn_mbcnt_lo(~0u, 0u)); asm volatile("" : "+v"(l)); F.lane = l; F.tid = (F.wave << 6) | l; return true; }
__global__ void __launch_bounds__(512, 2) mk_fwd(Args args) {
    extern __shared__ __attribute__((aligned(16))) unsigned char lds_raw[];
    Frame F;
    F.lds = (LAS unsigned char*)lds_raw; F.lds_g = lds_raw;
    F.MISC = (volatile LAS unsigned*)(F.lds + MISC_OFF);
    F.tid = threadIdx.x; F.lane = F.tid & 63; F.wave = __builtin_amdgcn_readfirstlane(F.tid >> 6);
    F.G = gridDim.x; F.bid = blockIdx.x; F.gw = F.bid * 8 + F.wave; F.NGW = F.G * 8;
    F.ws = args.ws; F.dout = (unsigned char*)args.out; F.ctl = (unsigned*)(args.ws + WS_CTL);
    const float* const* in = args.in;
    for (int u = F.tid; u < (LDS_BYTES - RING_BYTES) / 4; u += 512) ((LAS unsigned*)(F.lds + RING_BYTES))[u] = 0u;
    __syncthreads();
    const int lo = args.ph_lo, hi = args.ph_hi;
    const bool fused = (hi - lo) > 1;
    XcdBarrier bar; bar.bar = F.ctl + CW_BAR; bar.x = 0; bar.st = nullptr;
    if (fused) bar = xcd_barrier_post(F.ctl + CW_BAR, F.MISC + 8, F.tid);
#ifndef ONLY_PHASE
#define ONLY_PHASE -1
#endif
#define IN(k) ((ONLY_PHASE < 0 || ONLY_PHASE == (k)) && lo <= (k) && (k) < hi && fresh_lane(F))
#ifndef DUP_MASK
#define DUP_MASK 0
#endif
#define DUP_BEGIN(k) _Pragma("unroll") for (int rep_ = 0; rep_ < 1 + ((DUP_MASK >> (k)) & 1); ++rep_) { if (rep_) { xcd_barrier(bar, F.tid); fresh_lane(F); }
#define DUP_END }
#define SEAM(k) do { if ((ONLY_PHASE < 0 || ONLY_PHASE == (k) + 1) && lo <= (k) + 1 && (k) + 1 < hi) xcd_barrier(bar, F.tid); } while (0)
    const int G = F.G, c = F.bid;
    bf16_t* const HBF = (bf16_t*)(F.dout + DO_HBF);
    bf16_t* const WINT = (bf16_t*)(F.ws + WS_WINT);
    const bf16_t* const HBF8 = (const bf16_t*)(F.ws + WS_HBF8);
    const bf16_t* const WG8 = (const bf16_t*)(WINT + (size_t)11264 * 2048);

    if (IN(0)) { DUP_BEGIN(0) p0_prologue(F, in); DUP_END SEAM(0); }

    if (IN(1)) { DUP_BEGIN(1)
        if (F.bid < 8) ml0_seq(F, in, F.bid);
        pg8::SchedPA S{HBF, WINT, G, c};
        pg8::EpiPA E{(bf16_t*)(F.ws + WS_MQK), (bf16_t*)(F.ws + WS_MLO), (bf16_t*)(F.ws + WS_XQ), (bf16_t*)(F.ws + WS_VC)};
        pg8::gemm_phase(F.lds, 2048, 2048, 2048, S, E, F.tid);
        DUP_END SEAM(1);
    }
    if (IN(2)) { DUP_BEGIN(2)
        pg8::SchedMem S{(const bf16_t*)(F.ws + WS_MEMN), (const bf16_t*)(F.ws + WS_WMEMT), G, c};
        pg8::EpiMem E{(bf16_t*)(F.ws + WS_MK), (bf16_t*)(F.ws + WS_MVT)};
        pg8::gemm_phase(F.lds, 2048, 2048, 2048, S, E, F.tid);
        ml1_conv(F, in);
        DUP_END SEAM(2);
    }
    if (IN(3)) { DUP_BEGIN(3)
#ifndef SUB
#define SUB 7
#endif
        if (SUB & 1) { pg8::SchedHG S{(const bf16_t*)(F.ws + WS_Q), (const bf16_t*)(F.ws + WS_KW), (size_t)TT * 256, 65536, (size_t)TT * 256, 65536, G, c};
          pg8::EpiW E{(bf16_t*)(F.ws + WS_WQ), (const float*)(F.ws + WS_SCRS)};
          pg8::gemm_phase(F.lds, 256, 256, 256, S, E, F.tid); }
        if (SUB & 2) { pg8::SchedHG S{(const bf16_t*)(F.ws + WS_VC), (const bf16_t*)(F.ws + WS_KWT), (size_t)128 * 256 * 512, (size_t)256 * 512, (size_t)128 * 65536, 65536, G, c};
          pg8::EpiB16Tile E{(bf16_t*)(F.ws + WS_U), 65536, 0, (size_t)128 * 65536, 256, 1.0f};
          pg8::gemm_phase(F.lds, 512, 256, 256, S, E, F.tid); }
        if (SUB & 4) { pg8::SchedXA S{(const bf16_t*)(F.ws + WS_XQ), (const bf16_t*)(F.ws + WS_MK), G, c};
          pg8::EpiXSoft E{(bf16_t*)(F.ws + WS_XP2), (LAS float*)(F.lds + pg8::EPI_TBL_OFF)};
          pg8::gemm_phase(F.lds, 256, 256, 256, S, E, F.tid); }
        if (F.bid < 8) nscan_seq(F, F.bid);
        DUP_END SEAM(3);
    }
    if (IN(4)) { DUP_BEGIN(4) cscan(F); denpass(F); DUP_END SEAM(4); }
    if (IN(5)) { DUP_BEGIN(5)
        { pg8::SchedHG S{(const bf16_t*)(F.ws + WS_WQ), (const bf16_t*)(F.ws + WS_VC), (size_t)TT * 512, (size_t)256 * 512, (size_t)128 * 256 * 512, (size_t)256 * 512, G, c};
          pg8::EpiHNorm E{(bf16_t*)(F.dout + DO_HR), (const float*)(F.ws + WS_HDEN), (const bf16_t*)(F.ws + WS_MLO), in[13], (LAS float*)(F.lds + pg8::EPI_TBL_OFF)};
          pg8::gemm_phase(F.lds, 512, 512, 512, S, E, F.tid); }
        { pg8::SchedXA S{(const bf16_t*)(F.ws + WS_XP2), (const bf16_t*)(F.ws + WS_MVT), G, c};
          pg8::EpiXA E{(bf16_t*)(F.dout + DO_XA)};
          pg8::gemm_phase(F.lds, 256, 256, 256, S, E, F.tid); }
        DUP_END SEAM(5);
    }
    if (IN(6)) { DUP_BEGIN(6)
        pg8::SchedDense S{HBF, WINT, 2048, 2048, 128, 24, G, c};
        pg8::EpiPB E{(bf16_t*)(F.ws + WS_DQ), (bf16_t*)(F.ws + WS_DK), (bf16_t*)(F.ws + WS_DV)};
        pg8::gemm_phase(F.lds, 2048, 2048, 2048, S, E, F.tid);
        DUP_END SEAM(6);
    }
    if (IN(7)) { DUP_BEGIN(7) normmax(F); DUP_END SEAM(7); }
    if (IN(8)) { DUP_BEGIN(8) attn_phase(F, rep_); DUP_END SEAM(8); }
    if (IN(9)) { DUP_BEGIN(9) dacombine(F, in); expert_convert(F, in); DUP_END SEAM(9); }
    if (IN(10)) { DUP_BEGIN(10)
        pg8::SchedDense S{HBF8, WG8, 1024, 1024, 128, 8, G, c};
        pg8::EpiGate E{(bf16_t*)(F.ws + WS_GT0), in[19], 1.0f / 32.0f};
        pg8::gemm_phase<pg8::EpiGate, pg8::SchedDense, true>(F.lds, 1024, 1024, 1024, S, E, F.tid);
        DUP_END SEAM(10);
    }
    if (IN(11)) { DUP_BEGIN(11)
        { pg8::SchedDense S{(const bf16_t*)(F.ws + WS_DA), (const bf16_t*)(F.ws + WS_WBDT), 2048, 2048, 128, 8, G, c};
          pg8::EpiBranch<true> E{(const bf16_t*)(F.ws + WS_GT0), (bf16_t*)(F.ws + WS_MERGED)};
          pg8::gemm_phase(F.lds, 2048, 2048, 2048, S, E, F.tid); }
        { pg8::SchedDense S{HBF8, WG8 + (size_t)2048 * 1024, 1024, 1024, 128, 8, G, c};
          pg8::EpiGate E{(bf16_t*)(F.ws + WS_GT1), in[19] + 2048, 1.0f / 32.0f};
          pg8::gemm_phase<pg8::EpiGate, pg8::SchedDense, true>(F.lds, 1024, 1024, 1024, S, E, F.tid); }
        DUP_END SEAM(11);
    }
    if (IN(12)) { DUP_BEGIN(12)
        { pg8::SchedDense S{(const bf16_t*)(F.dout + DO_HR), (const bf16_t*)(F.ws + WS_WBMT), 1024, 1024, 128, 8, G, c};
          pg8::EpiBranch<false> E{(const bf16_t*)(F.ws + WS_GT1), (bf16_t*)(F.ws + WS_MERGED)};
          pg8::gemm_phase(F.lds, 1024, 1024, 1024, S, E, F.tid); }
        { pg8::SchedDense S{HBF8, WG8 + (size_t)4096 * 1024, 1024, 1024, 128, 8, G, c};
          pg8::EpiGate E{(bf16_t*)(F.ws + WS_GT0), in[19] + 4096, 1.0f / 32.0f};
          pg8::gemm_phase<pg8::EpiGate, pg8::SchedDense, true>(F.lds, 1024, 1024, 1024, S, E, F.tid); }
        DUP_END SEAM(12);
    }
    if (IN(13)) { DUP_BEGIN(13)
        pg8::SchedDense S{(const bf16_t*)(F.dout + DO_XA), (const bf16_t*)(F.ws + WS_WBCT), 1024, 1024, 128, 8, G, c};
        pg8::EpiBranch<false> E{(const bf16_t*)(F.ws + WS_GT0), (bf16_t*)(F.ws + WS_MERGED)};
        pg8::gemm_phase(F.lds, 1024, 1024, 1024, S, E, F.tid);
        DUP_END SEAM(13);
    }
    if (IN(14)) { DUP_BEGIN(14)
        pg8::SchedDense S{(const bf16_t*)(F.ws + WS_MERGED), (const bf16_t*)(F.ws + WS_WOUTT), 2048, 2048, 128, 8, G, c};
        pg8::EpiOut E{in[0], (bf16_t*)(F.ws + WS_X1B), (float*)(F.ws + WS_RSS)};
        pg8::gemm_phase(F.lds, 2048, 2048, 2048, S, E, F.tid);
        DUP_END SEAM(14);
    }
    if (IN(15)) { DUP_BEGIN(15)
        pg8::SchedDense S{(const bf16_t*)(F.ws + WS_X1B), (const bf16_t*)(F.ws + WS_WRT), 2048, 2048, 128, 1, G, c};
        pg8::EpiF32Tile E{(float*)(F.ws + WS_LG), 65536, 0, 0, 256};
        pg8::gemm_phase(F.lds, 2048, 2048, 2048, S, E, F.tid);
        DUP_END SEAM(15);
    }
    if (IN(16)) { DUP_BEGIN(16) topk_pass(F, in); DUP_END SEAM(16); }
    if (IN(17)) { DUP_BEGIN(17) gather_pass(F, in); DUP_END SEAM(17); }
    if (IN(18)) { DUP_BEGIN(18)
        const int nrt = (int)__builtin_amdgcn_readfirstlane(F.ctl[CW_NRT]);
        pg8::SchedMoE S{(const bf16_t*)(F.ws + WS_XSORT), (const bf16_t*)(F.ws + WS_WGU), (const int*)(F.ws + WS_TILEE), nrt, 6, 1024, (size_t)GU_N * 1024, (size_t)256 * 1024, G, c};
        pg8::EpiGU E{F.ws + WS_HD};
        pg8::gemm_phase<pg8::EpiGU, pg8::SchedMoE, true>(F.lds, 1024, 1024, 1024, S, E, F.tid);
        DUP_END SEAM(18);
    }
    if (IN(19)) { DUP_BEGIN(19)
        const int nrt = (int)__builtin_amdgcn_readfirstlane(F.ctl[CW_NRT]);
        pg8::SchedMoE S{(const bf16_t*)(F.ws + WS_HD), (const bf16_t*)(F.ws + WS_WD), (const int*)(F.ws + WS_TILEE), nrt, 8, DEXP_P / 2, (size_t)2048 * (DEXP_P / 2), (size_t)256 * (DEXP_P / 2), G, c};
        pg8::EpiDown E{(bf16_t*)(F.ws + WS_YS), (const float*)(F.ws + WS_WROW)};
        pg8::gemm_phase<pg8::EpiDown, pg8::SchedMoE, true>(F.lds, DEXP_P / 2, DEXP_P / 2, DEXP_P / 2, S, E, F.tid);
        DUP_END SEAM(19);
    }
    if (IN(20)) { DUP_BEGIN(20) final_pass(F, in); DUP_END }
#undef IN
#undef SEAM
}

#ifndef MK_FUSED
#define MK_FUSED 1
#endif
extern "C" void kernel_launch(void* const* d_in, const int* in_sizes, int n_in, void* d_out, int out_size, void* d_ws, size_t ws_size, hipStream_t stream) {
    static int grid = 0;
    if (grid == 0) {
        if (n_in != 30 || out_size != TT * DM || ws_size < WS_END) { fprintf(stderr, "kernel_launch: unexpected shapes (n_in %d out %d ws %zu)\n", n_in, out_size, ws_size); grid = -1; return; }
        int dev = 0, cus = 0, per_cu = 0;
        if (hipGetDevice(&dev) != hipSuccess || hipDeviceGetAttribute(&cus, hipDeviceAttributeMultiprocessorCount, dev) != hipSuccess) { grid = -1; return; }
        if (hipFuncSetAttribute((const void*)mk_fwd, hipFuncAttributeMaxDynamicSharedMemorySize, LDS_BYTES) != hipSuccess) { fprintf(stderr, "kernel_launch: hipFuncSetAttribute failed\n"); grid = -1; return; }
        if (hipOccupancyMaxActiveBlocksPerMultiprocessor(&per_cu, (const void*)mk_fwd, 512, LDS_BYTES) != hipSuccess || per_cu < 1) fprintf(stderr, "kernel_launch: occupancy query says %d\n", per_cu);
        (void)hipGetLastError();
        grid = cus;
    }
    if (grid < 0) return;
    (void)hipMemsetAsync((char*)d_ws + WS_CTL, 0, CTL_ZERO_BYTES, stream);
    Args a{};
    for (int i = 0; i < 30; ++i) a.in[i] = (const float*)d_in[i];
    a.out = (float*)d_out; a.ws = (unsigned char*)d_ws;
#if MK_FUSED
    a.ph_lo = 0; a.ph_hi = NPHASE;
    hipLaunchKernelGGL(mk_fwd, dim3(grid), dim3(512), LDS_BYTES, stream, a);
#else
#ifndef PROBE_DUP
#define PROBE_DUP 0u
#endif
    for (int p = 0; p < NPHASE; ++p) { a.ph_lo = p; a.ph_hi = p + 1; hipLaunchKernelGGL(mk_fwd, dim3(grid), dim3(512), LDS_BYTES, stream, a);
        if ((PROBE_DUP >> p) & 1u) {
            if (p == 8) (void)hipMemsetAsync((char*)d_ws + WS_CTL + CW_AHEAD * 4, 0, 256, stream);
            hipLaunchKernelGGL(mk_fwd, dim3(grid), dim3(512), LDS_BYTES, stream, a); } }
#endif
}
```

```cpp
#include <hip/hip_runtime.h>
#include <hip/hip_bf16.h>
#include <cstdio>
#include <cstdint>

#define LAS __attribute__((address_space(3)))
#define GAS __attribute__((address_space(1)))
typedef unsigned short bf16_t;
typedef short bf16x8 __attribute__((ext_vector_type(8)));
typedef short s16x4 __attribute__((ext_vector_type(4)));
typedef float f32x2 __attribute__((ext_vector_type(2)));
typedef float f32x4 __attribute__((ext_vector_type(4)));
typedef float f32x16 __attribute__((ext_vector_type(16)));
typedef unsigned u32x2 __attribute__((ext_vector_type(2)));
typedef unsigned u32x4 __attribute__((ext_vector_type(4)));

constexpr int NB = 2, SEQ = 16384, TT = NB * SEQ, DM = 2048, MEML = 256;
constexpr int DIN = 17416;
constexpr float EPS = 1e-6f;
constexpr int NEXP = 32, DEXP = 704, DEXP_P = 768, GU_N = 1536;
constexpr int MAX_RT = 288;

constexpr size_t MiB = 1u << 20;
constexpr size_t WS_CTL = 0, CTL_ZERO_BYTES = 1 * MiB;
constexpr size_t WS_MLG = 1 * MiB;
constexpr size_t WS_SCKW = 2 * MiB, WS_SCRS = 2 * MiB + 512 * 1024, WS_SCIT = 3 * MiB, WS_SCED = 3 * MiB + 512 * 1024;
constexpr size_t WS_HDEN = 4 * MiB;
constexpr size_t WS_KN = 13 * MiB;
constexpr size_t WS_NP = 5 * MiB + 512 * 1024;
constexpr size_t WS_DEC = 6 * MiB;
constexpr size_t WS_MEMN = 7 * MiB;
constexpr size_t WS_MK = 9 * MiB;
constexpr size_t WS_MVT = 10 * MiB;
constexpr size_t WS_TOKE = 11 * MiB;
constexpr size_t WS_TOKW = 11 * MiB + 256 * 1024;
constexpr size_t WS_POS = 11 * MiB + 512 * 1024;
constexpr size_t WS_WROW = 12 * MiB;
constexpr size_t WS_TILEE = 12 * MiB + 512 * 1024;
constexpr size_t WS_RT = 12 * MiB + 768 * 1024;
constexpr size_t WS_WINT = 16 * MiB;
constexpr size_t WS_WMEMT = 84 * MiB;
constexpr size_t WS_WBDT = 92 * MiB;
constexpr size_t WS_WBMT = 100 * MiB;
constexpr size_t WS_WBCT = 104 * MiB;
constexpr size_t WS_WOUTT = 108 * MiB;
constexpr size_t WS_WRT = 116 * MiB;
constexpr size_t WS_MQK = 120 * MiB;
constexpr size_t WS_U = 120 * MiB;
constexpr size_t WS_XQ = 312 * MiB;
constexpr size_t WS_XP = 312 * MiB;
constexpr size_t WS_VC = 376 * MiB;
constexpr size_t WS_Q = 504 * MiB;
constexpr size_t WS_WQ = 568 * MiB;
constexpr size_t WS_KW = 696 * MiB;
constexpr size_t WS_KWT = 760 * MiB;
constexpr size_t WS_XP2 = 824 * MiB;
constexpr size_t WS_XS = 824 * MiB;
constexpr size_t WS_MLO = 952 * MiB;
constexpr size_t WS_DQ = 120 * MiB, WS_DK = 248 * MiB, WS_DV = 376 * MiB;
constexpr size_t WS_O = 504 * MiB;
constexpr size_t WS_DA = 760 * MiB;
constexpr size_t WS_WGU = 120 * MiB;
constexpr size_t WS_WD = 216 * MiB;
constexpr size_t WS_HBF8 = 264 * MiB;
constexpr size_t WS_GT0 = 408 * MiB, WS_GT1 = 536 * MiB;
constexpr size_t WS_MERGED = 888 * MiB;
constexpr size_t WS_X1B = 264 * MiB;
constexpr size_t WS_RSS = 1016 * MiB;
constexpr size_t WS_LG = 536 * MiB;
constexpr size_t WS_XSORT = 568 * MiB;
constexpr size_t WS_HD = 856 * MiB;
constexpr size_t WS_YS = 568 * MiB;
constexpr size_t WS_END = 1024 * MiB;
constexpr size_t DO_HBF = 0, DO_HR = 128 * MiB, DO_XA = 192 * MiB;

constexpr int CW_BAR = 4096;
constexpr int CW_AHEAD = 8192;
constexpr int CW_QKMAX = 8256;
constexpr int CW_KMX = 8272;
constexpr int CW_QB2 = 16384;
constexpr int CW_ND = 16384 + 2048;
constexpr int CW_ECNT = 8320;
constexpr int CW_ECUR = 8384;
constexpr int CW_LAM = 8448;
constexpr int CW_NRT = 8449;

constexpr int RING_BYTES = 131072;
constexpr int MISC_OFF = RING_BYTES + 320;
constexpr int LDS_BYTES = 147456;

#define LDS_WAIT() asm volatile("s_waitcnt lgkmcnt(0)" ::: "memory")
#define VM_WAIT() asm volatile("s_waitcnt vmcnt(0)" ::: "memory")
#define RLX_AGENT __ATOMIC_RELAXED, __HIP_MEMORY_SCOPE_AGENT

__device__ __forceinline__ unsigned cvtpk(float lo, float hi) { unsigned r; asm volatile("v_cvt_pk_bf16_f32 %0, %1, %2" : "=v"(r) : "v"(lo), "v"(hi)); return r; }
__device__ __forceinline__ unsigned pk4_fp8(float a, float b, float c, float d) { int w = 0; w = __builtin_amdgcn_cvt_pk_fp8_f32(a, b, w, false); w = __builtin_amdgcn_cvt_pk_fp8_f32(c, d, w, true); return (unsigned)w; }
__device__ __forceinline__ float bf2f(unsigned short b) { return __uint_as_float(((unsigned)b) << 16); }
__device__ __forceinline__ float bflo(unsigned w) { return __uint_as_float(w << 16); }
__device__ __forceinline__ float bfhi(unsigned w) { return __uint_as_float(w & 0xffff0000u); }
__device__ __forceinline__ float wave_sum(float v) {
#pragma unroll
    for (int o = 1; o < 64; o <<= 1) v += __shfl_xor(v, o);
    return v;
}
__device__ __forceinline__ float wave_max(float v) {
#pragma unroll
    for (int o = 1; o < 64; o <<= 1) v = fmaxf(v, __shfl_xor(v, o));
    return v;
}
__device__ __forceinline__ float sigmoidf_(float x) { return 1.0f / (1.0f + __expf(-x)); }

#define XB_TMO      128
#define XB_XCNT(j)  (256  + 64 * (j))
#define XB_XSUB(j)  (1280 + 64 * (j))
#define XB_XGEN(j)  (2304 + 64 * (j))
#define XB_TOP      3328
#define XB_TOPGEN   3392
#define XCD_BAR_WORDS 3456
#define XB_SPIN_CAP (1u << 18)

__device__ __forceinline__ unsigned xb_ld(unsigned* p)              { return __hip_atomic_load(p, __ATOMIC_RELAXED, __HIP_MEMORY_SCOPE_AGENT); }
__device__ __forceinline__ unsigned xb_add(unsigned* p, unsigned v) { return __hip_atomic_fetch_add(p, v, __ATOMIC_RELAXED, __HIP_MEMORY_SCOPE_AGENT); }
__device__ __forceinline__ unsigned xb_xcc_id() { return (unsigned)__builtin_amdgcn_s_getreg((3 << 11) | 20) & 0xFu; }
#define XB_SPIN(cond, bar) do { unsigned _sp = 0; while (cond) { __builtin_amdgcn_s_sleep(1); \
    if ((++_sp & 255u) == 0u) { if (xb_ld(&(bar)[XB_TMO])) break; if (_sp > XB_SPIN_CAP) { atomicAdd(&(bar)[XB_TMO], 1u); break; } } } } while (0)

struct XcdBarrier { unsigned* bar; unsigned x; volatile LAS unsigned* st; };

__device__ __forceinline__ XcdBarrier xcd_barrier_post(unsigned* bar, volatile LAS unsigned* st, const int tid) {
    XcdBarrier b; b.bar = bar; b.x = xb_xcc_id(); b.st = st;
    if (tid == 0) (void)xb_add(&bar[XB_XCNT(b.x)], 1u);
    return b;
}
__device__ __forceinline__ void xcd_barrier_complete(unsigned* bar, unsigned x, unsigned& nloc, unsigned& nx) {
    const unsigned G = gridDim.x * gridDim.y * gridDim.z;
    unsigned sum, cnt, mine, sp = 0u;
    for (;;) {
        sum = 0u; cnt = 0u; mine = 0u;
#pragma unroll
        for (unsigned j = 0; j < 16; ++j) { const unsigned c = xb_ld(&bar[XB_XCNT(j)]); sum += c; cnt += (c > 0u) ? 1u : 0u; mine = (j == x) ? c : mine; }
        if (sum == G) break;
        __builtin_amdgcn_s_sleep(1);
        if ((++sp & 255u) == 0u) { if (xb_ld(&bar[XB_TMO])) break; if (sp > XB_SPIN_CAP) { atomicAdd(&bar[XB_TMO], 1u); break; } }
    }
    nloc = mine > 0u ? mine : 1u; nx = cnt > 0u ? cnt : 1u;
}
__device__ __forceinline__ void xcd_barrier(const XcdBarrier& b, const int tid) {
    asm volatile("s_waitcnt vmcnt(0)" ::: "memory");
    __syncthreads();
    if (tid == 0) {
        unsigned* bar = b.bar;
        __builtin_amdgcn_s_waitcnt(0);
        unsigned nloc = b.st[0], nx = b.st[1];
        if (nloc == 0u) { xcd_barrier_complete(bar, b.x, nloc, nx); b.st[0] = nloc; b.st[1] = nx; }
        const unsigned old = xb_add(&bar[XB_XSUB(b.x)], 1u);
        const unsigned gen = old / nloc;
        if (old + 1u == (gen + 1u) * nloc) {
            __builtin_amdgcn_fence(__ATOMIC_RELEASE, "agent");
            asm volatile("s_waitcnt vmcnt(0)" ::: "memory");
            const unsigned og = xb_add(&bar[XB_TOP], 1u);
            const unsigned tg = og / nx;
            if (og + 1u == (tg + 1u) * nx) xb_add(&bar[XB_TOPGEN], 1u);
            else XB_SPIN(xb_ld(&bar[XB_TOPGEN]) == tg, bar);
            __builtin_amdgcn_fence(__ATOMIC_ACQUIRE, "agent");
            xb_add(&bar[XB_XGEN(b.x)], 1u);
            asm volatile("s_waitcnt vmcnt(0)" ::: "memory");
        } else {
            XB_SPIN(xb_ld(&bar[XB_XGEN(b.x)]) == gen, bar);
            __builtin_amdgcn_fence(__ATOMIC_ACQUIRE, "agent");
            asm volatile("s_waitcnt vmcnt(0)" ::: "memory");
        }
    }
    __syncthreads();
}

namespace pg8 {
constexpr int BM = 256, BK = 64, HALF = 128, HTB = HALF * BK * 2, STAGE_BYTES = 8 * HTB, NXCD = 8, WGM = 8;
__host__ __device__ __forceinline__ int lds_byte(int r, int c) { const int st = (r >> 4) * 2 + (c >> 5), rr = r & 15, cc = c & 31, ob = rr * 64 + cc * 2; return st * 1024 + (ob ^ (((ob >> 9) & 1) << 5)); }
__host__ __device__ __forceinline__ void stage_rc(int b, int& R, int& C) { const int st = b / 1024, sb = b % 1024, swz = sb ^ (((sb >> 9) & 1) << 5); R = (st >> 1) * 16 + swz / 64; C = (st & 1) * 32 + (swz % 64) / 2; }
__host__ __device__ __forceinline__ int perm32(int rho) { const int n = rho >> 4, i = rho & 15; return 8 * (i >> 2) + 4 * n + (i & 3); }

struct Unit { const bf16_t* A; const bf16_t* B; int pm, pn, aux; };

__device__ __forceinline__ void tile_order(int L, int nM, int nN, int& pm, int& pn) {
    const int nwg = nM * nN; int wgid = L;
    { const int q = nwg / NXCD, r = nwg % NXCD, xcd = wgid % NXCD, off = wgid / NXCD; wgid = (xcd < r ? xcd * (q + 1) : r * (q + 1) + (xcd - r) * q) + off; }
    const int nig = WGM * nN, gid = wgid / nig, fm = gid * WGM, gsz = (nM - fm) < WGM ? (nM - fm) : WGM;
    pm = fm + ((wgid % nig) % gsz); pn = (wgid % nig) / gsz;
}

typedef int i32x4 __attribute__((ext_vector_type(4)));
typedef int i32x8 __attribute__((ext_vector_type(8)));
__device__ __forceinline__ i32x8 cat8(const bf16x8 a, const bf16x8 b) { const i32x4 x = __builtin_bit_cast(i32x4, a), y = __builtin_bit_cast(i32x4, b); return __builtin_shufflevector(x, y, 0, 1, 2, 3, 4, 5, 6, 7); }
template <class Epi, class Sched, bool F8 = false>
__device__ __forceinline__ void gemm_phase(LAS unsigned char* lds, const int lda, const int ldb, const int K, const Sched& S, const Epi& E, const int tid) {
    const int wid = __builtin_amdgcn_readfirstlane(tid >> 6), lane = tid & 63, wr = wid >> 2, wc = wid & 3, fr = lane & 15, fq = lane >> 4;
    const int nt = K / BK;
    unsigned voffA[2], voffB[2];
#pragma unroll
    for (int i = 0; i < 2; ++i) { int R, C; stage_rc(tid * 16 + i * 8192, R, C); const int Rb = Epi::PERM ? ((R & ~31) + perm32(R & 31)) : R;
        voffA[i] = (unsigned)(R * lda + C) * 2u; voffB[i] = (unsigned)(Rb * ldb + C) * 2u; }
    const size_t kstep = (size_t)(BK * 2);
    const size_t hstepA = (size_t)HALF * lda * 2, hstepB = (size_t)HALF * ldb * 2;
    const unsigned ldsw = (unsigned)wid * 1024u;
    const int aoff = lds_byte(wr * 64 + fr, fq * 8), boff = lds_byte(wc * 32 + fr, fq * 8);
#define PG8_SA(b, h) (((b) * 2 + (h)) * HTB)
#define PG8_SB(b, h) ((4 + (b) * 2 + (h)) * HTB)
#define PG8_STAGE(bufoff, gbase, voff) do { _Pragma("unroll") for (int _i = 0; _i < 2; ++_i) \
        __builtin_amdgcn_global_load_lds((const unsigned*)((const char*)(gbase) + (voff)[_i]), (LAS unsigned*)(lds + (bufoff) + ldsw + _i * 8192), 16, 0, 0); } while (0)
#define PG8_LDA(dst, b, h) do { _Pragma("unroll") for (int m = 0; m < 4; ++m) { \
        if constexpr (F8) { const i32x4 lo_ = *(const LAS i32x4*)(lds + PG8_SA(b, h) + aoff + m * 2048), hi_ = *(const LAS i32x4*)(lds + PG8_SA(b, h) + aoff + m * 2048 + 1024); dst##8[m] = __builtin_shufflevector(lo_, hi_, 0, 1, 2, 3, 4, 5, 6, 7); } \
        else { _Pragma("unroll") for (int k = 0; k < 2; ++k) dst[m][k] = *(const LAS bf16x8*)(lds + PG8_SA(b, h) + aoff + m * 2048 + k * 1024); } } } while (0)
#define PG8_LDB(dst, b, h) do { _Pragma("unroll") for (int n = 0; n < 2; ++n) { \
        if constexpr (F8) { const i32x4 lo_ = *(const LAS i32x4*)(lds + PG8_SB(b, h) + boff + n * 2048), hi_ = *(const LAS i32x4*)(lds + PG8_SB(b, h) + boff + n * 2048 + 1024); dst##8[n] = __builtin_shufflevector(lo_, hi_, 0, 1, 2, 3, 4, 5, 6, 7); } \
        else { _Pragma("unroll") for (int k = 0; k < 2; ++k) dst[n][k] = *(const LAS bf16x8*)(lds + PG8_SB(b, h) + boff + n * 2048 + k * 1024); } } } while (0)
#define PG8_MMA(ai, bj, At, Bt) do { __builtin_amdgcn_s_setprio(1); _Pragma("unroll") for (int m = 0; m < 4; ++m) _Pragma("unroll") for (int n = 0; n < 2; ++n) { \
        if constexpr (F8) asm volatile("v_mfma_f32_16x16x128_f8f6f4 %0, %1, %2, %0" : "+v"(acc[ai][bj][m][n]) : "v"(Bt##8[n]), "v"(At##8[m])); \
        else { _Pragma("unroll") for (int k = 0; k < 2; ++k) acc[ai][bj][m][n] = __builtin_amdgcn_mfma_f32_16x16x32_bf16(Bt[n][k], At[m][k], acc[ai][bj][m][n], 0, 0, 0); } } \
        __builtin_amdgcn_s_setprio(0); } while (0)
#define PG8_WAIT_V(n) asm volatile("s_waitcnt vmcnt(" #n ")" ::: "memory")
#define PG8_WAIT_L(n) asm volatile("s_waitcnt lgkmcnt(" #n ")" ::: "memory")
#define PG8_BAR __builtin_amdgcn_s_barrier()
#define PG8_SCHED __builtin_amdgcn_sched_barrier(0)
    Unit cur, nxt; int ui = 0;
    if (!S.next(0, cur)) return;
    f32x4 acc[2][2][4][2];
#pragma unroll
    for (int a = 0; a < 2; ++a)
#pragma unroll
        for (int b = 0; b < 2; ++b)
#pragma unroll
            for (int m = 0; m < 4; ++m)
#pragma unroll
                for (int n = 0; n < 2; ++n) acc[a][b][m][n] = (f32x4){0.f, 0.f, 0.f, 0.f};
    bf16x8 At[4][2], B0[2][2], B1[2][2]; i32x8 At8[4], B08[2], B18[2];
    const char* cA = (const char*)cur.A; const char* cB = (const char*)cur.B;
    PG8_STAGE(PG8_SB(0, 0), cB, voffB); PG8_STAGE(PG8_SA(0, 0), cA, voffA); PG8_STAGE(PG8_SB(0, 1), cB + hstepB, voffB); PG8_STAGE(PG8_SA(0, 1), cA + hstepA, voffA);
    if (wr == 1) PG8_BAR;
    PG8_WAIT_V(4); PG8_BAR;
    PG8_STAGE(PG8_SB(1, 0), cB + kstep, voffB); PG8_STAGE(PG8_SA(1, 0), cA + kstep, voffA); PG8_STAGE(PG8_SB(1, 1), cB + hstepB + kstep, voffB);
    PG8_WAIT_V(6); PG8_BAR;
    for (;;) {
        const bool has_next = S.next(ui + 1, nxt);
        const char* nA = has_next ? (const char*)nxt.A : cA; const char* nB = has_next ? (const char*)nxt.B : cB;
#pragma nounroll
        for (int t = 0; t < nt; t += 2) {
            const bool last = (t == nt - 2);
            const char* a1 = cA + (size_t)(t + 1) * kstep;
            const char* a2 = last ? nA : cA + (size_t)(t + 2) * kstep; const char* b2 = last ? nB : cB + (size_t)(t + 2) * kstep;
            const char* a3 = a2 + kstep; const char* b3 = b2 + kstep;
            PG8_LDB(B0, 0, 0); PG8_SCHED; PG8_LDA(At, 0, 0); PG8_STAGE(PG8_SA(1, 1), a1 + hstepA, voffA);
            PG8_WAIT_L(8); PG8_BAR; PG8_WAIT_L(0); PG8_MMA(0, 0, At, B0); PG8_BAR; PG8_SCHED;
            PG8_LDB(B1, 0, 1); PG8_STAGE(PG8_SB(0, 0), b2, voffB);
            PG8_BAR; PG8_WAIT_L(0); PG8_MMA(0, 1, At, B1); PG8_BAR;
            PG8_LDA(At, 0, 1); PG8_STAGE(PG8_SA(0, 0), a2, voffA);
            PG8_BAR; PG8_WAIT_L(0); PG8_MMA(1, 0, At, B0); PG8_BAR; PG8_SCHED;
            PG8_STAGE(PG8_SB(0, 1), b2 + hstepB, voffB);
            PG8_WAIT_V(6); PG8_BAR; PG8_MMA(1, 1, At, B1); PG8_BAR;
            PG8_LDB(B0, 1, 0); PG8_SCHED; PG8_LDA(At, 1, 0); PG8_STAGE(PG8_SA(0, 1), a2 + hstepA, voffA);
            PG8_WAIT_L(8); PG8_BAR; PG8_WAIT_L(0); PG8_MMA(0, 0, At, B0); PG8_BAR; PG8_SCHED;
            PG8_LDB(B1, 1, 1); PG8_STAGE(PG8_SB(1, 0), b3, voffB);
            PG8_BAR; PG8_WAIT_L(0); PG8_MMA(0, 1, At, B1); PG8_BAR;
            PG8_LDA(At, 1, 1); PG8_STAGE(PG8_SA(1, 0), a3, voffA);
            PG8_BAR; PG8_WAIT_L(0); PG8_MMA(1, 0, At, B0); PG8_BAR; PG8_SCHED;
            PG8_STAGE(PG8_SB(1, 1), b3 + hstepB, voffB);
            PG8_WAIT_V(6); PG8_BAR; PG8_MMA(1, 1, At, B1); PG8_BAR;
        }
        if constexpr (F8) asm volatile("s_nop 15\n\ts_nop 15" ::: "memory");
        { int l_e = (int)__builtin_amdgcn_mbcnt_hi(~0u, __builtin_amdgcn_mbcnt_lo(~0u, 0u)); asm volatile("" : "+v"(l_e)); int fr_e = l_e & 15, fq_e = l_e >> 4;
          E(acc, cur, wr, wc, fr_e, fq_e); }
        if (!has_next) break;
#pragma unroll
        for (int a = 0; a < 2; ++a)
#pragma unroll
            for (int b = 0; b < 2; ++b)
#pragma unroll
                for (int m = 0; m < 4; ++m)
#pragma unroll
                    for (int n = 0; n < 2; ++n) acc[a][b][m][n] = (f32x4){0.f, 0.f, 0.f, 0.f};
        cur = nxt; cA = nA; cB = nB; ++ui;
    }
    PG8_WAIT_V(0);
    if (wr == 0) PG8_BAR;
    PG8_BAR;
#undef PG8_SA
#undef PG8_SB
#undef PG8_STAGE
#undef PG8_LDA
#undef PG8_LDB
#undef PG8_MMA
#undef PG8_WAIT_V
#undef PG8_WAIT_L
#undef PG8_BAR
#undef PG8_SCHED
}
}
namespace pg8 {
typedef f32x4 Acc[2][2][4][2];
__device__ __forceinline__ void st_bf16x8(bf16_t* p, f32x4 v0, f32x4 v1) {
    u32x4 w; w.x = cvtpk(v0[0], v0[1]); w.y = cvtpk(v0[2], v0[3]); w.z = cvtpk(v1[0], v1[1]); w.w = cvtpk(v1[2], v1[3]);
    *(u32x4*)p = w;
}
#define EPI_BF16_LOOP(...) \
    _Pragma("unroll") for (int ai = 0; ai < 2; ++ai) \
    _Pragma("unroll") for (int m = 0; m < 4; ++m) { int r = ai * 128 + wr * 64 + m * 16 + fr; asm volatile("" : "+v"(r)); \
    _Pragma("unroll") for (int bj = 0; bj < 2; ++bj) { f32x4 v0 = acc[ai][bj][m][0], v1 = acc[ai][bj][m][1]; const int colh = wc * 32 + 8 * fq; (void)colh; __VA_ARGS__ } }
#define EPI_F32_LOOP(...) \
    _Pragma("unroll") for (int ai = 0; ai < 2; ++ai) \
    _Pragma("unroll") for (int m = 0; m < 4; ++m) { int r = ai * 128 + wr * 64 + m * 16 + fr; asm volatile("" : "+v"(r)); \
    _Pragma("unroll") for (int bj = 0; bj < 2; ++bj) \
    _Pragma("unroll") for (int n = 0; n < 2; ++n) { f32x4 v = acc[ai][bj][m][n]; const int col = bj * 128 + wc * 32 + n * 16 + 4 * fq; (void)col; __VA_ARGS__ } }

struct EpiPA {
    static constexpr bool PERM = true;
    bf16_t *MQK, *MLO, *XQ, *VC;
    __device__ __forceinline__ void operator()(const Acc& acc, const Unit& u, int wr, int wc, int fr, int fq) const {
        bf16_t* base; size_t ldc;
        if (u.aux == 0) {
            if (u.pn < 8)       { base = MQK + (size_t)u.pm * 256 * 2048 + u.pn * 256; ldc = 2048; }
            else if (u.pn < 12) { base = MLO + (size_t)u.pm * 256 * 1024 + (u.pn - 8) * 256; ldc = 1024; }
            else                { base = XQ + ((size_t)(u.pn - 12) * TT + (size_t)u.pm * 256) * 256; ldc = 256; }
        } else                  { base = VC + ((size_t)(u.pm * 128 + u.pn) * 256) * 512; ldc = 512; }
        EPI_BF16_LOOP( st_bf16x8(base + (size_t)r * ldc + bj * 128 + colh, v0, v1); )
    }
};
struct EpiMem {
    static constexpr bool PERM = true;
    bf16_t *MK, *MVT;
    __device__ __forceinline__ void operator()(const Acc& acc, const Unit& u, int wr, int wc, int fr, int fq) const {
        bf16_t* base = (u.aux == 0) ? MK + (size_t)(u.pm * 4 + u.pn) * 65536 : MVT + (size_t)(u.pn * 4 + u.pm) * 65536;
        EPI_BF16_LOOP( st_bf16x8(base + (size_t)r * 256 + bj * 128 + colh, v0, v1); )
    }
};
struct EpiPB {
    static constexpr bool PERM = true;
    bf16_t *DQ, *DK, *DV;
    __device__ __forceinline__ void operator()(const Acc& acc, const Unit& u, int wr, int wc, int fr, int fq) const {
        const int which = u.pn >> 3, c0 = (u.pn & 7) * 2;
        bf16_t* buf = DQ + (size_t)which * ((WS_DK - WS_DQ) / 2);
        EPI_BF16_LOOP( st_bf16x8(buf + ((size_t)(c0 + bj) * TT + (size_t)u.pm * 256 + r) * 128 + colh, v0, v1); )
    }
};
struct EpiF32Tile {
    static constexpr bool PERM = false;
    float* C; size_t off_pm, off_pn, off_aux; int ldc;
    __device__ __forceinline__ void operator()(const Acc& acc, const Unit& u, int wr, int wc, int fr, int fq) const {
        float* base = C + (size_t)u.pm * off_pm + (size_t)u.pn * off_pn + (size_t)u.aux * off_aux;
        EPI_F32_LOOP( *(f32x4*)(base + (size_t)r * ldc + col) = v; )
    }
};
struct EpiB16Tile {
    static constexpr bool PERM = true;
    bf16_t* C; size_t off_pm, off_pn, off_aux; int ldc; float sc;
    __device__ __forceinline__ void operator()(const Acc& acc, const Unit& u, int wr, int wc, int fr, int fq) const {
        bf16_t* base = C + (size_t)u.pm * off_pm + (size_t)u.pn * off_pn + (size_t)u.aux * off_aux;
        EPI_BF16_LOOP( v0 *= sc; v1 *= sc; st_bf16x8(base + (size_t)r * ldc + bj * 128 + colh, v0, v1); )
    }
};
constexpr int EPI_TBL_OFF = RING_BYTES + 4096;
#define EPI_XBAR() do { asm volatile("s_waitcnt lgkmcnt(0)" ::: "memory"); __builtin_amdgcn_s_barrier(); asm volatile("" ::: "memory"); } while (0)
struct EpiXSoft {
    static constexpr bool PERM = true;
    bf16_t* XP; LAS float* tbl;
    __device__ __forceinline__ void operator()(const Acc& acc, const Unit& u, int wr, int wc, int fr, int fq) const {
        LAS float* TM = tbl; LAS float* TS = tbl + 1024;
        const int colh = wc * 32 + 8 * fq;
        float mloc[2][4];
#pragma unroll
        for (int ai = 0; ai < 2; ++ai)
#pragma unroll
            for (int m = 0; m < 4; ++m) { const int r = ai * 128 + wr * 64 + m * 16 + fr; float mx = -__builtin_inff();
#pragma unroll
                for (int bj = 0; bj < 2; ++bj)
#pragma unroll
                    for (int n = 0; n < 2; ++n) { const f32x4 v = acc[ai][bj][m][n]; mx = fmaxf(mx, fmaxf(fmaxf(v[0], v[1]), fmaxf(v[2], v[3]))); }
                mx = fmaxf(mx, __shfl_xor(mx, 16)); mx = fmaxf(mx, __shfl_xor(mx, 32));
                if (fq == 0) TM[r * 4 + wc] = mx; mloc[ai][m] = mx; }
        EPI_XBAR();
        f32x4 ev[2][4][2][2];
#pragma unroll
        for (int ai = 0; ai < 2; ++ai)
#pragma unroll
            for (int m = 0; m < 4; ++m) { const int r = ai * 128 + wr * 64 + m * 16 + fr;
                const f32x4 t4 = *(const LAS f32x4*)(TM + r * 4); const float mx = fmaxf(fmaxf(t4[0], t4[1]), fmaxf(t4[2], t4[3])) * 0.0625f; float s = 0.f;
#pragma unroll
                for (int bj = 0; bj < 2; ++bj)
#pragma unroll
                    for (int n = 0; n < 2; ++n) { f32x4 v = acc[ai][bj][m][n];
#pragma unroll
                        for (int j = 0; j < 4; ++j) { v[j] = __expf(v[j] * 0.0625f - mx); s += v[j]; }
                        ev[ai][m][bj][n] = v; }
                s += __shfl_xor(s, 16); s += __shfl_xor(s, 32);
                if (fq == 0) TS[r * 4 + wc] = s; }
        EPI_XBAR();
        const size_t t0 = (size_t)u.aux * TT + (size_t)u.pm * 256;
#pragma unroll
        for (int ai = 0; ai < 2; ++ai)
#pragma unroll
            for (int m = 0; m < 4; ++m) { const int r = ai * 128 + wr * 64 + m * 16 + fr;
                const f32x4 t4 = *(const LAS f32x4*)(TS + r * 4); const float inv = 1.0f / ((t4[0] + t4[1]) + (t4[2] + t4[3]));
#pragma unroll
                for (int bj = 0; bj < 2; ++bj) st_bf16x8(XP + (t0 + r) * 256 + bj * 128 + colh, ev[ai][m][bj][0] * inv, ev[ai][m][bj][1] * inv); }
    }
};
struct EpiHNorm {
    static constexpr bool PERM = true;
    bf16_t* HM; const float* HDEN; const bf16_t* MLO; const float* G; LAS float* tbl;
    __device__ __forceinline__ void operator()(const Acc& acc, const Unit& u, int wr, int wc, int fr, int fq) const {
        LAS float* TQ = tbl;
        const size_t t0 = (size_t)u.pm * 256; const int colh = wc * 32 + 8 * fq;
        float inv[2][4];
#pragma unroll
        for (int ai = 0; ai < 2; ++ai)
#pragma unroll
            for (int m = 0; m < 4; ++m) { const int r = ai * 128 + wr * 64 + m * 16 + fr; const float iv = 1.0f / HDEN[(size_t)u.aux * TT + t0 + r]; inv[ai][m] = iv; float q = 0.f;
#pragma unroll
                for (int bj = 0; bj < 2; ++bj)
#pragma unroll
                    for (int n = 0; n < 2; ++n) { const f32x4 v = acc[ai][bj][m][n] * iv; q += (v[0] * v[0] + v[1] * v[1]) + (v[2] * v[2] + v[3] * v[3]); }
                q += __shfl_xor(q, 16); q += __shfl_xor(q, 32);
                if (fq == 0) TQ[r * 4 + wc] = q; }
        EPI_XBAR();
#pragma unroll
        for (int ai = 0; ai < 2; ++ai)
#pragma unroll
            for (int m = 0; m < 4; ++m) { const int r = ai * 128 + wr * 64 + m * 16 + fr;
                const f32x4 t4 = *(const LAS f32x4*)(TQ + r * 4); const float rs = rsqrtf(((t4[0] + t4[1]) + (t4[2] + t4[3])) * (1.0f / 256.0f) + EPS) * inv[ai][m];
#pragma unroll
                for (int bj = 0; bj < 2; ++bj) { const size_t o = (t0 + r) * 1024 + u.aux * 256 + bj * 128 + colh; const u32x4 og = *(const u32x4*)(MLO + o);
                    const f32x4 g0 = *(const f32x4*)(G + u.aux * 256 + bj * 128 + colh), g1 = *(const f32x4*)(G + u.aux * 256 + bj * 128 + colh + 4);
                    f32x4 v0 = acc[ai][bj][m][0] * rs, v1 = acc[ai][bj][m][1] * rs;
                    v0[0] *= sigmoidf_(bflo(og.x)) * g0[0]; v0[1] *= sigmoidf_(bfhi(og.x)) * g0[1]; v0[2] *= sigmoidf_(bflo(og.y)) * g0[2]; v0[3] *= sigmoidf_(bfhi(og.y)) * g0[3];
                    v1[0] *= sigmoidf_(bflo(og.z)) * g1[0]; v1[1] *= sigmoidf_(bfhi(og.z)) * g1[1]; v1[2] *= sigmoidf_(bflo(og.w)) * g1[2]; v1[3] *= sigmoidf_(bfhi(og.w)) * g1[3];
                    st_bf16x8(HM + o, v0, v1); } }
    }
};
struct EpiW {
    static constexpr bool PERM = true;
    bf16_t* WQ; const float* RS;
    __device__ __forceinline__ void operator()(const Acc& acc, const Unit& u, int wr, int wc, int fr, int fq) const {
        const size_t trow = (size_t)u.aux * TT + (size_t)u.pm * 256;
        const int colh = wc * 32 + 8 * fq;
#pragma unroll
        for (int ai = 0; ai < 2; ++ai)
#pragma unroll
            for (int m = 0; m < 4; ++m) { int r = ai * 128 + wr * 64 + m * 16 + fr; asm volatile("" : "+v"(r)); const float rs = RS[trow + r];
#pragma unroll
                for (int bj = 0; bj < 2; ++bj) { f32x4 v0 = acc[ai][bj][m][0], v1 = acc[ai][bj][m][1]; const int c = bj * 128 + colh; const float fl = (float)(r - c + 1);
#pragma unroll
                    for (int j = 0; j < 4; ++j) { v0[j] = v0[j] * (rs * __saturatef(fl - (float)j)); v1[j] = v1[j] * (rs * __saturatef(fl - (float)(4 + j))); }
                    st_bf16x8(WQ + (trow + r) * 512 + c, v0, v1);
                    } }
    }
};
struct EpiH {
    static constexpr bool PERM = true;
    bf16_t* HR; const float* HDEN;
    __device__ __forceinline__ void operator()(const Acc& acc, const Unit& u, int wr, int wc, int fr, int fq) const {
        const size_t t0 = (size_t)u.pm * 256;
        EPI_BF16_LOOP( const float inv = 1.0f / HDEN[(size_t)u.aux * TT + t0 + r];
            v0 *= inv; v1 *= inv; st_bf16x8(HR + (t0 + r) * 1024 + u.aux * 256 + bj * 128 + colh, v0, v1); )
    }
};
struct EpiXA {
    static constexpr bool PERM = true;
    bf16_t* XA;
    __device__ __forceinline__ void operator()(const Acc& acc, const Unit& u, int wr, int wc, int fr, int fq) const {
        const size_t t0 = (size_t)u.pm * 256;
        EPI_BF16_LOOP( st_bf16x8(XA + (t0 + r) * 1024 + u.aux * 256 + bj * 128 + colh, v0, v1); )
    }
};
struct EpiGate {
    static constexpr bool PERM = true;
    bf16_t* GT; const float* bg; float dsc;
    __device__ __forceinline__ void operator()(const Acc& acc, const Unit& u, int wr, int wc, int fr, int fq) const {
        const size_t t0 = (size_t)u.pm * 256;
        EPI_BF16_LOOP( const int c = u.pn * 256 + bj * 128 + colh; const f32x4 b0 = *(const f32x4*)(bg + c), b1 = *(const f32x4*)(bg + c + 4);
            _Pragma("unroll") for (int j = 0; j < 4; ++j) { v0[j] = sigmoidf_(v0[j] * dsc + b0[j]); v1[j] = sigmoidf_(v1[j] * dsc + b1[j]); }
            st_bf16x8(GT + (t0 + r) * 2048 + c, v0, v1); )
    }
};
template <bool FIRST> struct EpiBranch {
    static constexpr bool PERM = true;
    const bf16_t* GT; bf16_t* MG;
    __device__ __forceinline__ void operator()(const Acc& acc, const Unit& u, int wr, int wc, int fr, int fq) const {
        const size_t t0 = (size_t)u.pm * 256;
        EPI_BF16_LOOP( const size_t o = (t0 + r) * 2048 + u.pn * 256 + bj * 128 + colh; const u32x4 g = *(const u32x4*)(GT + o);
            v0[0] *= bflo(g.x); v0[1] *= bfhi(g.x); v0[2] *= bflo(g.y); v0[3] *= bfhi(g.y); v1[0] *= bflo(g.z); v1[1] *= bfhi(g.z); v1[2] *= bflo(g.w); v1[3] *= bfhi(g.w);
            if (!FIRST) { const u32x4 p = *(const u32x4*)(MG + o);
                v0[0] += bflo(p.x); v0[1] += bfhi(p.x); v0[2] += bflo(p.y); v0[3] += bfhi(p.y); v1[0] += bflo(p.z); v1[1] += bfhi(p.z); v1[2] += bflo(p.w); v1[3] += bfhi(p.w); }
            st_bf16x8(MG + o, v0, v1); )
    }
};
struct EpiOut {
    static constexpr bool PERM = true;
    const float* X; bf16_t* X1B; float* RSS;
    __device__ __forceinline__ void operator()(const Acc& acc, const Unit& u, int wr, int wc, int fr, int fq) const {
        const size_t t0 = (size_t)u.pm * 256; const int colh = wc * 32 + 8 * fq;
#pragma unroll
        for (int ai = 0; ai < 2; ++ai)
#pragma unroll
            for (int m = 0; m < 4; ++m) { int r = ai * 128 + wr * 64 + m * 16 + fr; asm volatile("" : "+v"(r)); float ss = 0.f;
#pragma unroll
                for (int bj = 0; bj < 2; ++bj) { const size_t o = (t0 + r) * 2048 + u.pn * 256 + bj * 128 + colh;
                    const f32x4 v0 = acc[ai][bj][m][0] + *(const f32x4*)(X + o), v1 = acc[ai][bj][m][1] + *(const f32x4*)(X + o + 4);
                    u32x4 w; w.x = cvtpk(v0[0], v0[1]); w.y = cvtpk(v0[2], v0[3]); w.z = cvtpk(v1[0], v1[1]); w.w = cvtpk(v1[2], v1[3]);
                    *(u32x4*)(X1B + o) = w;
                    ss += ((bflo(w.x) * bflo(w.x) + bfhi(w.x) * bfhi(w.x)) + (bflo(w.y) * bflo(w.y) + bfhi(w.y) * bfhi(w.y))) + ((bflo(w.z) * bflo(w.z) + bfhi(w.z) * bfhi(w.z)) + (bflo(w.w) * bflo(w.w) + bfhi(w.w) * bfhi(w.w))); }
                ss += __shfl_xor(ss, 16); ss += __shfl_xor(ss, 32);
                if (fq == 0) RSS[(t0 + r) * 32 + u.pn * 4 + wc] = ss; }
    }
};
struct EpiGU {
    static constexpr bool PERM = true;
    unsigned char* HD;
    __device__ __forceinline__ void operator()(const Acc& acc, const Unit& u, int wr, int wc, int fr, int fq) const {
        const size_t t0 = (size_t)u.pm * 256; const int colh = wc * 32 + 8 * fq;
#pragma unroll
        for (int ai = 0; ai < 2; ++ai)
#pragma unroll
            for (int m = 0; m < 4; ++m) { int r = ai * 128 + wr * 64 + m * 16 + fr; asm volatile("" : "+v"(r));
                f32x4 g0 = acc[ai][0][m][0], g1 = acc[ai][0][m][1]; const f32x4 u0 = acc[ai][1][m][0], u1 = acc[ai][1][m][1];
#pragma unroll
                for (int j = 0; j < 4; ++j) { const float a0 = g0[j] * (1.0f / 32.0f), a1 = g1[j] * (1.0f / 32.0f); g0[j] = a0 * sigmoidf_(a0) * (u0[j] * 0.25f); g1[j] = a1 * sigmoidf_(a1) * (u1[j] * 0.25f); }
                u32x2 w; w.x = pk4_fp8(g0[0], g0[1], g0[2], g0[3]); w.y = pk4_fp8(g1[0], g1[1], g1[2], g1[3]);
                *(u32x2*)(HD + (t0 + r) * DEXP_P + u.pn * 128 + colh) = w; }
    }
};
struct EpiDown {
    static constexpr bool PERM = true;
    bf16_t* YS; const float* WROW;
    __device__ __forceinline__ void operator()(const Acc& acc, const Unit& u, int wr, int wc, int fr, int fq) const {
        const size_t t0 = (size_t)u.pm * 256;
        EPI_BF16_LOOP( const float w = WROW[t0 + r] * (1.0f / 128.0f); v0 *= w; v1 *= w;      st_bf16x8(YS + (t0 + r) * 2048 + u.pn * 256 + bj * 128 + colh, v0, v1); )
    }
};

struct SchedDense {
    const bf16_t* A0; const bf16_t* B0; int lda, ldb, nM, nN, G, c;
    __device__ __forceinline__ bool next(int i, Unit& u) const {
        const int L = i * G + c; if (L >= nM * nN) return false;
        tile_order(L, nM, nN, u.pm, u.pn); u.aux = 0;
        u.A = A0 + (size_t)u.pm * 256 * lda; u.B = B0 + (size_t)u.pn * 256 * ldb; return true;
    }
};
struct SchedPA {
    const bf16_t* HBF; const bf16_t* WINT; int G, c;
    __device__ __forceinline__ bool next(int i, Unit& u) const {
        const int L = i * G + c;
        if (L < 2048) { tile_order(L, 128, 16, u.pm, u.pn); u.aux = 0; u.A = HBF + (size_t)u.pm * 256 * 2048; u.B = WINT + (size_t)(6144 + u.pn * 256) * 2048; return true; }
        if (L < 2560) { const int q = L - 2048; u.pm = q & 3; u.pn = q >> 2; u.aux = 1; u.A = WINT + (size_t)(10240 + u.pm * 256) * 2048; u.B = HBF + (size_t)u.pn * 256 * 2048; return true; }
        return false;
    }
};
struct SchedMem {
    const bf16_t* MEMN; const bf16_t* WMEMT; int G, c;
    __device__ __forceinline__ bool next(int i, Unit& u) const {
        const int L = i * G + c; if (L >= 16) return false;
        if (L < 8) { u.aux = 0; u.pm = L >> 2; u.pn = L & 3; u.A = MEMN + (size_t)u.pm * 256 * 2048; u.B = WMEMT + (size_t)u.pn * 256 * 2048; }
        else { const int q = L - 8; u.aux = 1; u.pm = q & 3; u.pn = q >> 2; u.A = WMEMT + (size_t)(1024 + u.pm * 256) * 2048; u.B = MEMN + (size_t)u.pn * 256 * 2048; }
        return true;
    }
};
struct SchedHG {
    const bf16_t* A0; const bf16_t* B0; size_t sa_h, sa_g, sb_h, sb_g; int G, c;
    __device__ __forceinline__ bool next(int i, Unit& u) const {
        const int L = i * G + c; if (L >= 512) return false;
        const int hh = L >> 7, g = L & 127; u.aux = hh; u.pm = g; u.pn = 0;
        u.A = A0 + (size_t)hh * sa_h + (size_t)g * sa_g; u.B = B0 + (size_t)hh * sb_h + (size_t)g * sb_g; return true;
    }
};
struct SchedXA {
    const bf16_t* A0; const bf16_t* B0; int G, c;
    __device__ __forceinline__ bool next(int i, Unit& u) const {
        const int L = i * G + c; if (L >= 512) return false;
        const int hh = L >> 7, pm = L & 127; u.aux = hh; u.pm = pm; u.pn = 0;
        u.A = A0 + ((size_t)hh * TT + (size_t)pm * 256) * 256; u.B = B0 + (size_t)((pm >> 6) * 4 + hh) * 65536; return true;
    }
};
struct SchedMoE {
    const bf16_t* A0; const bf16_t* B0; const int* tile_e; int nrt, NT, lda; size_t eb_stride, nb_stride; int G, c;
    __device__ __forceinline__ bool next(int i, Unit& u) const {
        const int L = i * G + c; if (L >= nrt * NT) return false;
        const int rt = L / NT, pn = L - rt * NT; const int e = __builtin_amdgcn_readfirstlane(tile_e[rt]);
        u.pm = rt; u.pn = pn; u.aux = e; u.A = A0 + (size_t)rt * 256 * lda; u.B = B0 + (size_t)e * eb_stride + (size_t)pn * nb_stride; return true;
    }
};
}
namespace attn {
constexpr int D = 128;
constexpr float THR = 8.f;
constexpr float SCALE = 0.08838834764831845f;
constexpr int NW = 8, QBLK = 32, KVBLK = 64, QB = NW * QBLK;
constexpr int SHM_V = KVBLK * D * 2, SHM_K = KVBLK * D * 2;
constexpr int LDS_BYTES = 2 * SHM_V + 2 * SHM_K + NW * 64 * 4;
typedef bf16_t bf16;

#define KSWZ(row, colB) ((row) * 256 + ((colB) ^ (((row) & 7) << 4)))
#define SBAR() __builtin_amdgcn_sched_barrier(0)
__device__ __forceinline__ int v_st(int k, int c) { const int kk = (k & ~0xC) | ((k & 4) << 1) | ((k & 8) >> 1); return ((kk >> 3) * 4 + (c >> 5)) * 512 + ((kk & 7) * 32 + (c & 31)) * 2; }
__device__ __forceinline__ int v_rd_base(int lane) { return ((lane & 3) << 3) | (((lane >> 2) & 3) << 6) | (((lane >> 4) & 1) << 5) | (((lane >> 5) & 1) << 8); }
constexpr int v_rd_off(int d0, int ks, int half) { return d0 * 512 + ks * 4096 + half * 2048; }
__device__ __forceinline__ int crow(int r, int hi) { return (r & 3) + 8 * (r >> 2) + 4 * hi; }
__device__ __forceinline__ bf16x8 load8(const bf16* p) { return *reinterpret_cast<const bf16x8*>(p); }

__device__ __forceinline__ void mask_tile(f32x16& p0, f32x16& p1, int dq, unsigned W) {
    const float NEG = -__builtin_inff();
#pragma unroll
    for (int r = 0; r < 16; ++r) {
        const int c = (r & 3) + 8 * (r >> 2);
        if ((unsigned)(dq - c) >= W) p0[r] = NEG;
        if ((unsigned)(dq - c - 32) >= W) p1[r] = NEG;
    }
}
__device__ __forceinline__ void partialSM(f32x16& p0, f32x16& p1, float& m_reg, float& mn, float& alpha) {
    float pmax = p0[0]; for (int r = 1; r < 16; ++r) pmax = fmaxf(pmax, p0[r]); for (int r = 0; r < 16; ++r) pmax = fmaxf(pmax, p1[r]);
    { auto rr = __builtin_amdgcn_permlane32_swap(__float_as_uint(pmax), __float_as_uint(pmax), false, false);
      pmax = fmaxf(__uint_as_float(rr[0]), __uint_as_float(rr[1])); }
    constexpr float C2 = 1.4426950408889634f * SCALE;
    if (__builtin_expect(__all((pmax - m_reg) * SCALE <= THR), 1)) { mn = m_reg; alpha = 1.f; }
    else { mn = fmaxf(m_reg, pmax); alpha = __builtin_amdgcn_exp2f((m_reg - mn) * C2); m_reg = mn; }
    const float mnL = -mn * C2;
    for (int r = 0; r < 16; ++r) p0[r] = fmaf(p0[r], C2, mnL); for (int r = 0; r < 16; ++r) p1[r] = fmaf(p1[r], C2, mnL);
    for (int r = 0; r < 16; ++r) p0[r] = __builtin_amdgcn_exp2f(p0[r]);
}
__device__ __forceinline__ void finishSM(f32x16& p0, f32x16& p1, float alpha, float& l_reg, bf16x8& pa0, bf16x8& pa1, bf16x8& pa2, bf16x8& pa3) {
    for (int r = 0; r < 16; ++r) p1[r] = __builtin_amdgcn_exp2f(p1[r]);
    float ps = 0; for (int r = 0; r < 16; ++r) ps += p0[r]; for (int r = 0; r < 16; ++r) ps += p1[r];
    { auto rr = __builtin_amdgcn_permlane32_swap(__float_as_uint(ps), __float_as_uint(ps), false, false);
      ps = __uint_as_float(rr[0]) + __uint_as_float(rr[1]); }
    l_reg = l_reg * alpha + ps;
#define PK4(P, B_, OUT) do { unsigned a0 = cvtpk(P[B_+0], P[B_+1]), a1 = cvtpk(P[B_+2], P[B_+3]);                          \
        unsigned b0 = cvtpk(P[B_+4], P[B_+5]), b1 = cvtpk(P[B_+6], P[B_+7]);                                             \
        auto r0 = __builtin_amdgcn_permlane32_swap(a0, b0, false, false); auto r1 = __builtin_amdgcn_permlane32_swap(a1, b1, false, false); \
        u32x4 w = {r0[0], r1[0], r0[1], r1[1]}; OUT = *reinterpret_cast<bf16x8*>(&w); } while (0)
    PK4(p0, 0, pa0); PK4(p0, 8, pa1); PK4(p1, 0, pa2); PK4(p1, 8, pa3);
#undef PK4
}
template <int KB>
__device__ __forceinline__ void qkt(f32x16& p0, f32x16& p1, const char* K_lds, int r32, int hi, const bf16x8* qr, float sl, int dq) {
    const float sl8 = 8.f * sl, sl32 = 32.f * sl;
    p0[0] = -sl * (float)dq; p0[1] = p0[0] + sl; p0[2] = p0[1] + sl; p0[3] = p0[2] + sl;
#pragma unroll
    for (int r = 4; r < 16; ++r) p0[r] = p0[r - 4] + sl8;
#pragma unroll
    for (int r = 0; r < 16; ++r) p1[r] = p0[r] + sl32;
    const char* kb[4];
#pragma unroll
    for (int dd = 0; dd < 4; ++dd) kb[dd] = K_lds + KB * SHM_K + KSWZ(r32, (dd * 16 + hi * 8) * 2);
#pragma unroll
    for (int d0 = 0; d0 < 8; ++d0) { const char* a = kb[d0 & 3] + (d0 >> 2) * 128;
        bf16x8 b0_ = *reinterpret_cast<const bf16x8*>(a);
        bf16x8 b1_ = *reinterpret_cast<const bf16x8*>(a + 32 * 256);
        p0 = __builtin_amdgcn_mfma_f32_32x32x16_bf16(b0_, qr[d0], p0, 0, 0, 0);
        p1 = __builtin_amdgcn_mfma_f32_32x32x16_bf16(b1_, qr[d0], p1, 0, 0, 0); }
}
template <int VB>
__device__ __forceinline__ void pv_tile(f32x16* o, int vb0, bf16x8 pa0, bf16x8 pa1, bf16x8 pa2, bf16x8 pa3) {
#define TRRD(dst, off) asm volatile("ds_read_b64_tr_b16 %0, %1 offset:%2" : "=&v"(dst) : "v"(vb0), "i"(off) : "memory")
#define PV_D0(d0) do { s16x4 l0, l1, l2, l3, h0, h1, h2, h3; constexpr int b_ = VB * SHM_V + v_rd_off(d0, 0, 0); \
        TRRD(l0, b_); TRRD(h0, b_ + 2048); TRRD(l1, b_ + 4096); TRRD(h1, b_ + 6144); TRRD(l2, b_ + 8192); TRRD(h2, b_ + 10240); TRRD(l3, b_ + 12288); TRRD(h3, b_ + 14336); \
        asm volatile("s_waitcnt lgkmcnt(0)" ::: "memory"); SBAR();   \
        o[d0] = __builtin_amdgcn_mfma_f32_32x32x16_bf16(pa0, (bf16x8){l0[0], l0[1], l0[2], l0[3], h0[0], h0[1], h0[2], h0[3]}, o[d0], 0, 0, 0);   \
        o[d0] = __builtin_amdgcn_mfma_f32_32x32x16_bf16(pa1, (bf16x8){l1[0], l1[1], l1[2], l1[3], h1[0], h1[1], h1[2], h1[3]}, o[d0], 0, 0, 0);   \
        o[d0] = __builtin_amdgcn_mfma_f32_32x32x16_bf16(pa2, (bf16x8){l2[0], l2[1], l2[2], l2[3], h2[0], h2[1], h2[2], h2[3]}, o[d0], 0, 0, 0);   \
        o[d0] = __builtin_amdgcn_mfma_f32_32x32x16_bf16(pa3, (bf16x8){l3[0], l3[1], l3[2], l3[3], h3[0], h3[1], h3[2], h3[3]}, o[d0], 0, 0, 0); } while (0)
    PV_D0(0); PV_D0(1); PV_D0(2); PV_D0(3);
#undef PV_D0
#undef TRRD
}

struct BlockRef { const bf16* Q; const bf16* K; const bf16* V; bf16* O; int P0; };
struct Seam { bf16x8 qr[8]; bf16x8 st_v0, st_v1, st_k0, st_k1; };
__device__ __forceinline__ int swa_jlo(int P0, int W) { const int lowk = P0 - W + 1; return lowk > 0 ? lowk / KVBLK : 0; }
#define ROW(p, k0, rr) ((p) + (size_t)((k0) + (rr)) * D + sc)
#define VMW() asm volatile("s_waitcnt vmcnt(0)" ::: "memory")
#define VMWN(n) asm volatile("s_waitcnt vmcnt(%0)" :: "i"(n) : "memory")
#define SLOAD_H(Kp, Vp, k0) do { S.st_v0 = load8(ROW(Vp, k0, sr)); S.st_v1 = load8(ROW(Vp, k0, 32 + sr));              \
                         S.st_k0 = load8(ROW(Kp, k0, sr)); S.st_k1 = load8(ROW(Kp, k0, 32 + sr)); } while (0)
#define SWRITE_HK(bf) do { *(bf16x8*)(K_lds + (bf) * SHM_K + kws) = S.st_k0; *(bf16x8*)(K_lds + (bf) * SHM_K + kws + 32 * 256) = S.st_k1; } while (0)
#define SWRITE_HV(bf) do { *(bf16x8*)(V_lds + (bf) * SHM_V + vst0) = S.st_v0; *(bf16x8*)(V_lds + (bf) * SHM_V + vst1) = S.st_v1; } while (0)
#define SWRITE_H(bf) do { SWRITE_HV(bf); SWRITE_HK(bf); } while (0)

__device__ __forceinline__ void causal_swa_prime(const BlockRef& cur, int W, char* lds, Seam& S, const int tid) {
    const int wid = __builtin_amdgcn_readfirstlane(tid >> 6), lane = tid & 63, r32 = lane & 31, hi = lane >> 5;
    const int sr = tid >> 4, sc = (tid & 15) * 8, kws = KSWZ(sr, sc * 2); char* K_lds = lds + 2 * SHM_V;
    const int kb0 = swa_jlo(cur.P0, W) * KVBLK;
    for (int d0 = 0; d0 < 8; ++d0) S.qr[d0] = load8(cur.Q + (size_t)(wid * QBLK + r32) * D + d0 * 16 + hi * 8);
    SLOAD_H(cur.K, cur.V, kb0); VMW(); SWRITE_HK(0);
    __syncthreads();
}
__device__ __forceinline__ void causal_swa_block(const BlockRef& cur, const BlockRef& nxt, int skv, int W, int Wn, float sl, char* lds, Seam& S, const int tid) {
    const int wid = __builtin_amdgcn_readfirstlane(tid >> 6), lane = tid & 63, r32 = lane & 31, hi = lane >> 5;
    const int j_lo = swa_jlo(cur.P0, W);
    int j_hi = (cur.P0 + QB - 1) / KVBLK + 1; if (j_hi > skv / KVBLK) j_hi = skv / KVBLK;
    const int NT = j_hi - j_lo;
    const int kbn = swa_jlo(nxt.P0, Wn) * KVBLK;
    const int qlo = cur.P0 + wid * QBLK, qm = qlo + r32 - 4 * hi;
    char* V_lds = lds; char* K_lds = lds + 2 * SHM_V;
    float* ws = (float*)(lds + 2 * SHM_V + 2 * SHM_K) + wid * 64; float* li_l = ws, * al_l = ws + 32;
    float m_reg = -1e30f, l_reg = 0; f32x16 o[4] = {};
    const int sr = tid >> 4, sc = (tid & 15) * 8, vst0 = v_st(sr, sc), vst1 = v_st(32 + sr, sc), kws = KSWZ(sr, sc * 2);
    const int vb0 = (int)(uintptr_t)V_lds + v_rd_base(lane);
    const bf16* Kh = cur.K; const bf16* Vh = cur.V;
#define RESC(a) do { if (__any((a) < 1.f)) { if (hi == 0) al_l[r32] = (a); asm volatile("s_waitcnt lgkmcnt(0)" ::: "memory");              \
                     for (int d_ = 0; d_ < 4; ++d_) for (int r = 0; r < 16; ++r) o[d_][r] *= al_l[crow(r, hi)]; } } while (0)
#define KBASE(t) ((j_lo + (t)) * KVBLK)
#define MASKT(P0_, P1_, t) do { const int kb_ = KBASE(t); if (kb_ + KVBLK - 1 > qlo || kb_ <= qlo + QBLK - 1 - W) mask_tile(P0_, P1_, qm - kb_, (unsigned)W); } while (0)
    constexpr int NQL = 8;
#define SEAM_K0() do { VMWN(NQL); SWRITE_HK(0); SBAR(); } while (0)
    f32x16 pA0, pA1, pB0, pB1; float mnA, mnB, alA, alB; bf16x8 pa0, pa1, pa2, pa3;
    SWRITE_HV(0); SBAR();
    if (NT > 1) { SLOAD_H(Kh, Vh, KBASE(1)); }
    SBAR(); qkt<0>(pA0, pA1, K_lds, r32, hi, S.qr, sl, qm - KBASE(0));
    MASKT(pA0, pA1, 0); partialSM(pA0, pA1, m_reg, mnA, alA);
    if (NT > 1) { VMW(); SWRITE_H(1); }
    __syncthreads();
#define HALF_STEP(PX0, PX1, mnX, alX, PY0, PY1, alY, t, KB, VB, SB) do {                                                      \
        SBAR(); qkt<KB>(PX0, PX1, K_lds, r32, hi, S.qr, sl, qm - KBASE(t));                                                   \
        finishSM(PY0, PY1, alY, l_reg, pa0, pa1, pa2, pa3); SBAR();                                                           \
        if ((t) + 1 < NT) { SLOAD_H(Kh, Vh, KBASE((t) + 1)); SBAR(); }                                                        \
        pv_tile<VB>(o, vb0, pa0, pa1, pa2, pa3); MASKT(PX0, PX1, (t)); partialSM(PX0, PX1, m_reg, mnX, alX);                  \
        __syncthreads();                                                                                                      \
        if ((t) + 1 < NT) { VMW(); SWRITE_H(SB); }                                                                            \
        RESC(alX); __syncthreads(); } while (0)
    for (int t = 1; t + 1 < NT; t += 2) {
        HALF_STEP(pB0, pB1, mnB, alB, pA0, pA1, alA, t, 1, 0, 0);
        HALF_STEP(pA0, pA1, mnA, alA, pB0, pB1, alB, t + 1, 0, 1, 1);
    }
    const bool even = (NT & 1) == 0;
    if (even) { SBAR(); qkt<1>(pB0, pB1, K_lds, r32, hi, S.qr, sl, qm - KBASE(NT - 1)); SBAR(); }
    SLOAD_H(nxt.K, nxt.V, kbn); SBAR();
#pragma unroll
    for (int d0 = 0; d0 < 8; ++d0) S.qr[d0] = load8(nxt.Q + (size_t)(wid * QBLK + r32) * D + d0 * 16 + hi * 8);
    SBAR();
    finishSM(pA0, pA1, alA, l_reg, pa0, pa1, pa2, pa3); SBAR();
    pv_tile<0>(o, vb0, pa0, pa1, pa2, pa3);
    if (even) { MASKT(pB0, pB1, NT - 1); partialSM(pB0, pB1, m_reg, mnB, alB); __syncthreads(); RESC(alB);
        finishSM(pB0, pB1, alB, l_reg, pa0, pa1, pa2, pa3); SBAR(); pv_tile<1>(o, vb0, pa0, pa1, pa2, pa3); }
    SBAR(); SEAM_K0();
    if (hi == 0) li_l[r32] = l_reg; asm volatile("s_waitcnt lgkmcnt(0)" ::: "memory");
    float rli[16];
#pragma unroll
    for (int r = 0; r < 16; ++r) rli[r] = __builtin_amdgcn_rcpf(li_l[crow(r, hi)]);
    bf16* Ow = cur.O + (size_t)(wid * QBLK) * D;
    int zo = 0; asm volatile("" : "+v"(zo));
    const unsigned ob = (unsigned)(4 * hi * D + r32 + zo);
#pragma unroll
    for (int r = 0; r < 16; ++r) { const unsigned off = ob + (unsigned)(((r & 3) + 8 * (r >> 2)) * D);
#pragma unroll
        for (int d0 = 0; d0 < 4; ++d0) { const float v = o[d0][r] * rli[r];
            const float vn = __shfl_xor(v, 1);
            if ((r32 & 1) == 0) *(unsigned*)(Ow + off + d0 * 32) = cvtpk(v, vn); } }
    __syncthreads();
#undef RESC
#undef KBASE
#undef MASKT
#undef SEAM_K0
#undef HALF_STEP
}
#undef ROW
#undef VMW
#undef VMWN
#undef SLOAD_H
#undef SWRITE_HK
#undef SWRITE_HV
#undef SWRITE_H
}
namespace attn4 {
using attn::bf16; using attn::KVBLK; using attn::QBLK; using attn::SHM_K;
constexpr int QB = 128, D = 128;
constexpr int V_OFF = 0, K_OFF = 65536, PX_OFF = 98304;
constexpr int AL_OFF = RING_BYTES + 1024;
struct Item { const bf16* Q; const bf16* K; const bf16* V0; const bf16* V1; bf16* O; int P0, W; float sl; };

template <int OFF>
__device__ __forceinline__ void pv_half(f32x16* o, int vb0, bf16x8 pa0, bf16x8 pa1, bf16x8 pa2, bf16x8 pa3) {
#define TRRD(dst, off) asm volatile("ds_read_b64_tr_b16 %0, %1 offset:%2" : "=&v"(dst) : "v"(vb0), "i"(off) : "memory")
#define PV_D0(d0) do { s16x4 l0, l1, l2, l3, h0, h1, h2, h3; constexpr int b_ = OFF + attn::v_rd_off(d0, 0, 0); \
        TRRD(l0, b_); TRRD(h0, b_ + 2048); TRRD(l1, b_ + 4096); TRRD(h1, b_ + 6144); TRRD(l2, b_ + 8192); TRRD(h2, b_ + 10240); TRRD(l3, b_ + 12288); TRRD(h3, b_ + 14336); \
        asm volatile("s_waitcnt lgkmcnt(0)" ::: "memory"); SBAR();   \
        o[d0] = __builtin_amdgcn_mfma_f32_32x32x16_bf16(pa0, (bf16x8){l0[0], l0[1], l0[2], l0[3], h0[0], h0[1], h0[2], h0[3]}, o[d0], 0, 0, 0);   \
        o[d0] = __builtin_amdgcn_mfma_f32_32x32x16_bf16(pa1, (bf16x8){l1[0], l1[1], l1[2], l1[3], h1[0], h1[1], h1[2], h1[3]}, o[d0], 0, 0, 0);   \
        o[d0] = __builtin_amdgcn_mfma_f32_32x32x16_bf16(pa2, (bf16x8){l2[0], l2[1], l2[2], l2[3], h2[0], h2[1], h2[2], h2[3]}, o[d0], 0, 0, 0);   \
        o[d0] = __builtin_amdgcn_mfma_f32_32x32x16_bf16(pa3, (bf16x8){l3[0], l3[1], l3[2], l3[3], h3[0], h3[1], h3[2], h3[3]}, o[d0], 0, 0, 0); } while (0)
    PV_D0(0); PV_D0(1); PV_D0(2); PV_D0(3);
#undef PV_D0
#undef TRRD
}

template <int KB>
__device__ __forceinline__ void qkt_b(f32x16& p0, f32x16& p1, const char* K_lds, int r32, int hi, const bf16x8* qr, const f32x16& bias0, const f32x16& bias1) {
    const char* kb[4];
#pragma unroll
    for (int dd = 0; dd < 4; ++dd) kb[dd] = K_lds + KB * SHM_K + KSWZ(r32, (dd * 16 + hi * 8) * 2);
    { const bf16x8 b0_ = *reinterpret_cast<const bf16x8*>(kb[0]), b1_ = *reinterpret_cast<const bf16x8*>(kb[0] + 32 * 256);
      p0 = __builtin_amdgcn_mfma_f32_32x32x16_bf16(b0_, qr[0], bias0, 0, 0, 0); p1 = __builtin_amdgcn_mfma_f32_32x32x16_bf16(b1_, qr[0], bias1, 0, 0, 0); }
#pragma unroll
    for (int d0 = 1; d0 < 8; ++d0) { const char* a = kb[d0 & 3] + (d0 >> 2) * 128;
        const bf16x8 b0_ = *reinterpret_cast<const bf16x8*>(a), b1_ = *reinterpret_cast<const bf16x8*>(a + 32 * 256);
        p0 = __builtin_amdgcn_mfma_f32_32x32x16_bf16(b0_, qr[d0], p0, 0, 0, 0); p1 = __builtin_amdgcn_mfma_f32_32x32x16_bf16(b1_, qr[d0], p1, 0, 0, 0); }
}

__device__ __forceinline__ void item(const Item& it, char* lds, LAS unsigned char* ldsL, const int tid) {
    const int wid = __builtin_amdgcn_readfirstlane(tid >> 6), lane = tid & 63, r32 = lane & 31, hi = lane >> 5, role = wid >> 2, g = wid & 3;
    const int j_lo = attn::swa_jlo(it.P0, it.W);
    const int j_hi = (it.P0 + QB - 1) / KVBLK + 1;
    const int NT = j_hi - j_lo;
    const int W = it.W; const float sl = it.sl;
    const int qlo = it.P0 + g * QBLK, qm = qlo + r32 - 4 * hi;
    const int sr = tid >> 4, sc = (tid & 15) * 8, vst0 = attn::v_st(sr, sc), vst1 = attn::v_st(32 + sr, sc), kws = KSWZ(sr, sc * 2);
    float* AL = (float*)(lds + AL_OFF); int* FLG = (int*)(lds + AL_OFF + 1024); float* LL = (float*)(lds + AL_OFF + 1088);
#define KBASE(t) ((j_lo + (t)) * KVBLK)
    const bf16* gp[6]; int dstA[6], dstB[6];
#pragma unroll
    for (int i = 0; i < 6; ++i) {
        if (i < 2) { const int q = wid * 2 + i, row = 4 * q + (lane >> 4), c = (lane & 15) ^ (row & 7);
            gp[i] = it.K + (size_t)KBASE(0) * D + row * D + c * 8; dstA[i] = K_OFF + 1 * SHM_K + q * 1024; dstB[i] = K_OFF + 0 * SHM_K + q * 1024; }
        else { const int v = wid * 4 + (i - 2), j = v & 15, eh = v >> 4, sidx = 2 * j + (lane >> 5), kk = (sidx >> 2) * 8 + ((lane & 31) >> 2), k = (kk & ~0xC) | ((kk & 4) << 1) | ((kk & 8) >> 1), col = (sidx & 3) * 32 + (lane & 3) * 8;
            gp[i] = (eh ? it.V1 : it.V0) + (size_t)KBASE(0) * D + k * D + col; dstA[i] = V_OFF + 0 * 32768 + eh * 16384 + j * 1024; dstB[i] = V_OFF + 1 * 32768 + eh * 16384 + j * 1024; } }
#define A4_DMA(src, ldsbyte) __builtin_amdgcn_global_load_lds((const unsigned*)(src), (LAS unsigned*)((LAS unsigned char*)ldsL + (ldsbyte)), 16, 0, 0)
#define A4_STAGE(t, PAR) do { const int tk_ = ((t) + 1 < NT ? (t) + 1 : NT - 1), tv_ = ((t) < NT ? (t) : NT - 1); const size_t ok_ = (size_t)tk_ * (KVBLK * D), ov_ = (size_t)tv_ * (KVBLK * D); \
            _Pragma("unroll") for (int i = 0; i < 6; ++i) A4_DMA(gp[i] + (i < 2 ? ok_ : ov_), (PAR) ? dstB[i] : dstA[i]); } while (0)
#define A4_SYNC() do { asm volatile("s_waitcnt vmcnt(0) lgkmcnt(0)" ::: "memory"); __builtin_amdgcn_s_barrier(); asm volatile("" ::: "memory"); } while (0)
#define A4_PROLOGUE() do { A4_DMA(gp[0], dstB[0]); A4_DMA(gp[1], dstB[1]); A4_SYNC(); } while (0)
    char* K_lds = lds + K_OFF;
    if (role == 0) {
        bf16x8 qr[8];
#pragma unroll
        for (int d0 = 0; d0 < 8; ++d0) qr[d0] = attn::load8(it.Q + (size_t)(g * QBLK + r32) * D + d0 * 16 + hi * 8);
        asm volatile("s_waitcnt vmcnt(0)" ::: "memory");
        A4_PROLOGUE();
        float m_reg = -1e30f, l_reg = 0.f;
        f32x16 bias0, bias1;
#pragma unroll
        for (int r = 0; r < 16; ++r) { bias0[r] = sl * (float)((r & 3) + 8 * (r >> 2) + 4 * hi); bias1[r] = bias0[r] + 32.f * sl; }
        const float mstep = 64.f * sl;
#define A2_QK_STEP(t, PAR) do { A4_STAGE(t, PAR); \
            if ((t) < NT) { f32x16 p0, p1; float mn, alpha; bf16x8 pa0, pa1, pa2, pa3; \
                qkt_b<PAR>(p0, p1, K_lds, r32, hi, qr, bias0, bias1); if ((t) > 0) m_reg -= mstep; \
                { const int kb_ = KBASE(t); if (kb_ + KVBLK - 1 > qlo || kb_ <= qlo + QBLK - 1 - W) attn::mask_tile(p0, p1, qm - kb_, (unsigned)W); } \
                attn::partialSM(p0, p1, m_reg, mn, alpha); attn::finishSM(p0, p1, alpha, l_reg, pa0, pa1, pa2, pa3); \
                char* px = lds + PX_OFF + (PAR) * 16384 + g * 4096 + lane * 16; \
                *(bf16x8*)px = pa0; *(bf16x8*)(px + 1024) = pa1; *(bf16x8*)(px + 2048) = pa2; *(bf16x8*)(px + 3072) = pa3; \
                if (hi == 0) AL[(PAR) * 128 + g * 32 + r32] = alpha; \
                const int anyr = __any(alpha < 1.f) ? 1 : 0; if (lane == 0) FLG[(PAR) * 4 + g] = anyr; } \
            A4_SYNC(); } while (0)
        for (int t = 0; t <= NT; t += 2) { A2_QK_STEP(t, 0); if (t + 1 <= NT) A2_QK_STEP(t + 1, 1); }
        if (hi == 0) LL[g * 32 + r32] = l_reg;
        __syncthreads();
        __syncthreads();
#undef A2_QK_STEP
    } else {
        A4_PROLOGUE();
        f32x16 o[8] = {};
        const int vb0 = (int)(uintptr_t)(lds + V_OFF) + attn::v_rd_base(lane);
#define A2_PV_STEP(t, PAR) do { A4_STAGE(t, PAR); \
            if ((t) >= 1) { constexpr int PB = (PAR) ^ 1; \
                const int flag = __builtin_amdgcn_readfirstlane(FLG[PB * 4 + g]); \
                if (flag) { _Pragma("unroll") for (int r = 0; r < 16; ++r) { const float a = AL[PB * 128 + g * 32 + attn::crow(r, hi)]; \
                        _Pragma("unroll") for (int d_ = 0; d_ < 8; ++d_) o[d_][r] *= a; } } \
                const char* px = lds + PX_OFF + PB * 16384 + g * 4096 + lane * 16; \
                const bf16x8 pa0 = *(const bf16x8*)px, pa1 = *(const bf16x8*)(px + 1024), pa2 = *(const bf16x8*)(px + 2048), pa3 = *(const bf16x8*)(px + 3072); \
                pv_half<PB * 32768>(o, vb0, pa0, pa1, pa2, pa3); pv_half<PB * 32768 + 16384>(o + 4, vb0, pa0, pa1, pa2, pa3); } \
            A4_SYNC(); } while (0)
        for (int t = 0; t <= NT; t += 2) { A2_PV_STEP(t, 0); if (t + 1 <= NT) A2_PV_STEP(t + 1, 1); }
        __syncthreads();
        float rli[16];
#pragma unroll
        for (int r = 0; r < 16; ++r) rli[r] = __builtin_amdgcn_rcpf(LL[g * 32 + attn::crow(r, hi)]);
        bf16* Ow = it.O + (size_t)(g * QBLK) * 256;
        int zo = 0; asm volatile("" : "+v"(zo));
        const unsigned ob = (unsigned)(4 * hi * 256 + r32 + zo);
#pragma unroll
        for (int r = 0; r < 16; ++r) { const unsigned off = ob + (unsigned)(((r & 3) + 8 * (r >> 2)) * 256);
#pragma unroll
            for (int d0 = 0; d0 < 8; ++d0) { const float v = o[d0][r] * rli[r];
                const float vn = __shfl_xor(v, 1);
                if ((r32 & 1) == 0) *(unsigned*)(Ow + off + d0 * 32) = cvtpk(v, vn); } }
        __syncthreads();
#undef A2_PV_STEP
    }
#undef KBASE
#undef A4_DMA
#undef A4_STAGE
#undef A4_SYNC
#undef A4_PROLOGUE
}
}
struct Frame {
    LAS unsigned char* lds; unsigned char* lds_g;
    volatile LAS unsigned* MISC;
    unsigned* ctl; unsigned char* ws; unsigned char* dout;
    int tid, lane, wave, G, bid, gw, NGW;
};

__device__ __forceinline__ void tr_item(const float* W, int ldw, int c0, bf16_t* WT, int ldt, int r0, int kb, int nb, LAS float* scr, int lane) {
    const int k0 = 64 * kb, n0 = 32 * nb;
#pragma unroll 8
    for (int i = 0; i < 32; ++i) { const int kk = 2 * i + (lane >> 5); scr[kk * 33 + (lane & 31)] = W[(size_t)(k0 + kk) * ldw + c0 + n0 + (lane & 31)]; }
    LDS_WAIT(); asm volatile("" ::: "memory");
    const int c = lane & 7;
#pragma unroll
    for (int j = 0; j < 4; ++j) { const int n = (lane >> 3) + 8 * j; const LAS float* s = scr + (8 * c) * 33 + n;
        u32x4 o; o.x = cvtpk(s[0 * 33], s[1 * 33]); o.y = cvtpk(s[2 * 33], s[3 * 33]); o.z = cvtpk(s[4 * 33], s[5 * 33]); o.w = cvtpk(s[6 * 33], s[7 * 33]);
        *(u32x4*)(WT + (size_t)(r0 + n0 + n) * ldt + k0 + 8 * c) = o; }
    LDS_WAIT(); asm volatile("" ::: "memory");
}
__device__ __forceinline__ void tr_item8(const float* W, int ldw, int c0, unsigned char* WT, int ldt, int r0, int kb, int nb, float sc, LAS float* scr, int lane) {
    const int k0 = 64 * kb, n0 = 32 * nb;
#pragma unroll 8
    for (int i = 0; i < 32; ++i) { const int kk = 2 * i + (lane >> 5); scr[kk * 33 + (lane & 31)] = W[(size_t)(k0 + kk) * ldw + c0 + n0 + (lane & 31)]; }
    LDS_WAIT(); asm volatile("" ::: "memory");
    const int c = lane & 7;
#pragma unroll
    for (int j = 0; j < 4; ++j) { const int n = (lane >> 3) + 8 * j; const LAS float* s = scr + (8 * c) * 33 + n;
        u32x2 o; o.x = pk4_fp8(s[0 * 33] * sc, s[1 * 33] * sc, s[2 * 33] * sc, s[3 * 33] * sc); o.y = pk4_fp8(s[4 * 33] * sc, s[5 * 33] * sc, s[6 * 33] * sc, s[7 * 33] * sc);
        *(u32x2*)(WT + (size_t)(r0 + n0 + n) * ldt + k0 + 8 * c) = o; }
    LDS_WAIT(); asm volatile("" ::: "memory");
}
__device__ __forceinline__ void rms_row2048(const float* xrow, const float* g, f32x4 (&v)[8], int lane) {
    const f32x4* xr = (const f32x4*)xrow + lane; float ss = 0.f;
#pragma unroll
    for (int j = 0; j < 8; ++j) { v[j] = xr[64 * j]; ss += (v[j].x * v[j].x + v[j].y * v[j].y) + (v[j].z * v[j].z + v[j].w * v[j].w); }
    ss = wave_sum(ss); const float r = rsqrtf(ss * (1.0f / 2048.0f) + EPS);
#pragma unroll
    for (int j = 0; j < 8; ++j) { const f32x4 gg = ((const f32x4*)g)[lane + 64 * j]; v[j] = v[j] * r * gg; }
}
__device__ __forceinline__ void store_row_bf16(bf16_t* orow, const f32x4 (&v)[8], int lane) {
#pragma unroll
    for (int j = 0; j < 8; ++j) { u32x2 w; w.x = cvtpk(v[j].x, v[j].y); w.y = cvtpk(v[j].z, v[j].w); *(u32x2*)(orow + 4 * lane + 256 * j) = w; }
}

__device__ __forceinline__ void p0_prologue(Frame& F, const float* const* in) {
    LAS float* scr = (LAS float*)(F.lds + F.wave * 16384);
    const float* w_in = in[3];
    bf16_t* WINT = (bf16_t*)(F.ws + WS_WINT);
    constexpr int I0 = 8192, I1 = 1024, I2 = 1024, I3 = 1024, I4 = 6144, I5 = 2048, I6 = 2048, I7 = 1024, I8 = 1024, I9 = 2048;
    constexpr int NITEMS = I0 + I1 + I2 + I3 + I4 + I5 + I6 + I7 + I8 + I9;
    for (int it = F.gw; it < NITEMS; it += F.NGW) {
        int r = it;
        if (r < I0) { tr_item(w_in, DIN, 0, WINT, 2048, 0, r / 256, r % 256, scr, F.lane); continue; } r -= I0;
        if (r < I1) { tr_item(w_in, DIN, 9216, WINT, 2048, 8192, r / 32, r % 32, scr, F.lane); continue; } r -= I1;
        if (r < I2) { tr_item(w_in, DIN, 10248, WINT, 2048, 9216, r / 32, r % 32, scr, F.lane); continue; } r -= I2;
        if (r < I3) { tr_item(w_in, DIN, 8192, WINT, 2048, 10240, r / 32, r % 32, scr, F.lane); continue; } r -= I3;
        if (r < I4) { tr_item8(w_in, DIN, 11272, (unsigned char*)(WINT + (size_t)11264 * 2048), 2048, 0, r / 192, r % 192, 32.0f, scr, F.lane); continue; } r -= I4;
        if (r < I5) { tr_item(in[15], 2048, 0, (bf16_t*)(F.ws + WS_WMEMT), 2048, 0, r / 64, r % 64, scr, F.lane); continue; } r -= I5;
        if (r < I6) { tr_item(in[16], 2048, 0, (bf16_t*)(F.ws + WS_WBDT), 2048, 0, r / 64, r % 64, scr, F.lane); continue; } r -= I6;
        if (r < I7) { tr_item(in[17], 2048, 0, (bf16_t*)(F.ws + WS_WBMT), 1024, 0, r / 64, r % 64, scr, F.lane); continue; } r -= I7;
        if (r < I8) { tr_item(in[18], 2048, 0, (bf16_t*)(F.ws + WS_WBCT), 1024, 0, r / 64, r % 64, scr, F.lane); continue; } r -= I8;
        tr_item(in[20], 2048, 0, (bf16_t*)(F.ws + WS_WOUTT), 2048, 0, r / 64, r % 64, scr, F.lane);
    }
    { bf16_t* WRT = (bf16_t*)(F.ws + WS_WRT); const float* wrg = in[22]; const float* wre = in[24];
      for (int idx = F.bid * 512 + F.tid; idx < 256 * 2048; idx += F.G * 512) { const int n = idx >> 11, k = idx & 2047;
          const float v = (n < 4 ? wrg[k * 4 + n] : (n < 36 ? wre[k * 32 + (n - 4)] : 0.f)) * in[21][k]; WRT[idx] = (bf16_t)(cvtpk(v, 0.f) & 0xffffu); } }
    __syncthreads();
    LAS float* wg = (LAS float*)F.lds;
    for (int idx = F.tid; idx < 16384; idx += 512) { const int k = idx >> 3, j = idx & 7; wg[j * 2048 + k] = w_in[(size_t)k * DIN + 10240 + j]; }
    __syncthreads();
    const float* x = in[0]; bf16_t* HBF = (bf16_t*)(F.dout + DO_HBF); float* MLG = (float*)(F.ws + WS_MLG);
    for (int m = F.gw; m < TT; m += F.NGW) {
        f32x4 v[8]; rms_row2048(x + (size_t)m * 2048, in[2], v, F.lane);
        store_row_bf16(HBF + (size_t)m * 2048, v, F.lane);
        float res = 0.f;
#pragma unroll
        for (int jj = 0; jj < 8; ++jj) { float a = 0.f;
#pragma unroll
            for (int j = 0; j < 8; ++j) { const f32x4 w = *(const LAS f32x4*)(wg + jj * 2048 + 4 * F.lane + 256 * j); a += (v[j].x * w.x + v[j].y * w.y) + (v[j].z * w.z + v[j].w * w.w); }
            a = wave_sum(a); if (F.lane == jj) res = a; }
        if (F.lane < 8) MLG[(size_t)m * 8 + F.lane] = res;
    }
    { const float* mem = in[1]; bf16_t* MEMN = (bf16_t*)(F.ws + WS_MEMN);
      for (int m = F.gw; m < NB * MEML; m += F.NGW) { f32x4 v[8]; rms_row2048(mem + (size_t)m * 2048, in[14], v, F.lane); store_row_bf16(MEMN + (size_t)m * 2048, v, F.lane); } }
    if (F.bid == 0 && F.wave == 0) {
        const float* q1 = in[8]; const float* k1 = in[9]; const float* q2 = in[10]; const float* k2 = in[11];
        float d1 = q1[F.lane] * k1[F.lane] + q1[F.lane + 64] * k1[F.lane + 64], d2 = q2[F.lane] * k2[F.lane] + q2[F.lane + 64] * k2[F.lane + 64];
        d1 = wave_sum(d1); d2 = wave_sum(d2);
        if (F.lane == 0) F.ctl[CW_LAM] = __float_as_uint(expf(d1) - expf(d2) + 0.2f);
    }
    __syncthreads();
}

__device__ __forceinline__ void ml0_seq(Frame& F, const float* const* in, int s) {
    const int b = s >> 2, hh = s & 3;
    const float* MLG = (const float*)(F.ws + WS_MLG);
    float* KW = (float*)(F.ws + WS_SCKW); float* RS = (float*)(F.ws + WS_SCRS); float* IT = (float*)(F.ws + WS_SCIT); float* ED = (float*)(F.ws + WS_SCED); float* DEC = (float*)(F.ws + WS_DEC);
    LAS float* sm_bl = (LAS float*)F.lds; LAS float* sm_cm = sm_bl + 64; LAS float* sm_mp = sm_bl + 128; LAS float* sm_R = sm_bl + 192;
    const float big = in[6][hh], bfg = in[7][hh];
    float bl[8][4], gh[8][4], cm[8][4];
#pragma unroll
    for (int rd = 0; rd < 8; ++rd) {
        const int c = rd * 8 + F.wave; const size_t t0 = (size_t)b * SEQ + (size_t)c * 256 + 4 * F.lane;
        float lf[4], ig[4];
#pragma unroll
        for (int i = 0; i < 4; ++i) { const float fg = MLG[(t0 + i) * 8 + 4 + hh] + bfg; lf[i] = fminf(fg, 0.f) - log1pf(expf(-fabsf(fg))); ig[i] = MLG[(t0 + i) * 8 + hh] + big; }
        float p[4]; p[0] = lf[0]; p[1] = p[0] + lf[1]; p[2] = p[1] + lf[2]; p[3] = p[2] + lf[3];
        float incl = p[3];
#pragma unroll
        for (int o = 1; o < 64; o <<= 1) { const float y = __shfl_up(incl, o); if (F.lane >= o) incl += y; }
        const float excl = incl - p[3];
#pragma unroll
        for (int i = 0; i < 4; ++i) { bl[rd][i] = excl + p[i]; gh[rd][i] = ig[i] - bl[rd][i]; }
        float q[4]; q[0] = gh[rd][0]; q[1] = fmaxf(q[0], gh[rd][1]); q[2] = fmaxf(q[1], gh[rd][2]); q[3] = fmaxf(q[2], gh[rd][3]);
        float im = q[3];
#pragma unroll
        for (int o = 1; o < 64; o <<= 1) { const float y = __shfl_up(im, o); if (F.lane >= o) im = fmaxf(im, y); }
        float em = __shfl_up(im, 1); if (F.lane == 0) em = -__builtin_inff();
#pragma unroll
        for (int i = 0; i < 4; ++i) cm[rd][i] = fmaxf(em, q[i]);
        if (F.lane == 63) { sm_bl[c] = bl[rd][3]; sm_cm[c] = cm[rd][3]; }
    }
    __syncthreads();
    if (F.tid == 0) { float M = 0.f; for (int c = 0; c < 64; ++c) { sm_mp[c] = M; const float R = fmaxf(M, sm_cm[c]); sm_R[c] = R; M = sm_bl[c] + R; } }
    __syncthreads();
#pragma unroll
    for (int rd = 0; rd < 8; ++rd) {
        const int c = rd * 8 + F.wave; const size_t idx = (size_t)hh * TT + (size_t)b * SEQ + (size_t)c * 256 + 4 * F.lane;
        const float Mp = sm_mp[c], R = sm_R[c];
        f32x4 kw, rs, it, ed;
#pragma unroll
        for (int i = 0; i < 4; ++i) { const float Gt = fmaxf(Mp, cm[rd][i]); kw[i] = expf(gh[rd][i] - R); rs[i] = expf(R - Gt); it[i] = expf(Mp - Gt); ed[i] = expf(-(bl[rd][i] + Gt)); }
        *(f32x4*)(KW + idx) = kw; *(f32x4*)(RS + idx) = rs; *(f32x4*)(IT + idx) = it; *(f32x4*)(ED + idx) = ed;
        if (F.lane == 0) DEC[s * 64 + c] = expf(Mp - R);
    }
    __syncthreads();
}

__device__ __forceinline__ void unpack8(const u32x4 r, float (&x)[8]) { x[0] = bflo(r.x); x[1] = bfhi(r.x); x[2] = bflo(r.y); x[3] = bfhi(r.y); x[4] = bflo(r.z); x[5] = bfhi(r.z); x[6] = bflo(r.w); x[7] = bfhi(r.w); }
__device__ __forceinline__ void ml1_conv(Frame& F, const float* const* in) {
    const bf16_t* MQK = (const bf16_t*)(F.ws + WS_MQK);
    bf16_t* Q = (bf16_t*)(F.ws + WS_Q); bf16_t* WQ = (bf16_t*)(F.ws + WS_WQ); bf16_t* KWB = (bf16_t*)(F.ws + WS_KW); bf16_t* KWT = (bf16_t*)(F.ws + WS_KWT);
    const float* KWS = (const float*)(F.ws + WS_SCKW); const float* ITS = (const float*)(F.ws + WS_SCIT); float* KN4 = (float*)(F.ws + WS_KN);
    const float* cw = in[4]; const float* cbp = in[5];
    for (int id = F.gw; id < 2048; id += F.NGW) {
        const int cg = id & 3, sc = id >> 2, kind = cg >> 1, hh = (cg & 1) * 2 + (F.lane >> 5), d0 = (F.lane & 31) * 8, col = cg * 512 + F.lane * 8;
        const size_t t0 = (size_t)sc * 64, hrow = (size_t)hh * TT + t0;
        float w[4][8], cb[8], h3[8], h2[8], h1[8], cs[8];
#pragma unroll
        for (int j = 0; j < 4; ++j) { const f32x4 a = *(const f32x4*)(cw + j * 2048 + col), b = *(const f32x4*)(cw + j * 2048 + col + 4);
            w[j][0] = a.x; w[j][1] = a.y; w[j][2] = a.z; w[j][3] = a.w; w[j][4] = b.x; w[j][5] = b.y; w[j][6] = b.z; w[j][7] = b.w; }
        { const f32x4 a = *(const f32x4*)(cbp + col), b = *(const f32x4*)(cbp + col + 4); cb[0] = a.x; cb[1] = a.y; cb[2] = a.z; cb[3] = a.w; cb[4] = b.x; cb[5] = b.y; cb[6] = b.z; cb[7] = b.w; }
#pragma unroll
        for (int c = 0; c < 8; ++c) { h3[c] = 0.f; h2[c] = 0.f; h1[c] = 0.f; cs[c] = 0.f; }
        if ((t0 & (size_t)(SEQ - 1)) != 0) {
            unpack8(*(const u32x4*)(MQK + (t0 - 3) * 2048 + col), h3); unpack8(*(const u32x4*)(MQK + (t0 - 2) * 2048 + col), h2); unpack8(*(const u32x4*)(MQK + (t0 - 1) * 2048 + col), h1); }
        u32x4 xn[8];
#pragma unroll
        for (int i = 0; i < 8; ++i) xn[i] = *(const u32x4*)(MQK + (t0 + i) * 2048 + col);
        for (int tb = 0; tb < 8; ++tb) {
            u32x4 xr[8]; unsigned pk[8][4];
#pragma unroll
            for (int i = 0; i < 8; ++i) xr[i] = xn[i];
            { const int tn = tb < 7 ? tb + 1 : 7;
#pragma unroll
              for (int i = 0; i < 8; ++i) xn[i] = *(const u32x4*)(MQK + (t0 + tn * 8 + i) * 2048 + col); }
#pragma unroll
            for (int i = 0; i < 8; ++i) {
                float xv[8], sv[8]; unpack8(xr[i], xv);
#pragma unroll
                for (int c = 0; c < 8; ++c) { const float y = w[0][c] * h3[c] + w[1][c] * h2[c] + w[2][c] * h1[c] + w[3][c] * xv[c] + cb[c]; sv[c] = y * sigmoidf_(y); h3[c] = h2[c]; h2[c] = h1[c]; h1[c] = xv[c]; }
                const size_t tr = hrow + tb * 8 + i;
                if (kind == 0) { const float itv = ITS[tr];
                    u32x4 o; o.x = cvtpk(sv[0], sv[1]); o.y = cvtpk(sv[2], sv[3]); o.z = cvtpk(sv[4], sv[5]); o.w = cvtpk(sv[6], sv[7]); *(u32x4*)(Q + tr * 256 + d0) = o;
                    u32x4 p; p.x = cvtpk(sv[0] * itv, sv[1] * itv); p.y = cvtpk(sv[2] * itv, sv[3] * itv); p.z = cvtpk(sv[4] * itv, sv[5] * itv); p.w = cvtpk(sv[6] * itv, sv[7] * itv); *(u32x4*)(WQ + tr * 512 + 256 + d0) = p;
                } else { const float kwv = KWS[tr] * 0.0625f;
                    u32x4 o; o.x = cvtpk(sv[0] * kwv, sv[1] * kwv); o.y = cvtpk(sv[2] * kwv, sv[3] * kwv); o.z = cvtpk(sv[4] * kwv, sv[5] * kwv); o.w = cvtpk(sv[6] * kwv, sv[7] * kwv); *(u32x4*)(KWB + tr * 256 + d0) = o;
                    pk[i][0] = o.x; pk[i][1] = o.y; pk[i][2] = o.z; pk[i][3] = o.w;
                    cs[0] += bflo(o.x); cs[1] += bfhi(o.x); cs[2] += bflo(o.y); cs[3] += bfhi(o.y); cs[4] += bflo(o.z); cs[5] += bfhi(o.z); cs[6] += bflo(o.w); cs[7] += bfhi(o.w); }
            }
            if (kind == 1) {
#pragma unroll
                for (int c = 0; c < 8; ++c) { u32x4 o;
                    unsigned wj[4];
#pragma unroll
                    for (int j = 0; j < 4; ++j) { const unsigned a = pk[2 * j][c >> 1], b = pk[2 * j + 1][c >> 1];
                        wj[j] = (c & 1) ? ((a >> 16) | (b & 0xffff0000u)) : ((a & 0xffffu) | (b << 16)); }
                    o.x = wj[0]; o.y = wj[1]; o.z = wj[2]; o.w = wj[3];
                    *(u32x4*)(KWT + (((size_t)hh * 128 + (sc >> 2)) * 256 + d0 + c) * 256 + (sc & 3) * 64 + tb * 8) = o; }
            }
        }
        if (kind == 1) { float* kn = KN4 + (((size_t)hh * 128 + (sc >> 2)) * 4 + (sc & 3)) * 256 + d0;
            *(f32x4*)kn = (f32x4){cs[0], cs[1], cs[2], cs[3]}; *(f32x4*)(kn + 4) = (f32x4){cs[4], cs[5], cs[6], cs[7]}; }
    }
}

__device__ __forceinline__ void nscan_seq(Frame& F, int s) {
    if (F.tid < 256) { const int hh = s & 3, b = s >> 2; const float* KN4 = (const float*)(F.ws + WS_KN); const float* DEC = (const float*)(F.ws + WS_DEC); float* NP = (float*)(F.ws + WS_NP);
        float n = 0.f;
        for (int c0 = 0; c0 < 64; c0 += 8) { float kn[8], dc[8];
#pragma unroll
            for (int i = 0; i < 8; ++i) { const float* p = KN4 + ((size_t)hh * 128 + b * 64 + c0 + i) * 1024 + F.tid; kn[i] = (p[0] + p[256]) + (p[512] + p[768]); dc[i] = DEC[s * 64 + c0 + i]; }
#pragma unroll
            for (int i = 0; i < 8; ++i) { NP[((size_t)s * 64 + c0 + i) * 256 + F.tid] = n; n = dc[i] * n + kn[i]; } }
    }
}
__device__ __forceinline__ void xsoftmax(Frame& F) {
    const bf16_t* XS = (const bf16_t*)(F.ws + WS_XS); bf16_t* XP = (bf16_t*)(F.ws + WS_XP);
    const int sub = F.lane >> 5, d8 = (F.lane & 31) * 8;
    for (int row0 = F.gw * 8; row0 < 4 * TT; row0 += F.NGW * 8) {
        u32x4 v[4];
#pragma unroll
        for (int i = 0; i < 4; ++i) v[i] = *(const u32x4*)(XS + (size_t)(row0 + 2 * i + sub) * 256 + d8);
#pragma unroll
        for (int i = 0; i < 4; ++i) { float x[8]; unpack8(v[i], x);
            float m = fmaxf(fmaxf(fmaxf(x[0], x[1]), fmaxf(x[2], x[3])), fmaxf(fmaxf(x[4], x[5]), fmaxf(x[6], x[7])));
#pragma unroll
            for (int o = 1; o < 32; o <<= 1) m = fmaxf(m, __shfl_xor(m, o));
            float s = 0.f;
#pragma unroll
            for (int c = 0; c < 8; ++c) { x[c] = __expf(x[c] - m); s += x[c]; }
#pragma unroll
            for (int o = 1; o < 32; o <<= 1) s += __shfl_xor(s, o);
            const float inv = 1.0f / s;
            u32x4 w; w.x = cvtpk(x[0] * inv, x[1] * inv); w.y = cvtpk(x[2] * inv, x[3] * inv); w.z = cvtpk(x[4] * inv, x[5] * inv); w.w = cvtpk(x[6] * inv, x[7] * inv);
            *(u32x4*)(XP + (size_t)(row0 + 2 * i + sub) * 256 + d8) = w; }
    }
}
__device__ __forceinline__ void cscan(Frame& F) {
    const bf16_t* U = (const bf16_t*)(F.ws + WS_U); bf16_t* VC = (bf16_t*)(F.ws + WS_VC); const float* DEC = (const float*)(F.ws + WS_DEC);
    for (int gid = F.bid * 512 + F.tid; gid < 131072; gid += F.G * 512) {
        const int s = gid >> 14, rem = gid & 16383, dv = rem >> 6, dk4 = (rem & 63) * 4, hh = s & 3, b = s >> 2;
        f32x4 C = {0.f, 0.f, 0.f, 0.f};
        for (int c0 = 0; c0 < 64; c0 += 8) { const size_t g0 = (size_t)hh * 128 + b * 64 + c0;
            f32x4 u[8]; float dc[8];
#pragma unroll
            for (int i = 0; i < 8; ++i) { const u32x2 w = *(const u32x2*)(U + (g0 + i) * 65536 + (size_t)dv * 256 + dk4); u[i] = (f32x4){bflo(w.x), bfhi(w.x), bflo(w.y), bfhi(w.y)}; dc[i] = DEC[s * 64 + c0 + i]; }
#pragma unroll
            for (int i = 0; i < 8; ++i) { u32x2 w; w.x = cvtpk(C.x, C.y); w.y = cvtpk(C.z, C.w); *(u32x2*)(VC + ((g0 + i) * 256 + dv) * 512 + 256 + dk4) = w; C = C * dc[i] + u[i]; } }
    }
}
__device__ __forceinline__ void denpass(Frame& F) {
    const bf16_t* WQ = (const bf16_t*)(F.ws + WS_WQ); const float* NP = (const float*)(F.ws + WS_NP); const float* ED = (const float*)(F.ws + WS_SCED); float* HDEN = (float*)(F.ws + WS_HDEN);
    for (int row0 = F.gw * 4; row0 < 4 * TT; row0 += F.NGW * 4) {
        const int hh = row0 / TT, t = row0 - hh * TT, b = t / SEQ, c = (t - b * SEQ) >> 8;
        u32x4 w[4]; f32x4 n0 = {0.f, 0.f, 0.f, 0.f}, n1 = {0.f, 0.f, 0.f, 0.f};
#pragma unroll
        for (int i = 0; i < 4; ++i) w[i] = *(const u32x4*)(WQ + (size_t)(row0 + i) * 512 + 8 * F.lane);
        if (F.lane >= 32) { const float* np = NP + ((size_t)(b * 4 + hh) * 64 + c) * 256 + 8 * (F.lane - 32); n0 = *(const f32x4*)np; n1 = *(const f32x4*)(np + 4); }
        else { n0 = (f32x4){1.f, 1.f, 1.f, 1.f}; n1 = n0; }
        const float edv = ED[row0 + (F.lane & 3)];
#pragma unroll
        for (int i = 0; i < 4; ++i) {
            const float part = ((bflo(w[i].x) * n0.x + bfhi(w[i].x) * n0.y) + (bflo(w[i].y) * n0.z + bfhi(w[i].y) * n0.w)) + ((bflo(w[i].z) * n1.x + bfhi(w[i].z) * n1.y) + (bflo(w[i].w) * n1.z + bfhi(w[i].w) * n1.w));
            const float den = wave_sum(part);
            if (F.lane == i) HDEN[row0 + i] = fmaxf(fabsf(den), edv); }
    }
}
__device__ __forceinline__ void hmnorm(Frame& F, const float* const* in) {
    bf16_t* HR = (bf16_t*)(F.dout + DO_HR); const bf16_t* MLO = (const bf16_t*)(F.ws + WS_MLO); const float* g = in[13];
    const int sub = F.lane >> 5, d8 = (F.lane & 31) * 8;
    for (int row0 = F.gw * 8; row0 < 4 * TT; row0 += F.NGW * 8) {
        u32x4 xw[4], ow[4];
#pragma unroll
        for (int i = 0; i < 4; ++i) { const int row = row0 + 2 * i + sub; const size_t o = (size_t)(row >> 2) * 1024 + (row & 3) * 256 + d8; xw[i] = *(const u32x4*)(HR + o); ow[i] = *(const u32x4*)(MLO + o); }
#pragma unroll
        for (int i = 0; i < 4; ++i) { const int row = row0 + 2 * i + sub, hh = row & 3; const size_t o = (size_t)(row >> 2) * 1024 + hh * 256 + d8;
            float x[8], og[8]; unpack8(xw[i], x); unpack8(ow[i], og);
            float ss = ((x[0] * x[0] + x[1] * x[1]) + (x[2] * x[2] + x[3] * x[3])) + ((x[4] * x[4] + x[5] * x[5]) + (x[6] * x[6] + x[7] * x[7]));
            ss += __shfl_xor(ss, 1); ss += __shfl_xor(ss, 2); ss += __shfl_xor(ss, 4); ss += __shfl_xor(ss, 8); ss += __shfl_xor(ss, 16);
            const float r = rsqrtf(ss * (1.0f / 256.0f) + EPS);
            const f32x4 g0 = *(const f32x4*)(g + hh * 256 + d8), g1 = *(const f32x4*)(g + hh * 256 + d8 + 4);
            u32x4 w; w.x = cvtpk(sigmoidf_(og[0]) * x[0] * r * g0.x, sigmoidf_(og[1]) * x[1] * r * g0.y); w.y = cvtpk(sigmoidf_(og[2]) * x[2] * r * g0.z, sigmoidf_(og[3]) * x[3] * r * g0.w);
            w.z = cvtpk(sigmoidf_(og[4]) * x[4] * r * g1.x, sigmoidf_(og[5]) * x[5] * r * g1.y); w.w = cvtpk(sigmoidf_(og[6]) * x[6] * r * g1.z, sigmoidf_(og[7]) * x[7] * r * g1.w);
            *(u32x4*)(HR + o) = w; }
    }
}
__device__ __forceinline__ unsigned fkey(float f) { const unsigned u = __float_as_uint(f); return (u & 0x80000000u) ? ~u : (u | 0x80000000u); }
__device__ __forceinline__ float fkey_inv(unsigned k) { return __uint_as_float((k & 0x80000000u) ? (k & 0x7fffffffu) : ~k); }
__device__ __forceinline__ float dot8(const u32x4 a, const u32x4 b) {
    return ((bflo(a.x) * bflo(b.x) + bfhi(a.x) * bfhi(b.x)) + (bflo(a.y) * bflo(b.y) + bfhi(a.y) * bfhi(b.y))) + ((bflo(a.z) * bflo(b.z) + bfhi(a.z) * bfhi(b.z)) + (bflo(a.w) * bflo(b.w) + bfhi(a.w) * bfhi(b.w))); }
__device__ __forceinline__ void normmax(Frame& F) {
    LAS float* red = (LAS float*)F.lds;
    const bf16_t* DQ = (const bf16_t*)(F.ws + WS_DQ); const bf16_t* DK = (const bf16_t*)(F.ws + WS_DK);
    const size_t row0 = (size_t)F.gw * 16 + (F.lane >> 4), coff = (F.lane & 15) * 8;
    u32x4 q[4], k[4];
#pragma unroll
    for (int i = 0; i < 4; ++i) { q[i] = *(const u32x4*)(DQ + (row0 + 4 * i) * 128 + coff); k[i] = *(const u32x4*)(DK + (row0 + 4 * i) * 128 + coff); }
    for (int c16 = 0; c16 < 16; ++c16) {
        u32x4 qn[4], kn[4];
        const int cn = c16 < 15 ? c16 + 1 : 15;
#pragma unroll
        for (int i = 0; i < 4; ++i) { qn[i] = *(const u32x4*)(DQ + ((size_t)cn * TT + row0 + 4 * i) * 128 + coff); kn[i] = *(const u32x4*)(DK + ((size_t)cn * TT + row0 + 4 * i) * 128 + coff); }
        float q2 = 0.f, k2 = 0.f, nd = -__builtin_inff();
#pragma unroll
        for (int i = 0; i < 4; ++i) { float a = dot8(q[i], q[i]), b = dot8(k[i], k[i]), c = dot8(q[i], k[i]);
#pragma unroll
            for (int o = 1; o < 16; o <<= 1) { a += __shfl_xor(a, o); b += __shfl_xor(b, o); c += __shfl_xor(c, o); }
            q2 = fmaxf(q2, a); k2 = fmaxf(k2, b); nd = fmaxf(nd, -c); }
        q2 = wave_max(q2); k2 = wave_max(k2); nd = wave_max(nd);
        if (F.lane == 0) { red[F.wave * 48 + c16] = q2; red[F.wave * 48 + 16 + c16] = k2; red[F.wave * 48 + 32 + c16] = nd; }
#pragma unroll
        for (int i = 0; i < 4; ++i) { q[i] = qn[i]; k[i] = kn[i]; }
    }
    __syncthreads();
    if (F.tid < 48) {
        const int blk = F.bid >> 1, b = (F.bid * 128) / SEQ, kind = F.tid >> 4, c16 = F.tid & 15;
        float a = red[F.tid];
#pragma unroll
        for (int w = 1; w < 8; ++w) a = fmaxf(a, red[w * 48 + F.tid]);
        if (kind == 0) atomicMax(F.ctl + CW_QB2 + c16 * 128 + blk, __float_as_uint(a));
        else if (kind == 1) atomicMax(F.ctl + CW_KMX + c16 * 2 + b, __float_as_uint(a));
        else atomicMax(F.ctl + CW_ND + c16 * 128 + blk, fkey(a));
    }
    __syncthreads();
}
__device__ __forceinline__ attn4::Item attn_item(Frame& F, int qx, int id) {
    const int b = qx >> 2, m = (qx >> 1) & 1, x = id, h = 7 - (x >> 6), qb = 2 * (63 - (x & 63)) + (qx & 1);
    const bf16_t* DQ = (const bf16_t*)(F.ws + WS_DQ); const bf16_t* DK = (const bf16_t*)(F.ws + WS_DK); const bf16_t* DV = (const bf16_t*)(F.ws + WS_DV); bf16_t* O = (bf16_t*)(F.ws + WS_O);
    attn4::Item it; const size_t srow = (size_t)b * SEQ;
    it.Q = DQ + ((size_t)(h * 2 + m) * TT + srow + (size_t)qb * 128) * 128;
    it.K = DK + ((size_t)(h * 2 + m) * TT + srow) * 128;
    it.V0 = DV + ((size_t)(h * 2 + 0) * TT + srow) * 128;
    it.V1 = DV + ((size_t)(h * 2 + 1) * TT + srow) * 128;
    it.O = O + ((size_t)(h * 2 + m) * TT + srow + (size_t)qb * 128) * 256;
    it.P0 = qb * 128;
    const int c16 = h * 2 + m, blk = b * 64 + (qb >> 1);
    const float q2 = __uint_as_float(F.ctl[CW_QB2 + c16 * 128 + blk]), k2 = __uint_as_float(F.ctl[CW_KMX + c16 * 2 + b]), ndg = fkey_inv(F.ctl[CW_ND + c16 * 128 + blk]);
    const float slope = exp2f(-(float)(h + 1));
    const float bnd = (sqrtf(q2) * sqrtf(k2) + ndg) * attn::SCALE + 32.02f;
    float wf = ceilf(bnd / slope) + 1.0f; if (!(wf < (float)SEQ)) wf = (float)SEQ; if (!(wf >= 1.0f)) wf = 1.0f;
    it.W = (int)wf; it.sl = slope / attn::SCALE;
    return it;
}
__device__ __forceinline__ int attn_ticket(Frame& F, int rep, int& myq) {
    if (F.tid == 0) { int res = -1;
        for (int k = 0; k < 8; ++k) { const int q = (myq + k) & 7; const unsigned t = atomicAdd(F.ctl + CW_AHEAD + rep * 64 + q * 8, 1u); if (t < 512u) { res = q * 512 + (int)t; break; } }
        F.MISC[0] = (unsigned)res; }
    __syncthreads();
    const int v = __builtin_amdgcn_readfirstlane((int)F.MISC[0]);
    __syncthreads();
    if (v >= 0) myq = v >> 9;
    return v;
}
__device__ __forceinline__ void attn_phase(Frame& F, int rep) {
    const int tid = F.tid; int myq = F.bid & 7;
    for (;;) {
        const int id = attn_ticket(F, rep, myq);
        if (id < 0) break;
        const attn4::Item it = attn_item(F, id >> 9, id & 511);
        attn4::item(it, (char*)F.lds_g, F.lds, tid);
    }
    VM_WAIT(); __syncthreads();
}
__device__ __forceinline__ void dacombine(Frame& F, const float* const* in) {
    const bf16_t* O = (const bf16_t*)(F.ws + WS_O); bf16_t* DA = (bf16_t*)(F.ws + WS_DA); const float* g = in[12];
    const float lam = __uint_as_float(F.ctl[CW_LAM]);
    const int sub = F.lane >> 5, d8 = (F.lane & 31) * 8;
    for (int row0 = F.gw * 8; row0 < 8 * TT; row0 += F.NGW * 8) {
        u32x4 a[4], bq[4];
#pragma unroll
        for (int i = 0; i < 4; ++i) { const int row = row0 + 2 * i + sub, t = row >> 3, h = row & 7;
            a[i] = *(const u32x4*)(O + ((size_t)(h * 2 + 0) * TT + t) * 256 + d8); bq[i] = *(const u32x4*)(O + ((size_t)(h * 2 + 1) * TT + t) * 256 + d8); }
#pragma unroll
        for (int i = 0; i < 4; ++i) { const int row = row0 + 2 * i + sub, t = row >> 3, h = row & 7;
            float x[8], y[8]; unpack8(a[i], x); unpack8(bq[i], y);
#pragma unroll
            for (int c = 0; c < 8; ++c) x[c] -= lam * y[c];
            float ss = ((x[0] * x[0] + x[1] * x[1]) + (x[2] * x[2] + x[3] * x[3])) + ((x[4] * x[4] + x[5] * x[5]) + (x[6] * x[6] + x[7] * x[7]));
            ss += __shfl_xor(ss, 1); ss += __shfl_xor(ss, 2); ss += __shfl_xor(ss, 4); ss += __shfl_xor(ss, 8); ss += __shfl_xor(ss, 16);
            const float r = rsqrtf(ss * (1.0f / 256.0f) + EPS) * 0.8f;
            const f32x4 g0 = *(const f32x4*)(g + h * 256 + d8), g1 = *(const f32x4*)(g + h * 256 + d8 + 4);
            u32x4 w; w.x = cvtpk(x[0] * r * g0.x, x[1] * r * g0.y); w.y = cvtpk(x[2] * r * g0.z, x[3] * r * g0.w); w.z = cvtpk(x[4] * r * g1.x, x[5] * r * g1.y); w.w = cvtpk(x[6] * r * g1.z, x[7] * r * g1.w);
            *(u32x4*)(DA + (size_t)t * 2048 + h * 256 + d8) = w; }
    }
}
__device__ __forceinline__ void expert_convert(Frame& F, const float* const* in) {
    LAS float* scr = (LAS float*)(F.lds + F.wave * 16384);
    unsigned char* WGU = F.ws + WS_WGU; unsigned char* WD = F.ws + WS_WD;
    constexpr int PER = 22528;
    for (int it = F.gw; it < 3 * PER; it += F.NGW) {
        const int kind = it / PER, r = it - kind * PER, e = r / 704, r2 = r - e * 704;
        if (kind < 2) { const int kb = r2 / 22, nb = r2 - kb * 22, pn = nb >> 2;
            tr_item8((kind == 0 ? in[26] : in[27]) + (size_t)e * 2048 * DEXP, DEXP, 0, WGU, 2048, e * GU_N + pn * 128 + kind * 128, kb, nb, 32.0f, scr, F.lane); }
        else { const int kb = r2 >> 6, nb = r2 & 63;
            tr_item8(in[28] + (size_t)e * DEXP * 2048, 2048, 0, WD + (size_t)e * 2048 * DEXP_P, DEXP_P, 0, kb, nb, 16.0f, scr, F.lane); }
    }
    const u32x4 z = {0u, 0u, 0u, 0u};
    for (int idx = F.bid * 512 + F.tid; idx < 32 * 2 * 64 * 128; idx += F.G * 512) { const int e = idx >> 14, rem = idx & 16383, blk = rem >> 13, row = (rem >> 7) & 63, c16 = rem & 127;
        *(u32x4*)(WGU + ((size_t)e * GU_N + 1280 + blk * 128 + 64 + row) * 2048 + c16 * 16) = z; }
    for (int idx = F.bid * 512 + F.tid; idx < 32 * 2048 * 4; idx += F.G * 512) { const int en = idx >> 2, j = idx & 3;
        *(u32x4*)(WD + (size_t)en * DEXP_P + DEXP + j * 16) = z; }
    { const bf16_t* HBF = (const bf16_t*)(F.dout + DO_HBF); unsigned char* H8 = F.ws + WS_HBF8;
      for (size_t g8 = (size_t)(F.gw * 64 + F.lane) * 4; g8 < (size_t)TT * 256; g8 += (size_t)F.NGW * 64 * 4) {
          u32x4 a[4];
#pragma unroll
          for (int i = 0; i < 4; ++i) a[i] = *(const u32x4*)(HBF + (g8 + i) * 8);
          u32x4 o0, o1;
          o0.x = pk4_fp8(bflo(a[0].x), bfhi(a[0].x), bflo(a[0].y), bfhi(a[0].y)); o0.y = pk4_fp8(bflo(a[0].z), bfhi(a[0].z), bflo(a[0].w), bfhi(a[0].w));
          o0.z = pk4_fp8(bflo(a[1].x), bfhi(a[1].x), bflo(a[1].y), bfhi(a[1].y)); o0.w = pk4_fp8(bflo(a[1].z), bfhi(a[1].z), bflo(a[1].w), bfhi(a[1].w));
          o1.x = pk4_fp8(bflo(a[2].x), bfhi(a[2].x), bflo(a[2].y), bfhi(a[2].y)); o1.y = pk4_fp8(bflo(a[2].z), bfhi(a[2].z), bflo(a[2].w), bfhi(a[2].w));
          o1.z = pk4_fp8(bflo(a[3].x), bfhi(a[3].x), bflo(a[3].y), bfhi(a[3].y)); o1.w = pk4_fp8(bflo(a[3].z), bfhi(a[3].z), bflo(a[3].w), bfhi(a[3].w));
          *(u32x4*)(H8 + g8 * 8) = o0; *(u32x4*)(H8 + g8 * 8 + 16) = o1; } }
    __syncthreads();
}
__device__ __forceinline__ void topk_pass(Frame& F, const float* const* in) {
    const float* LG = (const float*)(F.ws + WS_LG); int* TOKE = (int*)(F.ws + WS_TOKE); float* TOKW = (float*)(F.ws + WS_TOKW); const float* RSS = (const float*)(F.ws + WS_RSS); float* RT = (float*)(F.ws + WS_RT);
    LAS unsigned* hist = (LAS unsigned*)F.lds;
    if (F.tid < 32) hist[F.tid] = 0u;
    __syncthreads();
    const float* brg = in[23]; const float* bre = in[25];
    for (int t = F.bid * 512 + F.tid; t < TT; t += F.G * 512) {
        const float* lp = LG + (size_t)t * 256;
        float rt; { const f32x4* rs = (const f32x4*)(RSS + (size_t)t * 32); f32x4 a = rs[0];
#pragma unroll
            for (int j = 1; j < 8; ++j) a += rs[j];
            rt = rsqrtf(((a.x + a.y) + (a.z + a.w)) * (1.0f / 2048.0f) + EPS); RT[t] = rt; }
        const f32x4 g4 = *(const f32x4*)lp * rt;
        const float g0 = g4.x + brg[0], g1 = g4.y + brg[1], g2 = g4.z + brg[2], g3 = g4.w + brg[3];
        int grp = 0; float gm = g0; if (g1 > gm) { gm = g1; grp = 1; } if (g2 > gm) { gm = g2; grp = 2; } if (g3 > gm) { gm = g3; grp = 3; }
        const float pg = 1.0f / (expf(g0 - gm) + expf(g1 - gm) + expf(g2 - gm) + expf(g3 - gm));
        const f32x4 ea = *(const f32x4*)(lp + 4 + grp * 8) * rt, eb = *(const f32x4*)(lp + 8 + grp * 8) * rt;
        const f32x4 ba = *(const f32x4*)(bre + grp * 8), bb = *(const f32x4*)(bre + grp * 8 + 4);
        float ev[8] = {ea.x + ba.x, ea.y + ba.y, ea.z + ba.z, ea.w + ba.w, eb.x + bb.x, eb.y + bb.y, eb.z + bb.z, eb.w + bb.w};
        int i1 = 0; float v1 = ev[0];
#pragma unroll
        for (int j = 1; j < 8; ++j) if (ev[j] > v1) { v1 = ev[j]; i1 = j; }
        int i2 = -1; float v2 = -__builtin_inff();
#pragma unroll
        for (int j = 0; j < 8; ++j) if (j != i1 && ev[j] > v2) { v2 = ev[j]; i2 = j; }
        const float ex = expf(v2 - v1), inv = 1.0f / (1.0f + ex);
        const int e1 = grp * 8 + i1, e2 = grp * 8 + i2;
        TOKE[t * 2] = e1; TOKE[t * 2 + 1] = e2; TOKW[t * 2] = inv * pg; TOKW[t * 2 + 1] = ex * inv * pg;
        __hip_atomic_fetch_add(&hist[e1], 1u, __ATOMIC_RELAXED, __HIP_MEMORY_SCOPE_WORKGROUP); __hip_atomic_fetch_add(&hist[e2], 1u, __ATOMIC_RELAXED, __HIP_MEMORY_SCOPE_WORKGROUP);
    }
    __syncthreads();
    if (F.tid < 32 && hist[F.tid]) atomicAdd(F.ctl + CW_ECNT + F.tid, hist[F.tid]);
    __syncthreads();
}
__device__ __forceinline__ void gather_pass(Frame& F, const float* const* in) {
    const int* TOKE = (const int*)(F.ws + WS_TOKE); const float* TOKW = (const float*)(F.ws + WS_TOKW); int* POS = (int*)(F.ws + WS_POS); float* WROW = (float*)(F.ws + WS_WROW); int* TILEE = (int*)(F.ws + WS_TILEE);
    const bf16_t* X1B = (const bf16_t*)(F.ws + WS_X1B); const float* RT = (const float*)(F.ws + WS_RT); unsigned char* XSORT = F.ws + WS_XSORT;
    float gf[32];
#pragma unroll
    for (int j = 0; j < 8; ++j) { const f32x4 g = *(const f32x4*)(in[21] + 32 * F.lane + 4 * j); gf[4 * j] = g.x; gf[4 * j + 1] = g.y; gf[4 * j + 2] = g.z; gf[4 * j + 3] = g.w; }
    LAS unsigned* pstart = (LAS unsigned*)F.lds; LAS unsigned* hist = pstart + 32; LAS unsigned* base = pstart + 64; LAS unsigned* lcur = pstart + 96; LAS int* apos = (LAS int*)(pstart + 128); LAS int* atok = apos + 512;
    if (F.tid == 0) { unsigned acc = 0; for (int e = 0; e < 32; ++e) { pstart[e] = acc; const unsigned c = F.ctl[CW_ECNT + e]; const unsigned pc = (c + 255u) & ~255u;
            if (F.bid == 0) for (unsigned rt = acc >> 8; rt < (acc + pc) >> 8; ++rt) TILEE[rt] = e;
            acc += pc; }
        if (F.bid == 0) F.ctl[CW_NRT] = acc >> 8; }
    const int per = (TT + F.G - 1) / F.G;
    const int tbeg = F.bid * per, tend = (tbeg + per < TT) ? tbeg + per : TT;
    for (int ts = tbeg; ts < tend; ts += 256) {
        const int nasg = 2 * ((tend - ts < 256) ? tend - ts : 256);
        if (F.tid < 32) { hist[F.tid] = 0u; lcur[F.tid] = 0u; }
        __syncthreads();
        int e = 0; const int a = F.tid;
        if (a < nasg) { e = TOKE[ts * 2 + a]; __hip_atomic_fetch_add(&hist[e], 1u, __ATOMIC_RELAXED, __HIP_MEMORY_SCOPE_WORKGROUP); }
        __syncthreads();
        if (F.tid < 32) base[F.tid] = pstart[F.tid] + (hist[F.tid] ? atomicAdd(F.ctl + CW_ECUR + F.tid, hist[F.tid]) : 0u);
        __syncthreads();
        if (a < nasg) { const unsigned p = base[e] + __hip_atomic_fetch_add(&lcur[e], 1u, __ATOMIC_RELAXED, __HIP_MEMORY_SCOPE_WORKGROUP); POS[ts * 2 + a] = (int)p; WROW[p] = TOKW[ts * 2 + a]; apos[a] = (int)p; atok[a] = ts + (a >> 1); }
        __syncthreads();
        for (int i = F.wave; i < nasg; i += 8) { const int tok = atok[i]; const u32x4* src = (const u32x4*)(X1B + (size_t)tok * 2048) + 4 * F.lane; u32x4* dst = (u32x4*)(XSORT + (size_t)apos[i] * 2048) + 2 * F.lane;
            u32x4 a[4]; const float rt = RT[tok];
#pragma unroll
            for (int j = 0; j < 4; ++j) a[j] = src[j];
            unsigned o[8];
#pragma unroll
            for (int j = 0; j < 4; ++j) {
                o[2 * j]     = pk4_fp8(bflo(a[j].x) * rt * gf[8 * j],     bfhi(a[j].x) * rt * gf[8 * j + 1], bflo(a[j].y) * rt * gf[8 * j + 2], bfhi(a[j].y) * rt * gf[8 * j + 3]);
                o[2 * j + 1] = pk4_fp8(bflo(a[j].z) * rt * gf[8 * j + 4], bfhi(a[j].z) * rt * gf[8 * j + 5], bflo(a[j].w) * rt * gf[8 * j + 6], bfhi(a[j].w) * rt * gf[8 * j + 7]); }
            u32x4 o0, o1; o0.x = o[0]; o0.y = o[1]; o0.z = o[2]; o0.w = o[3]; o1.x = o[4]; o1.y = o[5]; o1.z = o[6]; o1.w = o[7];
            dst[0] = o0; dst[1] = o1; }
        __syncthreads();
    }
}
__device__ __forceinline__ void final_pass(Frame& F, const float* const* in) {
    const bf16_t* X1B = (const bf16_t*)(F.ws + WS_X1B); float* OUT = (float*)F.dout; const bf16_t* YS = (const bf16_t*)(F.ws + WS_YS); const int* POS = (const int*)(F.ws + WS_POS); const float* g = in[29];
    for (int m0 = F.gw * 2; m0 < TT; m0 += F.NGW * 2) {
        u32x4 x[2][4], a[2][4], bq[2][4];
#pragma unroll
        for (int rr = 0; rr < 2; ++rr) { const int m = m0 + rr; const int p0 = POS[m * 2], p1 = POS[m * 2 + 1];
#pragma unroll
            for (int j = 0; j < 4; ++j) { const size_t c = 8 * F.lane + 512 * j;
                x[rr][j] = *(const u32x4*)(X1B + (size_t)m * 2048 + c); a[rr][j] = *(const u32x4*)(YS + (size_t)p0 * 2048 + c); bq[rr][j] = *(const u32x4*)(YS + (size_t)p1 * 2048 + c); } }
#pragma unroll
        for (int rr = 0; rr < 2; ++rr) { const int m = m0 + rr; float v[4][8]; float ss = 0.f;
#pragma unroll
            for (int j = 0; j < 4; ++j) { float xa[8], ya[8], yb[8]; unpack8(x[rr][j], xa); unpack8(a[rr][j], ya); unpack8(bq[rr][j], yb);
#pragma unroll
                for (int c = 0; c < 8; ++c) { v[j][c] = xa[c] + (ya[c] + yb[c]); ss += v[j][c] * v[j][c]; } }
            ss = wave_sum(ss); const float r = rsqrtf(ss * (1.0f / 2048.0f) + EPS);
#pragma unroll
            for (int j = 0; j < 4; ++j) { const size_t c = 8 * F.lane + 512 * j; const f32x4 g0 = *(const f32x4*)(g + c), g1 = *(const f32x4*)(g + c + 4);
                *(f32x4*)(OUT + (size_t)m * 2048 + c) = (f32x4){v[j][0] * r * g0.x, v[j][1] * r * g0.y, v[j][2] * r * g0.z, v[j][3] * r * g0.w};
                *(f32x4*)(OUT + (size_t)m * 2048 + c + 4) = (f32x4){v[j][4] * r * g1.x, v[j][5] * r * g1.y, v[j][6] * r * g1.z, v[j][7] * r * g1.w}; } }
    }
}
constexpr int NPHASE = 21;
struct Args { const float* in[30]; float* out; unsigned char* ws; int ph_lo, ph_hi; };

__device__ __forceinline__ bool fresh_lane(Frame& F) { int l = (int)__builtin_amdgcn_mbcnt_hi(~0u, __builtin_amdgcn_mbcnt_lo(~0u, 0u)); asm volatile("" : "+v"(l)); F.lane = l; F.tid = (F.wave << 6) | l; return true; }
__global__ void __launch_bounds__(512, 2) mk_fwd(Args args) {
    extern __shared__ __attribute__((aligned(16))) unsigned char lds_raw[];
    Frame F;
    F.lds = (LAS unsigned char*)lds_raw; F.lds_g = lds_raw;
    F.MISC = (volatile LAS unsigned*)(F.lds + MISC_OFF);
    F.tid = threadIdx.x; F.lane = F.tid & 63; F.wave = __builtin_amdgcn_readfirstlane(F.tid >> 6);
    F.G = gridDim.x; F.bid = blockIdx.x; F.gw = F.bid * 8 + F.wave; F.NGW = F.G * 8;
    F.ws = args.ws; F.dout = (unsigned char*)args.out; F.ctl = (unsigned*)(args.ws + WS_CTL);
    const float* const* in = args.in;
    for (int u = F.tid; u < (LDS_BYTES - RING_BYTES) / 4; u += 512) ((LAS unsigned*)(F.lds + RING_BYTES))[u] = 0u;
    __syncthreads();
    const int lo = args.ph_lo, hi = args.ph_hi;
    const bool fused = (hi - lo) > 1;
    XcdBarrier bar; bar.bar = F.ctl + CW_BAR; bar.x = 0; bar.st = nullptr;
    if (fused) bar = xcd_barrier_post(F.ctl + CW_BAR, F.MISC + 8, F.tid);
#ifndef ONLY_PHASE
#define ONLY_PHASE -1
#endif
#define IN(k) ((ONLY_PHASE < 0 || ONLY_PHASE == (k)) && lo <= (k) && (k) < hi && fresh_lane(F))
#ifndef DUP_MASK
#define DUP_MASK 0
#endif
#define DUP_BEGIN(k) _Pragma("unroll") for (int rep_ = 0; rep_ < 1 + ((DUP_MASK >> (k)) & 1); ++rep_) { if (rep_) { xcd_barrier(bar, F.tid); fresh_lane(F); }
#define DUP_END }
#define SEAM(k) do { if ((ONLY_PHASE < 0 || ONLY_PHASE == (k) + 1) && lo <= (k) + 1 && (k) + 1 < hi) xcd_barrier(bar, F.tid); } while (0)
    const int G = F.G, c = F.bid;
    bf16_t* const HBF = (bf16_t*)(F.dout + DO_HBF);
    bf16_t* const WINT = (bf16_t*)(F.ws + WS_WINT);
    const bf16_t* const HBF8 = (const bf16_t*)(F.ws + WS_HBF8);
    const bf16_t* const WG8 = (const bf16_t*)(WINT + (size_t)11264 * 2048);

    if (IN(0)) { DUP_BEGIN(0) p0_prologue(F, in); DUP_END SEAM(0); }

    if (IN(1)) { DUP_BEGIN(1)
        if (F.bid < 8) ml0_seq(F, in, F.bid);
        pg8::SchedPA S{HBF, WINT, G, c};
        pg8::EpiPA E{(bf16_t*)(F.ws + WS_MQK), (bf16_t*)(F.ws + WS_MLO), (bf16_t*)(F.ws + WS_XQ), (bf16_t*)(F.ws + WS_VC)};
        pg8::gemm_phase(F.lds, 2048, 2048, 2048, S, E, F.tid);
        DUP_END SEAM(1);
    }
    if (IN(2)) { DUP_BEGIN(2)
        pg8::SchedMem S{(const bf16_t*)(F.ws + WS_MEMN), (const bf16_t*)(F.ws + WS_WMEMT), G, c};
        pg8::EpiMem E{(bf16_t*)(F.ws + WS_MK), (bf16_t*)(F.ws + WS_MVT)};
        pg8::gemm_phase(F.lds, 2048, 2048, 2048, S, E, F.tid);
        ml1_conv(F, in);
        DUP_END SEAM(2);
    }
    if (IN(3)) { DUP_BEGIN(3)
#ifndef SUB
#define SUB 7
#endif
        if (SUB & 1) { pg8::SchedHG S{(const bf16_t*)(F.ws + WS_Q), (const bf16_t*)(F.ws + WS_KW), (size_t)TT * 256, 65536, (size_t)TT * 256, 65536, G, c};
          pg8::EpiW E{(bf16_t*)(F.ws + WS_WQ), (const float*)(F.ws + WS_SCRS)};
          pg8::gemm_phase(F.lds, 256, 256, 256, S, E, F.tid); }
        if (SUB & 2) { pg8::SchedHG S{(const bf16_t*)(F.ws + WS_VC), (const bf16_t*)(F.ws + WS_KWT), (size_t)128 * 256 * 512, (size_t)256 * 512, (size_t)128 * 65536, 65536, G, c};
          pg8::EpiB16Tile E{(bf16_t*)(F.ws + WS_U), 65536, 0, (size_t)128 * 65536, 256, 1.0f};
          pg8::gemm_phase(F.lds, 512, 256, 256, S, E, F.tid); }
        if (SUB & 4) { pg8::SchedXA S{(const bf16_t*)(F.ws + WS_XQ), (const bf16_t*)(F.ws + WS_MK), G, c};
          pg8::EpiXSoft E{(bf16_t*)(F.ws + WS_XP2), (LAS float*)(F.lds + pg8::EPI_TBL_OFF)};
          pg8::gemm_phase(F.lds, 256, 256, 256, S, E, F.tid); }
        if (F.bid < 8) nscan_seq(F, F.bid);
        DUP_END SEAM(3);
    }
    if (IN(4)) { DUP_BEGIN(4) cscan(F); denpass(F); DUP_END SEAM(4); }
    if (IN(5)) { DUP_BEGIN(5)
        { pg8::SchedHG S{(const bf16_t*)(F.ws + WS_WQ), (const bf16_t*)(F.ws + WS_VC), (size_t)TT * 512, (size_t)256 * 512, (size_t)128 * 256 * 512, (size_t)256 * 512, G, c};
          pg8::EpiHNorm E{(bf16_t*)(F.dout + DO_HR), (const float*)(F.ws + WS_HDEN), (const bf16_t*)(F.ws + WS_MLO), in[13], (LAS float*)(F.lds + pg8::EPI_TBL_OFF)};
          pg8::gemm_phase(F.lds, 512, 512, 512, S, E, F.tid); }
        { pg8::SchedXA S{(const bf16_t*)(F.ws + WS_XP2), (const bf16_t*)(F.ws + WS_MVT), G, c};
          pg8::EpiXA E{(bf16_t*)(F.dout + DO_XA)};
          pg8::gemm_phase(F.lds, 256, 256, 256, S, E, F.tid); }
        DUP_END SEAM(5);
    }
    if (IN(6)) { DUP_BEGIN(6)
        pg8::SchedDense S{HBF, WINT, 2048, 2048, 128, 24, G, c};
        pg8::EpiPB E{(bf16_t*)(F.ws + WS_DQ), (bf16_t*)(F.ws + WS_DK), (bf16_t*)(F.ws + WS_DV)};
        pg8::gemm_phase(F.lds, 2048, 2048, 2048, S, E, F.tid);
        DUP_END SEAM(6);
    }
    if (IN(7)) { DUP_BEGIN(7) normmax(F); DUP_END SEAM(7); }
    if (IN(8)) { DUP_BEGIN(8) attn_phase(F, rep_); DUP_END SEAM(8); }
    if (IN(9)) { DUP_BEGIN(9) dacombine(F, in); expert_convert(F, in); DUP_END SEAM(9); }
    if (IN(10)) { DUP_BEGIN(10)
        pg8::SchedDense S{HBF8, WG8, 1024, 1024, 128, 8, G, c};
        pg8::EpiGate E{(bf16_t*)(F.ws + WS_GT0), in[19], 1.0f / 32.0f};
        pg8::gemm_phase<pg8::EpiGate, pg8::SchedDense, true>(F.lds, 1024, 1024, 1024, S, E, F.tid);
        DUP_END SEAM(10);
    }
    if (IN(11)) { DUP_BEGIN(11)
        { pg8::SchedDense S{(const bf16_t*)(F.ws + WS_DA), (const bf16_t*)(F.ws + WS_WBDT), 2048, 2048, 128, 8, G, c};
          pg8::EpiBranch<true> E{(const bf16_t*)(F.ws + WS_GT0), (bf16_t*)(F.ws + WS_MERGED)};
          pg8::gemm_phase(F.lds, 2048, 2048, 2048, S, E, F.tid); }
        { pg8::SchedDense S{HBF8, WG8 + (size_t)2048 * 1024, 1024, 1024, 128, 8, G, c};
          pg8::EpiGate E{(bf16_t*)(F.ws + WS_GT1), in[19] + 2048, 1.0f / 32.0f};
          pg8::gemm_phase<pg8::EpiGate, pg8::SchedDense, true>(F.lds, 1024, 1024, 1024, S, E, F.tid); }
        DUP_END SEAM(11);
    }
    if (IN(12)) { DUP_BEGIN(12)
        { pg8::SchedDense S{(const bf16_t*)(F.dout + DO_HR), (const bf16_t*)(F.ws + WS_WBMT), 1024, 1024, 128, 8, G, c};
          pg8::EpiBranch<false> E{(const bf16_t*)(F.ws + WS_GT1), (bf16_t*)(F.ws + WS_MERGED)};
          pg8::gemm_phase(F.lds, 1024, 1024, 1024, S, E, F.tid); }
        { pg8::SchedDense S{HBF8, WG8 + (size_t)4096 * 1024, 1024, 1024, 128, 8, G, c};
          pg8::EpiGate E{(bf16_t*)(F.ws + WS_GT0), in[19] + 4096, 1.0f / 32.0f};
          pg8::gemm_phase<pg8::EpiGate, pg8::SchedDense, true>(F.lds, 1024, 1024, 1024, S, E, F.tid); }
        DUP_END SEAM(12);
    }
    if (IN(13)) { DUP_BEGIN(13)
        pg8::SchedDense S{(const bf16_t*)(F.dout + DO_XA), (const bf16_t*)(F.ws + WS_WBCT), 1024, 1024, 128, 8, G, c};
        pg8::EpiBranch<false> E{(const bf16_t*)(F.ws + WS_GT0), (bf16_t*)(F.ws + WS_MERGED)};
        pg8::gemm_phase(F.lds, 1024, 1024, 1024, S, E, F.tid);
        DUP_END SEAM(13);
    }
    if (IN(14)) { DUP_BEGIN(14)
        pg8::SchedDense S{(const bf16_t*)(F.ws + WS_MERGED), (const bf16_t*)(F.ws + WS_WOUTT), 2048, 2048, 128, 8, G, c};
        pg8::EpiOut E{in[0], (bf16_t*)(F.ws + WS_X1B), (float*)(F.ws + WS_RSS)};
        pg8::gemm_phase(F.lds, 2048, 2048, 2048, S, E, F.tid);
        DUP_END SEAM(14);
    }
    if (IN(15)) { DUP_BEGIN(15)
        pg8::SchedDense S{(const bf16_t*)(F.ws + WS_X1B), (const bf16_t*)(F.ws + WS_WRT), 2048, 2048, 128, 1, G, c};
        pg8::EpiF32Tile E{(float*)(F.ws + WS_LG), 65536, 0, 0, 256};
        pg8::gemm_phase(F.lds, 2048, 2048, 2048, S, E, F.tid);
        DUP_END SEAM(15);
    }
    if (IN(16)) { DUP_BEGIN(16) topk_pass(F, in); DUP_END SEAM(16); }
    if (IN(17)) { DUP_BEGIN(17) gather_pass(F, in); DUP_END SEAM(17); }
    if (IN(18)) { DUP_BEGIN(18)
        const int nrt = (int)__builtin_amdgcn_readfirstlane(F.ctl[CW_NRT]);
        pg8::SchedMoE S{(const bf16_t*)(F.ws + WS_XSORT), (const bf16_t*)(F.ws + WS_WGU), (const int*)(F.ws + WS_TILEE), nrt, 6, 1024, (size_t)GU_N * 1024, (size_t)256 * 1024, G, c};
        pg8::EpiGU E{F.ws + WS_HD};
        pg8::gemm_phase<pg8::EpiGU, pg8::SchedMoE, true>(F.lds, 1024, 1024, 1024, S, E, F.tid);
        DUP_END SEAM(18);
    }
    if (IN(19)) { DUP_BEGIN(19)
        const int nrt = (int)__builtin_amdgcn_readfirstlane(F.ctl[CW_NRT]);
        pg8::SchedMoE S{(const bf16_t*)(F.ws + WS_HD), (const bf16_t*)(F.ws + WS_WD), (const int*)(F.ws + WS_TILEE), nrt, 8, DEXP_P / 2, (size_t)2048 * (DEXP_P / 2), (size_t)256 * (DEXP_P / 2), G, c};
        pg8::EpiDown E{(bf16_t*)(F.ws + WS_YS), (const float*)(F.ws + WS_WROW)};
        pg8::gemm_phase<pg8::EpiDown, pg8::SchedMoE, true>(F.lds, DEXP_P / 2, DEXP_P / 2, DEXP_P / 2, S, E, F.tid);
        DUP_END SEAM(19);
    }
    if (IN(20)) { DUP_BEGIN(20) final_pass(F, in); DUP_END }
#undef IN
#undef SEAM
}

#ifndef MK_FUSED
#define MK_FUSED 1
#endif
extern "C" void kernel_launch(void* const* d_in, const int* in_sizes, int n_in, void* d_out, int out_size, void* d_ws, size_t ws_size, hipStream_t stream) {
    static int grid = 0;
    if (grid == 0) {
        if (n_in != 30 || out_size != TT * DM || ws_size < WS_END) { fprintf(stderr, "kernel_launch: unexpected shapes (n_in %d out %d ws %zu)\n", n_in, out_size, ws_size); grid = -1; return; }
        int dev = 0, cus = 0, per_cu = 0;
        if (hipGetDevice(&dev) != hipSuccess || hipDeviceGetAttribute(&cus, hipDeviceAttributeMultiprocessorCount, dev) != hipSuccess) { grid = -1; return; }
        if (hipFuncSetAttribute((const void*)mk_fwd, hipFuncAttributeMaxDynamicSharedMemorySize, LDS_BYTES) != hipSuccess) { fprintf(stderr, "kernel_launch: hipFuncSetAttribute failed\n"); grid = -1; return; }
        if (hipOccupancyMaxActiveBlocksPerMultiprocessor(&per_cu, (const void*)mk_fwd, 512, LDS_BYTES) != hipSuccess || per_cu < 1) fprintf(stderr, "kernel_launch: occupancy query says %d\n", per_cu);
        (void)hipGetLastError();
        grid = cus;
    }
    if (grid < 0) return;
    (void)hipMemsetAsync((char*)d_ws + WS_CTL, 0, CTL_ZERO_BYTES, stream);
    Args a{};
    for (int i = 0; i < 30; ++i) a.in[i] = (const float*)d_in[i];
    a.out = (float*)d_out; a.ws = (unsigned char*)d_ws;
#if MK_FUSED
    a.ph_lo = 0; a.ph_hi = NPHASE;
    hipLaunchKernelGGL(mk_fwd, dim3(grid), dim3(512), LDS_BYTES, stream, a);
#else
#ifndef PROBE_DUP
#define PROBE_DUP 0u
#endif
    for (int p = 0; p < NPHASE; ++p) { a.ph_lo = p; a.ph_hi = p + 1; hipLaunchKernelGGL(mk_fwd, dim3(grid), dim3(512), LDS_BYTES, stream, a);
        if ((PROBE_DUP >> p) & 1u) {
            if (p == 8) (void)hipMemsetAsync((char*)d_ws + WS_CTL + CW_AHEAD * 4, 0, 256, stream);
            hipLaunchKernelGGL(mk_fwd, dim3(grid), dim3(512), LDS_BYTES, stream, a); } }
#endif
}
```

```cpp
#include <hip/hip_runtime.h>
#include <hip/hip_bf16.h>
#include <cstdio>
#include <cstdint>

#define LAS __attribute__((address_space(3)))
#define GAS __attribute__((address_space(1)))
typedef unsigned short bf16_t;
typedef short bf16x8 __attribute__((ext_vector_type(8)));
typedef short s16x4 __attribute__((ext_vector_type(4)));
typedef float f32x2 __attribute__((ext_vector_type(2)));
typedef float f32x4 __attribute__((ext_vector_type(4)));
typedef float f32x16 __attribute__((ext_vector_type(16)));
typedef unsigned u32x2 __attribute__((ext_vector_type(2)));
typedef unsigned u32x4 __attribute__((ext_vector_type(4)));

constexpr int NB = 2, SEQ = 16384, TT = NB * SEQ, DM = 2048, MEML = 256;
constexpr int DIN = 17416;
constexpr float EPS = 1e-6f;
constexpr int NEXP = 32, DEXP = 704, DEXP_P = 768, GU_N = 1536;
constexpr int MAX_RT = 288;

constexpr size_t MiB = 1u << 20;
constexpr size_t WS_CTL = 0, CTL_ZERO_BYTES = 1 * MiB;
constexpr size_t WS_MLG = 1 * MiB;
constexpr size_t WS_SCKW = 2 * MiB, WS_SCRS = 2 * MiB + 512 * 1024, WS_SCIT = 3 * MiB, WS_SCED = 3 * MiB + 512 * 1024;
constexpr size_t WS_HDEN = 4 * MiB;
constexpr size_t WS_KN = 13 * MiB;
constexpr size_t WS_NP = 5 * MiB + 512 * 1024;
constexpr size_t WS_DEC = 6 * MiB;
constexpr size_t WS_MEMN = 7 * MiB;
constexpr size_t WS_MK = 9 * MiB;
constexpr size_t WS_MVT = 10 * MiB;
constexpr size_t WS_TOKE = 11 * MiB;
constexpr size_t WS_TOKW = 11 * MiB + 256 * 1024;
constexpr size_t WS_POS = 11 * MiB + 512 * 1024;
constexpr size_t WS_WROW = 12 * MiB;
constexpr size_t WS_TILEE = 12 * MiB + 512 * 1024;
constexpr size_t WS_RT = 12 * MiB + 768 * 1024;
constexpr size_t WS_WINT = 16 * MiB;
constexpr size_t WS_WMEMT = 84 * MiB;
constexpr size_t WS_WBDT = 92 * MiB;
constexpr size_t WS_WBMT = 100 * MiB;
constexpr size_t WS_WBCT = 104 * MiB;
constexpr size_t WS_WOUTT = 108 * MiB;
constexpr size_t WS_WRT = 116 * MiB;
constexpr size_t WS_MQK = 120 * MiB;
constexpr size_t WS_U = 120 * MiB;
constexpr size_t WS_XQ = 312 * MiB;
constexpr size_t WS_XP = 312 * MiB;
constexpr size_t WS_VC = 376 * MiB;
constexpr size_t WS_Q = 504 * MiB;
constexpr size_t WS_WQ = 568 * MiB;
constexpr size_t WS_KW = 696 * MiB;
constexpr size_t WS_KWT = 760 * MiB;
constexpr size_t WS_XP2 = 824 * MiB;
constexpr size_t WS_XS = 824 * MiB;
constexpr size_t WS_MLO = 952 * MiB;
constexpr size_t WS_DQ = 120 * MiB, WS_DK = 248 * MiB, WS_DV = 376 * MiB;
constexpr size_t WS_O = 504 * MiB;
constexpr size_t WS_DA = 760 * MiB;
constexpr size_t WS_WGU = 120 * MiB;
constexpr size_t WS_WD = 216 * MiB;
constexpr size_t WS_HBF8 = 264 * MiB;
constexpr size_t WS_GT0 = 408 * MiB, WS_GT1 = 536 * MiB;
constexpr size_t WS_MERGED = 888 * MiB;
constexpr size_t WS_X1B = 264 * MiB;
constexpr size_t WS_RSS = 1016 * MiB;
constexpr size_t WS_LG = 536 * MiB;
constexpr size_t WS_XSORT = 568 * MiB;
constexpr size_t WS_HD = 856 * MiB;
constexpr size_t WS_YS = 568 * MiB;
constexpr size_t WS_END = 1024 * MiB;
constexpr size_t DO_HBF = 0, DO_HR = 128 * MiB, DO_XA = 192 * MiB;

constexpr int CW_BAR = 4096;
constexpr int CW_AHEAD = 8192;
constexpr int CW_QKMAX = 8256;
constexpr int CW_KMX = 8272;
constexpr int CW_QB2 = 16384;
constexpr int CW_ND = 16384 + 2048;
constexpr int CW_ECNT = 8320;
constexpr int CW_ECUR = 8384;
constexpr int CW_LAM = 8448;
constexpr int CW_NRT = 8449;

constexpr int RING_BYTES = 131072;
constexpr int MISC_OFF = RING_BYTES + 320;
constexpr int LDS_BYTES = 147456;

#define LDS_WAIT() asm volatile("s_waitcnt lgkmcnt(0)" ::: "memory")
#define VM_WAIT() asm volatile("s_waitcnt vmcnt(0)" ::: "memory")
#define RLX_AGENT __ATOMIC_RELAXED, __HIP_MEMORY_SCOPE_AGENT

__device__ __forceinline__ unsigned cvtpk(float lo, float hi) { unsigned r; asm volatile("v_cvt_pk_bf16_f32 %0, %1, %2" : "=v"(r) : "v"(lo), "v"(hi)); return r; }
__device__ __forceinline__ unsigned pk4_fp8(float a, float b, float c, float d) { int w = 0; w = __builtin_amdgcn_cvt_pk_fp8_f32(a, b, w, false); w = __builtin_amdgcn_cvt_pk_fp8_f32(c, d, w, true); return (unsigned)w; }
__device__ __forceinline__ float bf2f(unsigned short b) { return __uint_as_float(((unsigned)b) << 16); }
__device__ __forceinline__ float bflo(unsigned w) { return __uint_as_float(w << 16); }
__device__ __forceinline__ float bfhi(unsigned w) { return __uint_as_float(w & 0xffff0000u); }
__device__ __forceinline__ float wave_sum(float v) {
#pragma unroll
    for (int o = 1; o < 64; o <<= 1) v += __shfl_xor(v, o);
    return v;
}
__device__ __forceinline__ float wave_max(float v) {
#pragma unroll
    for (int o = 1; o < 64; o <<= 1) v = fmaxf(v, __shfl_xor(v, o));
    return v;
}
__device__ __forceinline__ float sigmoidf_(float x) { return 1.0f / (1.0f + __expf(-x)); }

#define XB_TMO      128
#define XB_XCNT(j)  (256  + 64 * (j))
#define XB_XSUB(j)  (1280 + 64 * (j))
#define XB_XGEN(j)  (2304 + 64 * (j))
#define XB_TOP      3328
#define XB_TOPGEN   3392
#define XCD_BAR_WORDS 3456
#define XB_SPIN_CAP (1u << 18)

__device__ __forceinline__ unsigned xb_ld(unsigned* p)              { return __hip_atomic_load(p, __ATOMIC_RELAXED, __HIP_MEMORY_SCOPE_AGENT); }
__device__ __forceinline__ unsigned xb_add(unsigned* p, unsigned v) { return __hip_atomic_fetch_add(p, v, __ATOMIC_RELAXED, __HIP_MEMORY_SCOPE_AGENT); }
__device__ __forceinline__ unsigned xb_xcc_id() { return (unsigned)__builtin_amdgcn_s_getreg((3 << 11) | 20) & 0xFu; }
#define XB_SPIN(cond, bar) do { unsigned _sp = 0; while (cond) { __builtin_amdgcn_s_sleep(1); \
    if ((++_sp & 255u) == 0u) { if (xb_ld(&(bar)[XB_TMO])) break; if (_sp > XB_SPIN_CAP) { atomicAdd(&(bar)[XB_TMO], 1u); break; } } } } while (0)

struct XcdBarrier { unsigned* bar; unsigned x; volatile LAS unsigned* st; };

__device__ __forceinline__ XcdBarrier xcd_barrier_post(unsigned* bar, volatile LAS unsigned* st, const int tid) {
    XcdBarrier b; b.bar = bar; b.x = xb_xcc_id(); b.st = st;
    if (tid == 0) (void)xb_add(&bar[XB_XCNT(b.x)], 1u);
    return b;
}
__device__ __forceinline__ void xcd_barrier_complete(unsigned* bar, unsigned x, unsigned& nloc, unsigned& nx) {
    const unsigned G = gridDim.x * gridDim.y * gridDim.z;
    unsigned sum, cnt, mine, sp = 0u;
    for (;;) {
        sum = 0u; cnt = 0u; mine = 0u;
#pragma unroll
        for (unsigned j = 0; j < 16; ++j) { const unsigned c = xb_ld(&bar[XB_XCNT(j)]); sum += c; cnt += (c > 0u) ? 1u : 0u; mine = (j == x) ? c : mine; }
        if (sum == G) break;
        __builtin_amdgcn_s_sleep(1);
        if ((++sp & 255u) == 0u) { if (xb_ld(&bar[XB_TMO])) break; if (sp > XB_SPIN_CAP) { atomicAdd(&bar[XB_TMO], 1u); break; } }
    }
    nloc = mine > 0u ? mine : 1u; nx = cnt > 0u ? cnt : 1u;
}
__device__ __forceinline__ void xcd_barrier(const XcdBarrier& b, const int tid) {
    asm volatile("s_waitcnt vmcnt(0)" ::: "memory");
    __syncthreads();
    if (tid == 0) {
        unsigned* bar = b.bar;
        __builtin_amdgcn_s_waitcnt(0);
        unsigned nloc = b.st[0], nx = b.st[1];
        if (nloc == 0u) { xcd_barrier_complete(bar, b.x, nloc, nx); b.st[0] = nloc; b.st[1] = nx; }
        const unsigned old = xb_add(&bar[XB_XSUB(b.x)], 1u);
        const unsigned gen = old / nloc;
        if (old + 1u == (gen + 1u) * nloc) {
            __builtin_amdgcn_fence(__ATOMIC_RELEASE, "agent");
            asm volatile("s_waitcnt vmcnt(0)" ::: "memory");
            const unsigned og = xb_add(&bar[XB_TOP], 1u);
            const unsigned tg = og / nx;
            if (og + 1u == (tg + 1u) * nx) xb_add(&bar[XB_TOPGEN], 1u);
            else XB_SPIN(xb_ld(&bar[XB_TOPGEN]) == tg, bar);
            __builtin_amdgcn_fence(__ATOMIC_ACQUIRE, "agent");
            xb_add(&bar[XB_XGEN(b.x)], 1u);
            asm volatile("s_waitcnt vmcnt(0)" ::: "memory");
        } else {
            XB_SPIN(xb_ld(&bar[XB_XGEN(b.x)]) == gen, bar);
            __builtin_amdgcn_fence(__ATOMIC_ACQUIRE, "agent");
            asm volatile("s_waitcnt vmcnt(0)" ::: "memory");
        }
    }
    __syncthreads();
}

namespace pg8 {
constexpr int BM = 256, BK = 64, HALF = 128, HTB = HALF * BK * 2, STAGE_BYTES = 8 * HTB, NXCD = 8, WGM = 8;
__host__ __device__ __forceinline__ int lds_byte(int r, int c) { const int st = (r >> 4) * 2 + (c >> 5), rr = r & 15, cc = c & 31, ob = rr * 64 + cc * 2; return st * 1024 + (ob ^ (((ob >> 9) & 1) << 5)); }
__host__ __device__ __forceinline__ void stage_rc(int b, int& R, int& C) { const int st = b / 1024, sb = b % 1024, swz = sb ^ (((sb >> 9) & 1) << 5); R = (st >> 1) * 16 + swz / 64; C = (st & 1) * 32 + (swz % 64) / 2; }
__host__ __device__ __forceinline__ int perm32(int rho) { const int n = rho >> 4, i = rho & 15; return 8 * (i >> 2) + 4 * n + (i & 3); }

struct Unit { const bf16_t* A; const bf16_t* B; int pm, pn, aux; };

__device__ __forceinline__ void tile_order(int L, int nM, int nN, int& pm, int& pn) {
    const int nwg = nM * nN; int wgid = L;
    { const int q = nwg / NXCD, r = nwg % NXCD, xcd = wgid % NXCD, off = wgid / NXCD; wgid = (xcd < r ? xcd * (q + 1) : r * (q + 1) + (xcd - r) * q) + off; }
    const int nig = WGM * nN, gid = wgid / nig, fm = gid * WGM, gsz = (nM - fm) < WGM ? (nM - fm) : WGM;
    pm = fm + ((wgid % nig) % gsz); pn = (wgid % nig) / gsz;
}

typedef int i32x4 __attribute__((ext_vector_type(4)));
typedef int i32x8 __attribute__((ext_vector_type(8)));
__device__ __forceinline__ i32x8 cat8(const bf16x8 a, const bf16x8 b) { const i32x4 x = __builtin_bit_cast(i32x4, a), y = __builtin_bit_cast(i32x4, b); return __builtin_shufflevector(x, y, 0, 1, 2, 3, 4, 5, 6, 7); }
template <class Epi, class Sched, bool F8 = false>
__device__ __forceinline__ void gemm_phase(LAS unsigned char* lds, const int lda, const int ldb, const int K, const Sched& S, const Epi& E, const int tid) {
    const int wid = __builtin_amdgcn_readfirstlane(tid >> 6), lane = tid & 63, wr = wid >> 2, wc = wid & 3, fr = lane & 15, fq = lane >> 4;
    const int nt = K / BK;
    unsigned voffA[2], voffB[2];
#pragma unroll
    for (int i = 0; i < 2; ++i) { int R, C; stage_rc(tid * 16 + i * 8192, R, C); const int Rb = Epi::PERM ? ((R & ~31) + perm32(R & 31)) : R;
        voffA[i] = (unsigned)(R * lda + C) * 2u; voffB[i] = (unsigned)(Rb * ldb + C) * 2u; }
    const size_t kstep = (size_t)(BK * 2);
    const size_t hstepA = (size_t)HALF * lda * 2, hstepB = (size_t)HALF * ldb * 2;
    const unsigned ldsw = (unsigned)wid * 1024u;
    const int aoff = lds_byte(wr * 64 + fr, fq * 8), boff = lds_byte(wc * 32 + fr, fq * 8);
#define PG8_SA(b, h) (((b) * 2 + (h)) * HTB)
#define PG8_SB(b, h) ((4 + (b) * 2 + (h)) * HTB)
#define PG8_STAGE(bufoff, gbase, voff) do { _Pragma("unroll") for (int _i = 0; _i < 2; ++_i) \
        __builtin_amdgcn_global_load_lds((const unsigned*)((const char*)(gbase) + (voff)[_i]), (LAS unsigned*)(lds + (bufoff) + ldsw + _i * 8192), 16, 0, 0); } while (0)
#define PG8_LDA(dst, b, h) do { _Pragma("unroll") for (int m = 0; m < 4; ++m) { \
        if constexpr (F8) { const i32x4 lo_ = *(const LAS i32x4*)(lds + PG8_SA(b, h) + aoff + m * 2048), hi_ = *(const LAS i32x4*)(lds + PG8_SA(b, h) + aoff + m * 2048 + 1024); dst##8[m] = __builtin_shufflevector(lo_, hi_, 0, 1, 2, 3, 4, 5, 6, 7); } \
        else { _Pragma("unroll") for (int k = 0; k < 2; ++k) dst[m][k] = *(const LAS bf16x8*)(lds + PG8_SA(b, h) + aoff + m * 2048 + k * 1024); } } } while (0)
#define PG8_LDB(dst, b, h) do { _Pragma("unroll") for (int n = 0; n < 2; ++n) { \
        if constexpr (F8) { const i32x4 lo_ = *(const LAS i32x4*)(lds + PG8_SB(b, h) + boff + n * 2048), hi_ = *(const LAS i32x4*)(lds + PG8_SB(b, h) + boff + n * 2048 + 1024); dst##8[n] = __builtin_shufflevector(lo_, hi_, 0, 1, 2, 3, 4, 5, 6, 7); } \
        else { _Pragma("unroll") for (int k = 0; k < 2; ++k) dst[n][k] = *(const LAS bf16x8*)(lds + PG8_SB(b, h) + boff + n * 2048 + k * 1024); } } } while (0)
#define PG8_MMA(ai, bj, At, Bt) do { __builtin_amdgcn_s_setprio(1); _Pragma("unroll") for (int m = 0; m < 4; ++m) _Pragma("unroll") for (int n = 0; n < 2; ++n) { \
        if constexpr (F8) asm volatile("v_mfma_f32_16x16x128_f8f6f4 %0, %1, %2, %0" : "+v"(acc[ai][bj][m][n]) : "v"(Bt##8[n]), "v"(At##8[m])); \
        else { _Pragma("unroll") for (int k = 0; k < 2; ++k) acc[ai][bj][m][n] = __builtin_amdgcn_mfma_f32_16x16x32_bf16(Bt[n][k], At[m][k], acc[ai][bj][m][n], 0, 0, 0); } } \
        __builtin_amdgcn_s_setprio(0); } while (0)
#define PG8_WAIT_V(n) asm volatile("s_waitcnt vmcnt(" #n ")" ::: "memory")
#define PG8_WAIT_L(n) asm volatile("s_waitcnt lgkmcnt(" #n ")" ::: "memory")
#define PG8_BAR __builtin_amdgcn_s_barrier()
#define PG8_SCHED __builtin_amdgcn_sched_barrier(0)
    Unit cur, nxt; int ui = 0;
    if (!S.next(0, cur)) return;
    f32x4 acc[2][2][4][2];
#pragma unroll
    for (int a = 0; a < 2; ++a)
#pragma unroll
        for (int b = 0; b < 2; ++b)
#pragma unroll
            for (int m = 0; m < 4; ++m)
#pragma unroll
                for (int n = 0; n < 2; ++n) acc[a][b][m][n] = (f32x4){0.f, 0.f, 0.f, 0.f};
    bf16x8 At[4][2], B0[2][2], B1[2][2]; i32x8 At8[4], B08[2], B18[2];
    const char* cA = (const char*)cur.A; const char* cB = (const char*)cur.B;
    PG8_STAGE(PG8_SB(0, 0), cB, voffB); PG8_STAGE(PG8_SA(0, 0), cA, voffA); PG8_STAGE(PG8_SB(0, 1), cB + hstepB, voffB); PG8_STAGE(PG8_SA(0, 1), cA + hstepA, voffA);
    if (wr == 1) PG8_BAR;
    PG8_WAIT_V(4); PG8_BAR;
    PG8_STAGE(PG8_SB(1, 0), cB + kstep, voffB); PG8_STAGE(PG8_SA(1, 0), cA + kstep, voffA); PG8_STAGE(PG8_SB(1, 1), cB + hstepB + kstep, voffB);
    PG8_WAIT_V(6); PG8_BAR;
    for (;;) {
        const bool has_next = S.next(ui + 1, nxt);
        const char* nA = has_next ? (const char*)nxt.A : cA; const char* nB = has_next ? (const char*)nxt.B : cB;
#pragma nounroll
        for (int t = 0; t < nt; t += 2) {
            const bool last = (t == nt - 2);
            const char* a1 = cA + (size_t)(t + 1) * kstep;
            const char* a2 = last ? nA : cA + (size_t)(t + 2) * kstep; const char* b2 = last ? nB : cB + (size_t)(t + 2) * kstep;
            const char* a3 = a2 + kstep; const char* b3 = b2 + kstep;
            PG8_LDB(B0, 0, 0); PG8_SCHED; PG8_LDA(At, 0, 0); PG8_STAGE(PG8_SA(1, 1), a1 + hstepA, voffA);
            PG8_WAIT_L(8); PG8_BAR; PG8_WAIT_L(0); PG8_MMA(0, 0, At, B0); PG8_BAR; PG8_SCHED;
            PG8_LDB(B1, 0, 1); PG8_STAGE(PG8_SB(0, 0), b2, voffB);
            PG8_BAR; PG8_WAIT_L(0); PG8_MMA(0, 1, At, B1); PG8_BAR;
            PG8_LDA(At, 0, 1); PG8_STAGE(PG8_SA(0, 0), a2, voffA);
            PG8_BAR; PG8_WAIT_L(0); PG8_MMA(1, 0, At, B0); PG8_BAR; PG8_SCHED;
            PG8_STAGE(PG8_SB(0, 1), b2 + hstepB, voffB);
            PG8_WAIT_V(6); PG8_BAR; PG8_MMA(1, 1, At, B1); PG8_BAR;
            PG8_LDB(B0, 1, 0); PG8_SCHED; PG8_LDA(At, 1, 0); PG8_STAGE(PG8_SA(0, 1), a2 + hstepA, voffA);
            PG8_WAIT_L(8); PG8_BAR; PG8_WAIT_L(0); PG8_MMA(0, 0, At, B0); PG8_BAR; PG8_SCHED;
            PG8_LDB(B1, 1, 1); PG8_STAGE(PG8_SB(1, 0), b3, voffB);
            PG8_BAR; PG8_WAIT_L(0); PG8_MMA(0, 1, At, B1); PG8_BAR;
            PG8_LDA(At, 1, 1); PG8_STAGE(PG8_SA(1, 0), a3, voffA);
            PG8_BAR; PG8_WAIT_L(0); PG8_MMA(1, 0, At, B0); PG8_BAR; PG8_SCHED;
            PG8_STAGE(PG8_SB(1, 1), b3 + hstepB, voffB);
            PG8_WAIT_V(6); PG8_BAR; PG8_MMA(1, 1, At, B1); PG8_BAR;
        }
        if constexpr (F8) asm volatile("s_nop 15\n\ts_nop 15" ::: "memory");
        { int l_e = (int)__builtin_amdgcn_mbcnt_hi(~0u, __builtin_amdgcn_mbcnt_lo(~0u, 0u)); asm volatile("" : "+v"(l_e)); int fr_e = l_e & 15, fq_e = l_e >> 4;
          E(acc, cur, wr, wc, fr_e, fq_e); }
        if (!has_next) break;
#pragma unroll
        for (int a = 0; a < 2; ++a)
#pragma unroll
            for (int b = 0; b < 2; ++b)
#pragma unroll
                for (int m = 0; m < 4; ++m)
#pragma unroll
                    for (int n = 0; n < 2; ++n) acc[a][b][m][n] = (f32x4){0.f, 0.f, 0.f, 0.f};
        cur = nxt; cA = nA; cB = nB; ++ui;
    }
    PG8_WAIT_V(0);
    if (wr == 0) PG8_BAR;
    PG8_BAR;
#undef PG8_SA
#undef PG8_SB
#undef PG8_STAGE
#undef PG8_LDA
#undef PG8_LDB
#undef PG8_MMA
#undef PG8_WAIT_V
#undef PG8_WAIT_L
#undef PG8_BAR
#undef PG8_SCHED
}
}
namespace pg8 {
typedef f32x4 Acc[2][2][4][2];
__device__ __forceinline__ void st_bf16x8(bf16_t* p, f32x4 v0, f32x4 v1) {
    u32x4 w; w.x = cvtpk(v0[0], v0[1]); w.y = cvtpk(v0[2], v0[3]); w.z = cvtpk(v1[0], v1[1]); w.w = cvtpk(v1[2], v1[3]);
    *(u32x4*)p = w;
}
#define EPI_BF16_LOOP(...) \
    _Pragma("unroll") for (int ai = 0; ai < 2; ++ai) \
    _Pragma("unroll") for (int m = 0; m < 4; ++m) { int r = ai * 128 + wr * 64 + m * 16 + fr; asm volatile("" : "+v"(r)); \
    _Pragma("unroll") for (int bj = 0; bj < 2; ++bj) { f32x4 v0 = acc[ai][bj][m][0], v1 = acc[ai][bj][m][1]; const int colh = wc * 32 + 8 * fq; (void)colh; __VA_ARGS__ } }
#define EPI_F32_LOOP(...) \
    _Pragma("unroll") for (int ai = 0; ai < 2; ++ai) \
    _Pragma("unroll") for (int m = 0; m < 4; ++m) { int r = ai * 128 + wr * 64 + m * 16 + fr; asm volatile("" : "+v"(r)); \
    _Pragma("unroll") for (int bj = 0; bj < 2; ++bj) \
    _Pragma("unroll") for (int n = 0; n < 2; ++n) { f32x4 v = acc[ai][bj][m][n]; const int col = bj * 128 + wc * 32 + n * 16 + 4 * fq; (void)col; __VA_ARGS__ } }

struct EpiPA {
    static constexpr bool PERM = true;
    bf16_t *MQK, *MLO, *XQ, *VC;
    __device__ __forceinline__ void operator()(const Acc& acc, const Unit& u, int wr, int wc, int fr, int fq) const {
        bf16_t* base; size_t ldc;
        if (u.aux == 0) {
            if (u.pn < 8)       { base = MQK + (size_t)u.pm * 256 * 2048 + u.pn * 256; ldc = 2048; }
            else if (u.pn < 12) { base = MLO + (size_t)u.pm * 256 * 1024 + (u.pn - 8) * 256; ldc = 1024; }
            else                { base = XQ + ((size_t)(u.pn - 12) * TT + (size_t)u.pm * 256) * 256; ldc = 256; }
        } else                  { base = VC + ((size_t)(u.pm * 128 + u.pn) * 256) * 512; ldc = 512; }
        EPI_BF16_LOOP( st_bf16x8(base + (size_t)r * ldc + bj * 128 + colh, v0, v1); )
    }
};
struct EpiMem {
    static constexpr bool PERM = true;
    bf16_t *MK, *MVT;
    __device__ __forceinline__ void operator()(const Acc& acc, const Unit& u, int wr, int wc, int fr, int fq) const {
        bf16_t* base = (u.aux == 0) ? MK + (size_t)(u.pm * 4 + u.pn) * 65536 : MVT + (size_t)(u.pn * 4 + u.pm) * 65536;
        EPI_BF16_LOOP( st_bf16x8(base + (size_t)r * 256 + bj * 128 + colh, v0, v1); )
    }
};
struct EpiPB {
    static constexpr bool PERM = true;
    bf16_t *DQ, *DK, *DV;
    __device__ __forceinline__ void operator()(const Acc& acc, const Unit& u, int wr, int wc, int fr, int fq) const {
        const int which = u.pn >> 3, c0 = (u.pn & 7) * 2;
        bf16_t* buf = DQ + (size_t)which * ((WS_DK - WS_DQ) / 2);
        EPI_BF16_LOOP( st_bf16x8(buf + ((size_t)(c0 + bj) * TT + (size_t)u.pm * 256 + r) * 128 + colh, v0, v1); )
    }
};
struct EpiF32Tile {
    static constexpr bool PERM = false;
    float* C; size_t off_pm, off_pn, off_aux; int ldc;
    __device__ __forceinline__ void operator()(const Acc& acc, const Unit& u, int wr, int wc, int fr, int fq) const {
        float* base = C + (size_t)u.pm * off_pm + (size_t)u.pn * off_pn + (size_t)u.aux * off_aux;
        EPI_F32_LOOP( *(f32x4*)(base + (size_t)r * ldc + col) = v; )
    }
};
struct EpiB16Tile {
    static constexpr bool PERM = true;
    bf16_t* C; size_t off_pm, off_pn, off_aux; int ldc; float sc;
    __device__ __forceinline__ void operator()(const Acc& acc, const Unit& u, int wr, int wc, int fr, int fq) const {
        bf16_t* base = C + (size_t)u.pm * off_pm + (size_t)u.pn * off_pn + (size_t)u.aux * off_aux;
        EPI_BF16_LOOP( v0 *= sc; v1 *= sc; st_bf16x8(base + (size_t)r * ldc + bj * 128 + colh, v0, v1); )
    }
};
constexpr int EPI_TBL_OFF = RING_BYTES + 4096;
#define EPI_XBAR() do { asm volatile("s_waitcnt lgkmcnt(0)" ::: "memory"); __builtin_amdgcn_s_barrier(); asm volatile("" ::: "memory"); } while (0)
struct EpiXSoft {
    static constexpr bool PERM = true;
    bf16_t* XP; LAS float* tbl;
    __device__ __forceinline__ void operator()(const Acc& acc, const Unit& u, int wr, int wc, int fr, int fq) const {
        LAS float* TM = tbl; LAS float* TS = tbl + 1024;
        const int colh = wc * 32 + 8 * fq;
        float mloc[2][4];
#pragma unroll
        for (int ai = 0; ai < 2; ++ai)
#pragma unroll
            for (int m = 0; m < 4; ++m) { const int r = ai * 128 + wr * 64 + m * 16 + fr; float mx = -__builtin_inff();
#pragma unroll
                for (int bj = 0; bj < 2; ++bj)
#pragma unroll
                    for (int n = 0; n < 2; ++n) { const f32x4 v = acc[ai][bj][m][n]; mx = fmaxf(mx, fmaxf(fmaxf(v[0], v[1]), fmaxf(v[2], v[3]))); }
                mx = fmaxf(mx, __shfl_xor(mx, 16)); mx = fmaxf(mx, __shfl_xor(mx, 32));
                if (fq == 0) TM[r * 4 + wc] = mx; mloc[ai][m] = mx; }
        EPI_XBAR();
        f32x4 ev[2][4][2][2];
#pragma unroll
        for (int ai = 0; ai < 2; ++ai)
#pragma unroll
            for (int m = 0; m < 4; ++m) { const int r = ai * 128 + wr * 64 + m * 16 + fr;
                const f32x4 t4 = *(const LAS f32x4*)(TM + r * 4); const float mx = fmaxf(fmaxf(t4[0], t4[1]), fmaxf(t4[2], t4[3])) * 0.0625f; float s = 0.f;
#pragma unroll
                for (int bj = 0; bj < 2; ++bj)
#pragma unroll
                    for (int n = 0; n < 2; ++n) { f32x4 v = acc[ai][bj][m][n];
#pragma unroll
                        for (int j = 0; j < 4; ++j) { v[j] = __expf(v[j] * 0.0625f - mx); s += v[j]; }
                        ev[ai][m][bj][n] = v; }
                s += __shfl_xor(s, 16); s += __shfl_xor(s, 32);
                if (fq == 0) TS[r * 4 + wc] = s; }
        EPI_XBAR();
        const size_t t0 = (size_t)u.aux * TT + (size_t)u.pm * 256;
#pragma unroll
        for (int ai = 0; ai < 2; ++ai)
#pragma unroll
            for (int m = 0; m < 4; ++m) { const int r = ai * 128 + wr * 64 + m * 16 + fr;
                const f32x4 t4 = *(const LAS f32x4*)(TS + r * 4); const float inv = 1.0f / ((t4[0] + t4[1]) + (t4[2] + t4[3]));
#pragma unroll
                for (int bj = 0; bj < 2; ++bj) st_bf16x8(XP + (t0 + r) * 256 + bj * 128 + colh, ev[ai][m][bj][0] * inv, ev[ai][m][bj][1] * inv); }
    }
};
struct EpiHNorm {
    static constexpr bool PERM = true;
    bf16_t* HM; const float* HDEN; const bf16_t* MLO; const float* G; LAS float* tbl;
    __device__ __forceinline__ void operator()(const Acc& acc, const Unit& u, int wr, int wc, int fr, int fq) const {
        LAS float* TQ = tbl;
        const size_t t0 = (size_t)u.pm * 256; const int colh = wc * 32 + 8 * fq;
        float inv[2][4];
#pragma unroll
        for (int ai = 0; ai < 2; ++ai)
#pragma unroll
            for (int m = 0; m < 4; ++m) { const int r = ai * 128 + wr * 64 + m * 16 + fr; const float iv = 1.0f / HDEN[(size_t)u.aux * TT + t0 + r]; inv[ai][m] = iv; float q = 0.f;
#pragma unroll
                for (int bj = 0; bj < 2; ++bj)
#pragma unroll
                    for (int n = 0; n < 2; ++n) { const f32x4 v = acc[ai][bj][m][n] * iv; q += (v[0] * v[0] + v[1] * v[1]) + (v[2] * v[2] + v[3] * v[3]); }
                q += __shfl_xor(q, 16); q += __shfl_xor(q, 32);
                if (fq == 0) TQ[r * 4 + wc] = q; }
        EPI_XBAR();
#pragma unroll
        for (int ai = 0; ai < 2; ++ai)
#pragma unroll
            for (int m = 0; m < 4; ++m) { const int r = ai * 128 + wr * 64 + m * 16 + fr;
                const f32x4 t4 = *(const LAS f32x4*)(TQ + r * 4); const float rs = rsqrtf(((t4[0] + t4[1]) + (t4[2] + t4[3])) * (1.0f / 256.0f) + EPS) * inv[ai][m];
#pragma unroll
                for (int bj = 0; bj < 2; ++bj) { const size_t o = (t0 + r) * 1024 + u.aux * 256 + bj * 128 + colh; const u32x4 og = *(const u32x4*)(MLO + o);
                    const f32x4 g0 = *(const f32x4*)(G + u.aux * 256 + bj * 128 + colh), g1 = *(const f32x4*)(G + u.aux * 256 + bj * 128 + colh + 4);
                    f32x4 v0 = acc[ai][bj][m][0] * rs, v1 = acc[ai][bj][m][1] * rs;
                    v0[0] *= sigmoidf_(bflo(og.x)) * g0[0]; v0[1] *= sigmoidf_(bfhi(og.x)) * g0[1]; v0[2] *= sigmoidf_(bflo(og.y)) * g0[2]; v0[3] *= sigmoidf_(bfhi(og.y)) * g0[3];
                    v1[0] *= sigmoidf_(bflo(og.z)) * g1[0]; v1[1] *= sigmoidf_(bfhi(og.z)) * g1[1]; v1[2] *= sigmoidf_(bflo(og.w)) * g1[2]; v1[3] *= sigmoidf_(bfhi(og.w)) * g1[3];
                    st_bf16x8(HM + o, v0, v1); } }
    }
};
struct EpiW {
    static constexpr bool PERM = true;
    bf16_t* WQ; const float* RS;
    __device__ __forceinline__ void operator()(const Acc& acc, const Unit& u, int wr, int wc, int fr, int fq) const {
        const size_t trow = (size_t)u.aux * TT + (size_t)u.pm * 256;
        const int colh = wc * 32 + 8 * fq;
#pragma unroll
        for (int ai = 0; ai < 2; ++ai)
#pragma unroll
            for (int m = 0; m < 4; ++m) { int r = ai * 128 + wr * 64 + m * 16 + fr; asm volatile("" : "+v"(r)); const float rs = RS[trow + r];
#pragma unroll
                for (int bj = 0; bj < 2; ++bj) { f32x4 v0 = acc[ai][bj][m][0], v1 = acc[ai][bj][m][1]; const int c = bj * 128 + colh; const float fl = (float)(r - c + 1);
#pragma unroll
                    for (int j = 0; j < 4; ++j) { v0[j] = v0[j] * (rs * __saturatef(fl - (float)j)); v1[j] = v1[j] * (rs * __saturatef(fl - (float)(4 + j))); }
                    st_bf16x8(WQ + (trow + r) * 512 + c, v0, v1);
                    } }
    }
};
struct EpiH {
    static constexpr bool PERM = true;
    bf16_t* HR; const float* HDEN;
    __device__ __forceinline__ void operator()(const Acc& acc, const Unit& u, int wr, int wc, int fr, int fq) const {
        const size_t t0 = (size_t)u.pm * 256;
        EPI_BF16_LOOP( const float inv = 1.0f / HDEN[(size_t)u.aux * TT + t0 + r];
            v0 *= inv; v1 *= inv; st_bf16x8(HR + (t0 + r) * 1024 + u.aux * 256 + bj * 128 + colh, v0, v1); )
    }
};
struct EpiXA {
    static constexpr bool PERM = true;
    bf16_t* XA;
    __device__ __forceinline__ void operator()(const Acc& acc, const Unit& u, int wr, int wc, int fr, int fq) const {
        const size_t t0 = (size_t)u.pm * 256;
        EPI_BF16_LOOP( st_bf16x8(XA + (t0 + r) * 1024 + u.aux * 256 + bj * 128 + colh, v0, v1); )
    }
};
struct EpiGate {
    static constexpr bool PERM = true;
    bf16_t* GT; const float* bg; float dsc;
    __device__ __forceinline__ void operator()(const Acc& acc, const Unit& u, int wr, int wc, int fr, int fq) const {
        const size_t t0 = (size_t)u.pm * 256;
        EPI_BF16_LOOP( const int c = u.pn * 256 + bj * 128 + colh; const f32x4 b0 = *(const f32x4*)(bg + c), b1 = *(const f32x4*)(bg + c + 4);
            _Pragma("unroll") for (int j = 0; j < 4; ++j) { v0[j] = sigmoidf_(v0[j] * dsc + b0[j]); v1[j] = sigmoidf_(v1[j] * dsc + b1[j]); }
            st_bf16x8(GT + (t0 + r) * 2048 + c, v0, v1); )
    }
};
template <bool FIRST> struct EpiBranch {
    static constexpr bool PERM = true;
    const bf16_t* GT; bf16_t* MG;
    __device__ __forceinline__ void operator()(const Acc& acc, const Unit& u, int wr, int wc, int fr, int fq) const {
        const size_t t0 = (size_t)u.pm * 256;
        EPI_BF16_LOOP( const size_t o = (t0 + r) * 2048 + u.pn * 256 + bj * 128 + colh; const u32x4 g = *(const u32x4*)(GT + o);
            v0[0] *= bflo(g.x); v0[1] *= bfhi(g.x); v0[2] *= bflo(g.y); v0[3] *= bfhi(g.y); v1[0] *= bflo(g.z); v1[1] *= bfhi(g.z); v1[2] *= bflo(g.w); v1[3] *= bfhi(g.w);
            if (!FIRST) { const u32x4 p = *(const u32x4*)(MG + o);
                v0[0] += bflo(p.x); v0[1] += bfhi(p.x); v0[2] += bflo(p.y); v0[3] += bfhi(p.y); v1[0] += bflo(p.z); v1[1] += bfhi(p.z); v1[2] += bflo(p.w); v1[3] += bfhi(p.w); }
            st_bf16x8(MG + o, v0, v1); )
    }
};
struct EpiOut {
    static constexpr bool PERM = true;
    const float* X; bf16_t* X1B; float* RSS;
    __device__ __forceinline__ void operator()(const Acc& acc, const Unit& u, int wr, int wc, int fr, int fq) const {
        const size_t t0 = (size_t)u.pm * 256; const int colh = wc * 32 + 8 * fq;
#pragma unroll
        for (int ai = 0; ai < 2; ++ai)
#pragma unroll
            for (int m = 0; m < 4; ++m) { int r = ai * 128 + wr * 64 + m * 16 + fr; asm volatile("" : "+v"(r)); float ss = 0.f;
#pragma unroll
                for (int bj = 0; bj < 2; ++bj) { const size_t o = (t0 + r) * 2048 + u.pn * 256 + bj * 128 + colh;
                    const f32x4 v0 = acc[ai][bj][m][0] + *(const f32x4*)(X + o), v1 = acc[ai][bj][m][1] + *(const f32x4*)(X + o + 4);
                    u32x4 w; w.x = cvtpk(v0[0], v0[1]); w.y = cvtpk(v0[2], v0[3]); w.z = cvtpk(v1[0], v1[1]); w.w = cvtpk(v1[2], v1[3]);
                    *(u32x4*)(X1B + o) = w;
                    ss += ((bflo(w.x) * bflo(w.x) + bfhi(w.x) * bfhi(w.x)) + (bflo(w.y) * bflo(w.y) + bfhi(w.y) * bfhi(w.y))) + ((bflo(w.z) * bflo(w.z) + bfhi(w.z) * bfhi(w.z)) + (bflo(w.w) * bflo(w.w) + bfhi(w.w) * bfhi(w.w))); }
                ss += __shfl_xor(ss, 16); ss += __shfl_xor(ss, 32);
                if (fq == 0) RSS[(t0 + r) * 32 + u.pn * 4 + wc] = ss; }
    }
};
struct EpiGU {
    static constexpr bool PERM = true;
    unsigned char* HD;
    __device__ __forceinline__ void operator()(const Acc& acc, const Unit& u, int wr, int wc, int fr, int fq) const {
        const size_t t0 = (size_t)u.pm * 256; const int colh = wc * 32 + 8 * fq;
#pragma unroll
        for (int ai = 0; ai < 2; ++ai)
#pragma unroll
            for (int m = 0; m < 4; ++m) { int r = ai * 128 + wr * 64 + m * 16 + fr; asm volatile("" : "+v"(r));
                f32x4 g0 = acc[ai][0][m][0], g1 = acc[ai][0][m][1]; const f32x4 u0 = acc[ai][1][m][0], u1 = acc[ai][1][m][1];
#pragma unroll
                for (int j = 0; j < 4; ++j) { const float a0 = g0[j] * (1.0f / 32.0f), a1 = g1[j] * (1.0f / 32.0f); g0[j] = a0 * sigmoidf_(a0) * (u0[j] * 0.25f); g1[j] = a1 * sigmoidf_(a1) * (u1[j] * 0.25f); }
                u32x2 w; w.x = pk4_fp8(g0[0], g0[1], g0[2], g0[3]); w.y = pk4_fp8(g1[0], g1[1], g1[2], g1[3]);
                *(u32x2*)(HD + (t0 + r) * DEXP_P + u.pn * 128 + colh) = w; }
    }
};
struct EpiDown {
    static constexpr bool PERM = true;
    unsigned char* YS; const float* WROW;
    __device__ __forceinline__ void operator()(const Acc& acc, const Unit& u, int wr, int wc, int fr, int fq) const {
        const size_t t0 = (size_t)u.pm * 256;
        EPI_BF16_LOOP( const float w = WROW[t0 + r] * (64.0f / 128.0f); v0 *= w; v1 *= w;
            u32x2 o; o.x = pk4_fp8(v0[0], v0[1], v0[2], v0[3]); o.y = pk4_fp8(v1[0], v1[1], v1[2], v1[3]); *(u32x2*)(YS + (t0 + r) * 2048 + u.pn * 256 + bj * 128 + colh) = o; )
    }
};

struct SchedDense {
    const bf16_t* A0; const bf16_t* B0; int lda, ldb, nM, nN, G, c;
    __device__ __forceinline__ bool next(int i, Unit& u) const {
        const int L = i * G + c; if (L >= nM * nN) return false;
        tile_order(L, nM, nN, u.pm, u.pn); u.aux = 0;
        u.A = A0 + (size_t)u.pm * 256 * lda; u.B = B0 + (size_t)u.pn * 256 * ldb; return true;
    }
};
struct SchedPA {
    const bf16_t* HBF; const bf16_t* WINT; int G, c;
    __device__ __forceinline__ bool next(int i, Unit& u) const {
        const int L = i * G + c;
        if (L < 2048) { tile_order(L, 128, 16, u.pm, u.pn); u.aux = 0; u.A = HBF + (size_t)u.pm * 256 * 2048; u.B = WINT + (size_t)(6144 + u.pn * 256) * 2048; return true; }
        if (L < 2560) { const int q = L - 2048; u.pm = q & 3; u.pn = q >> 2; u.aux = 1; u.A = WINT + (size_t)(10240 + u.pm * 256) * 2048; u.B = HBF + (size_t)u.pn * 256 * 2048; return true; }
        return false;
    }
};
struct SchedMem {
    const bf16_t* MEMN; const bf16_t* WMEMT; int G, c;
    __device__ __forceinline__ bool next(int i, Unit& u) const {
        const int L = i * G + c; if (L >= 16) return false;
        if (L < 8) { u.aux = 0; u.pm = L >> 2; u.pn = L & 3; u.A = MEMN + (size_t)u.pm * 256 * 2048; u.B = WMEMT + (size_t)u.pn * 256 * 2048; }
        else { const int q = L - 8; u.aux = 1; u.pm = q & 3; u.pn = q >> 2; u.A = WMEMT + (size_t)(1024 + u.pm * 256) * 2048; u.B = MEMN + (size_t)u.pn * 256 * 2048; }
        return true;
    }
};
struct SchedHG {
    const bf16_t* A0; const bf16_t* B0; size_t sa_h, sa_g, sb_h, sb_g; int G, c;
    __device__ __forceinline__ bool next(int i, Unit& u) const {
        const int L = i * G + c; if (L >= 512) return false;
        const int hh = L >> 7, g = L & 127; u.aux = hh; u.pm = g; u.pn = 0;
        u.A = A0 + (size_t)hh * sa_h + (size_t)g * sa_g; u.B = B0 + (size_t)hh * sb_h + (size_t)g * sb_g; return true;
    }
};
struct SchedXA {
    const bf16_t* A0; const bf16_t* B0; int G, c;
    __device__ __forceinline__ bool next(int i, Unit& u) const {
        const int L = i * G + c; if (L >= 512) return false;
        const int hh = L >> 7, pm = L & 127; u.aux = hh; u.pm = pm; u.pn = 0;
        u.A = A0 + ((size_t)hh * TT + (size_t)pm * 256) * 256; u.B = B0 + (size_t)((pm >> 6) * 4 + hh) * 65536; return true;
    }
};
struct SchedMoE {
    const bf16_t* A0; const bf16_t* B0; const int* tile_e; int nrt, NT, lda; size_t eb_stride, nb_stride; int G, c;
    __device__ __forceinline__ bool next(int i, Unit& u) const {
        const int L = i * G + c; if (L >= nrt * NT) return false;
        const int rt = L / NT, pn = L - rt * NT; const int e = __builtin_amdgcn_readfirstlane(tile_e[rt]);
        u.pm = rt; u.pn = pn; u.aux = e; u.A = A0 + (size_t)rt * 256 * lda; u.B = B0 + (size_t)e * eb_stride + (size_t)pn * nb_stride; return true;
    }
};
}
namespace attn {
constexpr int D = 128;
constexpr float THR = 8.f;
constexpr float SCALE = 0.08838834764831845f;
constexpr int NW = 8, QBLK = 32, KVBLK = 64, QB = NW * QBLK;
constexpr int SHM_V = KVBLK * D * 2, SHM_K = KVBLK * D * 2;
constexpr int LDS_BYTES = 2 * SHM_V + 2 * SHM_K + NW * 64 * 4;
typedef bf16_t bf16;

#define KSWZ(row, colB) ((row) * 256 + ((colB) ^ (((row) & 7) << 4)))
#define SBAR() __builtin_amdgcn_sched_barrier(0)
__device__ __forceinline__ int v_st(int k, int c) { const int kk = (k & ~0xC) | ((k & 4) << 1) | ((k & 8) >> 1); return ((kk >> 3) * 4 + (c >> 5)) * 512 + ((kk & 7) * 32 + (c & 31)) * 2; }
__device__ __forceinline__ int v_rd_base(int lane) { return ((lane & 3) << 3) | (((lane >> 2) & 3) << 6) | (((lane >> 4) & 1) << 5) | (((lane >> 5) & 1) << 8); }
constexpr int v_rd_off(int d0, int ks, int half) { return d0 * 512 + ks * 4096 + half * 2048; }
__device__ __forceinline__ int crow(int r, int hi) { return (r & 3) + 8 * (r >> 2) + 4 * hi; }
__device__ __forceinline__ bf16x8 load8(const bf16* p) { return *reinterpret_cast<const bf16x8*>(p); }

__device__ __forceinline__ void mask_tile(f32x16& p0, f32x16& p1, int dq, unsigned W) {
    const float NEG = -__builtin_inff();
#pragma unroll
    for (int r = 0; r < 16; ++r) {
        const int c = (r & 3) + 8 * (r >> 2);
        if ((unsigned)(dq - c) >= W) p0[r] = NEG;
        if ((unsigned)(dq - c - 32) >= W) p1[r] = NEG;
    }
}
__device__ __forceinline__ void partialSM(f32x16& p0, f32x16& p1, float& m_reg, float& mn, float& alpha) {
    float pmax = p0[0]; for (int r = 1; r < 16; ++r) pmax = fmaxf(pmax, p0[r]); for (int r = 0; r < 16; ++r) pmax = fmaxf(pmax, p1[r]);
    { auto rr = __builtin_amdgcn_permlane32_swap(__float_as_uint(pmax), __float_as_uint(pmax), false, false);
      pmax = fmaxf(__uint_as_float(rr[0]), __uint_as_float(rr[1])); }
    constexpr float C2 = 1.4426950408889634f * SCALE;
    if (__builtin_expect(__all((pmax - m_reg) * SCALE <= THR), 1)) { mn = m_reg; alpha = 1.f; }
    else { mn = fmaxf(m_reg, pmax); alpha = __builtin_amdgcn_exp2f((m_reg - mn) * C2); m_reg = mn; }
    const float mnL = -mn * C2;
    for (int r = 0; r < 16; ++r) p0[r] = fmaf(p0[r], C2, mnL); for (int r = 0; r < 16; ++r) p1[r] = fmaf(p1[r], C2, mnL);
    for (int r = 0; r < 16; ++r) p0[r] = __builtin_amdgcn_exp2f(p0[r]);
}
__device__ __forceinline__ void finishSM(f32x16& p0, f32x16& p1, float alpha, float& l_reg, bf16x8& pa0, bf16x8& pa1, bf16x8& pa2, bf16x8& pa3) {
    for (int r = 0; r < 16; ++r) p1[r] = __builtin_amdgcn_exp2f(p1[r]);
    float ps = 0; for (int r = 0; r < 16; ++r) ps += p0[r]; for (int r = 0; r < 16; ++r) ps += p1[r];
    { auto rr = __builtin_amdgcn_permlane32_swap(__float_as_uint(ps), __float_as_uint(ps), false, false);
      ps = __uint_as_float(rr[0]) + __uint_as_float(rr[1]); }
    l_reg = l_reg * alpha + ps;
#define PK4(P, B_, OUT) do { unsigned a0 = cvtpk(P[B_+0], P[B_+1]), a1 = cvtpk(P[B_+2], P[B_+3]);                          \
        unsigned b0 = cvtpk(P[B_+4], P[B_+5]), b1 = cvtpk(P[B_+6], P[B_+7]);                                             \
        auto r0 = __builtin_amdgcn_permlane32_swap(a0, b0, false, false); auto r1 = __builtin_amdgcn_permlane32_swap(a1, b1, false, false); \
        u32x4 w = {r0[0], r1[0], r0[1], r1[1]}; OUT = *reinterpret_cast<bf16x8*>(&w); } while (0)
    PK4(p0, 0, pa0); PK4(p0, 8, pa1); PK4(p1, 0, pa2); PK4(p1, 8, pa3);
#undef PK4
}
template <int KB>
__device__ __forceinline__ void qkt(f32x16& p0, f32x16& p1, const char* K_lds, int r32, int hi, const bf16x8* qr, float sl, int dq) {
    const float sl8 = 8.f * sl, sl32 = 32.f * sl;
    p0[0] = -sl * (float)dq; p0[1] = p0[0] + sl; p0[2] = p0[1] + sl; p0[3] = p0[2] + sl;
#pragma unroll
    for (int r = 4; r < 16; ++r) p0[r] = p0[r - 4] + sl8;
#pragma unroll
    for (int r = 0; r < 16; ++r) p1[r] = p0[r] + sl32;
    const char* kb[4];
#pragma unroll
    for (int dd = 0; dd < 4; ++dd) kb[dd] = K_lds + KB * SHM_K + KSWZ(r32, (dd * 16 + hi * 8) * 2);
#pragma unroll
    for (int d0 = 0; d0 < 8; ++d0) { const char* a = kb[d0 & 3] + (d0 >> 2) * 128;
        bf16x8 b0_ = *reinterpret_cast<const bf16x8*>(a);
        bf16x8 b1_ = *reinterpret_cast<const bf16x8*>(a + 32 * 256);
        p0 = __builtin_amdgcn_mfma_f32_32x32x16_bf16(b0_, qr[d0], p0, 0, 0, 0);
        p1 = __builtin_amdgcn_mfma_f32_32x32x16_bf16(b1_, qr[d0], p1, 0, 0, 0); }
}
template <int VB>
__device__ __forceinline__ void pv_tile(f32x16* o, int vb0, bf16x8 pa0, bf16x8 pa1, bf16x8 pa2, bf16x8 pa3) {
#define TRRD(dst, off) asm volatile("ds_read_b64_tr_b16 %0, %1 offset:%2" : "=&v"(dst) : "v"(vb0), "i"(off) : "memory")
#define PV_D0(d0) do { s16x4 l0, l1, l2, l3, h0, h1, h2, h3; constexpr int b_ = VB * SHM_V + v_rd_off(d0, 0, 0); \
        TRRD(l0, b_); TRRD(h0, b_ + 2048); TRRD(l1, b_ + 4096); TRRD(h1, b_ + 6144); TRRD(l2, b_ + 8192); TRRD(h2, b_ + 10240); TRRD(l3, b_ + 12288); TRRD(h3, b_ + 14336); \
        asm volatile("s_waitcnt lgkmcnt(0)" ::: "memory"); SBAR();   \
        o[d0] = __builtin_amdgcn_mfma_f32_32x32x16_bf16(pa0, (bf16x8){l0[0], l0[1], l0[2], l0[3], h0[0], h0[1], h0[2], h0[3]}, o[d0], 0, 0, 0);   \
        o[d0] = __builtin_amdgcn_mfma_f32_32x32x16_bf16(pa1, (bf16x8){l1[0], l1[1], l1[2], l1[3], h1[0], h1[1], h1[2], h1[3]}, o[d0], 0, 0, 0);   \
        o[d0] = __builtin_amdgcn_mfma_f32_32x32x16_bf16(pa2, (bf16x8){l2[0], l2[1], l2[2], l2[3], h2[0], h2[1], h2[2], h2[3]}, o[d0], 0, 0, 0);   \
        o[d0] = __builtin_amdgcn_mfma_f32_32x32x16_bf16(pa3, (bf16x8){l3[0], l3[1], l3[2], l3[3], h3[0], h3[1], h3[2], h3[3]}, o[d0], 0, 0, 0); } while (0)
    PV_D0(0); PV_D0(1); PV_D0(2); PV_D0(3);
#undef PV_D0
#undef TRRD
}

struct BlockRef { const bf16* Q; const bf16* K; const bf16* V; bf16* O; int P0; };
struct Seam { bf16x8 qr[8]; bf16x8 st_v0, st_v1, st_k0, st_k1; };
__device__ __forceinline__ int swa_jlo(int P0, int W) { const int lowk = P0 - W + 1; return lowk > 0 ? lowk / KVBLK : 0; }
#define ROW(p, k0, rr) ((p) + (size_t)((k0) + (rr)) * D + sc)
#define VMW() asm volatile("s_waitcnt vmcnt(0)" ::: "memory")
#define VMWN(n) asm volatile("s_waitcnt vmcnt(%0)" :: "i"(n) : "memory")
#define SLOAD_H(Kp, Vp, k0) do { S.st_v0 = load8(ROW(Vp, k0, sr)); S.st_v1 = load8(ROW(Vp, k0, 32 + sr));              \
                         S.st_k0 = load8(ROW(Kp, k0, sr)); S.st_k1 = load8(ROW(Kp, k0, 32 + sr)); } while (0)
#define SWRITE_HK(bf) do { *(bf16x8*)(K_lds + (bf) * SHM_K + kws) = S.st_k0; *(bf16x8*)(K_lds + (bf) * SHM_K + kws + 32 * 256) = S.st_k1; } while (0)
#define SWRITE_HV(bf) do { *(bf16x8*)(V_lds + (bf) * SHM_V + vst0) = S.st_v0; *(bf16x8*)(V_lds + (bf) * SHM_V + vst1) = S.st_v1; } while (0)
#define SWRITE_H(bf) do { SWRITE_HV(bf); SWRITE_HK(bf); } while (0)

__device__ __forceinline__ void causal_swa_prime(const BlockRef& cur, int W, char* lds, Seam& S, const int tid) {
    const int wid = __builtin_amdgcn_readfirstlane(tid >> 6), lane = tid & 63, r32 = lane & 31, hi = lane >> 5;
    const int sr = tid >> 4, sc = (tid & 15) * 8, kws = KSWZ(sr, sc * 2); char* K_lds = lds + 2 * SHM_V;
    const int kb0 = swa_jlo(cur.P0, W) * KVBLK;
    for (int d0 = 0; d0 < 8; ++d0) S.qr[d0] = load8(cur.Q + (size_t)(wid * QBLK + r32) * D + d0 * 16 + hi * 8);
    SLOAD_H(cur.K, cur.V, kb0); VMW(); SWRITE_HK(0);
    __syncthreads();
}
__device__ __forceinline__ void causal_swa_block(const BlockRef& cur, const BlockRef& nxt, int skv, int W, int Wn, float sl, char* lds, Seam& S, const int tid) {
    const int wid = __builtin_amdgcn_readfirstlane(tid >> 6), lane = tid & 63, r32 = lane & 31, hi = lane >> 5;
    const int j_lo = swa_jlo(cur.P0, W);
    int j_hi = (cur.P0 + QB - 1) / KVBLK + 1; if (j_hi > skv / KVBLK) j_hi = skv / KVBLK;
    const int NT = j_hi - j_lo;
    const int kbn = swa_jlo(nxt.P0, Wn) * KVBLK;
    const int qlo = cur.P0 + wid * QBLK, qm = qlo + r32 - 4 * hi;
    char* V_lds = lds; char* K_lds = lds + 2 * SHM_V;
    float* ws = (float*)(lds + 2 * SHM_V + 2 * SHM_K) + wid * 64; float* li_l = ws, * al_l = ws + 32;
    float m_reg = -1e30f, l_reg = 0; f32x16 o[4] = {};
    const int sr = tid >> 4, sc = (tid & 15) * 8, vst0 = v_st(sr, sc), vst1 = v_st(32 + sr, sc), kws = KSWZ(sr, sc * 2);
    const int vb0 = (int)(uintptr_t)V_lds + v_rd_base(lane);
    const bf16* Kh = cur.K; const bf16* Vh = cur.V;
#define RESC(a) do { if (__any((a) < 1.f)) { if (hi == 0) al_l[r32] = (a); asm volatile("s_waitcnt lgkmcnt(0)" ::: "memory");              \
                     for (int d_ = 0; d_ < 4; ++d_) for (int r = 0; r < 16; ++r) o[d_][r] *= al_l[crow(r, hi)]; } } while (0)
#define KBASE(t) ((j_lo + (t)) * KVBLK)
#define MASKT(P0_, P1_, t) do { const int kb_ = KBASE(t); if (kb_ + KVBLK - 1 > qlo || kb_ <= qlo + QBLK - 1 - W) mask_tile(P0_, P1_, qm - kb_, (unsigned)W); } while (0)
    constexpr int NQL = 8;
#define SEAM_K0() do { VMWN(NQL); SWRITE_HK(0); SBAR(); } while (0)
    f32x16 pA0, pA1, pB0, pB1; float mnA, mnB, alA, alB; bf16x8 pa0, pa1, pa2, pa3;
    SWRITE_HV(0); SBAR();
    if (NT > 1) { SLOAD_H(Kh, Vh, KBASE(1)); }
    SBAR(); qkt<0>(pA0, pA1, K_lds, r32, hi, S.qr, sl, qm - KBASE(0));
    MASKT(pA0, pA1, 0); partialSM(pA0, pA1, m_reg, mnA, alA);
    if (NT > 1) { VMW(); SWRITE_H(1); }
    __syncthreads();
#define HALF_STEP(PX0, PX1, mnX, alX, PY0, PY1, alY, t, KB, VB, SB) do {                                                      \
        SBAR(); qkt<KB>(PX0, PX1, K_lds, r32, hi, S.qr, sl, qm - KBASE(t));                                                   \
        finishSM(PY0, PY1, alY, l_reg, pa0, pa1, pa2, pa3); SBAR();                                                           \
        if ((t) + 1 < NT) { SLOAD_H(Kh, Vh, KBASE((t) + 1)); SBAR(); }                                                        \
        pv_tile<VB>(o, vb0, pa0, pa1, pa2, pa3); MASKT(PX0, PX1, (t)); partialSM(PX0, PX1, m_reg, mnX, alX);                  \
        __syncthreads();                                                                                                      \
        if ((t) + 1 < NT) { VMW(); SWRITE_H(SB); }                                                                            \
        RESC(alX); __syncthreads(); } while (0)
    for (int t = 1; t + 1 < NT; t += 2) {
        HALF_STEP(pB0, pB1, mnB, alB, pA0, pA1, alA, t, 1, 0, 0);
        HALF_STEP(pA0, pA1, mnA, alA, pB0, pB1, alB, t + 1, 0, 1, 1);
    }
    const bool even = (NT & 1) == 0;
    if (even) { SBAR(); qkt<1>(pB0, pB1, K_lds, r32, hi, S.qr, sl, qm - KBASE(NT - 1)); SBAR(); }
    SLOAD_H(nxt.K, nxt.V, kbn); SBAR();
#pragma unroll
    for (int d0 = 0; d0 < 8; ++d0) S.qr[d0] = load8(nxt.Q + (size_t)(wid * QBLK + r32) * D + d0 * 16 + hi * 8);
    SBAR();
    finishSM(pA0, pA1, alA, l_reg, pa0, pa1, pa2, pa3); SBAR();
    pv_tile<0>(o, vb0, pa0, pa1, pa2, pa3);
    if (even) { MASKT(pB0, pB1, NT - 1); partialSM(pB0, pB1, m_reg, mnB, alB); __syncthreads(); RESC(alB);
        finishSM(pB0, pB1, alB, l_reg, pa0, pa1, pa2, pa3); SBAR(); pv_tile<1>(o, vb0, pa0, pa1, pa2, pa3); }
    SBAR(); SEAM_K0();
    if (hi == 0) li_l[r32] = l_reg; asm volatile("s_waitcnt lgkmcnt(0)" ::: "memory");
    float rli[16];
#pragma unroll
    for (int r = 0; r < 16; ++r) rli[r] = __builtin_amdgcn_rcpf(li_l[crow(r, hi)]);
    bf16* Ow = cur.O + (size_t)(wid * QBLK) * D;
    int zo = 0; asm volatile("" : "+v"(zo));
    const unsigned ob = (unsigned)(4 * hi * D + r32 + zo);
#pragma unroll
    for (int r = 0; r < 16; ++r) { const unsigned off = ob + (unsigned)(((r & 3) + 8 * (r >> 2)) * D);
#pragma unroll
        for (int d0 = 0; d0 < 4; ++d0) { const float v = o[d0][r] * rli[r];
            const float vn = __shfl_xor(v, 1);
            if ((r32 & 1) == 0) *(unsigned*)(Ow + off + d0 * 32) = cvtpk(v, vn); } }
    __syncthreads();
#undef RESC
#undef KBASE
#undef MASKT
#undef SEAM_K0
#undef HALF_STEP
}
#undef ROW
#undef VMW
#undef VMWN
#undef SLOAD_H
#undef SWRITE_HK
#undef SWRITE_HV
#undef SWRITE_H
}
namespace attn4 {
using attn::bf16; using attn::KVBLK; using attn::QBLK; using attn::SHM_K;
constexpr int QB = 128, D = 128;
constexpr int V_OFF = 0, K_OFF = 65536, PX_OFF = 98304;
constexpr int AL_OFF = RING_BYTES + 1024;
struct Item { const bf16* Q; const bf16* K; const bf16* V0; const bf16* V1; bf16* O; int P0, W; float sl; };

template <int OFF>
__device__ __forceinline__ void pv_half(f32x16* o, int vb0, bf16x8 pa0, bf16x8 pa1, bf16x8 pa2, bf16x8 pa3) {
#define TRRD(dst, off) asm volatile("ds_read_b64_tr_b16 %0, %1 offset:%2" : "=&v"(dst) : "v"(vb0), "i"(off) : "memory")
#define PV_D0(d0) do { s16x4 l0, l1, l2, l3, h0, h1, h2, h3; constexpr int b_ = OFF + attn::v_rd_off(d0, 0, 0); \
        TRRD(l0, b_); TRRD(h0, b_ + 2048); TRRD(l1, b_ + 4096); TRRD(h1, b_ + 6144); TRRD(l2, b_ + 8192); TRRD(h2, b_ + 10240); TRRD(l3, b_ + 12288); TRRD(h3, b_ + 14336); \
        asm volatile("s_waitcnt lgkmcnt(0)" ::: "memory"); SBAR();   \
        o[d0] = __builtin_amdgcn_mfma_f32_32x32x16_bf16(pa0, (bf16x8){l0[0], l0[1], l0[2], l0[3], h0[0], h0[1], h0[2], h0[3]}, o[d0], 0, 0, 0);   \
        o[d0] = __builtin_amdgcn_mfma_f32_32x32x16_bf16(pa1, (bf16x8){l1[0], l1[1], l1[2], l1[3], h1[0], h1[1], h1[2], h1[3]}, o[d0], 0, 0, 0);   \
        o[d0] = __builtin_amdgcn_mfma_f32_32x32x16_bf16(pa2, (bf16x8){l2[0], l2[1], l2[2], l2[3], h2[0], h2[1], h2[2], h2[3]}, o[d0], 0, 0, 0);   \
        o[d0] = __builtin_amdgcn_mfma_f32_32x32x16_bf16(pa3, (bf16x8){l3[0], l3[1], l3[2], l3[3], h3[0], h3[1], h3[2], h3[3]}, o[d0], 0, 0, 0); } while (0)
    PV_D0(0); PV_D0(1); PV_D0(2); PV_D0(3);
#undef PV_D0
#undef TRRD
}

template <int KB>
__device__ __forceinline__ void qkt_b(f32x16& p0, f32x16& p1, const char* K_lds, int r32, int hi, const bf16x8* qr, const f32x16& bias0, const f32x16& bias1) {
    const char* kb[4];
#pragma unroll
    for (int dd = 0; dd < 4; ++dd) kb[dd] = K_lds + KB * SHM_K + KSWZ(r32, (dd * 16 + hi * 8) * 2);
    { const bf16x8 b0_ = *reinterpret_cast<const bf16x8*>(kb[0]), b1_ = *reinterpret_cast<const bf16x8*>(kb[0] + 32 * 256);
      p0 = __builtin_amdgcn_mfma_f32_32x32x16_bf16(b0_, qr[0], bias0, 0, 0, 0); p1 = __builtin_amdgcn_mfma_f32_32x32x16_bf16(b1_, qr[0], bias1, 0, 0, 0); }
#pragma unroll
    for (int d0 = 1; d0 < 8; ++d0) { const char* a = kb[d0 & 3] + (d0 >> 2) * 128;
        const bf16x8 b0_ = *reinterpret_cast<const bf16x8*>(a), b1_ = *reinterpret_cast<const bf16x8*>(a + 32 * 256);
        p0 = __builtin_amdgcn_mfma_f32_32x32x16_bf16(b0_, qr[d0], p0, 0, 0, 0); p1 = __builtin_amdgcn_mfma_f32_32x32x16_bf16(b1_, qr[d0], p1, 0, 0, 0); }
}

__device__ __forceinline__ void item(const Item& it, char* lds, LAS unsigned char* ldsL, const int tid) {
    const int wid = __builtin_amdgcn_readfirstlane(tid >> 6), lane = tid & 63, r32 = lane & 31, hi = lane >> 5, role = wid >> 2, g = wid & 3;
    const int j_lo = attn::swa_jlo(it.P0, it.W);
    const int j_hi = (it.P0 + QB - 1) / KVBLK + 1;
    const int NT = j_hi - j_lo;
    const int W = it.W; const float sl = it.sl;
    const int qlo = it.P0 + g * QBLK, qm = qlo + r32 - 4 * hi;
    const int sr = tid >> 4, sc = (tid & 15) * 8, vst0 = attn::v_st(sr, sc), vst1 = attn::v_st(32 + sr, sc), kws = KSWZ(sr, sc * 2);
    float* AL = (float*)(lds + AL_OFF); int* FLG = (int*)(lds + AL_OFF + 1024); float* LL = (float*)(lds + AL_OFF + 1088);
#define KBASE(t) ((j_lo + (t)) * KVBLK)
    const bf16* gp[6]; int dstA[6], dstB[6];
#pragma unroll
    for (int i = 0; i < 6; ++i) {
        if (i < 2) { const int q = wid * 2 + i, row = 4 * q + (lane >> 4), c = (lane & 15) ^ (row & 7);
            gp[i] = it.K + (size_t)KBASE(0) * D + row * D + c * 8; dstA[i] = K_OFF + 1 * SHM_K + q * 1024; dstB[i] = K_OFF + 0 * SHM_K + q * 1024; }
        else { const int v = wid * 4 + (i - 2), j = v & 15, eh = v >> 4, sidx = 2 * j + (lane >> 5), kk = (sidx >> 2) * 8 + ((lane & 31) >> 2), k = (kk & ~0xC) | ((kk & 4) << 1) | ((kk & 8) >> 1), col = (sidx & 3) * 32 + (lane & 3) * 8;
            gp[i] = (eh ? it.V1 : it.V0) + (size_t)KBASE(0) * D + k * D + col; dstA[i] = V_OFF + 0 * 32768 + eh * 16384 + j * 1024; dstB[i] = V_OFF + 1 * 32768 + eh * 16384 + j * 1024; } }
#define A4_DMA(src, ldsbyte) __builtin_amdgcn_global_load_lds((const unsigned*)(src), (LAS unsigned*)((LAS unsigned char*)ldsL + (ldsbyte)), 16, 0, 0)
#define A4_STAGE(t, PAR) do { const int tk_ = ((t) + 1 < NT ? (t) + 1 : NT - 1), tv_ = ((t) < NT ? (t) : NT - 1); const size_t ok_ = (size_t)tk_ * (KVBLK * D), ov_ = (size_t)tv_ * (KVBLK * D); \
            _Pragma("unroll") for (int i = 0; i < 6; ++i) A4_DMA(gp[i] + (i < 2 ? ok_ : ov_), (PAR) ? dstB[i] : dstA[i]); } while (0)
#define A4_SYNC() do { asm volatile("s_waitcnt vmcnt(0) lgkmcnt(0)" ::: "memory"); __builtin_amdgcn_s_barrier(); asm volatile("" ::: "memory"); } while (0)
#define A4_PROLOGUE() do { A4_DMA(gp[0], dstB[0]); A4_DMA(gp[1], dstB[1]); A4_SYNC(); } while (0)
    char* K_lds = lds + K_OFF;
    if (role == 0) {
        bf16x8 qr[8];
#pragma unroll
        for (int d0 = 0; d0 < 8; ++d0) qr[d0] = attn::load8(it.Q + (size_t)(g * QBLK + r32) * D + d0 * 16 + hi * 8);
        asm volatile("s_waitcnt vmcnt(0)" ::: "memory");
        A4_PROLOGUE();
        float m_reg = -1e30f, l_reg = 0.f;
        f32x16 bias0, bias1;
#pragma unroll
        for (int r = 0; r < 16; ++r) { bias0[r] = sl * (float)((r & 3) + 8 * (r >> 2) + 4 * hi); bias1[r] = bias0[r] + 32.f * sl; }
        const float mstep = 64.f * sl;
#define A2_QK_STEP(t, PAR) do { A4_STAGE(t, PAR); \
            if ((t) < NT) { f32x16 p0, p1; float mn, alpha; bf16x8 pa0, pa1, pa2, pa3; \
                qkt_b<PAR>(p0, p1, K_lds, r32, hi, qr, bias0, bias1); if ((t) > 0) m_reg -= mstep; \
                { const int kb_ = KBASE(t); if (kb_ + KVBLK - 1 > qlo || kb_ <= qlo + QBLK - 1 - W) attn::mask_tile(p0, p1, qm - kb_, (unsigned)W); } \
                attn::partialSM(p0, p1, m_reg, mn, alpha); attn::finishSM(p0, p1, alpha, l_reg, pa0, pa1, pa2, pa3); \
                char* px = lds + PX_OFF + (PAR) * 16384 + g * 4096 + lane * 16; \
                *(bf16x8*)px = pa0; *(bf16x8*)(px + 1024) = pa1; *(bf16x8*)(px + 2048) = pa2; *(bf16x8*)(px + 3072) = pa3; \
                if (hi == 0) AL[(PAR) * 128 + g * 32 + r32] = alpha; \
                const int anyr = __any(alpha < 1.f) ? 1 : 0; if (lane == 0) FLG[(PAR) * 4 + g] = anyr; } \
            A4_SYNC(); } while (0)
        for (int t = 0; t <= NT; t += 2) { A2_QK_STEP(t, 0); if (t + 1 <= NT) A2_QK_STEP(t + 1, 1); }
        if (hi == 0) LL[g * 32 + r32] = l_reg;
        __syncthreads();
        __syncthreads();
#undef A2_QK_STEP
    } else {
        A4_PROLOGUE();
        f32x16 o[8] = {};
        const int vb0 = (int)(uintptr_t)(lds + V_OFF) + attn::v_rd_base(lane);
#define A2_PV_STEP(t, PAR) do { A4_STAGE(t, PAR); \
            if ((t) >= 1) { constexpr int PB = (PAR) ^ 1; \
                const int flag = __builtin_amdgcn_readfirstlane(FLG[PB * 4 + g]); \
                if (flag) { _Pragma("unroll") for (int r = 0; r < 16; ++r) { const float a = AL[PB * 128 + g * 32 + attn::crow(r, hi)]; \
                        _Pragma("unroll") for (int d_ = 0; d_ < 8; ++d_) o[d_][r] *= a; } } \
                const char* px = lds + PX_OFF + PB * 16384 + g * 4096 + lane * 16; \
                const bf16x8 pa0 = *(const bf16x8*)px, pa1 = *(const bf16x8*)(px + 1024), pa2 = *(const bf16x8*)(px + 2048), pa3 = *(const bf16x8*)(px + 3072); \
                pv_half<PB * 32768>(o, vb0, pa0, pa1, pa2, pa3); pv_half<PB * 32768 + 16384>(o + 4, vb0, pa0, pa1, pa2, pa3); } \
            A4_SYNC(); } while (0)
        for (int t = 0; t <= NT; t += 2) { A2_PV_STEP(t, 0); if (t + 1 <= NT) A2_PV_STEP(t + 1, 1); }
        __syncthreads();
        float rli[16];
#pragma unroll
        for (int r = 0; r < 16; ++r) rli[r] = __builtin_amdgcn_rcpf(LL[g * 32 + attn::crow(r, hi)]);
        bf16* Ow = it.O + (size_t)(g * QBLK) * 256;
        int zo = 0; asm volatile("" : "+v"(zo));
        const unsigned ob = (unsigned)(4 * hi * 256 + r32 + zo);
#pragma unroll
        for (int r = 0; r < 16; ++r) { const unsigned off = ob + (unsigned)(((r & 3) + 8 * (r >> 2)) * 256);
#pragma unroll
            for (int d0 = 0; d0 < 8; ++d0) { const float v = o[d0][r] * rli[r];
                const float vn = __shfl_xor(v, 1);
                if ((r32 & 1) == 0) *(unsigned*)(Ow + off + d0 * 32) = cvtpk(v, vn); } }
        __syncthreads();
#undef A2_PV_STEP
    }
#undef KBASE
#undef A4_DMA
#undef A4_STAGE
#undef A4_SYNC
#undef A4_PROLOGUE
}
}
struct Frame {
    LAS unsigned char* lds; unsigned char* lds_g;
    volatile LAS unsigned* MISC;
    unsigned* ctl; unsigned char* ws; unsigned char* dout;
    int tid, lane, wave, G, bid, gw, NGW;
};

__device__ __forceinline__ void tr_item(const float* W, int ldw, int c0, bf16_t* WT, int ldt, int r0, int kb, int nb, LAS float* scr, int lane) {
    const int k0 = 64 * kb, n0 = 32 * nb;
#pragma unroll 8
    for (int i = 0; i < 32; ++i) { const int kk = 2 * i + (lane >> 5); scr[kk * 33 + (lane & 31)] = W[(size_t)(k0 + kk) * ldw + c0 + n0 + (lane & 31)]; }
    LDS_WAIT(); asm volatile("" ::: "memory");
    const int c = lane & 7;
#pragma unroll
    for (int j = 0; j < 4; ++j) { const int n = (lane >> 3) + 8 * j; const LAS float* s = scr + (8 * c) * 33 + n;
        u32x4 o; o.x = cvtpk(s[0 * 33], s[1 * 33]); o.y = cvtpk(s[2 * 33], s[3 * 33]); o.z = cvtpk(s[4 * 33], s[5 * 33]); o.w = cvtpk(s[6 * 33], s[7 * 33]);
        *(u32x4*)(WT + (size_t)(r0 + n0 + n) * ldt + k0 + 8 * c) = o; }
    LDS_WAIT(); asm volatile("" ::: "memory");
}
__device__ __forceinline__ void tr_item8(const float* W, int ldw, int c0, unsigned char* WT, int ldt, int r0, int kb, int nb, float sc, LAS float* scr, int lane) {
    const int k0 = 64 * kb, n0 = 32 * nb;
#pragma unroll 8
    for (int i = 0; i < 32; ++i) { const int kk = 2 * i + (lane >> 5); scr[kk * 33 + (lane & 31)] = W[(size_t)(k0 + kk) * ldw + c0 + n0 + (lane & 31)]; }
    LDS_WAIT(); asm volatile("" ::: "memory");
    const int c = lane & 7;
#pragma unroll
    for (int j = 0; j < 4; ++j) { const int n = (lane >> 3) + 8 * j; const LAS float* s = scr + (8 * c) * 33 + n;
        u32x2 o; o.x = pk4_fp8(s[0 * 33] * sc, s[1 * 33] * sc, s[2 * 33] * sc, s[3 * 33] * sc); o.y = pk4_fp8(s[4 * 33] * sc, s[5 * 33] * sc, s[6 * 33] * sc, s[7 * 33] * sc);
        *(u32x2*)(WT + (size_t)(r0 + n0 + n) * ldt + k0 + 8 * c) = o; }
    LDS_WAIT(); asm volatile("" ::: "memory");
}
__device__ __forceinline__ void rms_row2048(const float* xrow, const float* g, f32x4 (&v)[8], int lane) {
    const f32x4* xr = (const f32x4*)xrow + lane; float ss = 0.f;
#pragma unroll
    for (int j = 0; j < 8; ++j) { v[j] = xr[64 * j]; ss += (v[j].x * v[j].x + v[j].y * v[j].y) + (v[j].z * v[j].z + v[j].w * v[j].w); }
    ss = wave_sum(ss); const float r = rsqrtf(ss * (1.0f / 2048.0f) + EPS);
#pragma unroll
    for (int j = 0; j < 8; ++j) { const f32x4 gg = ((const f32x4*)g)[lane + 64 * j]; v[j] = v[j] * r * gg; }
}
__device__ __forceinline__ void store_row_bf16(bf16_t* orow, const f32x4 (&v)[8], int lane) {
#pragma unroll
    for (int j = 0; j < 8; ++j) { u32x2 w; w.x = cvtpk(v[j].x, v[j].y); w.y = cvtpk(v[j].z, v[j].w); *(u32x2*)(orow + 4 * lane + 256 * j) = w; }
}

__device__ __forceinline__ void p0_prologue(Frame& F, const float* const* in) {
    LAS float* scr = (LAS float*)(F.lds + F.wave * 16384);
    const float* w_in = in[3];
    bf16_t* WINT = (bf16_t*)(F.ws + WS_WINT);
    constexpr int I0 = 8192, I1 = 1024, I2 = 1024, I3 = 1024, I4 = 6144, I5 = 2048, I6 = 2048, I7 = 1024, I8 = 1024, I9 = 2048;
    constexpr int NITEMS = I0 + I1 + I2 + I3 + I4 + I5 + I6 + I7 + I8 + I9;
    for (int it = F.gw; it < NITEMS; it += F.NGW) {
        int r = it;
        if (r < I0) { tr_item(w_in, DIN, 0, WINT, 2048, 0, r / 256, r % 256, scr, F.lane); continue; } r -= I0;
        if (r < I1) { tr_item(w_in, DIN, 9216, WINT, 2048, 8192, r / 32, r % 32, scr, F.lane); continue; } r -= I1;
        if (r < I2) { tr_item(w_in, DIN, 10248, WINT, 2048, 9216, r / 32, r % 32, scr, F.lane); continue; } r -= I2;
        if (r < I3) { tr_item(w_in, DIN, 8192, WINT, 2048, 10240, r / 32, r % 32, scr, F.lane); continue; } r -= I3;
        if (r < I4) { tr_item8(w_in, DIN, 11272, (unsigned char*)(WINT + (size_t)11264 * 2048), 2048, 0, r / 192, r % 192, 32.0f, scr, F.lane); continue; } r -= I4;
        if (r < I5) { tr_item(in[15], 2048, 0, (bf16_t*)(F.ws + WS_WMEMT), 2048, 0, r / 64, r % 64, scr, F.lane); continue; } r -= I5;
        if (r < I6) { tr_item(in[16], 2048, 0, (bf16_t*)(F.ws + WS_WBDT), 2048, 0, r / 64, r % 64, scr, F.lane); continue; } r -= I6;
        if (r < I7) { tr_item(in[17], 2048, 0, (bf16_t*)(F.ws + WS_WBMT), 1024, 0, r / 64, r % 64, scr, F.lane); continue; } r -= I7;
        if (r < I8) { tr_item(in[18], 2048, 0, (bf16_t*)(F.ws + WS_WBCT), 1024, 0, r / 64, r % 64, scr, F.lane); continue; } r -= I8;
        tr_item(in[20], 2048, 0, (bf16_t*)(F.ws + WS_WOUTT), 2048, 0, r / 64, r % 64, scr, F.lane);
    }
    { bf16_t* WRT = (bf16_t*)(F.ws + WS_WRT); const float* wrg = in[22]; const float* wre = in[24];
      for (int idx = F.bid * 512 + F.tid; idx < 256 * 2048; idx += F.G * 512) { const int n = idx >> 11, k = idx & 2047;
          const float v = (n < 4 ? wrg[k * 4 + n] : (n < 36 ? wre[k * 32 + (n - 4)] : 0.f)) * in[21][k]; WRT[idx] = (bf16_t)(cvtpk(v, 0.f) & 0xffffu); } }
    __syncthreads();
    LAS float* wg = (LAS float*)F.lds;
    for (int idx = F.tid; idx < 16384; idx += 512) { const int k = idx >> 3, j = idx & 7; wg[j * 2048 + k] = w_in[(size_t)k * DIN + 10240 + j]; }
    __syncthreads();
    const float* x = in[0]; bf16_t* HBF = (bf16_t*)(F.dout + DO_HBF); float* MLG = (float*)(F.ws + WS_MLG);
    for (int m = F.gw; m < TT; m += F.NGW) {
        f32x4 v[8]; rms_row2048(x + (size_t)m * 2048, in[2], v, F.lane);
        store_row_bf16(HBF + (size_t)m * 2048, v, F.lane);
        float res = 0.f;
#pragma unroll
        for (int jj = 0; jj < 8; ++jj) { float a = 0.f;
#pragma unroll
            for (int j = 0; j < 8; ++j) { const f32x4 w = *(const LAS f32x4*)(wg + jj * 2048 + 4 * F.lane + 256 * j); a += (v[j].x * w.x + v[j].y * w.y) + (v[j].z * w.z + v[j].w * w.w); }
            a = wave_sum(a); if (F.lane == jj) res = a; }
        if (F.lane < 8) MLG[(size_t)m * 8 + F.lane] = res;
    }
    { const float* mem = in[1]; bf16_t* MEMN = (bf16_t*)(F.ws + WS_MEMN);
      for (int m = F.gw; m < NB * MEML; m += F.NGW) { f32x4 v[8]; rms_row2048(mem + (size_t)m * 2048, in[14], v, F.lane); store_row_bf16(MEMN + (size_t)m * 2048, v, F.lane); } }
    if (F.bid == 0 && F.wave == 0) {
        const float* q1 = in[8]; const float* k1 = in[9]; const float* q2 = in[10]; const float* k2 = in[11];
        float d1 = q1[F.lane] * k1[F.lane] + q1[F.lane + 64] * k1[F.lane + 64], d2 = q2[F.lane] * k2[F.lane] + q2[F.lane + 64] * k2[F.lane + 64];
        d1 = wave_sum(d1); d2 = wave_sum(d2);
        if (F.lane == 0) F.ctl[CW_LAM] = __float_as_uint(expf(d1) - expf(d2) + 0.2f);
    }
    __syncthreads();
}

__device__ __forceinline__ void ml0_seq(Frame& F, const float* const* in, int s) {
    const int b = s >> 2, hh = s & 3;
    const float* MLG = (const float*)(F.ws + WS_MLG);
    float* KW = (float*)(F.ws + WS_SCKW); float* RS = (float*)(F.ws + WS_SCRS); float* IT = (float*)(F.ws + WS_SCIT); float* ED = (float*)(F.ws + WS_SCED); float* DEC = (float*)(F.ws + WS_DEC);
    LAS float* sm_bl = (LAS float*)F.lds; LAS float* sm_cm = sm_bl + 64; LAS float* sm_mp = sm_bl + 128; LAS float* sm_R = sm_bl + 192;
    const float big = in[6][hh], bfg = in[7][hh];
    float bl[8][4], gh[8][4], cm[8][4];
#pragma unroll
    for (int rd = 0; rd < 8; ++rd) {
        const int c = rd * 8 + F.wave; const size_t t0 = (size_t)b * SEQ + (size_t)c * 256 + 4 * F.lane;
        float lf[4], ig[4];
#pragma unroll
        for (int i = 0; i < 4; ++i) { const float fg = MLG[(t0 + i) * 8 + 4 + hh] + bfg; lf[i] = fminf(fg, 0.f) - log1pf(expf(-fabsf(fg))); ig[i] = MLG[(t0 + i) * 8 + hh] + big; }
        float p[4]; p[0] = lf[0]; p[1] = p[0] + lf[1]; p[2] = p[1] + lf[2]; p[3] = p[2] + lf[3];
        float incl = p[3];
#pragma unroll
        for (int o = 1; o < 64; o <<= 1) { const float y = __shfl_up(incl, o); if (F.lane >= o) incl += y; }
        const float excl = incl - p[3];
#pragma unroll
        for (int i = 0; i < 4; ++i) { bl[rd][i] = excl + p[i]; gh[rd][i] = ig[i] - bl[rd][i]; }
        float q[4]; q[0] = gh[rd][0]; q[1] = fmaxf(q[0], gh[rd][1]); q[2] = fmaxf(q[1], gh[rd][2]); q[3] = fmaxf(q[2], gh[rd][3]);
        float im = q[3];
#pragma unroll
        for (int o = 1; o < 64; o <<= 1) { const float y = __shfl_up(im, o); if (F.lane >= o) im = fmaxf(im, y); }
        float em = __shfl_up(im, 1); if (F.lane == 0) em = -__builtin_inff();
#pragma unroll
        for (int i = 0; i < 4; ++i) cm[rd][i] = fmaxf(em, q[i]);
        if (F.lane == 63) { sm_bl[c] = bl[rd][3]; sm_cm[c] = cm[rd][3]; }
    }
    __syncthreads();
    if (F.tid == 0) { float M = 0.f; for (int c = 0; c < 64; ++c) { sm_mp[c] = M; const float R = fmaxf(M, sm_cm[c]); sm_R[c] = R; M = sm_bl[c] + R; } }
    __syncthreads();
#pragma unroll
    for (int rd = 0; rd < 8; ++rd) {
        const int c = rd * 8 + F.wave; const size_t idx = (size_t)hh * TT + (size_t)b * SEQ + (size_t)c * 256 + 4 * F.lane;
        const float Mp = sm_mp[c], R = sm_R[c];
        f32x4 kw, rs, it, ed;
#pragma unroll
        for (int i = 0; i < 4; ++i) { const float Gt = fmaxf(Mp, cm[rd][i]); kw[i] = expf(gh[rd][i] - R); rs[i] = expf(R - Gt); it[i] = expf(Mp - Gt); ed[i] = expf(-(bl[rd][i] + Gt)); }
        *(f32x4*)(KW + idx) = kw; *(f32x4*)(RS + idx) = rs; *(f32x4*)(IT + idx) = it; *(f32x4*)(ED + idx) = ed;
        if (F.lane == 0) DEC[s * 64 + c] = expf(Mp - R);
    }
    __syncthreads();
}

__device__ __forceinline__ void unpack8(const u32x4 r, float (&x)[8]) { x[0] = bflo(r.x); x[1] = bfhi(r.x); x[2] = bflo(r.y); x[3] = bfhi(r.y); x[4] = bflo(r.z); x[5] = bfhi(r.z); x[6] = bflo(r.w); x[7] = bfhi(r.w); }
__device__ __forceinline__ void ml1_conv(Frame& F, const float* const* in) {
    const bf16_t* MQK = (const bf16_t*)(F.ws + WS_MQK);
    bf16_t* Q = (bf16_t*)(F.ws + WS_Q); bf16_t* WQ = (bf16_t*)(F.ws + WS_WQ); bf16_t* KWB = (bf16_t*)(F.ws + WS_KW); bf16_t* KWT = (bf16_t*)(F.ws + WS_KWT);
    const float* KWS = (const float*)(F.ws + WS_SCKW); const float* ITS = (const float*)(F.ws + WS_SCIT); float* KN4 = (float*)(F.ws + WS_KN);
    const float* cw = in[4]; const float* cbp = in[5];
    for (int id = F.gw; id < 2048; id += F.NGW) {
        const int cg = id & 3, sc = id >> 2, kind = cg >> 1, hh = (cg & 1) * 2 + (F.lane >> 5), d0 = (F.lane & 31) * 8, col = cg * 512 + F.lane * 8;
        const size_t t0 = (size_t)sc * 64, hrow = (size_t)hh * TT + t0;
        float w[4][8], cb[8], h3[8], h2[8], h1[8], cs[8];
#pragma unroll
        for (int j = 0; j < 4; ++j) { const f32x4 a = *(const f32x4*)(cw + j * 2048 + col), b = *(const f32x4*)(cw + j * 2048 + col + 4);
            w[j][0] = a.x; w[j][1] = a.y; w[j][2] = a.z; w[j][3] = a.w; w[j][4] = b.x; w[j][5] = b.y; w[j][6] = b.z; w[j][7] = b.w; }
        { const f32x4 a = *(const f32x4*)(cbp + col), b = *(const f32x4*)(cbp + col + 4); cb[0] = a.x; cb[1] = a.y; cb[2] = a.z; cb[3] = a.w; cb[4] = b.x; cb[5] = b.y; cb[6] = b.z; cb[7] = b.w; }
#pragma unroll
        for (int c = 0; c < 8; ++c) { h3[c] = 0.f; h2[c] = 0.f; h1[c] = 0.f; cs[c] = 0.f; }
        if ((t0 & (size_t)(SEQ - 1)) != 0) {
            unpack8(*(const u32x4*)(MQK + (t0 - 3) * 2048 + col), h3); unpack8(*(const u32x4*)(MQK + (t0 - 2) * 2048 + col), h2); unpack8(*(const u32x4*)(MQK + (t0 - 1) * 2048 + col), h1); }
        u32x4 xn[8];
#pragma unroll
        for (int i = 0; i < 8; ++i) xn[i] = *(const u32x4*)(MQK + (t0 + i) * 2048 + col);
        for (int tb = 0; tb < 8; ++tb) {
            u32x4 xr[8]; unsigned pk[8][4];
#pragma unroll
            for (int i = 0; i < 8; ++i) xr[i] = xn[i];
            { const int tn = tb < 7 ? tb + 1 : 7;
#pragma unroll
              for (int i = 0; i < 8; ++i) xn[i] = *(const u32x4*)(MQK + (t0 + tn * 8 + i) * 2048 + col); }
#pragma unroll
            for (int i = 0; i < 8; ++i) {
                float xv[8], sv[8]; unpack8(xr[i], xv);
#pragma unroll
                for (int c = 0; c < 8; ++c) { const float y = w[0][c] * h3[c] + w[1][c] * h2[c] + w[2][c] * h1[c] + w[3][c] * xv[c] + cb[c]; sv[c] = y * sigmoidf_(y); h3[c] = h2[c]; h2[c] = h1[c]; h1[c] = xv[c]; }
                const size_t tr = hrow + tb * 8 + i;
                if (kind == 0) { const float itv = ITS[tr];
                    u32x4 o; o.x = cvtpk(sv[0], sv[1]); o.y = cvtpk(sv[2], sv[3]); o.z = cvtpk(sv[4], sv[5]); o.w = cvtpk(sv[6], sv[7]); *(u32x4*)(Q + tr * 256 + d0) = o;
                    u32x4 p; p.x = cvtpk(sv[0] * itv, sv[1] * itv); p.y = cvtpk(sv[2] * itv, sv[3] * itv); p.z = cvtpk(sv[4] * itv, sv[5] * itv); p.w = cvtpk(sv[6] * itv, sv[7] * itv); *(u32x4*)(WQ + tr * 512 + 256 + d0) = p;
                } else { const float kwv = KWS[tr] * 0.0625f;
                    u32x4 o; o.x = cvtpk(sv[0] * kwv, sv[1] * kwv); o.y = cvtpk(sv[2] * kwv, sv[3] * kwv); o.z = cvtpk(sv[4] * kwv, sv[5] * kwv); o.w = cvtpk(sv[6] * kwv, sv[7] * kwv); *(u32x4*)(KWB + tr * 256 + d0) = o;
                    pk[i][0] = o.x; pk[i][1] = o.y; pk[i][2] = o.z; pk[i][3] = o.w;
                    cs[0] += bflo(o.x); cs[1] += bfhi(o.x); cs[2] += bflo(o.y); cs[3] += bfhi(o.y); cs[4] += bflo(o.z); cs[5] += bfhi(o.z); cs[6] += bflo(o.w); cs[7] += bfhi(o.w); }
            }
            if (kind == 1) {
#pragma unroll
                for (int c = 0; c < 8; ++c) { u32x4 o;
                    unsigned wj[4];
#pragma unroll
                    for (int j = 0; j < 4; ++j) { const unsigned a = pk[2 * j][c >> 1], b = pk[2 * j + 1][c >> 1];
                        wj[j] = (c & 1) ? ((a >> 16) | (b & 0xffff0000u)) : ((a & 0xffffu) | (b << 16)); }
                    o.x = wj[0]; o.y = wj[1]; o.z = wj[2]; o.w = wj[3];
                    *(u32x4*)(KWT + (((size_t)hh * 128 + (sc >> 2)) * 256 + d0 + c) * 256 + (sc & 3) * 64 + tb * 8) = o; }
            }
        }
        if (kind == 1) { float* kn = KN4 + (((size_t)hh * 128 + (sc >> 2)) * 4 + (sc & 3)) * 256 + d0;
            *(f32x4*)kn = (f32x4){cs[0], cs[1], cs[2], cs[3]}; *(f32x4*)(kn + 4) = (f32x4){cs[4], cs[5], cs[6], cs[7]}; }
    }
}

__device__ __forceinline__ void nscan_seq(Frame& F, int s) {
    if (F.tid < 256) { const int hh = s & 3, b = s >> 2; const float* KN4 = (const float*)(F.ws + WS_KN); const float* DEC = (const float*)(F.ws + WS_DEC); float* NP = (float*)(F.ws + WS_NP);
        float n = 0.f;
        for (int c0 = 0; c0 < 64; c0 += 8) { float kn[8], dc[8];
#pragma unroll
            for (int i = 0; i < 8; ++i) { const float* p = KN4 + ((size_t)hh * 128 + b * 64 + c0 + i) * 1024 + F.tid; kn[i] = (p[0] + p[256]) + (p[512] + p[768]); dc[i] = DEC[s * 64 + c0 + i]; }
#pragma unroll
            for (int i = 0; i < 8; ++i) { NP[((size_t)s * 64 + c0 + i) * 256 + F.tid] = n; n = dc[i] * n + kn[i]; } }
    }
}
__device__ __forceinline__ void xsoftmax(Frame& F) {
    const bf16_t* XS = (const bf16_t*)(F.ws + WS_XS); bf16_t* XP = (bf16_t*)(F.ws + WS_XP);
    const int sub = F.lane >> 5, d8 = (F.lane & 31) * 8;
    for (int row0 = F.gw * 8; row0 < 4 * TT; row0 += F.NGW * 8) {
        u32x4 v[4];
#pragma unroll
        for (int i = 0; i < 4; ++i) v[i] = *(const u32x4*)(XS + (size_t)(row0 + 2 * i + sub) * 256 + d8);
#pragma unroll
        for (int i = 0; i < 4; ++i) { float x[8]; unpack8(v[i], x);
            float m = fmaxf(fmaxf(fmaxf(x[0], x[1]), fmaxf(x[2], x[3])), fmaxf(fmaxf(x[4], x[5]), fmaxf(x[6], x[7])));
#pragma unroll
            for (int o = 1; o < 32; o <<= 1) m = fmaxf(m, __shfl_xor(m, o));
            float s = 0.f;
#pragma unroll
            for (int c = 0; c < 8; ++c) { x[c] = __expf(x[c] - m); s += x[c]; }
#pragma unroll
            for (int o = 1; o < 32; o <<= 1) s += __shfl_xor(s, o);
            const float inv = 1.0f / s;
            u32x4 w; w.x = cvtpk(x[0] * inv, x[1] * inv); w.y = cvtpk(x[2] * inv, x[3] * inv); w.z = cvtpk(x[4] * inv, x[5] * inv); w.w = cvtpk(x[6] * inv, x[7] * inv);
            *(u32x4*)(XP + (size_t)(row0 + 2 * i + sub) * 256 + d8) = w; }
    }
}
__device__ __forceinline__ void cscan(Frame& F) {
    const bf16_t* U = (const bf16_t*)(F.ws + WS_U); bf16_t* VC = (bf16_t*)(F.ws + WS_VC); const float* DEC = (const float*)(F.ws + WS_DEC);
    for (int gid = F.bid * 512 + F.tid; gid < 131072; gid += F.G * 512) {
        const int s = gid >> 14, rem = gid & 16383, dv = rem >> 6, dk4 = (rem & 63) * 4, hh = s & 3, b = s >> 2;
        f32x4 C = {0.f, 0.f, 0.f, 0.f};
        for (int c0 = 0; c0 < 64; c0 += 8) { const size_t g0 = (size_t)hh * 128 + b * 64 + c0;
            f32x4 u[8]; float dc[8];
#pragma unroll
            for (int i = 0; i < 8; ++i) { const u32x2 w = *(const u32x2*)(U + (g0 + i) * 65536 + (size_t)dv * 256 + dk4); u[i] = (f32x4){bflo(w.x), bfhi(w.x), bflo(w.y), bfhi(w.y)}; dc[i] = DEC[s * 64 + c0 + i]; }
#pragma unroll
            for (int i = 0; i < 8; ++i) { u32x2 w; w.x = cvtpk(C.x, C.y); w.y = cvtpk(C.z, C.w); *(u32x2*)(VC + ((g0 + i) * 256 + dv) * 512 + 256 + dk4) = w; C = C * dc[i] + u[i]; } }
    }
}
__device__ __forceinline__ void denpass(Frame& F) {
    const bf16_t* WQ = (const bf16_t*)(F.ws + WS_WQ); const float* NP = (const float*)(F.ws + WS_NP); const float* ED = (const float*)(F.ws + WS_SCED); float* HDEN = (float*)(F.ws + WS_HDEN);
    for (int row0 = F.gw * 4; row0 < 4 * TT; row0 += F.NGW * 4) {
        const int hh = row0 / TT, t = row0 - hh * TT, b = t / SEQ, c = (t - b * SEQ) >> 8;
        u32x4 w[4]; f32x4 n0 = {0.f, 0.f, 0.f, 0.f}, n1 = {0.f, 0.f, 0.f, 0.f};
#pragma unroll
        for (int i = 0; i < 4; ++i) w[i] = *(const u32x4*)(WQ + (size_t)(row0 + i) * 512 + 8 * F.lane);
        if (F.lane >= 32) { const float* np = NP + ((size_t)(b * 4 + hh) * 64 + c) * 256 + 8 * (F.lane - 32); n0 = *(const f32x4*)np; n1 = *(const f32x4*)(np + 4); }
        else { n0 = (f32x4){1.f, 1.f, 1.f, 1.f}; n1 = n0; }
        const float edv = ED[row0 + (F.lane & 3)];
#pragma unroll
        for (int i = 0; i < 4; ++i) {
            const float part = ((bflo(w[i].x) * n0.x + bfhi(w[i].x) * n0.y) + (bflo(w[i].y) * n0.z + bfhi(w[i].y) * n0.w)) + ((bflo(w[i].z) * n1.x + bfhi(w[i].z) * n1.y) + (bflo(w[i].w) * n1.z + bfhi(w[i].w) * n1.w));
            const float den = wave_sum(part);
            if (F.lane == i) HDEN[row0 + i] = fmaxf(fabsf(den), edv); }
    }
}
__device__ __forceinline__ void hmnorm(Frame& F, const float* const* in) {
    bf16_t* HR = (bf16_t*)(F.dout + DO_HR); const bf16_t* MLO = (const bf16_t*)(F.ws + WS_MLO); const float* g = in[13];
    const int sub = F.lane >> 5, d8 = (F.lane & 31) * 8;
    for (int row0 = F.gw * 8; row0 < 4 * TT; row0 += F.NGW * 8) {
        u32x4 xw[4], ow[4];
#pragma unroll
        for (int i = 0; i < 4; ++i) { const int row = row0 + 2 * i + sub; const size_t o = (size_t)(row >> 2) * 1024 + (row & 3) * 256 + d8; xw[i] = *(const u32x4*)(HR + o); ow[i] = *(const u32x4*)(MLO + o); }
#pragma unroll
        for (int i = 0; i < 4; ++i) { const int row = row0 + 2 * i + sub, hh = row & 3; const size_t o = (size_t)(row >> 2) * 1024 + hh * 256 + d8;
            float x[8], og[8]; unpack8(xw[i], x); unpack8(ow[i], og);
            float ss = ((x[0] * x[0] + x[1] * x[1]) + (x[2] * x[2] + x[3] * x[3])) + ((x[4] * x[4] + x[5] * x[5]) + (x[6] * x[6] + x[7] * x[7]));
            ss += __shfl_xor(ss, 1); ss += __shfl_xor(ss, 2); ss += __shfl_xor(ss, 4); ss += __shfl_xor(ss, 8); ss += __shfl_xor(ss, 16);
            const float r = rsqrtf(ss * (1.0f / 256.0f) + EPS);
            const f32x4 g0 = *(const f32x4*)(g + hh * 256 + d8), g1 = *(const f32x4*)(g + hh * 256 + d8 + 4);
            u32x4 w; w.x = cvtpk(sigmoidf_(og[0]) * x[0] * r * g0.x, sigmoidf_(og[1]) * x[1] * r * g0.y); w.y = cvtpk(sigmoidf_(og[2]) * x[2] * r * g0.z, sigmoidf_(og[3]) * x[3] * r * g0.w);
            w.z = cvtpk(sigmoidf_(og[4]) * x[4] * r * g1.x, sigmoidf_(og[5]) * x[5] * r * g1.y); w.w = cvtpk(sigmoidf_(og[6]) * x[6] * r * g1.z, sigmoidf_(og[7]) * x[7] * r * g1.w);
            *(u32x4*)(HR + o) = w; }
    }
}
__device__ __forceinline__ unsigned fkey(float f) { const unsigned u = __float_as_uint(f); return (u & 0x80000000u) ? ~u : (u | 0x80000000u); }
__device__ __forceinline__ float fkey_inv(unsigned k) { return __uint_as_float((k & 0x80000000u) ? (k & 0x7fffffffu) : ~k); }
__device__ __forceinline__ float dot8(const u32x4 a, const u32x4 b) {
    return ((bflo(a.x) * bflo(b.x) + bfhi(a.x) * bfhi(b.x)) + (bflo(a.y) * bflo(b.y) + bfhi(a.y) * bfhi(b.y))) + ((bflo(a.z) * bflo(b.z) + bfhi(a.z) * bfhi(b.z)) + (bflo(a.w) * bflo(b.w) + bfhi(a.w) * bfhi(b.w))); }
__device__ __forceinline__ void normmax(Frame& F) {
    if (F.G != 256) return;
    LAS float* red = (LAS float*)F.lds;
    const bf16_t* DQ = (const bf16_t*)(F.ws + WS_DQ); const bf16_t* DK = (const bf16_t*)(F.ws + WS_DK);
    const size_t row0 = (size_t)F.gw * 16 + (F.lane >> 4), coff = (F.lane & 15) * 8;
    u32x4 q[4], k[4];
#pragma unroll
    for (int i = 0; i < 4; ++i) { q[i] = *(const u32x4*)(DQ + (row0 + 4 * i) * 128 + coff); k[i] = *(const u32x4*)(DK + (row0 + 4 * i) * 128 + coff); }
    for (int c16 = 0; c16 < 16; ++c16) {
        u32x4 qn[4], kn[4];
        const int cn = c16 < 15 ? c16 + 1 : 15;
#pragma unroll
        for (int i = 0; i < 4; ++i) { qn[i] = *(const u32x4*)(DQ + ((size_t)cn * TT + row0 + 4 * i) * 128 + coff); kn[i] = *(const u32x4*)(DK + ((size_t)cn * TT + row0 + 4 * i) * 128 + coff); }
        float q2 = 0.f, k2 = 0.f, nd = -__builtin_inff();
#pragma unroll
        for (int i = 0; i < 4; ++i) { float a = dot8(q[i], q[i]), b = dot8(k[i], k[i]), c = dot8(q[i], k[i]);
#pragma unroll
            for (int o = 1; o < 16; o <<= 1) { a += __shfl_xor(a, o); b += __shfl_xor(b, o); c += __shfl_xor(c, o); }
            q2 = fmaxf(q2, a); k2 = fmaxf(k2, b); nd = fmaxf(nd, -c); }
        q2 = wave_max(q2); k2 = wave_max(k2); nd = wave_max(nd);
        if (F.lane == 0) { red[F.wave * 48 + c16] = q2; red[F.wave * 48 + 16 + c16] = k2; red[F.wave * 48 + 32 + c16] = nd; }
#pragma unroll
        for (int i = 0; i < 4; ++i) { q[i] = qn[i]; k[i] = kn[i]; }
    }
    __syncthreads();
    if (F.tid < 48) {
        const int blk = F.bid >> 1, b = (F.bid * 128) / SEQ, kind = F.tid >> 4, c16 = F.tid & 15;
        float a = red[F.tid];
#pragma unroll
        for (int w = 1; w < 8; ++w) a = fmaxf(a, red[w * 48 + F.tid]);
        if (kind == 0) atomicMax(F.ctl + CW_QB2 + c16 * 128 + blk, __float_as_uint(a));
        else if (kind == 1) atomicMax(F.ctl + CW_KMX + c16 * 2 + b, __float_as_uint(a));
        else atomicMax(F.ctl + CW_ND + c16 * 128 + blk, fkey(a));
    }
    __syncthreads();
}
__device__ __forceinline__ attn4::Item attn_item(Frame& F, int qx, int id) {
    const int b = qx >> 2, m = (qx >> 1) & 1, x = id, h = 7 - (x >> 6), qb = 2 * (63 - (x & 63)) + (qx & 1);
    const bf16_t* DQ = (const bf16_t*)(F.ws + WS_DQ); const bf16_t* DK = (const bf16_t*)(F.ws + WS_DK); const bf16_t* DV = (const bf16_t*)(F.ws + WS_DV); bf16_t* O = (bf16_t*)(F.ws + WS_O);
    attn4::Item it; const size_t srow = (size_t)b * SEQ;
    it.Q = DQ + ((size_t)(h * 2 + m) * TT + srow + (size_t)qb * 128) * 128;
    it.K = DK + ((size_t)(h * 2 + m) * TT + srow) * 128;
    it.V0 = DV + ((size_t)(h * 2 + 0) * TT + srow) * 128;
    it.V1 = DV + ((size_t)(h * 2 + 1) * TT + srow) * 128;
    it.O = O + ((size_t)(h * 2 + m) * TT + srow + (size_t)qb * 128) * 256;
    it.P0 = qb * 128;
    const int c16 = h * 2 + m, blk = b * 64 + (qb >> 1);
    const float q2 = __uint_as_float(F.ctl[CW_QB2 + c16 * 128 + blk]), k2 = __uint_as_float(F.ctl[CW_KMX + c16 * 2 + b]), ndg = fkey_inv(F.ctl[CW_ND + c16 * 128 + blk]);
    const float slope = exp2f(-(float)(h + 1));
    const float bnd = (sqrtf(q2) * sqrtf(k2) + ndg) * attn::SCALE + 32.02f;
    float wf = ceilf(bnd / slope) + 1.0f; if (!(wf < (float)SEQ)) wf = (float)SEQ; if (!(wf >= 1.0f)) wf = 1.0f;
    if (F.G != 256) wf = (float)SEQ;
    it.W = (int)wf; it.sl = slope / attn::SCALE;
    return it;
}
__device__ __forceinline__ int attn_ticket(Frame& F, int rep, int& myq) {
    if (F.tid == 0) { int res = -1;
        for (int k = 0; k < 8; ++k) { const int q = (myq + k) & 7; const unsigned t = atomicAdd(F.ctl + CW_AHEAD + rep * 64 + q * 8, 1u); if (t < 512u) { res = q * 512 + (int)t; break; } }
        F.MISC[0] = (unsigned)res; }
    __syncthreads();
    const int v = __builtin_amdgcn_readfirstlane((int)F.MISC[0]);
    __syncthreads();
    if (v >= 0) myq = v >> 9;
    return v;
}
__device__ __forceinline__ void attn_phase(Frame& F, int rep) {
    const int tid = F.tid; int myq = F.bid & 7;
    for (;;) {
        const int id = attn_ticket(F, rep, myq);
        if (id < 0) break;
        const attn4::Item it = attn_item(F, id >> 9, id & 511);
        attn4::item(it, (char*)F.lds_g, F.lds, tid);
    }
    VM_WAIT(); __syncthreads();
}
__device__ __forceinline__ void dacombine(Frame& F, const float* const* in) {
    const bf16_t* O = (const bf16_t*)(F.ws + WS_O); bf16_t* DA = (bf16_t*)(F.ws + WS_DA); const float* g = in[12];
    const float lam = __uint_as_float(F.ctl[CW_LAM]);
    const int sub = F.lane >> 5, d8 = (F.lane & 31) * 8;
    for (int row0 = F.gw * 8; row0 < 8 * TT; row0 += F.NGW * 8) {
        u32x4 a[4], bq[4];
#pragma unroll
        for (int i = 0; i < 4; ++i) { const int row = row0 + 2 * i + sub, t = row >> 3, h = row & 7;
            a[i] = *(const u32x4*)(O + ((size_t)(h * 2 + 0) * TT + t) * 256 + d8); bq[i] = *(const u32x4*)(O + ((size_t)(h * 2 + 1) * TT + t) * 256 + d8); }
#pragma unroll
        for (int i = 0; i < 4; ++i) { const int row = row0 + 2 * i + sub, t = row >> 3, h = row & 7;
            float x[8], y[8]; unpack8(a[i], x); unpack8(bq[i], y);
#pragma unroll
            for (int c = 0; c < 8; ++c) x[c] -= lam * y[c];
            float ss = ((x[0] * x[0] + x[1] * x[1]) + (x[2] * x[2] + x[3] * x[3])) + ((x[4] * x[4] + x[5] * x[5]) + (x[6] * x[6] + x[7] * x[7]));
            ss += __shfl_xor(ss, 1); ss += __shfl_xor(ss, 2); ss += __shfl_xor(ss, 4); ss += __shfl_xor(ss, 8); ss += __shfl_xor(ss, 16);
            const float r = rsqrtf(ss * (1.0f / 256.0f) + EPS) * 0.8f;
            const f32x4 g0 = *(const f32x4*)(g + h * 256 + d8), g1 = *(const f32x4*)(g + h * 256 + d8 + 4);
            u32x4 w; w.x = cvtpk(x[0] * r * g0.x, x[1] * r * g0.y); w.y = cvtpk(x[2] * r * g0.z, x[3] * r * g0.w); w.z = cvtpk(x[4] * r * g1.x, x[5] * r * g1.y); w.w = cvtpk(x[6] * r * g1.z, x[7] * r * g1.w);
            *(u32x4*)(DA + (size_t)t * 2048 + h * 256 + d8) = w; }
    }
}
__device__ __forceinline__ void expert_convert(Frame& F, const float* const* in) {
    LAS float* scr = (LAS float*)(F.lds + F.wave * 16384);
    unsigned char* WGU = F.ws + WS_WGU; unsigned char* WD = F.ws + WS_WD;
    constexpr int PER = 22528;
    for (int it = F.gw; it < 3 * PER; it += F.NGW) {
        const int kind = it / PER, r = it - kind * PER, e = r / 704, r2 = r - e * 704;
        if (kind < 2) { const int kb = r2 / 22, nb = r2 - kb * 22, pn = nb >> 2;
            tr_item8((kind == 0 ? in[26] : in[27]) + (size_t)e * 2048 * DEXP, DEXP, 0, WGU, 2048, e * GU_N + pn * 128 + kind * 128, kb, nb, 32.0f, scr, F.lane); }
        else { const int kb = r2 >> 6, nb = r2 & 63;
            tr_item8(in[28] + (size_t)e * DEXP * 2048, 2048, 0, WD + (size_t)e * 2048 * DEXP_P, DEXP_P, 0, kb, nb, 16.0f, scr, F.lane); }
    }
    const u32x4 z = {0u, 0u, 0u, 0u};
    for (int idx = F.bid * 512 + F.tid; idx < 32 * 2 * 64 * 128; idx += F.G * 512) { const int e = idx >> 14, rem = idx & 16383, blk = rem >> 13, row = (rem >> 7) & 63, c16 = rem & 127;
        *(u32x4*)(WGU + ((size_t)e * GU_N + 1280 + blk * 128 + 64 + row) * 2048 + c16 * 16) = z; }
    for (int idx = F.bid * 512 + F.tid; idx < 32 * 2048 * 4; idx += F.G * 512) { const int en = idx >> 2, j = idx & 3;
        *(u32x4*)(WD + (size_t)en * DEXP_P + DEXP + j * 16) = z; }
    { const bf16_t* HBF = (const bf16_t*)(F.dout + DO_HBF); unsigned char* H8 = F.ws + WS_HBF8;
      for (size_t g8 = (size_t)(F.gw * 64 + F.lane) * 4; g8 < (size_t)TT * 256; g8 += (size_t)F.NGW * 64 * 4) {
          u32x4 a[4];
#pragma unroll
          for (int i = 0; i < 4; ++i) a[i] = *(const u32x4*)(HBF + (g8 + i) * 8);
          u32x4 o0, o1;
          o0.x = pk4_fp8(bflo(a[0].x), bfhi(a[0].x), bflo(a[0].y), bfhi(a[0].y)); o0.y = pk4_fp8(bflo(a[0].z), bfhi(a[0].z), bflo(a[0].w), bfhi(a[0].w));
          o0.z = pk4_fp8(bflo(a[1].x), bfhi(a[1].x), bflo(a[1].y), bfhi(a[1].y)); o0.w = pk4_fp8(bflo(a[1].z), bfhi(a[1].z), bflo(a[1].w), bfhi(a[1].w));
          o1.x = pk4_fp8(bflo(a[2].x), bfhi(a[2].x), bflo(a[2].y), bfhi(a[2].y)); o1.y = pk4_fp8(bflo(a[2].z), bfhi(a[2].z), bflo(a[2].w), bfhi(a[2].w));
          o1.z = pk4_fp8(bflo(a[3].x), bfhi(a[3].x), bflo(a[3].y), bfhi(a[3].y)); o1.w = pk4_fp8(bflo(a[3].z), bfhi(a[3].z), bflo(a[3].w), bfhi(a[3].w));
          *(u32x4*)(H8 + g8 * 8) = o0; *(u32x4*)(H8 + g8 * 8 + 16) = o1; } }
    __syncthreads();
}
__device__ __forceinline__ void topk_pass(Frame& F, const float* const* in, int tbeg, int tend) {
    const float* LG = (const float*)(F.ws + WS_LG); int* TOKE = (int*)(F.ws + WS_TOKE); float* TOKW = (float*)(F.ws + WS_TOKW); const float* RSS = (const float*)(F.ws + WS_RSS); float* RT = (float*)(F.ws + WS_RT);
    LAS unsigned* hist = (LAS unsigned*)F.lds;
    if (F.tid < 32) hist[F.tid] = 0u;
    __syncthreads();
    const float* brg = in[23]; const float* bre = in[25];
    for (int t = tbeg + F.tid; t < tend; t += 512) {
        const float* lp = LG + (size_t)t * 256;
        float rt; { const f32x4* rs = (const f32x4*)(RSS + (size_t)t * 32); f32x4 a = rs[0];
#pragma unroll
            for (int j = 1; j < 8; ++j) a += rs[j];
            rt = rsqrtf(((a.x + a.y) + (a.z + a.w)) * (1.0f / 2048.0f) + EPS); RT[t] = rt; }
        const f32x4 g4 = *(const f32x4*)lp * rt;
        const float g0 = g4.x + brg[0], g1 = g4.y + brg[1], g2 = g4.z + brg[2], g3 = g4.w + brg[3];
        int grp = 0; float gm = g0; if (g1 > gm) { gm = g1; grp = 1; } if (g2 > gm) { gm = g2; grp = 2; } if (g3 > gm) { gm = g3; grp = 3; }
        const float pg = 1.0f / (expf(g0 - gm) + expf(g1 - gm) + expf(g2 - gm) + expf(g3 - gm));
        const f32x4 ea = *(const f32x4*)(lp + 4 + grp * 8) * rt, eb = *(const f32x4*)(lp + 8 + grp * 8) * rt;
        const f32x4 ba = *(const f32x4*)(bre + grp * 8), bb = *(const f32x4*)(bre + grp * 8 + 4);
        float ev[8] = {ea.x + ba.x, ea.y + ba.y, ea.z + ba.z, ea.w + ba.w, eb.x + bb.x, eb.y + bb.y, eb.z + bb.z, eb.w + bb.w};
        int i1 = 0; float v1 = ev[0];
#pragma unroll
        for (int j = 1; j < 8; ++j) if (ev[j] > v1) { v1 = ev[j]; i1 = j; }
        int i2 = -1; float v2 = -__builtin_inff();
#pragma unroll
        for (int j = 0; j < 8; ++j) if (j != i1 && ev[j] > v2) { v2 = ev[j]; i2 = j; }
        const float ex = expf(v2 - v1), inv = 1.0f / (1.0f + ex);
        const int e1 = grp * 8 + i1, e2 = grp * 8 + i2;
        TOKE[t * 2] = e1; TOKE[t * 2 + 1] = e2; TOKW[t * 2] = inv * pg; TOKW[t * 2 + 1] = ex * inv * pg;
        __hip_atomic_fetch_add(&hist[e1], 1u, __ATOMIC_RELAXED, __HIP_MEMORY_SCOPE_WORKGROUP); __hip_atomic_fetch_add(&hist[e2], 1u, __ATOMIC_RELAXED, __HIP_MEMORY_SCOPE_WORKGROUP);
    }
    __syncthreads();
    if (F.tid < 32 && hist[F.tid]) atomicAdd(F.ctl + CW_ECNT + F.tid, hist[F.tid]);
    __syncthreads();
}
__device__ __forceinline__ void gather_pass(Frame& F, const float* const* in) {
    const int* TOKE = (const int*)(F.ws + WS_TOKE); const float* TOKW = (const float*)(F.ws + WS_TOKW); int* POS = (int*)(F.ws + WS_POS); float* WROW = (float*)(F.ws + WS_WROW); int* TILEE = (int*)(F.ws + WS_TILEE);
    const bf16_t* X1B = (const bf16_t*)(F.ws + WS_X1B); const float* RT = (const float*)(F.ws + WS_RT); unsigned char* XSORT = F.ws + WS_XSORT;
    float gf[32];
#pragma unroll
    for (int j = 0; j < 8; ++j) { const f32x4 g = *(const f32x4*)(in[21] + 32 * F.lane + 4 * j); gf[4 * j] = g.x; gf[4 * j + 1] = g.y; gf[4 * j + 2] = g.z; gf[4 * j + 3] = g.w; }
    LAS unsigned* pstart = (LAS unsigned*)F.lds; LAS unsigned* hist = pstart + 32; LAS unsigned* base = pstart + 64; LAS unsigned* lcur = pstart + 96; LAS int* apos = (LAS int*)(pstart + 128); LAS int* atok = apos + 512;
    if (F.tid == 0) { unsigned acc = 0; for (int e = 0; e < 32; ++e) { pstart[e] = acc; const unsigned c = F.ctl[CW_ECNT + e]; const unsigned pc = (c + 255u) & ~255u;
            if (F.bid == 0) for (unsigned rt = acc >> 8; rt < (acc + pc) >> 8; ++rt) TILEE[rt] = e;
            acc += pc; }
        if (F.bid == 0) F.ctl[CW_NRT] = acc >> 8; }
    const int per = (TT + F.G - 1) / F.G;
    const int tbeg = F.bid * per, tend = (tbeg + per < TT) ? tbeg + per : TT;
    for (int ts = tbeg; ts < tend; ts += 256) {
        const int nasg = 2 * ((tend - ts < 256) ? tend - ts : 256);
        if (F.tid < 32) { hist[F.tid] = 0u; lcur[F.tid] = 0u; }
        __syncthreads();
        int e = 0; const int a = F.tid;
        if (a < nasg) { e = TOKE[ts * 2 + a]; __hip_atomic_fetch_add(&hist[e], 1u, __ATOMIC_RELAXED, __HIP_MEMORY_SCOPE_WORKGROUP); }
        __syncthreads();
        if (F.tid < 32) base[F.tid] = pstart[F.tid] + (hist[F.tid] ? atomicAdd(F.ctl + CW_ECUR + F.tid, hist[F.tid]) : 0u);
        __syncthreads();
        if (a < nasg) { const unsigned p = base[e] + __hip_atomic_fetch_add(&lcur[e], 1u, __ATOMIC_RELAXED, __HIP_MEMORY_SCOPE_WORKGROUP); POS[ts * 2 + a] = (int)p; WROW[p] = TOKW[ts * 2 + a]; apos[a] = (int)p; atok[a] = ts + (a >> 1); }
        __syncthreads();
        for (int i = F.wave; i < nasg; i += 8) { const int tok = atok[i]; const u32x4* src = (const u32x4*)(X1B + (size_t)tok * 2048) + 4 * F.lane; u32x4* dst = (u32x4*)(XSORT + (size_t)apos[i] * 2048) + 2 * F.lane;
            u32x4 a[4]; const float rt = RT[tok];
#pragma unroll
            for (int j = 0; j < 4; ++j) a[j] = src[j];
            unsigned o[8];
#pragma unroll
            for (int j = 0; j < 4; ++j) {
                o[2 * j]     = pk4_fp8(bflo(a[j].x) * rt * gf[8 * j],     bfhi(a[j].x) * rt * gf[8 * j + 1], bflo(a[j].y) * rt * gf[8 * j + 2], bfhi(a[j].y) * rt * gf[8 * j + 3]);
                o[2 * j + 1] = pk4_fp8(bflo(a[j].z) * rt * gf[8 * j + 4], bfhi(a[j].z) * rt * gf[8 * j + 5], bflo(a[j].w) * rt * gf[8 * j + 6], bfhi(a[j].w) * rt * gf[8 * j + 7]); }
            u32x4 o0, o1; o0.x = o[0]; o0.y = o[1]; o0.z = o[2]; o0.w = o[3]; o1.x = o[4]; o1.y = o[5]; o1.z = o[6]; o1.w = o[7];
            dst[0] = o0; dst[1] = o1; }
        __syncthreads();
    }
}
__device__ __forceinline__ void unpack8_fp8(const u32x2 w, float (&x)[8]) {
    x[0] = __builtin_amdgcn_cvt_f32_fp8((int)w.x, 0); x[1] = __builtin_amdgcn_cvt_f32_fp8((int)w.x, 1); x[2] = __builtin_amdgcn_cvt_f32_fp8((int)w.x, 2); x[3] = __builtin_amdgcn_cvt_f32_fp8((int)w.x, 3);
    x[4] = __builtin_amdgcn_cvt_f32_fp8((int)w.y, 0); x[5] = __builtin_amdgcn_cvt_f32_fp8((int)w.y, 1); x[6] = __builtin_amdgcn_cvt_f32_fp8((int)w.y, 2); x[7] = __builtin_amdgcn_cvt_f32_fp8((int)w.y, 3); }
__device__ __forceinline__ void final_pass(Frame& F, const float* const* in) {
    const bf16_t* X1B = (const bf16_t*)(F.ws + WS_X1B); float* OUT = (float*)F.dout; const unsigned char* YS = F.ws + WS_YS; const int* POS = (const int*)(F.ws + WS_POS); const float* g = in[29];
    for (int m0 = F.gw * 2; m0 < TT; m0 += F.NGW * 2) {
        u32x4 x[2][4]; u32x2 a[2][4], bq[2][4];
#pragma unroll
        for (int rr = 0; rr < 2; ++rr) { const int m = m0 + rr; const int p0 = POS[m * 2], p1 = POS[m * 2 + 1];
#pragma unroll
            for (int j = 0; j < 4; ++j) { const size_t c = 8 * F.lane + 512 * j;
                x[rr][j] = *(const u32x4*)(X1B + (size_t)m * 2048 + c); a[rr][j] = *(const u32x2*)(YS + (size_t)p0 * 2048 + c); bq[rr][j] = *(const u32x2*)(YS + (size_t)p1 * 2048 + c); } }
#pragma unroll
        for (int rr = 0; rr < 2; ++rr) { const int m = m0 + rr; float v[4][8]; float ss = 0.f;
#pragma unroll
            for (int j = 0; j < 4; ++j) { float xa[8], ya[8], yb[8]; unpack8(x[rr][j], xa); unpack8_fp8(a[rr][j], ya); unpack8_fp8(bq[rr][j], yb);
#pragma unroll
                for (int c = 0; c < 8; ++c) { v[j][c] = xa[c] + (ya[c] + yb[c]) * (1.0f / 64.0f); ss += v[j][c] * v[j][c]; } }
            ss = wave_sum(ss); const float r = rsqrtf(ss * (1.0f / 2048.0f) + EPS);
#pragma unroll
            for (int j = 0; j < 4; ++j) { const size_t c = 8 * F.lane + 512 * j; const f32x4 g0 = *(const f32x4*)(g + c), g1 = *(const f32x4*)(g + c + 4);
                *(f32x4*)(OUT + (size_t)m * 2048 + c) = (f32x4){v[j][0] * r * g0.x, v[j][1] * r * g0.y, v[j][2] * r * g0.z, v[j][3] * r * g0.w};
                *(f32x4*)(OUT + (size_t)m * 2048 + c + 4) = (f32x4){v[j][4] * r * g1.x, v[j][5] * r * g1.y, v[j][6] * r * g1.z, v[j][7] * r * g1.w}; } }
    }
}
constexpr int NPHASE = 20;
struct Args { const float* in[30]; float* out; unsigned char* ws; int ph_lo, ph_hi; };

__device__ __forceinline__ bool fresh_lane(Frame& F) { int l = (int)__builtin_amdgcn_mbcnt_hi(~0u, __builtin_amdgcn_mbcnt_lo(~0u, 0u)); asm volatile("" : "+v"(l)); F.lane = l; F.tid = (F.wave << 6) | l; return true; }
__global__ void __launch_bounds__(512, 2) mk_fwd(Args args) {
    extern __shared__ __attribute__((aligned(16))) unsigned char lds_raw[];
    Frame F;
    F.lds = (LAS unsigned char*)lds_raw; F.lds_g = lds_raw;
    F.MISC = (volatile LAS unsigned*)(F.lds + MISC_OFF);
    F.tid = threadIdx.x; F.lane = F.tid & 63; F.wave = __builtin_amdgcn_readfirstlane(F.tid >> 6);
    F.G = gridDim.x; F.bid = blockIdx.x; F.gw = F.bid * 8 + F.wave; F.NGW = F.G * 8;
    F.ws = args.ws; F.dout = (unsigned char*)args.out; F.ctl = (unsigned*)(args.ws + WS_CTL);
    const float* const* in = args.in;
    for (int u = F.tid; u < (LDS_BYTES - RING_BYTES) / 4; u += 512) ((LAS unsigned*)(F.lds + RING_BYTES))[u] = 0u;
    __syncthreads();
    const int lo = args.ph_lo, hi = args.ph_hi;
    const bool fused = (hi - lo) > 1;
    XcdBarrier bar; bar.bar = F.ctl + CW_BAR; bar.x = 0; bar.st = nullptr;
    if (fused) bar = xcd_barrier_post(F.ctl + CW_BAR, F.MISC + 8, F.tid);
#ifndef ONLY_PHASE
#define ONLY_PHASE -1
#endif
#define IN(k) ((ONLY_PHASE < 0 || ONLY_PHASE == (k)) && lo <= (k) && (k) < hi && fresh_lane(F))
#ifndef DUP_MASK
#define DUP_MASK 0
#endif
#define DUP_BEGIN(k) _Pragma("unroll") for (int rep_ = 0; rep_ < 1 + ((DUP_MASK >> (k)) & 1); ++rep_) { if (rep_) { xcd_barrier(bar, F.tid); fresh_lane(F); }
#define DUP_END }
#define SEAM(k) do { if ((ONLY_PHASE < 0 || ONLY_PHASE == (k) + 1) && lo <= (k) + 1 && (k) + 1 < hi) xcd_barrier(bar, F.tid); } while (0)
    const int G = F.G, c = F.bid;
    bf16_t* const HBF = (bf16_t*)(F.dout + DO_HBF);
    bf16_t* const WINT = (bf16_t*)(F.ws + WS_WINT);
    const bf16_t* const HBF8 = (const bf16_t*)(F.ws + WS_HBF8);
    const bf16_t* const WG8 = (const bf16_t*)(WINT + (size_t)11264 * 2048);

    if (IN(0)) { DUP_BEGIN(0) p0_prologue(F, in); DUP_END SEAM(0); }

    if (IN(1)) { DUP_BEGIN(1)
        if (F.bid < 8) ml0_seq(F, in, F.bid);
        pg8::SchedPA S{HBF, WINT, G, c};
        pg8::EpiPA E{(bf16_t*)(F.ws + WS_MQK), (bf16_t*)(F.ws + WS_MLO), (bf16_t*)(F.ws + WS_XQ), (bf16_t*)(F.ws + WS_VC)};
        pg8::gemm_phase(F.lds, 2048, 2048, 2048, S, E, F.tid);
        DUP_END SEAM(1);
    }
    if (IN(2)) { DUP_BEGIN(2)
        pg8::SchedMem S{(const bf16_t*)(F.ws + WS_MEMN), (const bf16_t*)(F.ws + WS_WMEMT), G, c};
        pg8::EpiMem E{(bf16_t*)(F.ws + WS_MK), (bf16_t*)(F.ws + WS_MVT)};
        pg8::gemm_phase(F.lds, 2048, 2048, 2048, S, E, F.tid);
        ml1_conv(F, in);
        DUP_END SEAM(2);
    }
    if (IN(3)) { DUP_BEGIN(3)
#ifndef SUB
#define SUB 7
#endif
        if (SUB & 1) { pg8::SchedHG S{(const bf16_t*)(F.ws + WS_Q), (const bf16_t*)(F.ws + WS_KW), (size_t)TT * 256, 65536, (size_t)TT * 256, 65536, G, c};
          pg8::EpiW E{(bf16_t*)(F.ws + WS_WQ), (const float*)(F.ws + WS_SCRS)};
          pg8::gemm_phase(F.lds, 256, 256, 256, S, E, F.tid); }
        if (SUB & 2) { pg8::SchedHG S{(const bf16_t*)(F.ws + WS_VC), (const bf16_t*)(F.ws + WS_KWT), (size_t)128 * 256 * 512, (size_t)256 * 512, (size_t)128 * 65536, 65536, G, c};
          pg8::EpiB16Tile E{(bf16_t*)(F.ws + WS_U), 65536, 0, (size_t)128 * 65536, 256, 1.0f};
          pg8::gemm_phase(F.lds, 512, 256, 256, S, E, F.tid); }
        if (SUB & 4) { pg8::SchedXA S{(const bf16_t*)(F.ws + WS_XQ), (const bf16_t*)(F.ws + WS_MK), G, c};
          pg8::EpiXSoft E{(bf16_t*)(F.ws + WS_XP2), (LAS float*)(F.lds + pg8::EPI_TBL_OFF)};
          pg8::gemm_phase(F.lds, 256, 256, 256, S, E, F.tid); }
        if (F.bid < 8) nscan_seq(F, F.bid);
        DUP_END SEAM(3);
    }
    if (IN(4)) { DUP_BEGIN(4) cscan(F); denpass(F); DUP_END SEAM(4); }
    if (IN(5)) { DUP_BEGIN(5)
        { pg8::SchedHG S{(const bf16_t*)(F.ws + WS_WQ), (const bf16_t*)(F.ws + WS_VC), (size_t)TT * 512, (size_t)256 * 512, (size_t)128 * 256 * 512, (size_t)256 * 512, G, c};
          pg8::EpiHNorm E{(bf16_t*)(F.dout + DO_HR), (const float*)(F.ws + WS_HDEN), (const bf16_t*)(F.ws + WS_MLO), in[13], (LAS float*)(F.lds + pg8::EPI_TBL_OFF)};
          pg8::gemm_phase(F.lds, 512, 512, 512, S, E, F.tid); }
        { pg8::SchedXA S{(const bf16_t*)(F.ws + WS_XP2), (const bf16_t*)(F.ws + WS_MVT), G, c};
          pg8::EpiXA E{(bf16_t*)(F.dout + DO_XA)};
          pg8::gemm_phase(F.lds, 256, 256, 256, S, E, F.tid); }
        DUP_END SEAM(5);
    }
    if (IN(6)) { DUP_BEGIN(6)
        pg8::SchedDense S{HBF, WINT, 2048, 2048, 128, 24, G, c};
        pg8::EpiPB E{(bf16_t*)(F.ws + WS_DQ), (bf16_t*)(F.ws + WS_DK), (bf16_t*)(F.ws + WS_DV)};
        pg8::gemm_phase(F.lds, 2048, 2048, 2048, S, E, F.tid);
        DUP_END SEAM(6);
    }
    if (IN(7)) { DUP_BEGIN(7) normmax(F); DUP_END SEAM(7); }
    if (IN(8)) { DUP_BEGIN(8) attn_phase(F, rep_); DUP_END SEAM(8); }
    if (IN(9)) { DUP_BEGIN(9) dacombine(F, in); expert_convert(F, in); DUP_END SEAM(9); }
    if (IN(10)) { DUP_BEGIN(10)
        pg8::SchedDense S{HBF8, WG8, 1024, 1024, 128, 8, G, c};
        pg8::EpiGate E{(bf16_t*)(F.ws + WS_GT0), in[19], 1.0f / 32.0f};
        pg8::gemm_phase<pg8::EpiGate, pg8::SchedDense, true>(F.lds, 1024, 1024, 1024, S, E, F.tid);
        DUP_END SEAM(10);
    }
    if (IN(11)) { DUP_BEGIN(11)
        { pg8::SchedDense S{(const bf16_t*)(F.ws + WS_DA), (const bf16_t*)(F.ws + WS_WBDT), 2048, 2048, 128, 8, G, c};
          pg8::EpiBranch<true> E{(const bf16_t*)(F.ws + WS_GT0), (bf16_t*)(F.ws + WS_MERGED)};
          pg8::gemm_phase(F.lds, 2048, 2048, 2048, S, E, F.tid); }
        { pg8::SchedDense S{HBF8, WG8 + (size_t)2048 * 1024, 1024, 1024, 128, 8, G, c};
          pg8::EpiGate E{(bf16_t*)(F.ws + WS_GT1), in[19] + 2048, 1.0f / 32.0f};
          pg8::gemm_phase<pg8::EpiGate, pg8::SchedDense, true>(F.lds, 1024, 1024, 1024, S, E, F.tid); }
        DUP_END SEAM(11);
    }
    if (IN(12)) { DUP_BEGIN(12)
        { pg8::SchedDense S{(const bf16_t*)(F.dout + DO_HR), (const bf16_t*)(F.ws + WS_WBMT), 1024, 1024, 128, 8, G, c};
          pg8::EpiBranch<false> E{(const bf16_t*)(F.ws + WS_GT1), (bf16_t*)(F.ws + WS_MERGED)};
          pg8::gemm_phase(F.lds, 1024, 1024, 1024, S, E, F.tid); }
        { pg8::SchedDense S{HBF8, WG8 + (size_t)4096 * 1024, 1024, 1024, 128, 8, G, c};
          pg8::EpiGate E{(bf16_t*)(F.ws + WS_GT0), in[19] + 4096, 1.0f / 32.0f};
          pg8::gemm_phase<pg8::EpiGate, pg8::SchedDense, true>(F.lds, 1024, 1024, 1024, S, E, F.tid); }
        DUP_END SEAM(12);
    }
    if (IN(13)) { DUP_BEGIN(13)
        pg8::SchedDense S{(const bf16_t*)(F.dout + DO_XA), (const bf16_t*)(F.ws + WS_WBCT), 1024, 1024, 128, 8, G, c};
        pg8::EpiBranch<false> E{(const bf16_t*)(F.ws + WS_GT0), (bf16_t*)(F.ws + WS_MERGED)};
        pg8::gemm_phase(F.lds, 1024, 1024, 1024, S, E, F.tid);
        DUP_END SEAM(13);
    }
    if (IN(14)) { DUP_BEGIN(14)
        pg8::SchedDense S{(const bf16_t*)(F.ws + WS_MERGED), (const bf16_t*)(F.ws + WS_WOUTT), 2048, 2048, 128, 8, G, c};
        pg8::EpiOut E{in[0], (bf16_t*)(F.ws + WS_X1B), (float*)(F.ws + WS_RSS)};
        pg8::gemm_phase(F.lds, 2048, 2048, 2048, S, E, F.tid);
        DUP_END SEAM(14);
    }
    if (IN(15)) { DUP_BEGIN(15)
        pg8::SchedDense S{(const bf16_t*)(F.ws + WS_X1B), (const bf16_t*)(F.ws + WS_WRT), 2048, 2048, 128, 1, G, c};
        pg8::EpiF32Tile E{(float*)(F.ws + WS_LG), 65536, 0, 0, 256};
        pg8::gemm_phase(F.lds, 2048, 2048, 2048, S, E, F.tid);
        VM_WAIT(); __syncthreads();
        for (int L = c; L < 128; L += G) { int pm, pn; pg8::tile_order(L, 128, 1, pm, pn); topk_pass(F, in, pm * 256, pm * 256 + 256); }
        DUP_END SEAM(15);
    }
    if (IN(16)) { DUP_BEGIN(16) gather_pass(F, in); DUP_END SEAM(16); }
    if (IN(17)) { DUP_BEGIN(17)
        const int nrt = (int)__builtin_amdgcn_readfirstlane(F.ctl[CW_NRT]);
        pg8::SchedMoE S{(const bf16_t*)(F.ws + WS_XSORT), (const bf16_t*)(F.ws + WS_WGU), (const int*)(F.ws + WS_TILEE), nrt, 6, 1024, (size_t)GU_N * 1024, (size_t)256 * 1024, G, c};
        pg8::EpiGU E{F.ws + WS_HD};
        pg8::gemm_phase<pg8::EpiGU, pg8::SchedMoE, true>(F.lds, 1024, 1024, 1024, S, E, F.tid);
        DUP_END SEAM(17);
    }
    if (IN(18)) { DUP_BEGIN(18)
        const int nrt = (int)__builtin_amdgcn_readfirstlane(F.ctl[CW_NRT]);
        pg8::SchedMoE S{(const bf16_t*)(F.ws + WS_HD), (const bf16_t*)(F.ws + WS_WD), (const int*)(F.ws + WS_TILEE), nrt, 8, DEXP_P / 2, (size_t)2048 * (DEXP_P / 2), (size_t)256 * (DEXP_P / 2), G, c};
        pg8::EpiDown E{F.ws + WS_YS, (const float*)(F.ws + WS_WROW)};
        pg8::gemm_phase<pg8::EpiDown, pg8::SchedMoE, true>(F.lds, DEXP_P / 2, DEXP_P / 2, DEXP_P / 2, S, E, F.tid);
        DUP_END SEAM(18);
    }
    if (IN(19)) { DUP_BEGIN(19) final_pass(F, in); DUP_END }
#undef IN
#undef SEAM
}

#ifndef MK_FUSED
#define MK_FUSED 1
#endif
extern "C" void kernel_launch(void* const* d_in, const int* in_sizes, int n_in, void* d_out, int out_size, void* d_ws, size_t ws_size, hipStream_t stream) {
    static int grid = 0;
    if (grid == 0) {
        if (n_in != 30 || out_size != TT * DM || ws_size < WS_END) { fprintf(stderr, "kernel_launch: unexpected shapes (n_in %d out %d ws %zu)\n", n_in, out_size, ws_size); grid = -1; return; }
        int dev = 0, cus = 0, per_cu = 0;
        if (hipGetDevice(&dev) != hipSuccess || hipDeviceGetAttribute(&cus, hipDeviceAttributeMultiprocessorCount, dev) != hipSuccess) { grid = -1; return; }
        if (hipFuncSetAttribute((const void*)mk_fwd, hipFuncAttributeMaxDynamicSharedMemorySize, LDS_BYTES) != hipSuccess) { fprintf(stderr, "kernel_launch: hipFuncSetAttribute failed\n"); grid = -1; return; }
        if (hipOccupancyMaxActiveBlocksPerMultiprocessor(&per_cu, (const void*)mk_fwd, 512, LDS_BYTES) != hipSuccess || per_cu < 1) fprintf(stderr, "kernel_launch: occupancy query says %d\n", per_cu);
        (void)hipGetLastError();
        grid = cus;
    }
    if (grid < 0) return;
    (void)hipMemsetAsync((char*)d_ws + WS_CTL, 0, CTL_ZERO_BYTES, stream);
    Args a{};
    for (int i = 0; i < 30; ++i) a.in[i] = (const float*)d_in[i];
    a.out = (float*)d_out; a.ws = (unsigned char*)d_ws;
#if MK_FUSED
    a.ph_lo = 0; a.ph_hi = NPHASE;
    hipLaunchKernelGGL(mk_fwd, dim3(grid), dim3(512), LDS_BYTES, stream, a);
#else
#ifndef PROBE_DUP
#define PROBE_DUP 0u
#endif
    for (int p = 0; p < NPHASE; ++p) { a.ph_lo = p; a.ph_hi = p + 1; hipLaunchKernelGGL(mk_fwd, dim3(grid), dim3(512), LDS_BYTES, stream, a);
        if ((PROBE_DUP >> p) & 1u) {
            if (p == 8) (void)hipMemsetAsync((char*)d_ws + WS_CTL + CW_AHEAD * 4, 0, 256, stream);
            hipLaunchKernelGGL(mk_fwd, dim3(grid), dim3(512), LDS_BYTES, stream, a); } }
#endif
}
```

```cpp
#include <hip/hip_runtime.h>
#include <hip/hip_bf16.h>
#include <cstdio>
#include <cstdint>

#define LAS __attribute__((address_space(3)))
#define GAS __attribute__((address_space(1)))
typedef unsigned short bf16_t;
typedef short bf16x8 __attribute__((ext_vector_type(8)));
typedef short s16x4 __attribute__((ext_vector_type(4)));
typedef float f32x2 __attribute__((ext_vector_type(2)));
typedef float f32x4 __attribute__((ext_vector_type(4)));
typedef float f32x16 __attribute__((ext_vector_type(16)));
typedef unsigned u32x2 __attribute__((ext_vector_type(2)));
typedef unsigned u32x4 __attribute__((ext_vector_type(4)));

constexpr int NB = 2, SEQ = 16384, TT = NB * SEQ, DM = 2048, MEML = 256;
constexpr int DIN = 17416;
constexpr float EPS = 1e-6f;
constexpr int NEXP = 32, DEXP = 704, DEXP_P = 768, GU_N = 1536;
constexpr int MAX_RT = 288;

constexpr size_t MiB = 1u << 20;
constexpr size_t WS_CTL = 0, CTL_ZERO_BYTES = 1 * MiB;
constexpr size_t WS_MLG = 1 * MiB;
constexpr size_t WS_SCKW = 2 * MiB, WS_SCRS = 2 * MiB + 512 * 1024, WS_SCIT = 3 * MiB, WS_SCED = 3 * MiB + 512 * 1024;
constexpr size_t WS_HDEN = 4 * MiB;
constexpr size_t WS_KN = 13 * MiB;
constexpr size_t WS_NP = 5 * MiB + 512 * 1024;
constexpr size_t WS_DEC = 6 * MiB;
constexpr size_t WS_MEMN = 7 * MiB;
constexpr size_t WS_MK = 9 * MiB;
constexpr size_t WS_MVT = 10 * MiB;
constexpr size_t WS_TOKE = 11 * MiB;
constexpr size_t WS_TOKW = 11 * MiB + 256 * 1024;
constexpr size_t WS_POS = 11 * MiB + 512 * 1024;
constexpr size_t WS_WROW = 12 * MiB;
constexpr size_t WS_TILEE = 12 * MiB + 512 * 1024;
constexpr size_t WS_RT = 12 * MiB + 768 * 1024;
constexpr size_t WS_WINT = 16 * MiB;
constexpr size_t WS_WMEMT = 84 * MiB;
constexpr size_t WS_WBDT = 92 * MiB;
constexpr size_t WS_WBMT = 100 * MiB;
constexpr size_t WS_WBCT = 104 * MiB;
constexpr size_t WS_WOUTT = 108 * MiB;
constexpr size_t WS_WRT = 116 * MiB;
constexpr size_t WS_MQK = 120 * MiB;
constexpr size_t WS_U = 120 * MiB;
constexpr size_t WS_XQ = 312 * MiB;
constexpr size_t WS_XP = 312 * MiB;
constexpr size_t WS_VC = 376 * MiB;
constexpr size_t WS_Q = 504 * MiB;
constexpr size_t WS_WQ = 568 * MiB;
constexpr size_t WS_KW = 696 * MiB;
constexpr size_t WS_KWT = 760 * MiB;
constexpr size_t WS_XP2 = 824 * MiB;
constexpr size_t WS_XS = 824 * MiB;
constexpr size_t WS_MLO = 248 * MiB;
constexpr size_t WS_DQ = 120 * MiB, WS_DK = 248 * MiB, WS_DV = 376 * MiB;
constexpr size_t WS_O = 504 * MiB;
constexpr size_t WS_DA = 760 * MiB;
constexpr size_t WS_WGU = 120 * MiB;
constexpr size_t WS_WD = 216 * MiB;
constexpr size_t WS_HBF8 = 952 * MiB;
constexpr size_t WS_GT0 = 408 * MiB, WS_GT1 = 536 * MiB;
constexpr size_t DO_MERGED = 0;
constexpr size_t WS_X1B = 264 * MiB;
constexpr size_t WS_RSS = 1016 * MiB;
constexpr size_t WS_LG = 536 * MiB;
constexpr size_t WS_XSORT = 568 * MiB;
constexpr size_t WS_HD = 856 * MiB;
constexpr size_t WS_YS = 568 * MiB;
constexpr size_t WS_END = 1024 * MiB;
constexpr size_t DO_HBF = 0, DO_HR = 128 * MiB, DO_XA = 192 * MiB;

constexpr int CW_BAR = 4096;
constexpr int CW_AHEAD = 8192;
constexpr int CW_QKMAX = 8256;
constexpr int CW_KMX = 8272;
constexpr int CW_QB2 = 16384;
constexpr int CW_RCNT = 49152;
constexpr int CW_CH = 40960;
constexpr int CW_KT = 32768;
constexpr int KMX_LDS = 131072 + 3072;
constexpr int CW_ND = 16384 + 2048;
constexpr int CW_ECNT = 8320;
constexpr int CW_ECUR = 8384;
constexpr int CW_LAM = 8448;
constexpr int CW_NRT = 8449;

constexpr int RING_BYTES = 131072;
constexpr int MISC_OFF = RING_BYTES + 320;
constexpr int LDS_BYTES = 147456;

#define LDS_WAIT() asm volatile("s_waitcnt lgkmcnt(0)" ::: "memory")
#define VM_WAIT() asm volatile("s_waitcnt vmcnt(0)" ::: "memory")
#define RLX_AGENT __ATOMIC_RELAXED, __HIP_MEMORY_SCOPE_AGENT

__device__ __forceinline__ unsigned cvtpk(float lo, float hi) { unsigned r; asm volatile("s_nop 0\n\tv_cvt_pk_bf16_f32 %0, %1, %2" : "=v"(r) : "v"(lo), "v"(hi)); return r; }
__device__ __forceinline__ unsigned pk4_fp8(float a, float b, float c, float d) { int w = 0; w = __builtin_amdgcn_cvt_pk_fp8_f32(a, b, w, false); w = __builtin_amdgcn_cvt_pk_fp8_f32(c, d, w, true); return (unsigned)w; }
__device__ __forceinline__ float bf2f(unsigned short b) { return __uint_as_float(((unsigned)b) << 16); }
__device__ __forceinline__ float bflo(unsigned w) { return __uint_as_float(w << 16); }
__device__ __forceinline__ float bfhi(unsigned w) { return __uint_as_float(w & 0xffff0000u); }
#define DPP_F(x, ctrl) __builtin_bit_cast(float, __builtin_amdgcn_update_dpp(0, __builtin_bit_cast(int, (x)), (ctrl), 0xF, 0xF, true))
__device__ __forceinline__ float wave_sum(float v) {
    v += DPP_F(v, 0xB1); v += DPP_F(v, 0x4E); v += DPP_F(v, 0x124); v += DPP_F(v, 0x128);
    const int iv = __builtin_bit_cast(int, v);
    return (__builtin_bit_cast(float, __builtin_amdgcn_readlane(iv, 0)) + __builtin_bit_cast(float, __builtin_amdgcn_readlane(iv, 16))) + (__builtin_bit_cast(float, __builtin_amdgcn_readlane(iv, 32)) + __builtin_bit_cast(float, __builtin_amdgcn_readlane(iv, 48)));
}
__device__ __forceinline__ float wave_max(float v) {
    v = fmaxf(v, DPP_F(v, 0xB1)); v = fmaxf(v, DPP_F(v, 0x4E)); v = fmaxf(v, DPP_F(v, 0x124)); v = fmaxf(v, DPP_F(v, 0x128));
    const int iv = __builtin_bit_cast(int, v);
    return fmaxf(fmaxf(__builtin_bit_cast(float, __builtin_amdgcn_readlane(iv, 0)), __builtin_bit_cast(float, __builtin_amdgcn_readlane(iv, 16))), fmaxf(__builtin_bit_cast(float, __builtin_amdgcn_readlane(iv, 32)), __builtin_bit_cast(float, __builtin_amdgcn_readlane(iv, 48))));
}
__device__ __forceinline__ float xsum16(float x) { auto rr = __builtin_amdgcn_permlane16_swap(__float_as_uint(x), __float_as_uint(x), false, false); return __uint_as_float(rr[0]) + __uint_as_float(rr[1]); }
__device__ __forceinline__ float xsum32(float x) { auto rr = __builtin_amdgcn_permlane32_swap(__float_as_uint(x), __float_as_uint(x), false, false); return __uint_as_float(rr[0]) + __uint_as_float(rr[1]); }
__device__ __forceinline__ float xmax16(float x) { auto rr = __builtin_amdgcn_permlane16_swap(__float_as_uint(x), __float_as_uint(x), false, false); return fmaxf(__uint_as_float(rr[0]), __uint_as_float(rr[1])); }
__device__ __forceinline__ float xmax32(float x) { auto rr = __builtin_amdgcn_permlane32_swap(__float_as_uint(x), __float_as_uint(x), false, false); return fmaxf(__uint_as_float(rr[0]), __uint_as_float(rr[1])); }
__device__ __forceinline__ float sigmoidf_(float x) { return __builtin_amdgcn_rcpf(1.0f + __expf(-x)); }

#define XB_TMO      128
#define XB_XCNT(j)  (256  + 64 * (j))
#define XB_XSUB(j)  (1280 + 64 * (j))
#define XB_XGEN(j)  (2304 + 64 * (j))
#define XB_TOP      3328
#define XB_TOPGEN   3392
#define XCD_BAR_WORDS 3456
#define XB_SPIN_CAP (1u << 18)

__device__ __forceinline__ unsigned xb_ld(unsigned* p)              { return __hip_atomic_load(p, __ATOMIC_RELAXED, __HIP_MEMORY_SCOPE_AGENT); }
__device__ __forceinline__ unsigned xb_add(unsigned* p, unsigned v) { return __hip_atomic_fetch_add(p, v, __ATOMIC_RELAXED, __HIP_MEMORY_SCOPE_AGENT); }
__device__ __forceinline__ unsigned xb_xcc_id() { return (unsigned)__builtin_amdgcn_s_getreg((3 << 11) | 20) & 0xFu; }
#define XB_SPIN(cond, bar) do { unsigned _sp = 0; while (cond) { __builtin_amdgcn_s_sleep(1); \
    if ((++_sp & 255u) == 0u) { if (xb_ld(&(bar)[XB_TMO])) break; if (_sp > XB_SPIN_CAP) { atomicAdd(&(bar)[XB_TMO], 1u); break; } } } } while (0)

struct XcdBarrier { unsigned* bar; unsigned x; volatile LAS unsigned* st; };

__device__ __forceinline__ XcdBarrier xcd_barrier_post(unsigned* bar, volatile LAS unsigned* st, const int tid) {
    XcdBarrier b; b.bar = bar; b.x = xb_xcc_id(); b.st = st;
    if (tid == 0) (void)xb_add(&bar[XB_XCNT(b.x)], 1u);
    return b;
}
__device__ __forceinline__ void xcd_barrier_complete(unsigned* bar, unsigned x, unsigned& nloc, unsigned& nx) {
    const unsigned G = gridDim.x * gridDim.y * gridDim.z;
    unsigned sum, cnt, mine, sp = 0u;
    for (;;) {
        sum = 0u; cnt = 0u; mine = 0u;
#pragma unroll
        for (unsigned j = 0; j < 16; ++j) { const unsigned c = xb_ld(&bar[XB_XCNT(j)]); sum += c; cnt += (c > 0u) ? 1u : 0u; mine = (j == x) ? c : mine; }
        if (sum == G) break;
        __builtin_amdgcn_s_sleep(1);
        if ((++sp & 255u) == 0u) { if (xb_ld(&bar[XB_TMO])) break; if (sp > XB_SPIN_CAP) { atomicAdd(&bar[XB_TMO], 1u); break; } }
    }
    nloc = mine > 0u ? mine : 1u; nx = cnt > 0u ? cnt : 1u;
}
__device__ __forceinline__ void xcd_barrier(const XcdBarrier& b, const int tid) {
    asm volatile("s_waitcnt vmcnt(0)" ::: "memory");
    __syncthreads();
    if (tid == 0) {
        unsigned* bar = b.bar;
        __builtin_amdgcn_s_waitcnt(0);
        unsigned nloc = b.st[0], nx = b.st[1];
        if (nloc == 0u) { xcd_barrier_complete(bar, b.x, nloc, nx); b.st[0] = nloc; b.st[1] = nx; }
        const unsigned old = xb_add(&bar[XB_XSUB(b.x)], 1u);
        const unsigned gen = old / nloc;
        if (old + 1u == (gen + 1u) * nloc) {
            __builtin_amdgcn_fence(__ATOMIC_RELEASE, "agent");
            asm volatile("s_waitcnt vmcnt(0)" ::: "memory");
            const unsigned og = xb_add(&bar[XB_TOP], 1u);
            const unsigned tg = og / nx;
            if (og + 1u == (tg + 1u) * nx) xb_add(&bar[XB_TOPGEN], 1u);
            else XB_SPIN(xb_ld(&bar[XB_TOPGEN]) == tg, bar);
            __builtin_amdgcn_fence(__ATOMIC_ACQUIRE, "agent");
            xb_add(&bar[XB_XGEN(b.x)], 1u);
            asm volatile("s_waitcnt vmcnt(0)" ::: "memory");
        } else {
            XB_SPIN(xb_ld(&bar[XB_XGEN(b.x)]) == gen, bar);
            __builtin_amdgcn_fence(__ATOMIC_ACQUIRE, "agent");
            asm volatile("s_waitcnt vmcnt(0)" ::: "memory");
        }
    }
    __syncthreads();
}

namespace pg8 {
constexpr int BM = 256, BK = 64, HALF = 128, HTB = HALF * BK * 2, STAGE_BYTES = 8 * HTB, NXCD = 8, WGM = 8;
__host__ __device__ __forceinline__ int lds_byte(int r, int c) { const int st = (r >> 4) * 2 + (c >> 5), rr = r & 15, cc = c & 31, ob = rr * 64 + cc * 2; return st * 1024 + (ob ^ (((ob >> 9) & 1) << 5)); }
__host__ __device__ __forceinline__ void stage_rc(int b, int& R, int& C) { const int st = b / 1024, sb = b % 1024, swz = sb ^ (((sb >> 9) & 1) << 5); R = (st >> 1) * 16 + swz / 64; C = (st & 1) * 32 + (swz % 64) / 2; }
__host__ __device__ __forceinline__ int perm32(int rho) { const int n = rho >> 4, i = rho & 15; return 8 * (i >> 2) + 4 * n + (i & 3); }

struct Unit { const bf16_t* A; const bf16_t* B; int pm, pn, aux; };

__device__ __forceinline__ void tile_order(int L, int nM, int nN, int& pm, int& pn) {
    const int nwg = nM * nN; int wgid = L;
    { const int q = nwg / NXCD, r = nwg % NXCD, xcd = wgid % NXCD, off = wgid / NXCD; wgid = (xcd < r ? xcd * (q + 1) : r * (q + 1) + (xcd - r) * q) + off; }
    const int nig = WGM * nN, gid = wgid / nig, fm = gid * WGM, gsz = (nM - fm) < WGM ? (nM - fm) : WGM;
    pm = fm + ((wgid % nig) % gsz); pn = (wgid % nig) / gsz;
}

typedef int i32x4 __attribute__((ext_vector_type(4)));
typedef int i32x8 __attribute__((ext_vector_type(8)));
__device__ __forceinline__ i32x8 cat8(const bf16x8 a, const bf16x8 b) { const i32x4 x = __builtin_bit_cast(i32x4, a), y = __builtin_bit_cast(i32x4, b); return __builtin_shufflevector(x, y, 0, 1, 2, 3, 4, 5, 6, 7); }
template <class Epi, class Sched, bool F8 = false>
__device__ __forceinline__ void gemm_phase(LAS unsigned char* lds, const int lda, const int ldb, const int K, const Sched& S, const Epi& E, const int tid) {
    const int wid = __builtin_amdgcn_readfirstlane(tid >> 6), lane = tid & 63, wr = wid >> 2, wc = wid & 3, fr = lane & 15, fq = lane >> 4;
    const int nt = K / BK;
    unsigned voffA[2], voffB[2];
#pragma unroll
    for (int i = 0; i < 2; ++i) { int R, C; stage_rc(tid * 16 + i * 8192, R, C); const int Rb = Epi::PERM ? ((R & ~31) + perm32(R & 31)) : R;
        voffA[i] = (unsigned)(R * lda + C) * 2u; voffB[i] = (unsigned)(Rb * ldb + C) * 2u; }
    const size_t kstep = (size_t)(BK * 2);
    const size_t hstepA = (size_t)HALF * lda * 2, hstepB = (size_t)HALF * ldb * 2;
    const unsigned ldsw = (unsigned)wid * 1024u;
    const int aoff = lds_byte(wr * 64 + fr, fq * 8), boff = lds_byte(wc * 32 + fr, fq * 8);
#define PG8_SA(b, h) (((b) * 2 + (h)) * HTB)
#define PG8_SB(b, h) ((4 + (b) * 2 + (h)) * HTB)
#define PG8_STAGE(bufoff, gbase, voff) do { _Pragma("unroll") for (int _i = 0; _i < 2; ++_i) \
        __builtin_amdgcn_global_load_lds((const unsigned*)((const char*)(gbase) + (voff)[_i]), (LAS unsigned*)(lds + (bufoff) + ldsw + _i * 8192), 16, 0, 0); } while (0)
#define PG8_LDA(dst, b, h) do { _Pragma("unroll") for (int m = 0; m < 4; ++m) { \
        if constexpr (F8) { const i32x4 lo_ = *(const LAS i32x4*)(lds + PG8_SA(b, h) + aoff + m * 2048), hi_ = *(const LAS i32x4*)(lds + PG8_SA(b, h) + aoff + m * 2048 + 1024); dst##8[m] = __builtin_shufflevector(lo_, hi_, 0, 1, 2, 3, 4, 5, 6, 7); } \
        else { _Pragma("unroll") for (int k = 0; k < 2; ++k) dst[m][k] = *(const LAS bf16x8*)(lds + PG8_SA(b, h) + aoff + m * 2048 + k * 1024); } } } while (0)
#define PG8_LDB(dst, b, h) do { _Pragma("unroll") for (int n = 0; n < 2; ++n) { \
        if constexpr (F8) { const i32x4 lo_ = *(const LAS i32x4*)(lds + PG8_SB(b, h) + boff + n * 2048), hi_ = *(const LAS i32x4*)(lds + PG8_SB(b, h) + boff + n * 2048 + 1024); dst##8[n] = __builtin_shufflevector(lo_, hi_, 0, 1, 2, 3, 4, 5, 6, 7); } \
        else { _Pragma("unroll") for (int k = 0; k < 2; ++k) dst[n][k] = *(const LAS bf16x8*)(lds + PG8_SB(b, h) + boff + n * 2048 + k * 1024); } } } while (0)
#define PG8_MMA(ai, bj, At, Bt) do { __builtin_amdgcn_s_setprio(1); _Pragma("unroll") for (int m = 0; m < 4; ++m) _Pragma("unroll") for (int n = 0; n < 2; ++n) { \
        if constexpr (F8) asm volatile("v_mfma_f32_16x16x128_f8f6f4 %0, %1, %2, %0" : "+v"(acc[ai][bj][m][n]) : "v"(Bt##8[n]), "v"(At##8[m])); \
        else { _Pragma("unroll") for (int k = 0; k < 2; ++k) acc[ai][bj][m][n] = __builtin_amdgcn_mfma_f32_16x16x32_bf16(Bt[n][k], At[m][k], acc[ai][bj][m][n], 0, 0, 0); } } \
        __builtin_amdgcn_s_setprio(0); } while (0)
#define PG8_WAIT_V(n) asm volatile("s_waitcnt vmcnt(" #n ")" ::: "memory")
#define PG8_WAIT_L(n) asm volatile("s_waitcnt lgkmcnt(" #n ")" ::: "memory")
#define PG8_BAR __builtin_amdgcn_s_barrier()
#define PG8_SCHED __builtin_amdgcn_sched_barrier(0)
    Unit cur, nxt; int ui = 0;
    if (!S.next(0, cur)) return;
    f32x4 acc[2][2][4][2];
#pragma unroll
    for (int a = 0; a < 2; ++a)
#pragma unroll
        for (int b = 0; b < 2; ++b)
#pragma unroll
            for (int m = 0; m < 4; ++m)
#pragma unroll
                for (int n = 0; n < 2; ++n) acc[a][b][m][n] = (f32x4){0.f, 0.f, 0.f, 0.f};
    bf16x8 At[4][2], B0[2][2], B1[2][2]; i32x8 At8[4], B08[2], B18[2];
    const char* cA = (const char*)cur.A; const char* cB = (const char*)cur.B;
    PG8_STAGE(PG8_SB(0, 0), cB, voffB); PG8_STAGE(PG8_SA(0, 0), cA, voffA); PG8_STAGE(PG8_SB(0, 1), cB + hstepB, voffB); PG8_STAGE(PG8_SA(0, 1), cA + hstepA, voffA);
    if (wr == 1) PG8_BAR;
    PG8_WAIT_V(4); PG8_BAR;
    PG8_STAGE(PG8_SB(1, 0), cB + kstep, voffB); PG8_STAGE(PG8_SA(1, 0), cA + kstep, voffA); PG8_STAGE(PG8_SB(1, 1), cB + hstepB + kstep, voffB);
    PG8_WAIT_V(6); PG8_BAR;
    for (;;) {
        const bool has_next = S.next(ui + 1, nxt);
        const char* nA = has_next ? (const char*)nxt.A : cA; const char* nB = has_next ? (const char*)nxt.B : cB;
#pragma nounroll
        for (int t = 0; t < nt; t += 2) {
            const bool last = (t == nt - 2);
            const char* a1 = cA + (size_t)(t + 1) * kstep;
            const char* a2 = last ? nA : cA + (size_t)(t + 2) * kstep; const char* b2 = last ? nB : cB + (size_t)(t + 2) * kstep;
            const char* a3 = a2 + kstep; const char* b3 = b2 + kstep;
            PG8_LDB(B0, 0, 0); PG8_SCHED; PG8_LDA(At, 0, 0); PG8_STAGE(PG8_SA(1, 1), a1 + hstepA, voffA);
            PG8_WAIT_L(8); PG8_BAR; PG8_WAIT_L(0); PG8_MMA(0, 0, At, B0); PG8_BAR; PG8_SCHED;
            PG8_LDB(B1, 0, 1); PG8_STAGE(PG8_SB(0, 0), b2, voffB);
            PG8_BAR; PG8_WAIT_L(0); PG8_MMA(0, 1, At, B1); PG8_BAR;
            PG8_LDA(At, 0, 1); PG8_STAGE(PG8_SA(0, 0), a2, voffA);
            PG8_BAR; PG8_WAIT_L(0); PG8_MMA(1, 0, At, B0); PG8_BAR; PG8_SCHED;
            PG8_STAGE(PG8_SB(0, 1), b2 + hstepB, voffB);
            PG8_WAIT_V(6); PG8_BAR; PG8_MMA(1, 1, At, B1); PG8_BAR;
            PG8_LDB(B0, 1, 0); PG8_SCHED; PG8_LDA(At, 1, 0); PG8_STAGE(PG8_SA(0, 1), a2 + hstepA, voffA);
            PG8_WAIT_L(8); PG8_BAR; PG8_WAIT_L(0); PG8_MMA(0, 0, At, B0); PG8_BAR; PG8_SCHED;
            PG8_LDB(B1, 1, 1); PG8_STAGE(PG8_SB(1, 0), b3, voffB);
            PG8_BAR; PG8_WAIT_L(0); PG8_MMA(0, 1, At, B1); PG8_BAR;
            PG8_LDA(At, 1, 1); PG8_STAGE(PG8_SA(1, 0), a3, voffA);
            PG8_BAR; PG8_WAIT_L(0); PG8_MMA(1, 0, At, B0); PG8_BAR; PG8_SCHED;
            PG8_STAGE(PG8_SB(1, 1), b3 + hstepB, voffB);
            PG8_WAIT_V(6); PG8_BAR; PG8_MMA(1, 1, At, B1); PG8_BAR;
        }
        if constexpr (F8) asm volatile("s_nop 15\n\ts_nop 15" ::: "memory");
        { int l_e = (int)__builtin_amdgcn_mbcnt_hi(~0u, __builtin_amdgcn_mbcnt_lo(~0u, 0u)); asm volatile("" : "+v"(l_e)); int fr_e = l_e & 15, fq_e = l_e >> 4;
          E(acc, cur, wr, wc, fr_e, fq_e); }
        if (!has_next) break;
#pragma unroll
        for (int a = 0; a < 2; ++a)
#pragma unroll
            for (int b = 0; b < 2; ++b)
#pragma unroll
                for (int m = 0; m < 4; ++m)
#pragma unroll
                    for (int n = 0; n < 2; ++n) acc[a][b][m][n] = (f32x4){0.f, 0.f, 0.f, 0.f};
        cur = nxt; cA = nA; cB = nB; ++ui;
    }
    PG8_WAIT_V(0);
    if (wr == 0) PG8_BAR;
    PG8_BAR;
#undef PG8_SA
#undef PG8_SB
#undef PG8_STAGE
#undef PG8_LDA
#undef PG8_LDB
#undef PG8_MMA
#undef PG8_WAIT_V
#undef PG8_WAIT_L
#undef PG8_BAR
#undef PG8_SCHED
}
}
namespace pg8 {
typedef f32x4 Acc[2][2][4][2];
__device__ __forceinline__ void st_bf16x8(bf16_t* p, f32x4 v0, f32x4 v1) {
    u32x4 w; w.x = cvtpk(v0[0], v0[1]); w.y = cvtpk(v0[2], v0[3]); w.z = cvtpk(v1[0], v1[1]); w.w = cvtpk(v1[2], v1[3]);
    *(u32x4*)p = w;
}
#define EPI_BF16_LOOP(...) \
    _Pragma("unroll") for (int ai = 0; ai < 2; ++ai) \
    _Pragma("unroll") for (int m = 0; m < 4; ++m) { int r = ai * 128 + wr * 64 + m * 16 + fr; asm volatile("" : "+v"(r)); \
    _Pragma("unroll") for (int bj = 0; bj < 2; ++bj) { f32x4 v0 = acc[ai][bj][m][0], v1 = acc[ai][bj][m][1]; const int colh = wc * 32 + 8 * fq; (void)colh; __VA_ARGS__ } }
#define EPI_F32_LOOP(...) \
    _Pragma("unroll") for (int ai = 0; ai < 2; ++ai) \
    _Pragma("unroll") for (int m = 0; m < 4; ++m) { int r = ai * 128 + wr * 64 + m * 16 + fr; asm volatile("" : "+v"(r)); \
    _Pragma("unroll") for (int bj = 0; bj < 2; ++bj) \
    _Pragma("unroll") for (int n = 0; n < 2; ++n) { f32x4 v = acc[ai][bj][m][n]; const int col = bj * 128 + wc * 32 + n * 16 + 4 * fq; (void)col; __VA_ARGS__ } }

struct EpiPA {
    static constexpr bool PERM = true;
    bf16_t *MQK, *MLO, *XQ, *VC; float sc;
    __device__ __forceinline__ void operator()(const Acc& acc, const Unit& u, int wr, int wc, int fr, int fq) const {
        bf16_t* base; size_t ldc;
        if (u.aux == 0) {
            if (u.pn < 8)       { base = MQK + (size_t)u.pm * 256 * 2048 + u.pn * 256; ldc = 2048; }
            else if (u.pn < 12) { base = MLO + (size_t)u.pm * 256 * 1024 + (u.pn - 8) * 256; ldc = 1024; }
            else                { base = XQ + ((size_t)(u.pn - 12) * TT + (size_t)u.pm * 256) * 256; ldc = 256; }
        } else                  { base = VC + ((size_t)(u.pm * 128 + u.pn) * 256) * 512; ldc = 512; }
        EPI_BF16_LOOP( v0 *= sc; v1 *= sc; st_bf16x8(base + (size_t)r * ldc + bj * 128 + colh, v0, v1); )
    }
};
struct EpiMem {
    static constexpr bool PERM = true;
    bf16_t *MK, *MVT;
    __device__ __forceinline__ void operator()(const Acc& acc, const Unit& u, int wr, int wc, int fr, int fq) const {
        bf16_t* base = (u.aux == 0) ? MK + (size_t)(u.pm * 4 + u.pn) * 65536 : MVT + (size_t)(u.pn * 4 + u.pm) * 65536;
        EPI_BF16_LOOP( st_bf16x8(base + (size_t)r * 256 + bj * 128 + colh, v0, v1); )
    }
};
struct EpiPB {
    static constexpr bool PERM = true;
    bf16_t *DQ, *DK, *DV;
    __device__ __forceinline__ void operator()(const Acc& acc, const Unit& u, int wr, int wc, int fr, int fq) const {
        const int which = u.pn >> 3, c0 = (u.pn & 7) * 2;
        bf16_t* buf = DQ + (size_t)which * ((WS_DK - WS_DQ) / 2);
        EPI_BF16_LOOP( st_bf16x8(buf + ((size_t)(c0 + bj) * TT + (size_t)u.pm * 256 + r) * 128 + colh, v0, v1); )
    }
};
struct EpiF32Tile {
    static constexpr bool PERM = false;
    float* C; size_t off_pm, off_pn, off_aux; int ldc;
    __device__ __forceinline__ void operator()(const Acc& acc, const Unit& u, int wr, int wc, int fr, int fq) const {
        float* base = C + (size_t)u.pm * off_pm + (size_t)u.pn * off_pn + (size_t)u.aux * off_aux;
        EPI_F32_LOOP( *(f32x4*)(base + (size_t)r * ldc + col) = v; )
    }
};
struct EpiB16Tile {
    static constexpr bool PERM = true;
    bf16_t* C; size_t off_pm, off_pn, off_aux; int ldc; float sc;
    __device__ __forceinline__ void operator()(const Acc& acc, const Unit& u, int wr, int wc, int fr, int fq) const {
        bf16_t* base = C + (size_t)u.pm * off_pm + (size_t)u.pn * off_pn + (size_t)u.aux * off_aux;
        EPI_BF16_LOOP( v0 *= sc; v1 *= sc; st_bf16x8(base + (size_t)r * ldc + bj * 128 + colh, v0, v1); )
    }
};
constexpr int EPI_TBL_OFF = RING_BYTES + 4096;
#define EPI_XBAR() do { asm volatile("s_waitcnt lgkmcnt(0)" ::: "memory"); __builtin_amdgcn_s_barrier(); asm volatile("" ::: "memory"); } while (0)
struct EpiXSoft {
    static constexpr bool PERM = true;
    bf16_t* XP; LAS float* tbl;
    __device__ __forceinline__ void operator()(const Acc& acc, const Unit& u, int wr, int wc, int fr, int fq) const {
        LAS float* TM = tbl; LAS float* TS = tbl + 1024;
        const int colh = wc * 32 + 8 * fq;
        float mloc[2][4];
#pragma unroll
        for (int ai = 0; ai < 2; ++ai)
#pragma unroll
            for (int m = 0; m < 4; ++m) { const int r = ai * 128 + wr * 64 + m * 16 + fr; float mx = -__builtin_inff();
#pragma unroll
                for (int bj = 0; bj < 2; ++bj)
#pragma unroll
                    for (int n = 0; n < 2; ++n) { const f32x4 v = acc[ai][bj][m][n]; mx = fmaxf(mx, fmaxf(fmaxf(v[0], v[1]), fmaxf(v[2], v[3]))); }
                mx = xmax16(mx); mx = xmax32(mx);
                if (fq == 0) TM[r * 4 + wc] = mx; mloc[ai][m] = mx; }
        EPI_XBAR();
        f32x4 ev[2][4][2][2];
#pragma unroll
        for (int ai = 0; ai < 2; ++ai)
#pragma unroll
            for (int m = 0; m < 4; ++m) { const int r = ai * 128 + wr * 64 + m * 16 + fr;
                const f32x4 t4 = *(const LAS f32x4*)(TM + r * 4); const float mx = fmaxf(fmaxf(t4[0], t4[1]), fmaxf(t4[2], t4[3])) * 0.0625f; float s = 0.f;
#pragma unroll
                for (int bj = 0; bj < 2; ++bj)
#pragma unroll
                    for (int n = 0; n < 2; ++n) { f32x4 v = acc[ai][bj][m][n];
#pragma unroll
                        for (int j = 0; j < 4; ++j) { v[j] = __expf(v[j] * 0.0625f - mx); s += v[j]; }
                        ev[ai][m][bj][n] = v; }
                s = xsum16(s); s = xsum32(s);
                if (fq == 0) TS[r * 4 + wc] = s; }
        EPI_XBAR();
        const size_t t0 = (size_t)u.aux * TT + (size_t)u.pm * 256;
#pragma unroll
        for (int ai = 0; ai < 2; ++ai)
#pragma unroll
            for (int m = 0; m < 4; ++m) { const int r = ai * 128 + wr * 64 + m * 16 + fr;
                const f32x4 t4 = *(const LAS f32x4*)(TS + r * 4); const float inv = 1.0f / ((t4[0] + t4[1]) + (t4[2] + t4[3]));
#pragma unroll
                for (int bj = 0; bj < 2; ++bj) st_bf16x8(XP + (t0 + r) * 256 + bj * 128 + colh, ev[ai][m][bj][0] * inv, ev[ai][m][bj][1] * inv); }
    }
};
struct EpiHNorm {
    static constexpr bool PERM = true;
    bf16_t* HM; const float* HDEN; const bf16_t* MLO; const float* G; LAS float* tbl;
    __device__ __forceinline__ void operator()(const Acc& acc, const Unit& u, int wr, int wc, int fr, int fq) const {
        LAS float* TQ = tbl;
        const size_t t0 = (size_t)u.pm * 256; const int colh = wc * 32 + 8 * fq;
        float inv[2][4];
#pragma unroll
        for (int ai = 0; ai < 2; ++ai)
#pragma unroll
            for (int m = 0; m < 4; ++m) inv[ai][m] = HDEN[(size_t)u.aux * TT + t0 + ai * 128 + wr * 64 + m * 16 + fr];
        asm volatile("" : "+v"(inv[0][0]), "+v"(inv[0][1]), "+v"(inv[0][2]), "+v"(inv[0][3]), "+v"(inv[1][0]), "+v"(inv[1][1]), "+v"(inv[1][2]), "+v"(inv[1][3]));
#pragma unroll
        for (int ai = 0; ai < 2; ++ai)
#pragma unroll
            for (int m = 0; m < 4; ++m) { const int r = ai * 128 + wr * 64 + m * 16 + fr; const float iv = 1.0f / inv[ai][m]; inv[ai][m] = iv; float q = 0.f;
#pragma unroll
                for (int bj = 0; bj < 2; ++bj)
#pragma unroll
                    for (int n = 0; n < 2; ++n) { const f32x4 v = acc[ai][bj][m][n] * iv; q += (v[0] * v[0] + v[1] * v[1]) + (v[2] * v[2] + v[3] * v[3]); }
                q = xsum16(q); q = xsum32(q);
                if (fq == 0) TQ[r * 4 + wc] = q; }
        EPI_XBAR();
        f32x4 gg[2][2];
#pragma unroll
        for (int bj = 0; bj < 2; ++bj) { gg[bj][0] = *(const f32x4*)(G + u.aux * 256 + bj * 128 + colh); gg[bj][1] = *(const f32x4*)(G + u.aux * 256 + bj * 128 + colh + 4); }
#pragma unroll
        for (int ai = 0; ai < 2; ++ai) {
            u32x4 ogv[4][2];
#pragma unroll
            for (int m = 0; m < 4; ++m)
#pragma unroll
                for (int bj = 0; bj < 2; ++bj) ogv[m][bj] = *(const u32x4*)(MLO + (t0 + ai * 128 + wr * 64 + m * 16 + fr) * 1024 + u.aux * 256 + bj * 128 + colh);
#pragma unroll
            for (int m = 0; m < 4; ++m) { const int r = ai * 128 + wr * 64 + m * 16 + fr;
                const f32x4 t4 = *(const LAS f32x4*)(TQ + r * 4); const float rs = rsqrtf(((t4[0] + t4[1]) + (t4[2] + t4[3])) * (1.0f / 256.0f) + EPS) * inv[ai][m];
#pragma unroll
                for (int bj = 0; bj < 2; ++bj) { const size_t o = (t0 + r) * 1024 + u.aux * 256 + bj * 128 + colh; const u32x4 og = ogv[m][bj];
                    const f32x4 g0 = gg[bj][0], g1 = gg[bj][1];
                    f32x4 v0 = acc[ai][bj][m][0] * rs, v1 = acc[ai][bj][m][1] * rs;
                    v0[0] *= sigmoidf_(bflo(og.x)) * g0[0]; v0[1] *= sigmoidf_(bfhi(og.x)) * g0[1]; v0[2] *= sigmoidf_(bflo(og.y)) * g0[2]; v0[3] *= sigmoidf_(bfhi(og.y)) * g0[3];
                    v1[0] *= sigmoidf_(bflo(og.z)) * g1[0]; v1[1] *= sigmoidf_(bfhi(og.z)) * g1[1]; v1[2] *= sigmoidf_(bflo(og.w)) * g1[2]; v1[3] *= sigmoidf_(bfhi(og.w)) * g1[3];
                    st_bf16x8(HM + o, v0, v1); } } }
    }
};
struct EpiW {
    static constexpr bool PERM = true;
    bf16_t* WQ; const float* RS;
    __device__ __forceinline__ void operator()(const Acc& acc, const Unit& u, int wr, int wc, int fr, int fq) const {
        const size_t trow = (size_t)u.aux * TT + (size_t)u.pm * 256;
        const int colh = wc * 32 + 8 * fq;
        float rsv[2][4];
#pragma unroll
        for (int ai = 0; ai < 2; ++ai)
#pragma unroll
            for (int m = 0; m < 4; ++m) rsv[ai][m] = RS[trow + ai * 128 + wr * 64 + m * 16 + fr];
#pragma unroll
        for (int ai = 0; ai < 2; ++ai)
#pragma unroll
            for (int m = 0; m < 4; ++m) { int r = ai * 128 + wr * 64 + m * 16 + fr; asm volatile("" : "+v"(r)); const float rs = rsv[ai][m];
#pragma unroll
                for (int bj = 0; bj < 2; ++bj) { f32x4 v0 = acc[ai][bj][m][0], v1 = acc[ai][bj][m][1]; const int c = bj * 128 + colh; const float fl = (float)(r - c + 1);
#pragma unroll
                    for (int j = 0; j < 4; ++j) { v0[j] = v0[j] * (rs * __saturatef(fl - (float)j)); v1[j] = v1[j] * (rs * __saturatef(fl - (float)(4 + j))); }
                    st_bf16x8(WQ + (trow + r) * 512 + c, v0, v1);
                    } }
    }
};
struct EpiH {
    static constexpr bool PERM = true;
    bf16_t* HR; const float* HDEN;
    __device__ __forceinline__ void operator()(const Acc& acc, const Unit& u, int wr, int wc, int fr, int fq) const {
        const size_t t0 = (size_t)u.pm * 256;
        EPI_BF16_LOOP( const float inv = 1.0f / HDEN[(size_t)u.aux * TT + t0 + r];
            v0 *= inv; v1 *= inv; st_bf16x8(HR + (t0 + r) * 1024 + u.aux * 256 + bj * 128 + colh, v0, v1); )
    }
};
struct EpiXA {
    static constexpr bool PERM = true;
    bf16_t* XA;
    __device__ __forceinline__ void operator()(const Acc& acc, const Unit& u, int wr, int wc, int fr, int fq) const {
        const size_t t0 = (size_t)u.pm * 256;
        EPI_BF16_LOOP( st_bf16x8(XA + (t0 + r) * 1024 + u.aux * 256 + bj * 128 + colh, v0, v1); )
    }
};
struct EpiGate {
    static constexpr bool PERM = true;
    bf16_t* GT; const float* bg; float dsc;
    __device__ __forceinline__ void operator()(const Acc& acc, const Unit& u, int wr, int wc, int fr, int fq) const {
        const size_t t0 = (size_t)u.pm * 256;
        constexpr float L2E = 1.4426950408889634f; const float ns = -dsc * L2E;
        f32x4 bb[2][2];
#pragma unroll
        for (int bj = 0; bj < 2; ++bj) { const int c = u.pn * 256 + bj * 128 + wc * 32 + 8 * fq; bb[bj][0] = *(const f32x4*)(bg + c) * (-L2E); bb[bj][1] = *(const f32x4*)(bg + c + 4) * (-L2E); }
        EPI_BF16_LOOP( const int c = u.pn * 256 + bj * 128 + colh; const f32x4 b0 = bb[bj][0], b1 = bb[bj][1];
            _Pragma("unroll") for (int j = 0; j < 4; ++j) { v0[j] = __builtin_amdgcn_rcpf(1.0f + __builtin_amdgcn_exp2f(fmaf(v0[j], ns, b0[j]))); v1[j] = __builtin_amdgcn_rcpf(1.0f + __builtin_amdgcn_exp2f(fmaf(v1[j], ns, b1[j]))); }
            st_bf16x8(GT + (t0 + r) * 2048 + c, v0, v1); )
    }
};
template <bool FIRST> struct EpiBranch {
    static constexpr bool PERM = true;
    const bf16_t* GT; bf16_t* MG; float dsc;
    __device__ __forceinline__ void operator()(const Acc& acc, const Unit& u, int wr, int wc, int fr, int fq) const {
        const size_t t0 = (size_t)u.pm * 256; const int colh = wc * 32 + 8 * fq;
#pragma unroll
        for (int ai = 0; ai < 2; ++ai) {
            int rb = ai * 128 + wr * 64 + fr; asm volatile("" : "+v"(rb));
            const size_t ob = (t0 + rb) * 2048 + u.pn * 256 + colh;
            u32x4 g[4][2], p[4][2];
#pragma unroll
            for (int m = 0; m < 4; ++m)
#pragma unroll
                for (int bj = 0; bj < 2; ++bj) { const size_t o = ob + (size_t)m * 16 * 2048 + bj * 128; g[m][bj] = *(const u32x4*)(GT + o); if (!FIRST) p[m][bj] = *(const u32x4*)(MG + o); }
#pragma unroll
            for (int m = 0; m < 4; ++m)
#pragma unroll
                for (int bj = 0; bj < 2; ++bj) { const size_t o = ob + (size_t)m * 16 * 2048 + bj * 128; f32x4 v0 = acc[ai][bj][m][0] * dsc, v1 = acc[ai][bj][m][1] * dsc; const u32x4 gg = g[m][bj];
                    v0[0] *= bflo(gg.x); v0[1] *= bfhi(gg.x); v0[2] *= bflo(gg.y); v0[3] *= bfhi(gg.y); v1[0] *= bflo(gg.z); v1[1] *= bfhi(gg.z); v1[2] *= bflo(gg.w); v1[3] *= bfhi(gg.w);
                    if (!FIRST) { const u32x4 pp = p[m][bj];
                        v0[0] += bflo(pp.x); v0[1] += bfhi(pp.x); v0[2] += bflo(pp.y); v0[3] += bfhi(pp.y); v1[0] += bflo(pp.z); v1[1] += bfhi(pp.z); v1[2] += bflo(pp.w); v1[3] += bfhi(pp.w); }
                    st_bf16x8(MG + o, v0, v1); }
        }
    }
};
struct EpiOut {
    static constexpr bool PERM = true;
    const float* X; bf16_t* X1B; float* RSS;
    __device__ __forceinline__ void operator()(const Acc& acc, const Unit& u, int wr, int wc, int fr, int fq) const {
        const size_t t0 = (size_t)u.pm * 256; const int colh = wc * 32 + 8 * fq;
#pragma unroll
        for (int ai = 0; ai < 2; ++ai) {
            int rb = ai * 128 + wr * 64 + fr; asm volatile("" : "+v"(rb));
            const size_t ob = (t0 + rb) * 2048 + u.pn * 256 + colh;
            f32x4 x0[4][2], x1[4][2];
#pragma unroll
            for (int m = 0; m < 4; ++m)
#pragma unroll
                for (int bj = 0; bj < 2; ++bj) { const size_t o = ob + (size_t)m * 16 * 2048 + bj * 128; x0[m][bj] = *(const f32x4*)(X + o); x1[m][bj] = *(const f32x4*)(X + o + 4); }
#pragma unroll
            for (int m = 0; m < 4; ++m) { float ss = 0.f;
#pragma unroll
                for (int bj = 0; bj < 2; ++bj) { const size_t o = ob + (size_t)m * 16 * 2048 + bj * 128;
                    const f32x4 v0 = acc[ai][bj][m][0] + x0[m][bj], v1 = acc[ai][bj][m][1] + x1[m][bj];
                    u32x4 w; w.x = cvtpk(v0[0], v0[1]); w.y = cvtpk(v0[2], v0[3]); w.z = cvtpk(v1[0], v1[1]); w.w = cvtpk(v1[2], v1[3]);
                    *(u32x4*)(X1B + o) = w;
                    ss += ((bflo(w.x) * bflo(w.x) + bfhi(w.x) * bfhi(w.x)) + (bflo(w.y) * bflo(w.y) + bfhi(w.y) * bfhi(w.y))) + ((bflo(w.z) * bflo(w.z) + bfhi(w.z) * bfhi(w.z)) + (bflo(w.w) * bflo(w.w) + bfhi(w.w) * bfhi(w.w))); }
                ss = xsum16(ss); ss = xsum32(ss);
                if (fq == 0) RSS[(t0 + rb + m * 16) * 32 + u.pn * 4 + wc] = ss; }
        }
    }
};
struct EpiGU {
    static constexpr bool PERM = true;
    unsigned char* HD;
    __device__ __forceinline__ void operator()(const Acc& acc, const Unit& u, int wr, int wc, int fr, int fq) const {
        const size_t t0 = (size_t)u.pm * 256; const int colh = wc * 32 + 8 * fq;
#pragma unroll
        for (int ai = 0; ai < 2; ++ai)
#pragma unroll
            for (int m = 0; m < 4; ++m) { int r = ai * 128 + wr * 64 + m * 16 + fr; asm volatile("" : "+v"(r));
                f32x4 g0 = acc[ai][0][m][0], g1 = acc[ai][0][m][1]; const f32x4 u0 = acc[ai][1][m][0], u1 = acc[ai][1][m][1];
#pragma unroll
                for (int j = 0; j < 4; ++j) { const float a0 = g0[j] * (1.0f / 32.0f), a1 = g1[j] * (1.0f / 32.0f); g0[j] = a0 * sigmoidf_(a0) * (u0[j] * 0.25f); g1[j] = a1 * sigmoidf_(a1) * (u1[j] * 0.25f); }
                u32x2 w; w.x = pk4_fp8(g0[0], g0[1], g0[2], g0[3]); w.y = pk4_fp8(g1[0], g1[1], g1[2], g1[3]);
                *(u32x2*)(HD + (t0 + r) * DEXP_P + u.pn * 128 + colh) = w; }
    }
};
struct EpiDown {
    static constexpr bool PERM = true;
    unsigned char* YS; const float* WROW;
    __device__ __forceinline__ void operator()(const Acc& acc, const Unit& u, int wr, int wc, int fr, int fq) const {
        const size_t t0 = (size_t)u.pm * 256;
        float wv[2][4];
#pragma unroll
        for (int ai = 0; ai < 2; ++ai)
#pragma unroll
            for (int m = 0; m < 4; ++m) wv[ai][m] = WROW[t0 + ai * 128 + wr * 64 + m * 16 + fr] * (64.0f / 128.0f);
        EPI_BF16_LOOP( const float w = wv[ai][m]; v0 *= w; v1 *= w;
            u32x2 o; o.x = pk4_fp8(v0[0], v0[1], v0[2], v0[3]); o.y = pk4_fp8(v1[0], v1[1], v1[2], v1[3]); *(u32x2*)(YS + (t0 + r) * 2048 + u.pn * 256 + bj * 128 + colh) = o; )
    }
};

struct SchedDense {
    const bf16_t* A0; const bf16_t* B0; int lda, ldb, nM, nN, G, c;
    __device__ __forceinline__ bool next(int i, Unit& u) const {
        const int L = i * G + c; if (L >= nM * nN) return false;
        tile_order(L, nM, nN, u.pm, u.pn); u.aux = 0;
        u.A = A0 + (size_t)u.pm * 256 * lda; u.B = B0 + (size_t)u.pn * 256 * ldb; return true;
    }
};
struct SchedRouter {
    const bf16_t* X; const bf16_t* W; int G, c;
    __device__ __forceinline__ bool next(int i, Unit& u) const {
        const int L = i * G + c; if (L >= 256) return false;
        u.pm = L >> 1; u.pn = L & 1; u.aux = 0;
        u.A = X + (size_t)u.pm * 256 * 2048 + u.pn * 1024; u.B = W + u.pn * 1024; return true;
    }
};
struct SchedPA {
    const bf16_t* HBF; const bf16_t* WINT; int G, c;
    __device__ __forceinline__ bool next(int i, Unit& u) const {
        const int L = i * G + c;
        if (L < 1024) { tile_order(L, 128, 8, u.pm, u.pn); u.aux = 0; u.A = HBF + (size_t)u.pm * 256 * 2048; u.B = WINT + (size_t)(6144 + u.pn * 256) * 2048; return true; }
        if (L < 1536) { const int q = L - 1024; u.pm = q & 3; u.pn = q >> 2; u.aux = 1; u.A = WINT + (size_t)(10240 + u.pm * 256) * 2048; u.B = HBF + (size_t)u.pn * 256 * 2048; return true; }
        return false;
    }
};
struct SchedPA8 {
    const bf16_t* H8; const bf16_t* W8; int G, c;
    __device__ __forceinline__ bool next(int i, Unit& u) const {
        const int L = i * G + c; if (L >= 1024) return false;
        int pn; tile_order(L, 128, 8, u.pm, pn); u.pn = pn + 8; u.aux = 0; u.A = H8 + (size_t)u.pm * 256 * 1024; u.B = W8 + (size_t)pn * 256 * 1024; return true;
    }
};
struct SchedMem {
    const bf16_t* MEMN; const bf16_t* WMEMT; int G, c;
    __device__ __forceinline__ bool next(int i, Unit& u) const {
        const int L = i * G + c; if (L >= 16) return false;
        if (L < 8) { u.aux = 0; u.pm = L >> 2; u.pn = L & 3; u.A = MEMN + (size_t)u.pm * 256 * 2048; u.B = WMEMT + (size_t)u.pn * 256 * 2048; }
        else { const int q = L - 8; u.aux = 1; u.pm = q & 3; u.pn = q >> 2; u.A = WMEMT + (size_t)(1024 + u.pm * 256) * 2048; u.B = MEMN + (size_t)u.pn * 256 * 2048; }
        return true;
    }
};
struct SchedHG {
    const bf16_t* A0; const bf16_t* B0; size_t sa_h, sa_g, sb_h, sb_g; int G, c;
    __device__ __forceinline__ bool next(int i, Unit& u) const {
        const int L = i * G + c; if (L >= 512) return false;
        const int hh = L >> 7, g = L & 127; u.aux = hh; u.pm = g; u.pn = 0;
        u.A = A0 + (size_t)hh * sa_h + (size_t)g * sa_g; u.B = B0 + (size_t)hh * sb_h + (size_t)g * sb_g; return true;
    }
};
struct SchedXA {
    const bf16_t* A0; const bf16_t* B0; int G, c;
    __device__ __forceinline__ bool next(int i, Unit& u) const {
        const int L = i * G + c; if (L >= 512) return false;
        const int hh = L >> 7, pm = L & 127; u.aux = hh; u.pm = pm; u.pn = 0;
        u.A = A0 + ((size_t)hh * TT + (size_t)pm * 256) * 256; u.B = B0 + (size_t)((pm >> 6) * 4 + hh) * 65536; return true;
    }
};
struct SchedMoE {
    const bf16_t* A0; const bf16_t* B0; const LAS int* unit_e; int nrt, NT, lda; size_t eb_stride, nb_stride; int G, c;
    __device__ __forceinline__ bool next(int i, Unit& u) const {
        const int L = i * G + c; if (L >= nrt * NT) return false;
        const int rt = L / NT, pn = L - rt * NT; const int e = __builtin_amdgcn_readfirstlane(unit_e[i]);
        u.pm = rt; u.pn = pn; u.aux = e; u.A = A0 + (size_t)rt * 256 * lda; u.B = B0 + (size_t)e * eb_stride + (size_t)pn * nb_stride; return true;
    }
};
}
namespace attn {
constexpr int D = 128;
constexpr float THR = 8.f;
constexpr float SCALE = 0.08838834764831845f;
constexpr int NW = 8, QBLK = 32, KVBLK = 64, QB = NW * QBLK;
constexpr int SHM_V = KVBLK * D * 2, SHM_K = KVBLK * D * 2;
constexpr int LDS_BYTES = 2 * SHM_V + 2 * SHM_K + NW * 64 * 4;
typedef bf16_t bf16;

#define KSWZ(row, colB) ((row) * 256 + ((colB) ^ (((row) & 7) << 4)))
#define SBAR() __builtin_amdgcn_sched_barrier(0)
__device__ __forceinline__ int v_st(int k, int c) { const int kk = (k & ~0xC) | ((k & 4) << 1) | ((k & 8) >> 1); return ((kk >> 3) * 4 + (c >> 5)) * 512 + ((kk & 7) * 32 + (c & 31)) * 2; }
__device__ __forceinline__ int v_rd_base(int lane) { return ((lane & 3) << 3) | (((lane >> 2) & 3) << 6) | (((lane >> 4) & 1) << 5) | (((lane >> 5) & 1) << 8); }
constexpr int v_rd_off(int d0, int ks, int half) { return d0 * 512 + ks * 4096 + half * 2048; }
__device__ __forceinline__ int crow(int r, int hi) { return (r & 3) + 8 * (r >> 2) + 4 * hi; }
__device__ __forceinline__ bf16x8 load8(const bf16* p) { return *reinterpret_cast<const bf16x8*>(p); }

__device__ __forceinline__ void mask_tile(f32x16& p0, f32x16& p1, int dq, unsigned W) {
    const float NEG = -__builtin_inff();
#pragma unroll
    for (int r = 0; r < 16; ++r) {
        const int c = (r & 3) + 8 * (r >> 2);
        if ((unsigned)(dq - c) >= W) p0[r] = NEG;
        if ((unsigned)(dq - c - 32) >= W) p1[r] = NEG;
    }
}
__device__ __forceinline__ void partialSM(f32x16& p0, f32x16& p1, float& m_reg, float& mn, float& alpha) {
    float pmax = p0[0]; for (int r = 1; r < 16; ++r) pmax = fmaxf(pmax, p0[r]); for (int r = 0; r < 16; ++r) pmax = fmaxf(pmax, p1[r]);
    { auto rr = __builtin_amdgcn_permlane32_swap(__float_as_uint(pmax), __float_as_uint(pmax), false, false);
      pmax = fmaxf(__uint_as_float(rr[0]), __uint_as_float(rr[1])); }
    constexpr float C2 = 1.4426950408889634f * SCALE;
    if (__builtin_expect(__all((pmax - m_reg) * SCALE <= THR), 1)) { mn = m_reg; alpha = 1.f; }
    else { mn = fmaxf(m_reg, pmax); alpha = __builtin_amdgcn_exp2f((m_reg - mn) * C2); m_reg = mn; }
    const float mnL = -mn * C2;
    for (int r = 0; r < 16; ++r) p0[r] = fmaf(p0[r], C2, mnL); for (int r = 0; r < 16; ++r) p1[r] = fmaf(p1[r], C2, mnL);
    for (int r = 0; r < 16; ++r) p0[r] = __builtin_amdgcn_exp2f(p0[r]);
}
__device__ __forceinline__ void finishSM(f32x16& p0, f32x16& p1, float alpha, float& l_reg, bf16x8& pa0, bf16x8& pa1, bf16x8& pa2, bf16x8& pa3) {
    for (int r = 0; r < 16; ++r) p1[r] = __builtin_amdgcn_exp2f(p1[r]);
    float ps = 0; for (int r = 0; r < 16; ++r) ps += p0[r]; for (int r = 0; r < 16; ++r) ps += p1[r];
    { auto rr = __builtin_amdgcn_permlane32_swap(__float_as_uint(ps), __float_as_uint(ps), false, false);
      ps = __uint_as_float(rr[0]) + __uint_as_float(rr[1]); }
    l_reg = l_reg * alpha + ps;
#define PK4(P, B_, OUT) do { unsigned a0 = cvtpk(P[B_+0], P[B_+1]), a1 = cvtpk(P[B_+2], P[B_+3]);                          \
        unsigned b0 = cvtpk(P[B_+4], P[B_+5]), b1 = cvtpk(P[B_+6], P[B_+7]);                                             \
        auto r0 = __builtin_amdgcn_permlane32_swap(a0, b0, false, false); auto r1 = __builtin_amdgcn_permlane32_swap(a1, b1, false, false); \
        u32x4 w = {r0[0], r1[0], r0[1], r1[1]}; OUT = *reinterpret_cast<bf16x8*>(&w); } while (0)
    PK4(p0, 0, pa0); PK4(p0, 8, pa1); PK4(p1, 0, pa2); PK4(p1, 8, pa3);
#undef PK4
}
template <int KB>
__device__ __forceinline__ void qkt(f32x16& p0, f32x16& p1, const char* K_lds, int r32, int hi, const bf16x8* qr, float sl, int dq) {
    const float sl8 = 8.f * sl, sl32 = 32.f * sl;
    p0[0] = -sl * (float)dq; p0[1] = p0[0] + sl; p0[2] = p0[1] + sl; p0[3] = p0[2] + sl;
#pragma unroll
    for (int r = 4; r < 16; ++r) p0[r] = p0[r - 4] + sl8;
#pragma unroll
    for (int r = 0; r < 16; ++r) p1[r] = p0[r] + sl32;
    const char* kb[4];
#pragma unroll
    for (int dd = 0; dd < 4; ++dd) kb[dd] = K_lds + KB * SHM_K + KSWZ(r32, (dd * 16 + hi * 8) * 2);
#pragma unroll
    for (int d0 = 0; d0 < 8; ++d0) { const char* a = kb[d0 & 3] + (d0 >> 2) * 128;
        bf16x8 b0_ = *reinterpret_cast<const bf16x8*>(a);
        bf16x8 b1_ = *reinterpret_cast<const bf16x8*>(a + 32 * 256);
        p0 = __builtin_amdgcn_mfma_f32_32x32x16_bf16(b0_, qr[d0], p0, 0, 0, 0);
        p1 = __builtin_amdgcn_mfma_f32_32x32x16_bf16(b1_, qr[d0], p1, 0, 0, 0); }
}
template <int VB>
__device__ __forceinline__ void pv_tile(f32x16* o, int vb0, bf16x8 pa0, bf16x8 pa1, bf16x8 pa2, bf16x8 pa3) {
#define TRRD(dst, off) asm volatile("ds_read_b64_tr_b16 %0, %1 offset:%2" : "=&v"(dst) : "v"(vb0), "i"(off) : "memory")
#define PV_D0(d0) do { s16x4 l0, l1, l2, l3, h0, h1, h2, h3; constexpr int b_ = VB * SHM_V + v_rd_off(d0, 0, 0); \
        TRRD(l0, b_); TRRD(h0, b_ + 2048); TRRD(l1, b_ + 4096); TRRD(h1, b_ + 6144); TRRD(l2, b_ + 8192); TRRD(h2, b_ + 10240); TRRD(l3, b_ + 12288); TRRD(h3, b_ + 14336); \
        asm volatile("s_waitcnt lgkmcnt(0)" ::: "memory"); SBAR();   \
        o[d0] = __builtin_amdgcn_mfma_f32_32x32x16_bf16(pa0, (bf16x8){l0[0], l0[1], l0[2], l0[3], h0[0], h0[1], h0[2], h0[3]}, o[d0], 0, 0, 0);   \
        o[d0] = __builtin_amdgcn_mfma_f32_32x32x16_bf16(pa1, (bf16x8){l1[0], l1[1], l1[2], l1[3], h1[0], h1[1], h1[2], h1[3]}, o[d0], 0, 0, 0);   \
        o[d0] = __builtin_amdgcn_mfma_f32_32x32x16_bf16(pa2, (bf16x8){l2[0], l2[1], l2[2], l2[3], h2[0], h2[1], h2[2], h2[3]}, o[d0], 0, 0, 0);   \
        o[d0] = __builtin_amdgcn_mfma_f32_32x32x16_bf16(pa3, (bf16x8){l3[0], l3[1], l3[2], l3[3], h3[0], h3[1], h3[2], h3[3]}, o[d0], 0, 0, 0); } while (0)
    PV_D0(0); PV_D0(1); PV_D0(2); PV_D0(3);
#undef PV_D0
#undef TRRD
}

struct BlockRef { const bf16* Q; const bf16* K; const bf16* V; bf16* O; int P0; };
struct Seam { bf16x8 qr[8]; bf16x8 st_v0, st_v1, st_k0, st_k1; };
__device__ __forceinline__ int swa_jlo(int P0, int W) { const int lowk = P0 - W + 1; return lowk > 0 ? lowk / KVBLK : 0; }
#define ROW(p, k0, rr) ((p) + (size_t)((k0) + (rr)) * D + sc)
#define VMW() asm volatile("s_waitcnt vmcnt(0)" ::: "memory")
#define VMWN(n) asm volatile("s_waitcnt vmcnt(%0)" :: "i"(n) : "memory")
#define SLOAD_H(Kp, Vp, k0) do { S.st_v0 = load8(ROW(Vp, k0, sr)); S.st_v1 = load8(ROW(Vp, k0, 32 + sr));              \
                         S.st_k0 = load8(ROW(Kp, k0, sr)); S.st_k1 = load8(ROW(Kp, k0, 32 + sr)); } while (0)
#define SWRITE_HK(bf) do { *(bf16x8*)(K_lds + (bf) * SHM_K + kws) = S.st_k0; *(bf16x8*)(K_lds + (bf) * SHM_K + kws + 32 * 256) = S.st_k1; } while (0)
#define SWRITE_HV(bf) do { *(bf16x8*)(V_lds + (bf) * SHM_V + vst0) = S.st_v0; *(bf16x8*)(V_lds + (bf) * SHM_V + vst1) = S.st_v1; } while (0)
#define SWRITE_H(bf) do { SWRITE_HV(bf); SWRITE_HK(bf); } while (0)

__device__ __forceinline__ void causal_swa_prime(const BlockRef& cur, int W, char* lds, Seam& S, const int tid) {
    const int wid = __builtin_amdgcn_readfirstlane(tid >> 6), lane = tid & 63, r32 = lane & 31, hi = lane >> 5;
    const int sr = tid >> 4, sc = (tid & 15) * 8, kws = KSWZ(sr, sc * 2); char* K_lds = lds + 2 * SHM_V;
    const int kb0 = swa_jlo(cur.P0, W) * KVBLK;
    for (int d0 = 0; d0 < 8; ++d0) S.qr[d0] = load8(cur.Q + (size_t)(wid * QBLK + r32) * D + d0 * 16 + hi * 8);
    SLOAD_H(cur.K, cur.V, kb0); VMW(); SWRITE_HK(0);
    __syncthreads();
}
__device__ __forceinline__ void causal_swa_block(const BlockRef& cur, const BlockRef& nxt, int skv, int W, int Wn, float sl, char* lds, Seam& S, const int tid) {
    const int wid = __builtin_amdgcn_readfirstlane(tid >> 6), lane = tid & 63, r32 = lane & 31, hi = lane >> 5;
    const int j_lo = swa_jlo(cur.P0, W);
    int j_hi = (cur.P0 + QB - 1) / KVBLK + 1; if (j_hi > skv / KVBLK) j_hi = skv / KVBLK;
    const int NT = j_hi - j_lo;
    const int kbn = swa_jlo(nxt.P0, Wn) * KVBLK;
    const int qlo = cur.P0 + wid * QBLK, qm = qlo + r32 - 4 * hi;
    char* V_lds = lds; char* K_lds = lds + 2 * SHM_V;
    float* ws = (float*)(lds + 2 * SHM_V + 2 * SHM_K) + wid * 64; float* li_l = ws, * al_l = ws + 32;
    float m_reg = -1e30f, l_reg = 0; f32x16 o[4] = {};
    const int sr = tid >> 4, sc = (tid & 15) * 8, vst0 = v_st(sr, sc), vst1 = v_st(32 + sr, sc), kws = KSWZ(sr, sc * 2);
    const int vb0 = (int)(uintptr_t)V_lds + v_rd_base(lane);
    const bf16* Kh = cur.K; const bf16* Vh = cur.V;
#define RESC(a) do { if (__any((a) < 1.f)) { if (hi == 0) al_l[r32] = (a); asm volatile("s_waitcnt lgkmcnt(0)" ::: "memory");              \
                     for (int d_ = 0; d_ < 4; ++d_) for (int r = 0; r < 16; ++r) o[d_][r] *= al_l[crow(r, hi)]; } } while (0)
#define KBASE(t) ((j_lo + (t)) * KVBLK)
#define MASKT(P0_, P1_, t) do { const int kb_ = KBASE(t); if (kb_ + KVBLK - 1 > qlo || kb_ <= qlo + QBLK - 1 - W) mask_tile(P0_, P1_, qm - kb_, (unsigned)W); } while (0)
    constexpr int NQL = 8;
#define SEAM_K0() do { VMWN(NQL); SWRITE_HK(0); SBAR(); } while (0)
    f32x16 pA0, pA1, pB0, pB1; float mnA, mnB, alA, alB; bf16x8 pa0, pa1, pa2, pa3;
    SWRITE_HV(0); SBAR();
    if (NT > 1) { SLOAD_H(Kh, Vh, KBASE(1)); }
    SBAR(); qkt<0>(pA0, pA1, K_lds, r32, hi, S.qr, sl, qm - KBASE(0));
    MASKT(pA0, pA1, 0); partialSM(pA0, pA1, m_reg, mnA, alA);
    if (NT > 1) { VMW(); SWRITE_H(1); }
    __syncthreads();
#define HALF_STEP(PX0, PX1, mnX, alX, PY0, PY1, alY, t, KB, VB, SB) do {                                                      \
        SBAR(); qkt<KB>(PX0, PX1, K_lds, r32, hi, S.qr, sl, qm - KBASE(t));                                                   \
        finishSM(PY0, PY1, alY, l_reg, pa0, pa1, pa2, pa3); SBAR();                                                           \
        if ((t) + 1 < NT) { SLOAD_H(Kh, Vh, KBASE((t) + 1)); SBAR(); }                                                        \
        pv_tile<VB>(o, vb0, pa0, pa1, pa2, pa3); MASKT(PX0, PX1, (t)); partialSM(PX0, PX1, m_reg, mnX, alX);                  \
        __syncthreads();                                                                                                      \
        if ((t) + 1 < NT) { VMW(); SWRITE_H(SB); }                                                                            \
        RESC(alX); __syncthreads(); } while (0)
    for (int t = 1; t + 1 < NT; t += 2) {
        HALF_STEP(pB0, pB1, mnB, alB, pA0, pA1, alA, t, 1, 0, 0);
        HALF_STEP(pA0, pA1, mnA, alA, pB0, pB1, alB, t + 1, 0, 1, 1);
    }
    const bool even = (NT & 1) == 0;
    if (even) { SBAR(); qkt<1>(pB0, pB1, K_lds, r32, hi, S.qr, sl, qm - KBASE(NT - 1)); SBAR(); }
    SLOAD_H(nxt.K, nxt.V, kbn); SBAR();
#pragma unroll
    for (int d0 = 0; d0 < 8; ++d0) S.qr[d0] = load8(nxt.Q + (size_t)(wid * QBLK + r32) * D + d0 * 16 + hi * 8);
    SBAR();
    finishSM(pA0, pA1, alA, l_reg, pa0, pa1, pa2, pa3); SBAR();
    pv_tile<0>(o, vb0, pa0, pa1, pa2, pa3);
    if (even) { MASKT(pB0, pB1, NT - 1); partialSM(pB0, pB1, m_reg, mnB, alB); __syncthreads(); RESC(alB);
        finishSM(pB0, pB1, alB, l_reg, pa0, pa1, pa2, pa3); SBAR(); pv_tile<1>(o, vb0, pa0, pa1, pa2, pa3); }
    SBAR(); SEAM_K0();
    if (hi == 0) li_l[r32] = l_reg; asm volatile("s_waitcnt lgkmcnt(0)" ::: "memory");
    float rli[16];
#pragma unroll
    for (int r = 0; r < 16; ++r) rli[r] = __builtin_amdgcn_rcpf(li_l[crow(r, hi)]);
    bf16* Ow = cur.O + (size_t)(wid * QBLK) * D;
    int zo = 0; asm volatile("" : "+v"(zo));
    const unsigned ob = (unsigned)(4 * hi * D + r32 + zo);
#pragma unroll
    for (int r = 0; r < 16; ++r) { const unsigned off = ob + (unsigned)(((r & 3) + 8 * (r >> 2)) * D);
#pragma unroll
        for (int d0 = 0; d0 < 4; ++d0) { const float v = o[d0][r] * rli[r];
            const float vn = __shfl_xor(v, 1);
            if ((r32 & 1) == 0) *(unsigned*)(Ow + off + d0 * 32) = cvtpk(v, vn); } }
    __syncthreads();
#undef RESC
#undef KBASE
#undef MASKT
#undef SEAM_K0
#undef HALF_STEP
}
#undef ROW
#undef VMW
#undef VMWN
#undef SLOAD_H
#undef SWRITE_HK
#undef SWRITE_HV
#undef SWRITE_H
}
namespace attn4 {
using attn::bf16; using attn::KVBLK; using attn::QBLK; using attn::SHM_K;
constexpr int QB = 128, D = 128;
constexpr int V_OFF = 0, K_OFF = 65536, PX_OFF = 98304;
constexpr int AL_OFF = RING_BYTES + 1024;
struct Item { const bf16* Q; const bf16* K; const bf16* V0; const bf16* V1; bf16* O; int P0, W; float sl; };

template <int OFF>
__device__ __forceinline__ void pv_half(f32x16* o, int vb0, bf16x8 pa0, bf16x8 pa1, bf16x8 pa2, bf16x8 pa3) {
#define TRRD(dst, off) asm volatile("ds_read_b64_tr_b16 %0, %1 offset:%2" : "=&v"(dst) : "v"(vb0), "i"(off) : "memory")
#define PV_D0(d0) do { s16x4 l0, l1, l2, l3, h0, h1, h2, h3; constexpr int b_ = OFF + attn::v_rd_off(d0, 0, 0); \
        TRRD(l0, b_); TRRD(h0, b_ + 2048); TRRD(l1, b_ + 4096); TRRD(h1, b_ + 6144); TRRD(l2, b_ + 8192); TRRD(h2, b_ + 10240); TRRD(l3, b_ + 12288); TRRD(h3, b_ + 14336); \
        asm volatile("s_waitcnt lgkmcnt(0)" ::: "memory"); SBAR();   \
        o[d0] = __builtin_amdgcn_mfma_f32_32x32x16_bf16(pa0, (bf16x8){l0[0], l0[1], l0[2], l0[3], h0[0], h0[1], h0[2], h0[3]}, o[d0], 0, 0, 0);   \
        o[d0] = __builtin_amdgcn_mfma_f32_32x32x16_bf16(pa1, (bf16x8){l1[0], l1[1], l1[2], l1[3], h1[0], h1[1], h1[2], h1[3]}, o[d0], 0, 0, 0);   \
        o[d0] = __builtin_amdgcn_mfma_f32_32x32x16_bf16(pa2, (bf16x8){l2[0], l2[1], l2[2], l2[3], h2[0], h2[1], h2[2], h2[3]}, o[d0], 0, 0, 0);   \
        o[d0] = __builtin_amdgcn_mfma_f32_32x32x16_bf16(pa3, (bf16x8){l3[0], l3[1], l3[2], l3[3], h3[0], h3[1], h3[2], h3[3]}, o[d0], 0, 0, 0); } while (0)
    PV_D0(0); PV_D0(1); PV_D0(2); PV_D0(3);
#undef PV_D0
#undef TRRD
}

template <int KB>
__device__ __forceinline__ void qkt_b(f32x16& p0, f32x16& p1, const char* K_lds, int r32, int hi, const bf16x8* qr, const f32x16& bias0, const f32x16& bias1) {
    const char* kb[4];
#pragma unroll
    for (int dd = 0; dd < 4; ++dd) kb[dd] = K_lds + KB * SHM_K + KSWZ(r32, (dd * 16 + hi * 8) * 2);
    { const bf16x8 b0_ = *reinterpret_cast<const bf16x8*>(kb[0]), b1_ = *reinterpret_cast<const bf16x8*>(kb[0] + 32 * 256);
      p0 = __builtin_amdgcn_mfma_f32_32x32x16_bf16(b0_, qr[0], bias0, 0, 0, 0); p1 = __builtin_amdgcn_mfma_f32_32x32x16_bf16(b1_, qr[0], bias1, 0, 0, 0); }
#pragma unroll
    for (int d0 = 1; d0 < 8; ++d0) { const char* a = kb[d0 & 3] + (d0 >> 2) * 128;
        const bf16x8 b0_ = *reinterpret_cast<const bf16x8*>(a), b1_ = *reinterpret_cast<const bf16x8*>(a + 32 * 256);
        p0 = __builtin_amdgcn_mfma_f32_32x32x16_bf16(b0_, qr[d0], p0, 0, 0, 0); p1 = __builtin_amdgcn_mfma_f32_32x32x16_bf16(b1_, qr[d0], p1, 0, 0, 0); }
}

__device__ __forceinline__ void item(const Item& it, char* lds, LAS unsigned char* ldsL, const int tid) {
    const int wid = __builtin_amdgcn_readfirstlane(tid >> 6), lane = tid & 63, r32 = lane & 31, hi = lane >> 5, role = wid >> 2, g = wid & 3;
    const int j_lo = attn::swa_jlo(it.P0, it.W);
    const int j_hi = (it.P0 + QB - 1) / KVBLK + 1;
    const int NT = j_hi - j_lo;
    const int W = it.W; const float sl = it.sl;
    const int qlo = it.P0 + g * QBLK, qm = qlo + r32 - 4 * hi;
    const int sr = tid >> 4, sc = (tid & 15) * 8, vst0 = attn::v_st(sr, sc), vst1 = attn::v_st(32 + sr, sc), kws = KSWZ(sr, sc * 2);
    float* AL = (float*)(lds + AL_OFF); int* FLG = (int*)(lds + AL_OFF + 1024); float* LL = (float*)(lds + AL_OFF + 1088);
#define KBASE(t) ((j_lo + (t)) * KVBLK)
    const bf16* gp[6]; int dstA[6], dstB[6];
#pragma unroll
    for (int i = 0; i < 6; ++i) {
        if (i < 2) { const int q = wid * 2 + i, row = 4 * q + (lane >> 4), c = (lane & 15) ^ (row & 7);
            gp[i] = it.K + (size_t)KBASE(0) * D + row * D + c * 8; dstA[i] = K_OFF + 1 * SHM_K + q * 1024; dstB[i] = K_OFF + 0 * SHM_K + q * 1024; }
        else { const int v = wid * 4 + (i - 2), j = v & 15, eh = v >> 4, sidx = 2 * j + (lane >> 5), kk = (sidx >> 2) * 8 + ((lane & 31) >> 2), k = (kk & ~0xC) | ((kk & 4) << 1) | ((kk & 8) >> 1), col = (sidx & 3) * 32 + (lane & 3) * 8;
            gp[i] = (eh ? it.V1 : it.V0) + (size_t)KBASE(0) * D + k * D + col; dstA[i] = V_OFF + 0 * 32768 + eh * 16384 + j * 1024; dstB[i] = V_OFF + 1 * 32768 + eh * 16384 + j * 1024; } }
#define A4_DMA(src, ldsbyte) __builtin_amdgcn_global_load_lds((const unsigned*)(src), (LAS unsigned*)((LAS unsigned char*)ldsL + (ldsbyte)), 16, 0, 0)
#define A4_STAGE(t, PAR) do { const int tk_ = ((t) + 1 < NT ? (t) + 1 : NT - 1), tv_ = ((t) < NT ? (t) : NT - 1); const size_t ok_ = (size_t)tk_ * (KVBLK * D), ov_ = (size_t)tv_ * (KVBLK * D); \
            _Pragma("unroll") for (int i = 0; i < 6; ++i) A4_DMA(gp[i] + (i < 2 ? ok_ : ov_), (PAR) ? dstB[i] : dstA[i]); } while (0)
#define A4_SYNC() do { asm volatile("s_waitcnt vmcnt(0) lgkmcnt(0)" ::: "memory"); __builtin_amdgcn_s_barrier(); asm volatile("" ::: "memory"); } while (0)
#define A4_PROLOGUE() do { A4_DMA(gp[0], dstB[0]); A4_DMA(gp[1], dstB[1]); A4_SYNC(); } while (0)
    char* K_lds = lds + K_OFF;
    if (role == 0) {
        bf16x8 qr[8];
#pragma unroll
        for (int d0 = 0; d0 < 8; ++d0) qr[d0] = attn::load8(it.Q + (size_t)(g * QBLK + r32) * D + d0 * 16 + hi * 8);
        asm volatile("s_waitcnt vmcnt(0)" ::: "memory");
        A4_PROLOGUE();
        float m_reg = -1e30f, l_reg = 0.f;
        f32x16 bias0, bias1;
#pragma unroll
        for (int r = 0; r < 16; ++r) { bias0[r] = sl * (float)((r & 3) + 8 * (r >> 2) + 4 * hi); bias1[r] = bias0[r] + 32.f * sl; }
        const float mstep = 64.f * sl;
#define A2_QK_STEP(t, PAR) do { A4_STAGE(t, PAR); \
            if ((t) < NT) { f32x16 p0, p1; float mn, alpha; bf16x8 pa0, pa1, pa2, pa3; \
                qkt_b<PAR>(p0, p1, K_lds, r32, hi, qr, bias0, bias1); if ((t) > 0) m_reg -= mstep; \
                { const int kb_ = KBASE(t); if (kb_ + KVBLK - 1 > qlo || kb_ <= qlo + QBLK - 1 - W) attn::mask_tile(p0, p1, qm - kb_, (unsigned)W); } \
                attn::partialSM(p0, p1, m_reg, mn, alpha); attn::finishSM(p0, p1, alpha, l_reg, pa0, pa1, pa2, pa3); \
                char* px = lds + PX_OFF + (PAR) * 16384 + g * 4096 + lane * 16; \
                *(bf16x8*)px = pa0; *(bf16x8*)(px + 1024) = pa1; *(bf16x8*)(px + 2048) = pa2; *(bf16x8*)(px + 3072) = pa3; \
                if (hi == 0) AL[(PAR) * 128 + g * 32 + r32] = alpha; \
                const int anyr = __any(alpha < 1.f) ? 1 : 0; if (lane == 0) FLG[(PAR) * 4 + g] = anyr; } \
            A4_SYNC(); } while (0)
        for (int t = 0; t <= NT; t += 2) { A2_QK_STEP(t, 0); if (t + 1 <= NT) A2_QK_STEP(t + 1, 1); }
        if (hi == 0) LL[g * 32 + r32] = l_reg;
        __syncthreads();
        __syncthreads();
#undef A2_QK_STEP
    } else {
        A4_PROLOGUE();
        f32x16 o[8] = {};
        const int vb0 = (int)(uintptr_t)(lds + V_OFF) + attn::v_rd_base(lane);
#define A2_PV_STEP(t, PAR) do { A4_STAGE(t, PAR); \
            if ((t) >= 1) { constexpr int PB = (PAR) ^ 1; \
                const int flag = __builtin_amdgcn_readfirstlane(FLG[PB * 4 + g]); \
                if (flag) { _Pragma("unroll") for (int r = 0; r < 16; ++r) { const float a = AL[PB * 128 + g * 32 + attn::crow(r, hi)]; \
                        _Pragma("unroll") for (int d_ = 0; d_ < 8; ++d_) o[d_][r] *= a; } } \
                const char* px = lds + PX_OFF + PB * 16384 + g * 4096 + lane * 16; \
                const bf16x8 pa0 = *(const bf16x8*)px, pa1 = *(const bf16x8*)(px + 1024), pa2 = *(const bf16x8*)(px + 2048), pa3 = *(const bf16x8*)(px + 3072); \
                pv_half<PB * 32768>(o, vb0, pa0, pa1, pa2, pa3); pv_half<PB * 32768 + 16384>(o + 4, vb0, pa0, pa1, pa2, pa3); } \
            A4_SYNC(); } while (0)
        for (int t = 0; t <= NT; t += 2) { A2_PV_STEP(t, 0); if (t + 1 <= NT) A2_PV_STEP(t + 1, 1); }
        __syncthreads();
        float rli[16];
#pragma unroll
        for (int r = 0; r < 16; ++r) rli[r] = __builtin_amdgcn_rcpf(LL[g * 32 + attn::crow(r, hi)]);
        bf16* Ow = it.O + (size_t)(g * QBLK) * 256;
        int zo = 0; asm volatile("" : "+v"(zo));
        const unsigned ob = (unsigned)(4 * hi * 256 + r32 + zo);
#pragma unroll
        for (int r = 0; r < 16; ++r) { const unsigned off = ob + (unsigned)(((r & 3) + 8 * (r >> 2)) * 256);
#pragma unroll
            for (int d0 = 0; d0 < 8; ++d0) { const float v = o[d0][r] * rli[r];
                const float vn = __builtin_bit_cast(float, __builtin_amdgcn_mov_dpp(__builtin_bit_cast(int, v), 0xB1, 0xF, 0xF, true));
                if ((r32 & 1) == 0) *(unsigned*)(Ow + off + d0 * 32) = cvtpk(v, vn); } }
        __syncthreads();
#undef A2_PV_STEP
    }
#undef KBASE
#undef A4_DMA
#undef A4_STAGE
#undef A4_SYNC
#undef A4_PROLOGUE
}
}
struct Frame {
    LAS unsigned char* lds; unsigned char* lds_g;
    volatile LAS unsigned* MISC;
    unsigned* ctl; unsigned char* ws; unsigned char* dout;
    int tid, lane, wave, G, bid, gw, NGW;
};

__device__ __forceinline__ void tr_item(const float* W, int ldw, int c0, bf16_t* WT, int ldt, int r0, int kb, int nb, LAS float* scr, int lane) {
    const int k0 = 64 * kb, n0 = 32 * nb;
    float ld_[32];
#pragma unroll
    for (int i = 0; i < 32; ++i) ld_[i] = W[(size_t)(k0 + 2 * i + (lane >> 5)) * ldw + c0 + n0 + (lane & 31)];
#pragma unroll
    for (int i = 0; i < 32; ++i) scr[(2 * i + (lane >> 5)) * 33 + (lane & 31)] = ld_[i];
    LDS_WAIT(); asm volatile("" ::: "memory");
    const int c = lane & 7;
#pragma unroll
    for (int j = 0; j < 4; ++j) { const int n = (lane >> 3) + 8 * j; const LAS float* s = scr + (8 * c) * 33 + n;
        u32x4 o; o.x = cvtpk(s[0 * 33], s[1 * 33]); o.y = cvtpk(s[2 * 33], s[3 * 33]); o.z = cvtpk(s[4 * 33], s[5 * 33]); o.w = cvtpk(s[6 * 33], s[7 * 33]);
        *(u32x4*)(WT + (size_t)(r0 + n0 + n) * ldt + k0 + 8 * c) = o; }
    LDS_WAIT(); asm volatile("" ::: "memory");
}
__device__ __forceinline__ void tr_item8(const float* W, int ldw, int c0, unsigned char* WT, int ldt, int r0, int kb, int nb, float sc, LAS float* scr, int lane) {
    const int k0 = 64 * kb, n0 = 32 * nb;
    float ld_[32];
#pragma unroll
    for (int i = 0; i < 32; ++i) ld_[i] = W[(size_t)(k0 + 2 * i + (lane >> 5)) * ldw + c0 + n0 + (lane & 31)];
#pragma unroll
    for (int i = 0; i < 32; ++i) scr[(2 * i + (lane >> 5)) * 33 + (lane & 31)] = ld_[i];
    LDS_WAIT(); asm volatile("" ::: "memory");
    const int c = lane & 7;
#pragma unroll
    for (int j = 0; j < 4; ++j) { const int n = (lane >> 3) + 8 * j; const LAS float* s = scr + (8 * c) * 33 + n;
        u32x2 o; o.x = pk4_fp8(s[0 * 33] * sc, s[1 * 33] * sc, s[2 * 33] * sc, s[3 * 33] * sc); o.y = pk4_fp8(s[4 * 33] * sc, s[5 * 33] * sc, s[6 * 33] * sc, s[7 * 33] * sc);
        *(u32x2*)(WT + (size_t)(r0 + n0 + n) * ldt + k0 + 8 * c) = o; }
    LDS_WAIT(); asm volatile("" ::: "memory");
}
struct TrD { const float* src; size_t ldw2; unsigned char* dst; size_t ldtb; float sc; int f8; };
__device__ __forceinline__ TrD tr_desc(const float* W, int ldw, int c0, void* WT, int ldt, int r0, int kb, int nb, float sc, int f8, int lane) {
    TrD d; d.src = W + (size_t)(64 * kb + (lane >> 5)) * ldw + c0 + 32 * nb + (lane & 31); d.ldw2 = (size_t)2 * ldw;
    d.ldtb = f8 ? (size_t)ldt : (size_t)ldt * 2; d.dst = (unsigned char*)WT + (size_t)(r0 + 32 * nb) * d.ldtb + (f8 ? (size_t)64 * kb : (size_t)128 * kb); d.sc = sc; d.f8 = f8; return d; }
__device__ __forceinline__ void tr_load(const TrD& d, float (&ld)[32]) {
#pragma unroll
    for (int i = 0; i < 32; ++i) ld[i] = d.src[(size_t)i * d.ldw2]; }
__device__ __forceinline__ void tr_flush(const TrD& d, const float (&ld)[32], LAS float* scr, int lane) {
#pragma unroll
    for (int i = 0; i < 32; ++i) scr[(2 * i + (lane >> 5)) * 33 + (lane & 31)] = ld[i];
    LDS_WAIT(); asm volatile("" ::: "memory");
    const int c = lane & 7;
    if (d.f8) {
#pragma unroll
        for (int j = 0; j < 4; ++j) { const int n = (lane >> 3) + 8 * j; const LAS float* s = scr + (8 * c) * 33 + n; const float sc = d.sc;
            u32x2 o; o.x = pk4_fp8(s[0 * 33] * sc, s[1 * 33] * sc, s[2 * 33] * sc, s[3 * 33] * sc); o.y = pk4_fp8(s[4 * 33] * sc, s[5 * 33] * sc, s[6 * 33] * sc, s[7 * 33] * sc);
            *(u32x2*)(d.dst + (size_t)n * d.ldtb + 8 * c) = o; }
    } else {
#pragma unroll
        for (int j = 0; j < 4; ++j) { const int n = (lane >> 3) + 8 * j; const LAS float* s = scr + (8 * c) * 33 + n;
            u32x4 o; o.x = cvtpk(s[0 * 33], s[1 * 33]); o.y = cvtpk(s[2 * 33], s[3 * 33]); o.z = cvtpk(s[4 * 33], s[5 * 33]); o.w = cvtpk(s[6 * 33], s[7 * 33]);
            *(u32x4*)(d.dst + (size_t)n * d.ldtb + 16 * c) = o; }
    }
    LDS_WAIT(); asm volatile("" ::: "memory");
}
template <class Dec>
__device__ __forceinline__ void tr_run(int first, int n_items, int step, const Dec& dec, LAS float* scr, int lane) {
    int it = first; if (it >= n_items) return;
    float la[32], lb[32], lc[32]; TrD da, db, dc;
    da = dec(it); tr_load(da, la);
    { const int i1 = it + step; db = dec(i1 < n_items ? i1 : first); tr_load(db, lb); }
    for (;;) {
        { const int i2 = it + 2 * step; dc = dec(i2 < n_items ? i2 : first); tr_load(dc, lc); }
        tr_flush(da, la, scr, lane);
        it += step; if (it >= n_items) break;
        { const int i2 = it + 2 * step; da = dec(i2 < n_items ? i2 : first); tr_load(da, la); }
        tr_flush(db, lb, scr, lane);
        it += step; if (it >= n_items) break;
        { const int i2 = it + 2 * step; db = dec(i2 < n_items ? i2 : first); tr_load(db, lb); }
        tr_flush(dc, lc, scr, lane);
        it += step; if (it >= n_items) break;
    }
}
__device__ __forceinline__ void rms_row2048(const float* xrow, const float* g, f32x4 (&v)[8], int lane) {
    const f32x4* xr = (const f32x4*)xrow + lane; float ss = 0.f;
#pragma unroll
    for (int j = 0; j < 8; ++j) { v[j] = xr[64 * j]; ss += (v[j].x * v[j].x + v[j].y * v[j].y) + (v[j].z * v[j].z + v[j].w * v[j].w); }
    ss = wave_sum(ss); const float r = rsqrtf(ss * (1.0f / 2048.0f) + EPS);
#pragma unroll
    for (int j = 0; j < 8; ++j) { const f32x4 gg = ((const f32x4*)g)[lane + 64 * j]; v[j] = v[j] * r * gg; }
}
__device__ __forceinline__ void store_row_bf16(bf16_t* orow, const f32x4 (&v)[8], int lane) {
#pragma unroll
    for (int j = 0; j < 8; ++j) { u32x2 w; w.x = cvtpk(v[j].x, v[j].y); w.y = cvtpk(v[j].z, v[j].w); *(u32x2*)(orow + 4 * lane + 256 * j) = w; }
}

__device__ __forceinline__ void p0_prologue(Frame& F, const float* const* in, const int parts = 3) {
    LAS float* scr = (LAS float*)(F.lds + F.wave * 16384);
    const float* w_in = in[3];
    bf16_t* WINT = (bf16_t*)(F.ws + WS_WINT);
    constexpr int I0 = 8192, I1 = 1024, I2 = 1024, I3 = 1024, I4 = 6144, I5 = 2048, I6 = 2048, I7 = 1024, I8 = 1024, I9 = 2048;
    constexpr int NITEMS = I0 + I1 + I2 + I3 + I4 + I5 + I6 + I7 + I8 + I9;
    if (parts & 1) { struct Dec { const float* const* in; const float* w_in; unsigned char* ws; bf16_t* WINT; int lane;
        __device__ __forceinline__ TrD operator()(int it) const { int r = it;
            if (r < I0) return tr_desc(w_in, DIN, 0, WINT, 2048, 0, r / 256, r % 256, 1.f, 0, lane); r -= I0;
            if (r < I1) return tr_desc(w_in, DIN, 9216, WINT + (size_t)8192 * 2048, 2048, 0, r / 32, r % 32, 32.0f, 1, lane); r -= I1;
            if (r < I2) return tr_desc(w_in, DIN, 10248, WINT + (size_t)8192 * 2048, 2048, 1024, r / 32, r % 32, 32.0f, 1, lane); r -= I2;
            if (r < I3) return tr_desc(w_in, DIN, 8192, WINT, 2048, 10240, r / 32, r % 32, 1.f, 0, lane); r -= I3;
            if (r < I4) return tr_desc(w_in, DIN, 11272, WINT + (size_t)11264 * 2048, 2048, 0, r / 192, r % 192, 32.0f, 1, lane); r -= I4;
            if (r < I5) return tr_desc(in[15], 2048, 0, ws + WS_WMEMT, 2048, 0, r / 64, r % 64, 1.f, 0, lane); r -= I5;
            if (r < I6) return tr_desc(in[16], 2048, 0, ws + WS_WBDT, 2048, 0, r / 64, r % 64, 32.0f, 1, lane); r -= I6;
            if (r < I7) return tr_desc(in[17], 2048, 0, ws + WS_WBMT, 1024, 0, r / 64, r % 64, 1.f, 0, lane); r -= I7;
            if (r < I8) return tr_desc(in[18], 2048, 0, ws + WS_WBCT, 1024, 0, r / 64, r % 64, 1.f, 0, lane); r -= I8;
            return tr_desc(in[20], 2048, 0, ws + WS_WOUTT, 2048, 0, r / 64, r % 64, 1.f, 0, lane); } };
      const Dec dec{in, w_in, F.ws, WINT, F.lane};
      tr_run(F.gw, NITEMS, F.NGW, dec, scr, F.lane); }
    if (!(parts & 2)) return;
    { bf16_t* WRT = (bf16_t*)(F.ws + WS_WRT); const float* wrg = in[22]; const float* wre = in[24];
      for (int idx = F.bid * 512 + F.tid; idx < 256 * 2048; idx += F.G * 512) { const int n = idx >> 11, k = idx & 2047;
          const float v = (n < 4 ? wrg[k * 4 + n] : (n < 36 ? wre[k * 32 + (n - 4)] : 0.f)) * in[21][k]; WRT[idx] = (bf16_t)(cvtpk(v, 0.f) & 0xffffu); } }
    __syncthreads();
    LAS float* wg = (LAS float*)F.lds;
    for (int idx = F.tid; idx < 16384; idx += 512) { const int k = idx >> 3, j = idx & 7; wg[j * 2048 + k] = w_in[(size_t)k * DIN + 10240 + j]; }
    __syncthreads();
    const float* x = in[0]; bf16_t* HBF = (bf16_t*)(F.dout + DO_HBF); float* MLG = (float*)(F.ws + WS_MLG);
    f32x4 v[8], gg[8];
#pragma unroll
    for (int j = 0; j < 8; ++j) { v[j] = ((const f32x4*)(x + (size_t)F.gw * 2048))[F.lane + 64 * j]; gg[j] = ((const f32x4*)in[2])[F.lane + 64 * j]; }
    for (int m = F.gw; m < TT; m += F.NGW) {
        f32x4 vn[8];
        { const int mn = m + F.NGW < TT ? m + F.NGW : m;
#pragma unroll
          for (int j = 0; j < 8; ++j) vn[j] = ((const f32x4*)(x + (size_t)mn * 2048))[F.lane + 64 * j]; }
        { float ss = 0.f;
#pragma unroll
          for (int j = 0; j < 8; ++j) ss += (v[j].x * v[j].x + v[j].y * v[j].y) + (v[j].z * v[j].z + v[j].w * v[j].w);
          ss = wave_sum(ss); const float r = rsqrtf(ss * (1.0f / 2048.0f) + EPS);
#pragma unroll
          for (int j = 0; j < 8; ++j) v[j] = v[j] * r * gg[j]; }
        store_row_bf16(HBF + (size_t)m * 2048, v, F.lane);
        { unsigned char* h8 = F.ws + WS_HBF8 + (size_t)m * 2048 + 4 * F.lane;
#pragma unroll
          for (int j = 0; j < 8; ++j) *(unsigned*)(h8 + 256 * j) = pk4_fp8(v[j].x, v[j].y, v[j].z, v[j].w); }
        float res = 0.f;
#pragma unroll
        for (int jj = 0; jj < 8; ++jj) { float a = 0.f;
#pragma unroll
            for (int j = 0; j < 8; ++j) { const f32x4 w = *(const LAS f32x4*)(wg + jj * 2048 + 4 * F.lane + 256 * j); a += (v[j].x * w.x + v[j].y * w.y) + (v[j].z * w.z + v[j].w * w.w); }
            a = wave_sum(a); if (F.lane == jj) res = a; }
        if (F.lane < 8) MLG[(size_t)m * 8 + F.lane] = res;
#pragma unroll
        for (int j = 0; j < 8; ++j) v[j] = vn[j];
    }
    { const float* mem = in[1]; bf16_t* MEMN = (bf16_t*)(F.ws + WS_MEMN);
      for (int m = F.gw; m < NB * MEML; m += F.NGW) { f32x4 v[8]; rms_row2048(mem + (size_t)m * 2048, in[14], v, F.lane); store_row_bf16(MEMN + (size_t)m * 2048, v, F.lane); } }
    if (F.bid == 0 && F.wave == 0) {
        const float* q1 = in[8]; const float* k1 = in[9]; const float* q2 = in[10]; const float* k2 = in[11];
        float d1 = q1[F.lane] * k1[F.lane] + q1[F.lane + 64] * k1[F.lane + 64], d2 = q2[F.lane] * k2[F.lane] + q2[F.lane + 64] * k2[F.lane + 64];
        d1 = wave_sum(d1); d2 = wave_sum(d2);
        if (F.lane == 0) F.ctl[CW_LAM] = __float_as_uint(expf(d1) - expf(d2) + 0.2f);
    }
    __syncthreads();
}

__device__ __forceinline__ void ml0_seq(Frame& F, const float* const* in, int s) {
    const int b = s >> 2, hh = s & 3;
    const float* MLG = (const float*)(F.ws + WS_MLG);
    float* KW = (float*)(F.ws + WS_SCKW); float* RS = (float*)(F.ws + WS_SCRS); float* IT = (float*)(F.ws + WS_SCIT); float* ED = (float*)(F.ws + WS_SCED); float* DEC = (float*)(F.ws + WS_DEC);
    LAS float* sm_bl = (LAS float*)F.lds; LAS float* sm_cm = sm_bl + 64; LAS float* sm_mp = sm_bl + 128; LAS float* sm_R = sm_bl + 192;
    const float big = in[6][hh], bfg = in[7][hh];
    float bl[8][4], gh[8][4], cm[8][4];
#pragma unroll
    for (int rd = 0; rd < 8; ++rd) {
        const int c = rd * 8 + F.wave; const size_t t0 = (size_t)b * SEQ + (size_t)c * 256 + 4 * F.lane;
        float lf[4], ig[4];
#pragma unroll
        for (int i = 0; i < 4; ++i) { const float fg = MLG[(t0 + i) * 8 + 4 + hh] + bfg; lf[i] = fminf(fg, 0.f) - log1pf(__expf(-fabsf(fg))); ig[i] = MLG[(t0 + i) * 8 + hh] + big; }
        float p[4]; p[0] = lf[0]; p[1] = p[0] + lf[1]; p[2] = p[1] + lf[2]; p[3] = p[2] + lf[3];
        float incl = p[3];
#pragma unroll
        for (int o = 1; o < 64; o <<= 1) { const float y = __shfl_up(incl, o); if (F.lane >= o) incl += y; }
        const float excl = incl - p[3];
#pragma unroll
        for (int i = 0; i < 4; ++i) { bl[rd][i] = excl + p[i]; gh[rd][i] = ig[i] - bl[rd][i]; }
        float q[4]; q[0] = gh[rd][0]; q[1] = fmaxf(q[0], gh[rd][1]); q[2] = fmaxf(q[1], gh[rd][2]); q[3] = fmaxf(q[2], gh[rd][3]);
        float im = q[3];
#pragma unroll
        for (int o = 1; o < 64; o <<= 1) { const float y = __shfl_up(im, o); if (F.lane >= o) im = fmaxf(im, y); }
        float em = __shfl_up(im, 1); if (F.lane == 0) em = -__builtin_inff();
#pragma unroll
        for (int i = 0; i < 4; ++i) cm[rd][i] = fmaxf(em, q[i]);
        if (F.lane == 63) { sm_bl[c] = bl[rd][3]; sm_cm[c] = cm[rd][3]; }
    }
    __syncthreads();
    if (F.tid == 0) { float M = 0.f; for (int c = 0; c < 64; ++c) { sm_mp[c] = M; const float R = fmaxf(M, sm_cm[c]); sm_R[c] = R; M = sm_bl[c] + R; } }
    __syncthreads();
#pragma unroll
    for (int rd = 0; rd < 8; ++rd) {
        const int c = rd * 8 + F.wave; const size_t idx = (size_t)hh * TT + (size_t)b * SEQ + (size_t)c * 256 + 4 * F.lane;
        const float Mp = sm_mp[c], R = sm_R[c];
        f32x4 kw, rs, it, ed;
#pragma unroll
        for (int i = 0; i < 4; ++i) { const float Gt = fmaxf(Mp, cm[rd][i]); kw[i] = __expf(gh[rd][i] - R); rs[i] = __expf(R - Gt); it[i] = __expf(Mp - Gt); ed[i] = __expf(-(bl[rd][i] + Gt)); }
        *(f32x4*)(KW + idx) = kw; *(f32x4*)(RS + idx) = rs; *(f32x4*)(IT + idx) = it; *(f32x4*)(ED + idx) = ed;
        if (F.lane == 0) DEC[s * 64 + c] = __expf(Mp - R);
    }
    __syncthreads();
}

__device__ __forceinline__ void unpack8(const u32x4 r, float (&x)[8]) { x[0] = bflo(r.x); x[1] = bfhi(r.x); x[2] = bflo(r.y); x[3] = bfhi(r.y); x[4] = bflo(r.z); x[5] = bfhi(r.z); x[6] = bflo(r.w); x[7] = bfhi(r.w); }
__device__ __forceinline__ void ml1_conv(Frame& F, const float* const* in, const int first, const int nstep) {
    const bf16_t* MQK = (const bf16_t*)(F.ws + WS_MQK);
    bf16_t* Q = (bf16_t*)(F.ws + WS_Q); bf16_t* WQ = (bf16_t*)(F.ws + WS_WQ); bf16_t* KWB = (bf16_t*)(F.ws + WS_KW); bf16_t* KWT = (bf16_t*)(F.ws + WS_KWT);
    const float* KWS = (const float*)(F.ws + WS_SCKW); const float* ITS = (const float*)(F.ws + WS_SCIT); float* KN4 = (float*)(F.ws + WS_KN);
    const float* cw = in[4]; const float* cbp = in[5];
    LAS unsigned char* stg = F.lds + F.wave * 16384;
    const int cl = F.lane & 15, tq = F.lane >> 4;
    for (int id = first; id < 8192; id += nstep) {
        const int g16 = id & 15, sc = id >> 4, kind = g16 >> 3, hh = (g16 >> 1) & 3, dl = (g16 & 1) * 128 + cl * 8, col = g16 * 128 + cl * 8;
        const size_t t0 = (size_t)sc * 64 + tq * 16, tr0 = (size_t)hh * TT + t0;
        const bool st = (t0 & (size_t)(SEQ - 1)) == 0;
        u32x4 xr[19];
#pragma unroll
        for (int i = 0; i < 19; ++i) { const size_t row = (st && i < 3) ? t0 : t0 + i - 3; xr[i] = *(const u32x4*)(MQK + row * 2048 + col); }
        float scl[16];
        { const float* sp = (kind ? KWS : ITS) + tr0;
#pragma unroll
          for (int j = 0; j < 4; ++j) { const f32x4 a = *(const f32x4*)(sp + 4 * j); scl[4 * j] = a.x; scl[4 * j + 1] = a.y; scl[4 * j + 2] = a.z; scl[4 * j + 3] = a.w; } }
        float w[4][8], cb[8], h3[8], h2[8], h1[8], cs[8];
#pragma unroll
        for (int j = 0; j < 4; ++j) { const f32x4 a = *(const f32x4*)(cw + j * 2048 + col), b = *(const f32x4*)(cw + j * 2048 + col + 4);
            w[j][0] = a.x; w[j][1] = a.y; w[j][2] = a.z; w[j][3] = a.w; w[j][4] = b.x; w[j][5] = b.y; w[j][6] = b.z; w[j][7] = b.w; }
        { const f32x4 a = *(const f32x4*)(cbp + col), b = *(const f32x4*)(cbp + col + 4); cb[0] = a.x; cb[1] = a.y; cb[2] = a.z; cb[3] = a.w; cb[4] = b.x; cb[5] = b.y; cb[6] = b.z; cb[7] = b.w; }
        unpack8(xr[0], h3); unpack8(xr[1], h2); unpack8(xr[2], h1);
        if (st) {
#pragma unroll
            for (int c = 0; c < 8; ++c) { h3[c] = 0.f; h2[c] = 0.f; h1[c] = 0.f; } }
#pragma unroll
        for (int c = 0; c < 8; ++c) cs[c] = 0.f;
#pragma unroll
        for (int hf = 0; hf < 2; ++hf) {
#pragma unroll
            for (int i8 = 0; i8 < 8; ++i8) { const int i = hf * 8 + i8;
                float xv[8], sv[8]; unpack8(xr[3 + i], xv);
#pragma unroll
                for (int c = 0; c < 8; ++c) { const float y = w[0][c] * h3[c] + w[1][c] * h2[c] + w[2][c] * h1[c] + w[3][c] * xv[c] + cb[c]; sv[c] = y * sigmoidf_(y); h3[c] = h2[c]; h2[c] = h1[c]; h1[c] = xv[c]; }
                const size_t tr = tr0 + i;
                if (kind == 0) { const float itv = scl[i];
                    u32x4 o; o.x = cvtpk(sv[0], sv[1]); o.y = cvtpk(sv[2], sv[3]); o.z = cvtpk(sv[4], sv[5]); o.w = cvtpk(sv[6], sv[7]); *(u32x4*)(Q + tr * 256 + dl) = o;
                    u32x4 p; p.x = cvtpk(sv[0] * itv, sv[1] * itv); p.y = cvtpk(sv[2] * itv, sv[3] * itv); p.z = cvtpk(sv[4] * itv, sv[5] * itv); p.w = cvtpk(sv[6] * itv, sv[7] * itv); *(u32x4*)(WQ + tr * 512 + 256 + dl) = p;
                } else { const float kwv = scl[i] * 0.0625f;
                    u32x4 o; o.x = cvtpk(sv[0] * kwv, sv[1] * kwv); o.y = cvtpk(sv[2] * kwv, sv[3] * kwv); o.z = cvtpk(sv[4] * kwv, sv[5] * kwv); o.w = cvtpk(sv[6] * kwv, sv[7] * kwv); *(u32x4*)(KWB + tr * 256 + dl) = o;
                    { LAS unsigned char* cp = stg + (cl * 8) * 128 + (((2 * tq + hf) ^ (cl & 7)) << 4) + i8 * 2;
                      *(LAS unsigned short*)(cp + 0 * 128) = (unsigned short)o.x; *(LAS unsigned short*)(cp + 1 * 128) = (unsigned short)(o.x >> 16);
                      *(LAS unsigned short*)(cp + 2 * 128) = (unsigned short)o.y; *(LAS unsigned short*)(cp + 3 * 128) = (unsigned short)(o.y >> 16);
                      *(LAS unsigned short*)(cp + 4 * 128) = (unsigned short)o.z; *(LAS unsigned short*)(cp + 5 * 128) = (unsigned short)(o.z >> 16);
                      *(LAS unsigned short*)(cp + 6 * 128) = (unsigned short)o.w; *(LAS unsigned short*)(cp + 7 * 128) = (unsigned short)(o.w >> 16); }
                    cs[0] += bflo(o.x); cs[1] += bfhi(o.x); cs[2] += bflo(o.y); cs[3] += bfhi(o.y); cs[4] += bflo(o.z); cs[5] += bfhi(o.z); cs[6] += bflo(o.w); cs[7] += bfhi(o.w); }
            }
        }
        if (kind == 1) {
            LDS_WAIT(); asm volatile("" ::: "memory");
            bf16_t* kt = KWT + (((size_t)hh * 128 + (sc >> 2)) * 256 + (g16 & 1) * 128) * 256 + (sc & 3) * 64;
#pragma unroll
            for (int q = 0; q < 16; ++q) { const int r = q * 8 + (F.lane >> 3), k = F.lane & 7;
                const u32x4 v = *(const LAS u32x4*)(stg + r * 128 + ((k ^ (q & 7)) << 4));
                *(u32x4*)(kt + (size_t)r * 256 + k * 8) = v; }
            LDS_WAIT(); asm volatile("" ::: "memory");
#pragma unroll
            for (int c = 0; c < 8; ++c) { cs[c] = xsum16(cs[c]); cs[c] = xsum32(cs[c]); }
            if (tq == 0) { float* kn = KN4 + (((size_t)hh * 128 + (sc >> 2)) * 4 + (sc & 3)) * 256 + dl;
                *(f32x4*)kn = (f32x4){cs[0], cs[1], cs[2], cs[3]}; *(f32x4*)(kn + 4) = (f32x4){cs[4], cs[5], cs[6], cs[7]}; }
        }
    }
}

__device__ __forceinline__ void nscan_seq(Frame& F, int s) {
    if (F.tid < 256) { const int hh = s & 3, b = s >> 2; const float* KN4 = (const float*)(F.ws + WS_KN); const float* DEC = (const float*)(F.ws + WS_DEC); float* NP = (float*)(F.ws + WS_NP);
        float n = 0.f;
        for (int c0 = 0; c0 < 64; c0 += 8) { float kn[8], dc[8];
#pragma unroll
            for (int i = 0; i < 8; ++i) { const float* p = KN4 + ((size_t)hh * 128 + b * 64 + c0 + i) * 1024 + F.tid; kn[i] = (p[0] + p[256]) + (p[512] + p[768]); dc[i] = DEC[s * 64 + c0 + i]; }
#pragma unroll
            for (int i = 0; i < 8; ++i) { NP[((size_t)s * 64 + c0 + i) * 256 + F.tid] = n; n = dc[i] * n + kn[i]; } }
    }
}
__device__ __forceinline__ void xsoftmax(Frame& F) {
    const bf16_t* XS = (const bf16_t*)(F.ws + WS_XS); bf16_t* XP = (bf16_t*)(F.ws + WS_XP);
    const int sub = F.lane >> 5, d8 = (F.lane & 31) * 8;
    for (int row0 = F.gw * 8; row0 < 4 * TT; row0 += F.NGW * 8) {
        u32x4 v[4];
#pragma unroll
        for (int i = 0; i < 4; ++i) v[i] = *(const u32x4*)(XS + (size_t)(row0 + 2 * i + sub) * 256 + d8);
#pragma unroll
        for (int i = 0; i < 4; ++i) { float x[8]; unpack8(v[i], x);
            float m = fmaxf(fmaxf(fmaxf(x[0], x[1]), fmaxf(x[2], x[3])), fmaxf(fmaxf(x[4], x[5]), fmaxf(x[6], x[7])));
#pragma unroll
            for (int o = 1; o < 32; o <<= 1) m = fmaxf(m, __shfl_xor(m, o));
            float s = 0.f;
#pragma unroll
            for (int c = 0; c < 8; ++c) { x[c] = __expf(x[c] - m); s += x[c]; }
#pragma unroll
            for (int o = 1; o < 32; o <<= 1) s += __shfl_xor(s, o);
            const float inv = 1.0f / s;
            u32x4 w; w.x = cvtpk(x[0] * inv, x[1] * inv); w.y = cvtpk(x[2] * inv, x[3] * inv); w.z = cvtpk(x[4] * inv, x[5] * inv); w.w = cvtpk(x[6] * inv, x[7] * inv);
            *(u32x4*)(XP + (size_t)(row0 + 2 * i + sub) * 256 + d8) = w; }
    }
}
__device__ __forceinline__ void cscan(Frame& F) {
    const bf16_t* U = (const bf16_t*)(F.ws + WS_U); bf16_t* VC = (bf16_t*)(F.ws + WS_VC); const float* DEC = (const float*)(F.ws + WS_DEC);
    for (int gid = F.bid * 512 + F.tid; gid < 131072; gid += F.G * 512) {
        const int s = gid >> 14, rem = gid & 16383, dv = rem >> 6, dk4 = (rem & 63) * 4, hh = s & 3, b = s >> 2;
        f32x4 C = {0.f, 0.f, 0.f, 0.f};
        for (int c0 = 0; c0 < 64; c0 += 8) { const size_t g0 = (size_t)hh * 128 + b * 64 + c0;
            f32x4 u[8]; float dc[8];
#pragma unroll
            for (int i = 0; i < 8; ++i) { const u32x2 w = *(const u32x2*)(U + (g0 + i) * 65536 + (size_t)dv * 256 + dk4); u[i] = (f32x4){bflo(w.x), bfhi(w.x), bflo(w.y), bfhi(w.y)}; dc[i] = DEC[s * 64 + c0 + i]; }
#pragma unroll
            for (int i = 0; i < 8; ++i) { u32x2 w; w.x = cvtpk(C.x, C.y); w.y = cvtpk(C.z, C.w); *(u32x2*)(VC + ((g0 + i) * 256 + dv) * 512 + 256 + dk4) = w; C = C * dc[i] + u[i]; } }
    }
}
__device__ __forceinline__ void denpass(Frame& F) {
    const bf16_t* WQ = (const bf16_t*)(F.ws + WS_WQ); const float* NP = (const float*)(F.ws + WS_NP); const float* ED = (const float*)(F.ws + WS_SCED); float* HDEN = (float*)(F.ws + WS_HDEN);
    for (int row0 = F.gw * 4; row0 < 4 * TT; row0 += F.NGW * 4) {
        const int hh = row0 / TT, t = row0 - hh * TT, b = t / SEQ, c = (t - b * SEQ) >> 8;
        u32x4 w[4]; f32x4 n0 = {0.f, 0.f, 0.f, 0.f}, n1 = {0.f, 0.f, 0.f, 0.f};
#pragma unroll
        for (int i = 0; i < 4; ++i) w[i] = *(const u32x4*)(WQ + (size_t)(row0 + i) * 512 + 8 * F.lane);
        if (F.lane >= 32) { const float* np = NP + ((size_t)(b * 4 + hh) * 64 + c) * 256 + 8 * (F.lane - 32); n0 = *(const f32x4*)np; n1 = *(const f32x4*)(np + 4); }
        else { n0 = (f32x4){1.f, 1.f, 1.f, 1.f}; n1 = n0; }
        const float edv = ED[row0 + (F.lane & 3)];
#pragma unroll
        for (int i = 0; i < 4; ++i) {
            const float part = ((bflo(w[i].x) * n0.x + bfhi(w[i].x) * n0.y) + (bflo(w[i].y) * n0.z + bfhi(w[i].y) * n0.w)) + ((bflo(w[i].z) * n1.x + bfhi(w[i].z) * n1.y) + (bflo(w[i].w) * n1.z + bfhi(w[i].w) * n1.w));
            const float den = wave_sum(part);
            if (F.lane == i) HDEN[row0 + i] = fmaxf(fabsf(den), edv); }
    }
}
__device__ __forceinline__ void hmnorm(Frame& F, const float* const* in) {
    bf16_t* HR = (bf16_t*)(F.dout + DO_HR); const bf16_t* MLO = (const bf16_t*)(F.ws + WS_MLO); const float* g = in[13];
    const int sub = F.lane >> 5, d8 = (F.lane & 31) * 8;
    for (int row0 = F.gw * 8; row0 < 4 * TT; row0 += F.NGW * 8) {
        u32x4 xw[4], ow[4];
#pragma unroll
        for (int i = 0; i < 4; ++i) { const int row = row0 + 2 * i + sub; const size_t o = (size_t)(row >> 2) * 1024 + (row & 3) * 256 + d8; xw[i] = *(const u32x4*)(HR + o); ow[i] = *(const u32x4*)(MLO + o); }
#pragma unroll
        for (int i = 0; i < 4; ++i) { const int row = row0 + 2 * i + sub, hh = row & 3; const size_t o = (size_t)(row >> 2) * 1024 + hh * 256 + d8;
            float x[8], og[8]; unpack8(xw[i], x); unpack8(ow[i], og);
            float ss = ((x[0] * x[0] + x[1] * x[1]) + (x[2] * x[2] + x[3] * x[3])) + ((x[4] * x[4] + x[5] * x[5]) + (x[6] * x[6] + x[7] * x[7]));
            ss += __shfl_xor(ss, 1); ss += __shfl_xor(ss, 2); ss += __shfl_xor(ss, 4); ss += __shfl_xor(ss, 8); ss += __shfl_xor(ss, 16);
            const float r = rsqrtf(ss * (1.0f / 256.0f) + EPS);
            const f32x4 g0 = *(const f32x4*)(g + hh * 256 + d8), g1 = *(const f32x4*)(g + hh * 256 + d8 + 4);
            u32x4 w; w.x = cvtpk(sigmoidf_(og[0]) * x[0] * r * g0.x, sigmoidf_(og[1]) * x[1] * r * g0.y); w.y = cvtpk(sigmoidf_(og[2]) * x[2] * r * g0.z, sigmoidf_(og[3]) * x[3] * r * g0.w);
            w.z = cvtpk(sigmoidf_(og[4]) * x[4] * r * g1.x, sigmoidf_(og[5]) * x[5] * r * g1.y); w.w = cvtpk(sigmoidf_(og[6]) * x[6] * r * g1.z, sigmoidf_(og[7]) * x[7] * r * g1.w);
            *(u32x4*)(HR + o) = w; }
    }
}
__device__ __forceinline__ unsigned fkey(float f) { const unsigned u = __float_as_uint(f); return (u & 0x80000000u) ? ~u : (u | 0x80000000u); }
__device__ __forceinline__ float fkey_inv(unsigned k) { return __uint_as_float((k & 0x80000000u) ? (k & 0x7fffffffu) : ~k); }
__device__ __forceinline__ float dot8(const u32x4 a, const u32x4 b) {
    return ((bflo(a.x) * bflo(b.x) + bfhi(a.x) * bfhi(b.x)) + (bflo(a.y) * bflo(b.y) + bfhi(a.y) * bfhi(b.y))) + ((bflo(a.z) * bflo(b.z) + bfhi(a.z) * bfhi(b.z)) + (bflo(a.w) * bflo(b.w) + bfhi(a.w) * bfhi(b.w))); }
__device__ __forceinline__ void normmax(Frame& F) {
    if (F.G != 256) return;
    LAS float* red = (LAS float*)F.lds;
    const bf16_t* DQ = (const bf16_t*)(F.ws + WS_DQ); const bf16_t* DK = (const bf16_t*)(F.ws + WS_DK);
    const int r32 = F.lane & 31, hi = F.lane >> 5, g = F.wave & 3;
    const int tq0 = F.bid * 128 + 32 * g, bstart = ((F.bid * 128) / SEQ) * SEQ;
    const float NEG = -__builtin_inff();
    for (int ci = 0; ci < 8; ++ci) {
        const int c16 = (F.wave >> 2) * 8 + ci;
        const bf16_t* Qc = DQ + (size_t)c16 * TT * 128; const bf16_t* Kc = DK + (size_t)c16 * TT * 128;
        const float slope = exp2f(-(float)((c16 >> 1) + 1));
        bf16x8 qf[8], kf[3][8];
#pragma unroll
        for (int kk = 0; kk < 8; ++kk) qf[kk] = *(const bf16x8*)(Qc + (size_t)(tq0 + r32) * 128 + kk * 16 + hi * 8);
#pragma unroll
        for (int u = 0; u < 3; ++u) { const int ks = tq0 - 32 * (2 - u) >= bstart ? tq0 - 32 * (2 - u) : tq0;
#pragma unroll
            for (int kk = 0; kk < 8; ++kk) kf[u][kk] = *(const bf16x8*)(Kc + (size_t)(ks + r32) * 128 + kk * 16 + hi * 8); }
        float q2 = 0.f, k2 = 0.f;
#pragma unroll
        for (int kk = 0; kk < 8; ++kk) { q2 += dot8(__builtin_bit_cast(u32x4, qf[kk]), __builtin_bit_cast(u32x4, qf[kk])); k2 += dot8(__builtin_bit_cast(u32x4, kf[2][kk]), __builtin_bit_cast(u32x4, kf[2][kk])); }
        q2 = xsum32(q2); k2 = xsum32(k2);
        float vals[3][16]; float m = NEG;
#pragma unroll
        for (int u = 0; u < 3; ++u) { f32x16 acc = {};
#pragma unroll
            for (int kk = 0; kk < 8; ++kk) acc = __builtin_amdgcn_mfma_f32_32x32x16_bf16(kf[u][kk], qf[kk], acc, 0, 0, 0);
            const bool gv = tq0 - 32 * (2 - u) >= bstart;
#pragma unroll
            for (int r = 0; r < 16; ++r) { const int dist = 32 * (2 - u) + r32 - attn::crow(r, hi);
                const float v = (gv && dist >= 0) ? acc[r] * attn::SCALE - slope * (float)dist : NEG; vals[u][r] = v; m = fmaxf(m, v); } }
        const float ms = (m == NEG) ? 0.f : m; float l = 0.f;
#pragma unroll
        for (int u = 0; u < 3; ++u) {
#pragma unroll
            for (int r = 0; r < 16; ++r) l += __expf(vals[u][r] - ms); }
        const float mo = __shfl_xor(m, 32), lo = __shfl_xor(l, 32);
        const float M = fmaxf(m, mo);
        const float L = l * __expf(ms - M) * (m == NEG ? 0.f : 1.f) + lo * ((mo == NEG) ? 0.f : __expf(mo - M));
        float nlb = -(M + __logf(L));
        q2 = wave_max(q2); k2 = wave_max(k2); nlb = wave_max(nlb);
        if (F.lane == 0) { red[F.wave * 48 + c16] = q2; red[F.wave * 48 + 16 + c16] = k2; red[F.wave * 48 + 32 + c16] = nlb; }
    }
    __syncthreads();
    if (F.tid < 48) {
        const int blk = F.bid >> 1, b = (F.bid * 128) / SEQ, kind = F.tid >> 4, c16 = F.tid & 15, w0 = (c16 >> 3) * 4;
        float a = red[w0 * 48 + F.tid];
#pragma unroll
        for (int w = 1; w < 4; ++w) a = fmaxf(a, red[(w0 + w) * 48 + F.tid]);
        if (kind == 0) atomicMax(F.ctl + CW_QB2 + c16 * 128 + blk, __float_as_uint(a));
        else if (kind == 1) F.ctl[CW_KT + (c16 * 2 + b) * 128 + (F.bid - b * (SEQ / 128))] = __float_as_uint(a);
        else atomicMax(F.ctl + CW_ND + c16 * 128 + blk, fkey(a));
    }
    __syncthreads();
}
__device__ __forceinline__ attn4::Item attn_item(Frame& F, int qx, int id) {
    const int b = qx >> 2, m = (qx >> 1) & 1, x = id, h = 7 - (x >> 6), qb = 2 * (63 - (x & 63)) + (qx & 1);
    const bf16_t* DQ = (const bf16_t*)(F.ws + WS_DQ); const bf16_t* DK = (const bf16_t*)(F.ws + WS_DK); const bf16_t* DV = (const bf16_t*)(F.ws + WS_DV); bf16_t* O = (bf16_t*)(F.ws + WS_O);
    attn4::Item it; const size_t srow = (size_t)b * SEQ;
    it.Q = DQ + ((size_t)(h * 2 + m) * TT + srow + (size_t)qb * 128) * 128;
    it.K = DK + ((size_t)(h * 2 + m) * TT + srow) * 128;
    it.V0 = DV + ((size_t)(h * 2 + 0) * TT + srow) * 128;
    it.V1 = DV + ((size_t)(h * 2 + 1) * TT + srow) * 128;
    it.O = O + ((size_t)(h * 2 + m) * TT + srow + (size_t)qb * 128) * 256;
    it.P0 = qb * 128;
    const int c16 = h * 2 + m, blk = b * 64 + (qb >> 1);
    const float q2 = __uint_as_float(F.ctl[CW_QB2 + c16 * 128 + blk]), k2 = ((const LAS float*)(F.lds + KMX_LDS))[c16 * 2 + b], ndg = fkey_inv(F.ctl[CW_ND + c16 * 128 + blk]);
    const float slope = exp2f(-(float)(h + 1));
    const float bnd = sqrtf(q2) * sqrtf(k2) * attn::SCALE + ndg + 18.05f - logf(1.0f - expf(-slope));
    float wf = ceilf(bnd / slope) + 1.0f; if (!(wf < (float)SEQ)) wf = (float)SEQ; if (!(wf >= 1.0f)) wf = 1.0f;
    if (F.G != 256) wf = (float)SEQ;
    it.W = (int)wf; it.sl = slope / attn::SCALE;
    return it;
}
__device__ __forceinline__ int attn_ticket(Frame& F, int rep, int& myq) {
    if (F.tid == 0) { int res = -1;
        for (int k = 0; k < 8; ++k) { const int q = (myq + k) & 7; const unsigned t = atomicAdd(F.ctl + CW_AHEAD + rep * 64 + q * 8, 1u); if (t < 512u) { res = q * 512 + (int)t; break; } }
        F.MISC[0] = (unsigned)res; }
    __syncthreads();
    const int v = __builtin_amdgcn_readfirstlane((int)F.MISC[0]);
    __syncthreads();
    if (v >= 0) myq = v >> 9;
    return v;
}
__device__ __forceinline__ void attn_phase(Frame& F, int rep) {
    const int tid = F.tid; int myq = F.bid & 7;
    { const int ent = F.tid >> 4, sub = F.tid & 15; float m = 0.f;
#pragma unroll
      for (int j = 0; j < 8; ++j) m = fmaxf(m, __uint_as_float(F.ctl[CW_KT + ent * 128 + sub * 8 + j]));
      m = fmaxf(m, __shfl_xor(m, 1)); m = fmaxf(m, __shfl_xor(m, 2)); m = fmaxf(m, __shfl_xor(m, 4)); m = fmaxf(m, __shfl_xor(m, 8));
      if (sub == 0) ((LAS float*)(F.lds + KMX_LDS))[ent] = m;
      __syncthreads(); }
    for (;;) {
        const int id = attn_ticket(F, rep, myq);
        if (id < 0) break;
        const attn4::Item it = attn_item(F, id >> 9, id & 511);
        attn4::item(it, (char*)F.lds_g, F.lds, tid);
    }
    VM_WAIT(); __syncthreads();
}
__device__ __forceinline__ void dacombine(Frame& F, const float* const* in, const bf16_t* O, bf16_t* DA) {
    const float* g = in[12];
    const float lam = __uint_as_float(F.ctl[CW_LAM]);
    const int sub = F.lane >> 5, d8 = (F.lane & 31) * 8;
    const int h = F.gw & 7;
    const f32x4 g0 = *(const f32x4*)(g + h * 256 + d8) * 0.8f, g1 = *(const f32x4*)(g + h * 256 + d8 + 4) * 0.8f;
    const bf16_t* O0 = O + (size_t)(h * 2 + 0) * TT * 256 + d8; const bf16_t* O1 = O + (size_t)(h * 2 + 1) * TT * 256 + d8;
    u32x4 a[4], bq[4];
#define DAC_LOAD(tb_, A_, B_) _Pragma("unroll") for (int i = 0; i < 4; ++i) { const size_t t = (size_t)(tb_) * 8 + 2 * i + sub; A_[i] = *(const u32x4*)(O0 + t * 256); B_[i] = *(const u32x4*)(O1 + t * 256); }
    const int tstep = F.NGW >> 3;
    DAC_LOAD(F.gw >> 3, a, bq);
    for (int tb = F.gw >> 3; tb < TT / 8; tb += tstep) {
        u32x4 an[4], bn[4];
        { const int tn = tb + tstep < TT / 8 ? tb + tstep : tb;
          DAC_LOAD(tn, an, bn); }
#pragma unroll
        for (int i = 0; i < 4; ++i) { const size_t t = (size_t)tb * 8 + 2 * i + sub;
            float x[8], y[8]; unpack8(a[i], x); unpack8(bq[i], y);
#pragma unroll
            for (int c = 0; c < 8; ++c) x[c] -= lam * y[c];
            float ss = ((x[0] * x[0] + x[1] * x[1]) + (x[2] * x[2] + x[3] * x[3])) + ((x[4] * x[4] + x[5] * x[5]) + (x[6] * x[6] + x[7] * x[7]));
            ss += DPP_F(ss, 0xB1); ss += DPP_F(ss, 0x4E); ss += DPP_F(ss, 0x124); ss += DPP_F(ss, 0x128);
            { const int iv = __builtin_bit_cast(int, ss);
              const float h0 = __builtin_bit_cast(float, __builtin_amdgcn_readlane(iv, 0)) + __builtin_bit_cast(float, __builtin_amdgcn_readlane(iv, 16)), h1 = __builtin_bit_cast(float, __builtin_amdgcn_readlane(iv, 32)) + __builtin_bit_cast(float, __builtin_amdgcn_readlane(iv, 48));
              ss = sub ? h1 : h0; }
            const float r = rsqrtf(ss * (1.0f / 256.0f) + EPS);
            u32x2 w; w.x = pk4_fp8(x[0] * r * g0.x, x[1] * r * g0.y, x[2] * r * g0.z, x[3] * r * g0.w); w.y = pk4_fp8(x[4] * r * g1.x, x[5] * r * g1.y, x[6] * r * g1.z, x[7] * r * g1.w);
            *(u32x2*)((unsigned char*)DA + t * 2048 + h * 256 + d8) = w; }
#pragma unroll
        for (int i = 0; i < 4; ++i) { a[i] = an[i]; bq[i] = bn[i]; }
    }
#undef DAC_LOAD
}
#ifndef P9DUP
#define P9DUP 0
#endif
__device__ __forceinline__ void expert_convert(Frame& F, const float* const* in, const int parts = 3) {
    LAS float* scr = (LAS float*)(F.lds + F.wave * 16384);
    unsigned char* WGU = F.ws + WS_WGU; unsigned char* WD = F.ws + WS_WD;
    constexpr int PER = 22528;
    if (parts & 1) { struct Dec { const float* const* in; unsigned char* WGU; unsigned char* WD; int lane;
        __device__ __forceinline__ TrD operator()(int it) const {
            const int kind = it / PER, r = it - kind * PER, e = r / 704, r2 = r - e * 704;
            if (kind < 2) { const int kb = r2 / 22, nb = r2 - kb * 22, pn = nb >> 2;
                return tr_desc((kind == 0 ? in[26] : in[27]) + (size_t)e * 2048 * DEXP, DEXP, 0, WGU, 2048, e * GU_N + pn * 128 + kind * 128, kb, nb, 32.0f, 1, lane); }
            const int kb = r2 >> 6, nb = r2 & 63;
            return tr_desc(in[28] + (size_t)e * DEXP * 2048, 2048, 0, WD + (size_t)e * 2048 * DEXP_P, DEXP_P, 0, kb, nb, 16.0f, 1, lane); } };
      const Dec dec{in, WGU, WD, F.lane};
      for (int rr_ = 0; rr_ < 1 + ((P9DUP >> 1) & 1); ++rr_) tr_run(F.gw, 3 * PER, F.NGW, dec, scr, F.lane);
    const u32x4 z = {0u, 0u, 0u, 0u};
    for (int idx = F.bid * 512 + F.tid; idx < 32 * 2 * 64 * 128; idx += F.G * 512) { const int e = idx >> 14, rem = idx & 16383, blk = rem >> 13, row = (rem >> 7) & 63, c16 = rem & 127;
        *(u32x4*)(WGU + ((size_t)e * GU_N + 1280 + blk * 128 + 64 + row) * 2048 + c16 * 16) = z; }
    for (int idx = F.bid * 512 + F.tid; idx < 32 * 2048 * 4; idx += F.G * 512) { const int en = idx >> 2, j = idx & 3;
        *(u32x4*)(WD + (size_t)en * DEXP_P + DEXP + j * 16) = z; }
    }
    if (parts & 2) { const bf16_t* HBF = (const bf16_t*)(F.dout + DO_HBF); unsigned char* H8 = F.ws + WS_HBF8;
      const size_t stride = (size_t)F.NGW * 64 * 4;
      for (int rr_ = 0; rr_ < 1 + ((P9DUP >> 2) & 1); ++rr_)
      for (size_t g8 = (size_t)(F.gw * 64 + F.lane) * 4; g8 < (size_t)TT * 256; g8 += 4 * stride) {
          u32x4 a[4][4];
#pragma unroll
          for (int j = 0; j < 4; ++j) { const size_t gj = g8 + j * stride < (size_t)TT * 256 ? g8 + j * stride : g8;
#pragma unroll
              for (int i = 0; i < 4; ++i) a[j][i] = *(const u32x4*)(HBF + (gj + i) * 8); }
#pragma unroll
          for (int j = 0; j < 4; ++j) { const size_t gj = g8 + j * stride;
              if (gj < (size_t)TT * 256) { u32x4 o0, o1;
                  o0.x = pk4_fp8(bflo(a[j][0].x), bfhi(a[j][0].x), bflo(a[j][0].y), bfhi(a[j][0].y)); o0.y = pk4_fp8(bflo(a[j][0].z), bfhi(a[j][0].z), bflo(a[j][0].w), bfhi(a[j][0].w));
                  o0.z = pk4_fp8(bflo(a[j][1].x), bfhi(a[j][1].x), bflo(a[j][1].y), bfhi(a[j][1].y)); o0.w = pk4_fp8(bflo(a[j][1].z), bfhi(a[j][1].z), bflo(a[j][1].w), bfhi(a[j][1].w));
                  o1.x = pk4_fp8(bflo(a[j][2].x), bfhi(a[j][2].x), bflo(a[j][2].y), bfhi(a[j][2].y)); o1.y = pk4_fp8(bflo(a[j][2].z), bfhi(a[j][2].z), bflo(a[j][2].w), bfhi(a[j][2].w));
                  o1.z = pk4_fp8(bflo(a[j][3].x), bfhi(a[j][3].x), bflo(a[j][3].y), bfhi(a[j][3].y)); o1.w = pk4_fp8(bflo(a[j][3].z), bfhi(a[j][3].z), bflo(a[j][3].w), bfhi(a[j][3].w));
                  *(u32x4*)(H8 + gj * 8) = o0; *(u32x4*)(H8 + gj * 8 + 16) = o1; } } } }
    __syncthreads();
}
__device__ __forceinline__ void topk_pass(Frame& F, const float* const* in, int tbeg, int tend, const bool split) {
    const float* LG = (const float*)(F.ws + WS_LG); int* TOKE = (int*)(F.ws + WS_TOKE); float* TOKW = (float*)(F.ws + WS_TOKW); const float* RSS = (const float*)(F.ws + WS_RSS); float* RT = (float*)(F.ws + WS_RT);
    LAS unsigned* hist = (LAS unsigned*)F.lds;
    if (F.tid < 64) hist[F.tid] = 0u;
    __syncthreads();
    const float* brg = in[23]; const float* bre = in[25];
    for (int t = tbeg + F.tid; t < tend; t += 512) {
        const float* lp = LG + (size_t)t * 256; const float* lq = lp + (size_t)TT * 256;
        float rt; { const f32x4* rs = (const f32x4*)(RSS + (size_t)t * 32); f32x4 a = rs[0];
#pragma unroll
            for (int j = 1; j < 8; ++j) a += rs[j];
            rt = rsqrtf(((a.x + a.y) + (a.z + a.w)) * (1.0f / 2048.0f) + EPS); RT[t] = rt; }
        f32x4 g4 = *(const f32x4*)lp; if (split) g4 += *(const f32x4*)lq; g4 *= rt;
        const float g0 = g4.x + brg[0], g1 = g4.y + brg[1], g2 = g4.z + brg[2], g3 = g4.w + brg[3];
        int grp = 0; float gm = g0; if (g1 > gm) { gm = g1; grp = 1; } if (g2 > gm) { gm = g2; grp = 2; } if (g3 > gm) { gm = g3; grp = 3; }
        const float pg = 1.0f / (expf(g0 - gm) + expf(g1 - gm) + expf(g2 - gm) + expf(g3 - gm));
        f32x4 ea = *(const f32x4*)(lp + 4 + grp * 8), eb = *(const f32x4*)(lp + 8 + grp * 8); if (split) { ea += *(const f32x4*)(lq + 4 + grp * 8); eb += *(const f32x4*)(lq + 8 + grp * 8); } ea *= rt; eb *= rt;
        const f32x4 ba = *(const f32x4*)(bre + grp * 8), bb = *(const f32x4*)(bre + grp * 8 + 4);
        float ev[8] = {ea.x + ba.x, ea.y + ba.y, ea.z + ba.z, ea.w + ba.w, eb.x + bb.x, eb.y + bb.y, eb.z + bb.z, eb.w + bb.w};
        int i1 = 0; float v1 = ev[0];
#pragma unroll
        for (int j = 1; j < 8; ++j) if (ev[j] > v1) { v1 = ev[j]; i1 = j; }
        int i2 = -1; float v2 = -__builtin_inff();
#pragma unroll
        for (int j = 0; j < 8; ++j) if (j != i1 && ev[j] > v2) { v2 = ev[j]; i2 = j; }
        const float ex = expf(v2 - v1), inv = 1.0f / (1.0f + ex);
        const int e1 = grp * 8 + i1, e2 = grp * 8 + i2;
        TOKE[t * 2] = e1; TOKE[t * 2 + 1] = e2; TOKW[t * 2] = inv * pg; TOKW[t * 2 + 1] = ex * inv * pg;
        const int hf = ((t - tbeg) >> 7) & 1;
        __hip_atomic_fetch_add(&hist[hf * 32 + e1], 1u, __ATOMIC_RELAXED, __HIP_MEMORY_SCOPE_WORKGROUP); __hip_atomic_fetch_add(&hist[hf * 32 + e2], 1u, __ATOMIC_RELAXED, __HIP_MEMORY_SCOPE_WORKGROUP);
    }
    __syncthreads();
    if (F.tid < 32 && (hist[F.tid] + hist[32 + F.tid])) atomicAdd(F.ctl + CW_ECNT + F.tid, hist[F.tid] + hist[32 + F.tid]);
    if (F.tid < 64) F.ctl[CW_CH + ((tbeg >> 7) + (F.tid >> 5)) * 32 + (F.tid & 31)] = hist[F.tid];
    __syncthreads();
}
__device__ __forceinline__ void gather_pass(Frame& F, const float* const* in) {
    const int* TOKE = (const int*)(F.ws + WS_TOKE); const float* TOKW = (const float*)(F.ws + WS_TOKW); int* POS = (int*)(F.ws + WS_POS); float* WROW = (float*)(F.ws + WS_WROW); int* TILEE = (int*)(F.ws + WS_TILEE);
    const bf16_t* X1B = (const bf16_t*)(F.ws + WS_X1B); const float* RT = (const float*)(F.ws + WS_RT); unsigned char* XSORT = F.ws + WS_XSORT;
    float gf[32];
#pragma unroll
    for (int j = 0; j < 8; ++j) { const f32x4 g = *(const f32x4*)(in[21] + 32 * F.lane + 4 * j); gf[4 * j] = g.x; gf[4 * j + 1] = g.y; gf[4 * j + 2] = g.z; gf[4 * j + 3] = g.w; }
    LAS unsigned* pstart = (LAS unsigned*)F.lds; LAS unsigned* hist = pstart + 32; LAS unsigned* base = pstart + 64; LAS unsigned* lcur = pstart + 96; LAS int* apos = (LAS int*)(pstart + 128); LAS int* atok = apos + 512;
    LAS unsigned* ecnt = pstart + 2048; LAS unsigned* part = pstart + 2112;
    if (F.tid < 32) ecnt[F.tid] = F.ctl[CW_ECNT + F.tid];
    const bool det = (F.G == 256);
    if (det) { const int e = F.tid & 31, pt = F.tid >> 5; unsigned sum = 0;
#pragma unroll
        for (int j = 0; j < 16; ++j) { const int hq = pt + 16 * j; sum += (hq < F.bid) ? F.ctl[CW_CH + hq * 32 + e] : 0u; }
        part[pt * 32 + e] = sum; }
    __syncthreads();
    if (F.tid == 0) { unsigned acc = 0; for (int e = 0; e < 32; ++e) { pstart[e] = acc; const unsigned c = ecnt[e]; const unsigned pc = (c + 255u) & ~255u;
            if (F.bid == 0) for (unsigned rt = acc >> 8; rt < (acc + pc) >> 8; ++rt) TILEE[rt] = e;
            acc += pc; }
        if (F.bid == 0) F.ctl[CW_NRT] = acc >> 8; }
    if (det && F.tid >= 64 && F.tid < 96) { const int e = F.tid - 64; unsigned sum = 0;
#pragma unroll
        for (int j = 0; j < 16; ++j) sum += part[j * 32 + e];
        part[512 + e] = sum; }
    const int per = (TT + F.G - 1) / F.G;
    const int tbeg = F.bid * per, tend = (tbeg + per < TT) ? tbeg + per : TT;
    for (int ts = tbeg; ts < tend; ts += 256) {
        const int nasg = 2 * ((tend - ts < 256) ? tend - ts : 256);
        if (F.tid < 32) { hist[F.tid] = 0u; lcur[F.tid] = 0u; }
        __syncthreads();
        int e = 0; const int a = F.tid;
        if (a < nasg) { e = TOKE[ts * 2 + a]; __hip_atomic_fetch_add(&hist[e], 1u, __ATOMIC_RELAXED, __HIP_MEMORY_SCOPE_WORKGROUP); }
        __syncthreads();
        if (F.tid < 32) base[F.tid] = pstart[F.tid] + (det ? part[512 + F.tid] : (hist[F.tid] ? atomicAdd(F.ctl + CW_ECUR + F.tid, hist[F.tid]) : 0u));
        __syncthreads();
        if (a < nasg) { const unsigned p = base[e] + __hip_atomic_fetch_add(&lcur[e], 1u, __ATOMIC_RELAXED, __HIP_MEMORY_SCOPE_WORKGROUP); POS[ts * 2 + a] = (int)p; WROW[p] = TOKW[ts * 2 + a]; apos[a] = (int)p; atok[a] = ts + (a >> 1); }
        __syncthreads();
        for (int i = F.wave; i < nasg; i += 8) { const int tok = atok[i]; const u32x4* src = (const u32x4*)(X1B + (size_t)tok * 2048) + 4 * F.lane; u32x4* dst = (u32x4*)(XSORT + (size_t)apos[i] * 2048) + 2 * F.lane;
            u32x4 a[4]; const float rt = RT[tok];
#pragma unroll
            for (int j = 0; j < 4; ++j) a[j] = src[j];
            unsigned o[8];
#pragma unroll
            for (int j = 0; j < 4; ++j) {
                o[2 * j]     = pk4_fp8(bflo(a[j].x) * rt * gf[8 * j],     bfhi(a[j].x) * rt * gf[8 * j + 1], bflo(a[j].y) * rt * gf[8 * j + 2], bfhi(a[j].y) * rt * gf[8 * j + 3]);
                o[2 * j + 1] = pk4_fp8(bflo(a[j].z) * rt * gf[8 * j + 4], bfhi(a[j].z) * rt * gf[8 * j + 5], bflo(a[j].w) * rt * gf[8 * j + 6], bfhi(a[j].w) * rt * gf[8 * j + 7]); }
            u32x4 o0, o1; o0.x = o[0]; o0.y = o[1]; o0.z = o[2]; o0.w = o[3]; o1.x = o[4]; o1.y = o[5]; o1.z = o[6]; o1.w = o[7];
            dst[0] = o0; dst[1] = o1; }
        __syncthreads();
    }
}
__device__ __forceinline__ void unpack8_fp8(const u32x2 w, float (&x)[8]) {
    x[0] = __builtin_amdgcn_cvt_f32_fp8((int)w.x, 0); x[1] = __builtin_amdgcn_cvt_f32_fp8((int)w.x, 1); x[2] = __builtin_amdgcn_cvt_f32_fp8((int)w.x, 2); x[3] = __builtin_amdgcn_cvt_f32_fp8((int)w.x, 3);
    x[4] = __builtin_amdgcn_cvt_f32_fp8((int)w.y, 0); x[5] = __builtin_amdgcn_cvt_f32_fp8((int)w.y, 1); x[6] = __builtin_amdgcn_cvt_f32_fp8((int)w.y, 2); x[7] = __builtin_amdgcn_cvt_f32_fp8((int)w.y, 3); }
__device__ __forceinline__ void final_pass(Frame& F, const float* const* in) {
    const bf16_t* X1B = (const bf16_t*)(F.ws + WS_X1B); float* OUT = (float*)F.dout; const unsigned char* YS = F.ws + WS_YS; const int* POS = (const int*)(F.ws + WS_POS); const float* g = in[29];
    f32x4 gv[4][2];
#pragma unroll
    for (int j = 0; j < 4; ++j) { gv[j][0] = *(const f32x4*)(g + 8 * F.lane + 512 * j); gv[j][1] = *(const f32x4*)(g + 8 * F.lane + 512 * j + 4); }
    for (int m0 = F.gw * 2; m0 < TT; m0 += F.NGW * 2) {
        u32x4 x[2][4]; u32x2 a[2][4], bq[2][4];
#pragma unroll
        for (int rr = 0; rr < 2; ++rr) { const int m = m0 + rr; const int p0 = POS[m * 2], p1 = POS[m * 2 + 1];
#pragma unroll
            for (int j = 0; j < 4; ++j) { const size_t c = 8 * F.lane + 512 * j;
                x[rr][j] = *(const u32x4*)(X1B + (size_t)m * 2048 + c); a[rr][j] = *(const u32x2*)(YS + (size_t)p0 * 2048 + c); bq[rr][j] = *(const u32x2*)(YS + (size_t)p1 * 2048 + c); } }
#pragma unroll
        for (int rr = 0; rr < 2; ++rr) { const int m = m0 + rr; float v[4][8]; float ss = 0.f;
#pragma unroll
            for (int j = 0; j < 4; ++j) { float xa[8], ya[8], yb[8]; unpack8(x[rr][j], xa); unpack8_fp8(a[rr][j], ya); unpack8_fp8(bq[rr][j], yb);
#pragma unroll
                for (int c = 0; c < 8; ++c) { v[j][c] = xa[c] + (ya[c] + yb[c]) * (1.0f / 64.0f); ss += v[j][c] * v[j][c]; } }
            ss = wave_sum(ss); const float r = rsqrtf(ss * (1.0f / 2048.0f) + EPS);
#pragma unroll
            for (int j = 0; j < 4; ++j) { const size_t c = 8 * F.lane + 512 * j; const f32x4 g0 = gv[j][0], g1 = gv[j][1];
                *(f32x4*)(OUT + (size_t)m * 2048 + c) = (f32x4){v[j][0] * r * g0.x, v[j][1] * r * g0.y, v[j][2] * r * g0.z, v[j][3] * r * g0.w};
                *(f32x4*)(OUT + (size_t)m * 2048 + c + 4) = (f32x4){v[j][4] * r * g1.x, v[j][5] * r * g1.y, v[j][6] * r * g1.z, v[j][7] * r * g1.w}; } }
    }
}
constexpr int NPHASE = 20;
struct Args { const float* in[30]; float* out; unsigned char* ws; int ph_lo, ph_hi; };

__device__ __forceinline__ bool fresh_lane(Frame& F) { int l = (int)__builtin_amdgcn_mbcnt_hi(~0u, __builtin_amdgcn_mbcnt_lo(~0u, 0u)); asm volatile("" : "+v"(l)); F.lane = l; F.tid = (F.wave << 6) | l; return true; }
__global__ void __launch_bounds__(512, 2) mk_fwd(Args args) {
    extern __shared__ __attribute__((aligned(16))) unsigned char lds_raw[];
    Frame F;
    F.lds = (LAS unsigned char*)lds_raw; F.lds_g = lds_raw;
    F.MISC = (volatile LAS unsigned*)(F.lds + MISC_OFF);
    F.tid = threadIdx.x; F.lane = F.tid & 63; F.wave = __builtin_amdgcn_readfirstlane(F.tid >> 6);
    F.G = gridDim.x; F.bid = blockIdx.x; F.gw = F.bid * 8 + F.wave; F.NGW = F.G * 8;
    F.ws = args.ws; F.dout = (unsigned char*)args.out; F.ctl = (unsigned*)(args.ws + WS_CTL);
    const float* const* in = args.in;
    for (int u = F.tid; u < (LDS_BYTES - RING_BYTES) / 4; u += 512) ((LAS unsigned*)(F.lds + RING_BYTES))[u] = 0u;
    __syncthreads();
    const int lo = args.ph_lo, hi = args.ph_hi;
    const bool fused = (hi - lo) > 1;
    XcdBarrier bar; bar.bar = F.ctl + CW_BAR; bar.x = 0; bar.st = nullptr;
    if (fused) bar = xcd_barrier_post(F.ctl + CW_BAR, F.MISC + 8, F.tid);
#ifndef ONLY_PHASE
#define ONLY_PHASE -1
#endif
#define IN(k) ((ONLY_PHASE < 0 || ONLY_PHASE == (k)) && lo <= (k) && (k) < hi && fresh_lane(F))
#ifndef DUP_MASK
#define DUP_MASK 0
#endif
#define DUP_BEGIN(k) _Pragma("unroll") for (int rep_ = 0; rep_ < 1 + ((DUP_MASK >> (k)) & 1); ++rep_) { if (rep_) { xcd_barrier(bar, F.tid); fresh_lane(F); }
#define DUP_END }
#define SEAM(k) do { if ((ONLY_PHASE < 0 || ONLY_PHASE == (k) + 1) && lo <= (k) + 1 && (k) + 1 < hi) xcd_barrier(bar, F.tid); } while (0)
    const int G = F.G, c = F.bid;
    bf16_t* const HBF = (bf16_t*)(F.dout + DO_HBF);
    bf16_t* const WINT = (bf16_t*)(F.ws + WS_WINT);
    const bf16_t* const HBF8 = (const bf16_t*)(F.ws + WS_HBF8);
    const bf16_t* const WG8 = (const bf16_t*)(WINT + (size_t)11264 * 2048);

    if (IN(0)) { DUP_BEGIN(0) p0_prologue(F, in); DUP_END SEAM(0); }

    if (IN(1)) { DUP_BEGIN(1)
        if (F.bid >= 16 && F.bid < 24) ml0_seq(F, in, F.bid - 16);
        { pg8::SchedPA S{HBF, WINT, G, c};
          pg8::EpiPA E{(bf16_t*)(F.ws + WS_MQK), (bf16_t*)(F.ws + WS_MLO), (bf16_t*)(F.ws + WS_XQ), (bf16_t*)(F.ws + WS_VC), 1.0f};
          pg8::gemm_phase(F.lds, 2048, 2048, 2048, S, E, F.tid); }
        { pg8::SchedPA8 S{HBF8, (const bf16_t*)(WINT + (size_t)8192 * 2048), G, c};
          pg8::EpiPA E{(bf16_t*)(F.ws + WS_MQK), (bf16_t*)(F.ws + WS_MLO), (bf16_t*)(F.ws + WS_XQ), (bf16_t*)(F.ws + WS_VC), 1.0f / 32.0f};
          pg8::gemm_phase<pg8::EpiPA, pg8::SchedPA8, true>(F.lds, 1024, 1024, 1024, S, E, F.tid); }
        DUP_END SEAM(1);
    }
    if (IN(2)) { DUP_BEGIN(2)
        if (G <= 16 || c < 16) { pg8::SchedMem S{(const bf16_t*)(F.ws + WS_MEMN), (const bf16_t*)(F.ws + WS_WMEMT), G, c};
            pg8::EpiMem E{(bf16_t*)(F.ws + WS_MK), (bf16_t*)(F.ws + WS_MVT)};
            pg8::gemm_phase(F.lds, 2048, 2048, 2048, S, E, F.tid); }
        if (G <= 16 || c >= 16) { const int first = G > 16 ? (c - 16) * 8 + F.wave : F.gw, nstep = G > 16 ? (G - 16) * 8 : F.NGW; ml1_conv(F, in, first, nstep); }
        DUP_END SEAM(2);
    }
    if (IN(3)) { DUP_BEGIN(3)
#ifndef SUB
#define SUB 7
#endif
        if (SUB & 1) { pg8::SchedHG S{(const bf16_t*)(F.ws + WS_Q), (const bf16_t*)(F.ws + WS_KW), (size_t)TT * 256, 65536, (size_t)TT * 256, 65536, G, c};
          pg8::EpiW E{(bf16_t*)(F.ws + WS_WQ), (const float*)(F.ws + WS_SCRS)};
          pg8::gemm_phase(F.lds, 256, 256, 256, S, E, F.tid); }
        if (SUB & 2) { pg8::SchedHG S{(const bf16_t*)(F.ws + WS_VC), (const bf16_t*)(F.ws + WS_KWT), (size_t)128 * 256 * 512, (size_t)256 * 512, (size_t)128 * 65536, 65536, G, c};
          pg8::EpiB16Tile E{(bf16_t*)(F.ws + WS_U), 65536, 0, (size_t)128 * 65536, 256, 1.0f};
          pg8::gemm_phase(F.lds, 512, 256, 256, S, E, F.tid); }
        if (SUB & 4) { pg8::SchedXA S{(const bf16_t*)(F.ws + WS_XQ), (const bf16_t*)(F.ws + WS_MK), G, c};
          pg8::EpiXSoft E{(bf16_t*)(F.ws + WS_XP2), (LAS float*)(F.lds + pg8::EPI_TBL_OFF)};
          pg8::gemm_phase(F.lds, 256, 256, 256, S, E, F.tid); }
        if (F.bid < 8) nscan_seq(F, F.bid);
        DUP_END SEAM(3);
    }
    if (IN(4)) { DUP_BEGIN(4) cscan(F); denpass(F); DUP_END SEAM(4); }
    if (IN(5)) { DUP_BEGIN(5)
        { pg8::SchedHG S{(const bf16_t*)(F.ws + WS_WQ), (const bf16_t*)(F.ws + WS_VC), (size_t)TT * 512, (size_t)256 * 512, (size_t)128 * 256 * 512, (size_t)256 * 512, G, c};
          pg8::EpiHNorm E{(bf16_t*)(F.dout + DO_HR), (const float*)(F.ws + WS_HDEN), (const bf16_t*)(F.ws + WS_MLO), in[13], (LAS float*)(F.lds + pg8::EPI_TBL_OFF)};
          pg8::gemm_phase(F.lds, 512, 512, 512, S, E, F.tid); }
        { pg8::SchedXA S{(const bf16_t*)(F.ws + WS_XP2), (const bf16_t*)(F.ws + WS_MVT), G, c};
          pg8::EpiXA E{(bf16_t*)(F.dout + DO_XA)};
          pg8::gemm_phase(F.lds, 256, 256, 256, S, E, F.tid); }
        DUP_END SEAM(5);
    }
    if (IN(6)) { DUP_BEGIN(6)
        pg8::SchedDense S{HBF, WINT, 2048, 2048, 128, 24, G, c};
        pg8::EpiPB E{(bf16_t*)(F.ws + WS_DQ), (bf16_t*)(F.ws + WS_DK), (bf16_t*)(F.ws + WS_DV)};
        pg8::gemm_phase(F.lds, 2048, 2048, 2048, S, E, F.tid);
        DUP_END SEAM(6);
    }
    if (IN(7)) { DUP_BEGIN(7) normmax(F); DUP_END SEAM(7); }
    if (IN(8)) { DUP_BEGIN(8) attn_phase(F, rep_); DUP_END SEAM(8); }
#ifndef SLEEP_US
#define SLEEP_US 0
#endif
    if (IN(9)) { if (SLEEP_US) { const unsigned long long t0_ = __builtin_amdgcn_s_memrealtime(); while (__builtin_amdgcn_s_memrealtime() - t0_ < (unsigned long long)SLEEP_US * 100ull) __builtin_amdgcn_s_sleep(127); }
        DUP_BEGIN(9) dacombine(F, in, (const bf16_t*)(F.ws + WS_O), (bf16_t*)(F.ws + WS_DA)); if (P9DUP & 1) dacombine(F, in, (const bf16_t*)in[0], (bf16_t*)(F.ws + WS_DV)); expert_convert(F, in, 1); DUP_END SEAM(9); }
    if (IN(10)) { DUP_BEGIN(10)
        pg8::SchedDense S{HBF8, WG8, 1024, 1024, 128, 8, G, c};
        pg8::EpiGate E{(bf16_t*)(F.ws + WS_GT0), in[19], 1.0f / 32.0f};
        pg8::gemm_phase<pg8::EpiGate, pg8::SchedDense, true>(F.lds, 1024, 1024, 1024, S, E, F.tid);
        DUP_END SEAM(10);
    }
    if (IN(11)) { DUP_BEGIN(11)
        { pg8::SchedDense S{(const bf16_t*)(F.ws + WS_DA), (const bf16_t*)(F.ws + WS_WBDT), 1024, 1024, 128, 8, G, c};
          pg8::EpiBranch<true> E{(const bf16_t*)(F.ws + WS_GT0), (bf16_t*)(F.dout + DO_MERGED), 1.0f / 32.0f};
          pg8::gemm_phase<pg8::EpiBranch<true>, pg8::SchedDense, true>(F.lds, 1024, 1024, 1024, S, E, F.tid); }
        { pg8::SchedDense S{HBF8, WG8 + (size_t)2048 * 1024, 1024, 1024, 128, 8, G, c};
          pg8::EpiGate E{(bf16_t*)(F.ws + WS_GT1), in[19] + 2048, 1.0f / 32.0f};
          pg8::gemm_phase<pg8::EpiGate, pg8::SchedDense, true>(F.lds, 1024, 1024, 1024, S, E, F.tid); }
        DUP_END SEAM(11);
    }
    if (IN(12)) { DUP_BEGIN(12)
        { pg8::SchedDense S{(const bf16_t*)(F.dout + DO_HR), (const bf16_t*)(F.ws + WS_WBMT), 1024, 1024, 128, 8, G, c};
          pg8::EpiBranch<false> E{(const bf16_t*)(F.ws + WS_GT1), (bf16_t*)(F.dout + DO_MERGED), 1.0f};
          pg8::gemm_phase(F.lds, 1024, 1024, 1024, S, E, F.tid); }
        { pg8::SchedDense S{HBF8, WG8 + (size_t)4096 * 1024, 1024, 1024, 128, 8, G, c};
          pg8::EpiGate E{(bf16_t*)(F.ws + WS_GT0), in[19] + 4096, 1.0f / 32.0f};
          pg8::gemm_phase<pg8::EpiGate, pg8::SchedDense, true>(F.lds, 1024, 1024, 1024, S, E, F.tid); }
        DUP_END SEAM(12);
    }
    if (IN(13)) { DUP_BEGIN(13)
        pg8::SchedDense S{(const bf16_t*)(F.dout + DO_XA), (const bf16_t*)(F.ws + WS_WBCT), 1024, 1024, 128, 8, G, c};
        pg8::EpiBranch<false> E{(const bf16_t*)(F.ws + WS_GT0), (bf16_t*)(F.dout + DO_MERGED), 1.0f};
        pg8::gemm_phase(F.lds, 1024, 1024, 1024, S, E, F.tid);
        DUP_END SEAM(13);
    }
    if (IN(14)) { DUP_BEGIN(14)
        pg8::SchedDense S{(const bf16_t*)(F.dout + DO_MERGED), (const bf16_t*)(F.ws + WS_WOUTT), 2048, 2048, 128, 8, G, c};
        pg8::EpiOut E{in[0], (bf16_t*)(F.ws + WS_X1B), (float*)(F.ws + WS_RSS)};
        pg8::gemm_phase(F.lds, 2048, 2048, 2048, S, E, F.tid);
        DUP_END SEAM(14);
    }
    if (IN(15)) { DUP_BEGIN(15)
        if (G >= 256) {
            pg8::SchedRouter S{(const bf16_t*)(F.ws + WS_X1B), (const bf16_t*)(F.ws + WS_WRT), G, c};
            pg8::EpiF32Tile E{(float*)(F.ws + WS_LG), 65536, (size_t)TT * 256, 0, 256};
            pg8::gemm_phase(F.lds, 2048, 2048, 1024, S, E, F.tid);
            if (c < 256) {
                VM_WAIT(); __syncthreads();
                if (F.tid == 0) { __threadfence(); F.MISC[0] = atomicAdd(F.ctl + CW_RCNT + (c >> 1), 1u); }
                __syncthreads();
                const unsigned arrived = F.MISC[0];
                __syncthreads();
                if (arrived == 1u) { __threadfence(); topk_pass(F, in, (c >> 1) * 256, (c >> 1) * 256 + 256, true); }
            }
        } else {
            pg8::SchedDense S{(const bf16_t*)(F.ws + WS_X1B), (const bf16_t*)(F.ws + WS_WRT), 2048, 2048, 128, 1, G, c};
            pg8::EpiF32Tile E{(float*)(F.ws + WS_LG), 65536, 0, 0, 256};
            pg8::gemm_phase(F.lds, 2048, 2048, 2048, S, E, F.tid);
            VM_WAIT(); __syncthreads();
            for (int L = c; L < 128; L += G) { int pm, pn; pg8::tile_order(L, 128, 1, pm, pn); topk_pass(F, in, pm * 256, pm * 256 + 256, false); }
        }
        DUP_END SEAM(15);
    }
    if (IN(16)) { DUP_BEGIN(16) gather_pass(F, in); DUP_END SEAM(16); }
    if (IN(17)) { DUP_BEGIN(17)
        const int nrt = (int)__builtin_amdgcn_readfirstlane(F.ctl[CW_NRT]);
        LAS int* ue = (LAS int*)(F.lds + RING_BYTES + 3328);
        if (F.tid < 16) { const int L = F.tid * G + c; ue[F.tid] = (L < nrt * 6) ? ((const int*)(F.ws + WS_TILEE))[L / 6] : 0; }
        __syncthreads();
        pg8::SchedMoE S{(const bf16_t*)(F.ws + WS_XSORT), (const bf16_t*)(F.ws + WS_WGU), ue, nrt, 6, 1024, (size_t)GU_N * 1024, (size_t)256 * 1024, G, c};
        pg8::EpiGU E{F.ws + WS_HD};
        pg8::gemm_phase<pg8::EpiGU, pg8::SchedMoE, true>(F.lds, 1024, 1024, 1024, S, E, F.tid);
        DUP_END SEAM(17);
    }
    if (IN(18)) { DUP_BEGIN(18)
        const int nrt = (int)__builtin_amdgcn_readfirstlane(F.ctl[CW_NRT]);
        LAS int* ue = (LAS int*)(F.lds + RING_BYTES + 3328);
        if (F.tid < 16) { const int L = F.tid * G + c; ue[F.tid] = (L < nrt * 8) ? ((const int*)(F.ws + WS_TILEE))[L / 8] : 0; }
        __syncthreads();
        pg8::SchedMoE S{(const bf16_t*)(F.ws + WS_HD), (const bf16_t*)(F.ws + WS_WD), ue, nrt, 8, DEXP_P / 2, (size_t)2048 * (DEXP_P / 2), (size_t)256 * (DEXP_P / 2), G, c};
        pg8::EpiDown E{F.ws + WS_YS, (const float*)(F.ws + WS_WROW)};
        pg8::gemm_phase<pg8::EpiDown, pg8::SchedMoE, true>(F.lds, DEXP_P / 2, DEXP_P / 2, DEXP_P / 2, S, E, F.tid);
        DUP_END SEAM(18);
    }
    if (IN(19)) { DUP_BEGIN(19) final_pass(F, in); DUP_END }
#ifdef TAIL_PROBE
    if (fused) { xcd_barrier(bar, F.tid); fresh_lane(F);
        if (TAIL_PROBE == 1) dacombine(F, in, (const bf16_t*)(F.ws + WS_O), (bf16_t*)(F.ws + WS_DA));
        if (TAIL_PROBE == 2) expert_convert(F, in, 1);
        if (TAIL_PROBE == 4) ml1_conv(F, in, F.gw, F.NGW);
        if (TAIL_PROBE == 5) cscan(F);
        if (TAIL_PROBE == 6) denpass(F);
        if (TAIL_PROBE == 7) normmax(F);
        if (TAIL_PROBE == 10) p0_prologue(F, in, 1);
    }
#endif
#undef IN
#undef SEAM
}

#ifndef MK_FUSED
#define MK_FUSED 1
#endif
extern "C" void kernel_launch(void* const* d_in, const int* in_sizes, int n_in, void* d_out, int out_size, void* d_ws, size_t ws_size, hipStream_t stream) {
    static int grid = 0;
    if (grid == 0) {
        if (n_in != 30 || out_size != TT * DM || ws_size < WS_END) { fprintf(stderr, "kernel_launch: unexpected shapes (n_in %d out %d ws %zu)\n", n_in, out_size, ws_size); grid = -1; return; }
        int dev = 0, cus = 0, per_cu = 0;
        if (hipGetDevice(&dev) != hipSuccess || hipDeviceGetAttribute(&cus, hipDeviceAttributeMultiprocessorCount, dev) != hipSuccess) { grid = -1; return; }
        if (hipFuncSetAttribute((const void*)mk_fwd, hipFuncAttributeMaxDynamicSharedMemorySize, LDS_BYTES) != hipSuccess) { fprintf(stderr, "kernel_launch: hipFuncSetAttribute failed\n"); grid = -1; return; }
        if (hipOccupancyMaxActiveBlocksPerMultiprocessor(&per_cu, (const void*)mk_fwd, 512, LDS_BYTES) != hipSuccess || per_cu < 1) fprintf(stderr, "kernel_launch: occupancy query says %d\n", per_cu);
        (void)hipGetLastError();
        grid = cus;
    }
    if (grid < 0) return;
    (void)hipMemsetAsync((char*)d_ws + WS_CTL, 0, CTL_ZERO_BYTES, stream);
    Args a{};
    for (int i = 0; i < 30; ++i) a.in[i] = (const float*)d_in[i];
    a.out = (float*)d_out; a.ws = (unsigned char*)d_ws;
#if MK_FUSED
    a.ph_lo = 0; a.ph_hi = NPHASE;
    hipLaunchKernelGGL(mk_fwd, dim3(grid), dim3(512), LDS_BYTES, stream, a);
#else
#ifndef PROBE_DUP
#define PROBE_DUP 0u
#endif
    for (int p = 0; p < NPHASE; ++p) { a.ph_lo = p; a.ph_hi = p + 1; hipLaunchKernelGGL(mk_fwd, dim3(grid), dim3(512), LDS_BYTES, stream, a);
        if ((PROBE_DUP >> p) & 1u) {
            if (p == 8) (void)hipMemsetAsync((char*)d_ws + WS_CTL + CW_AHEAD * 4, 0, 256, stream);
            hipLaunchKernelGGL(mk_fwd, dim3(grid), dim3(512), LDS_BYTES, stream, a); } }
#endif
}
```

```cpp
#include <hip/hip_runtime.h>
#include <hip/hip_bf16.h>
#include <cstdio>
#include <cstdint>

#define LAS __attribute__((address_space(3)))
#define GAS __attribute__((address_space(1)))
typedef unsigned short bf16_t;
typedef short bf16x8 __attribute__((ext_vector_type(8)));
typedef short s16x4 __attribute__((ext_vector_type(4)));
typedef float f32x2 __attribute__((ext_vector_type(2)));
typedef float f32x4 __attribute__((ext_vector_type(4)));
typedef float f32x16 __attribute__((ext_vector_type(16)));
typedef unsigned u32x2 __attribute__((ext_vector_type(2)));
typedef unsigned u32x4 __attribute__((ext_vector_type(4)));

constexpr int NB = 2, SEQ = 16384, TT = NB * SEQ, DM = 2048, MEML = 256;
constexpr int DIN = 17416;
constexpr float EPS = 1e-6f;
constexpr int NEXP = 32, DEXP = 704, DEXP_P = 768, GU_N = 1536;
constexpr int MAX_RT = 288;

constexpr size_t MiB = 1u << 20;
constexpr size_t WS_CTL = 0, CTL_ZERO_BYTES = 1 * MiB;
constexpr size_t WS_MLG = 1 * MiB;
constexpr size_t WS_SCKW = 2 * MiB, WS_SCRS = 2 * MiB + 512 * 1024, WS_SCIT = 3 * MiB, WS_SCED = 3 * MiB + 512 * 1024;
constexpr size_t WS_HDEN = 4 * MiB;
constexpr size_t WS_KN = 13 * MiB;
constexpr size_t WS_NP = 5 * MiB + 512 * 1024;
constexpr size_t WS_DEC = 6 * MiB;
constexpr size_t WS_MEMN = 7 * MiB;
constexpr size_t WS_MK = 9 * MiB;
constexpr size_t WS_MVT = 10 * MiB;
constexpr size_t WS_TOKE = 11 * MiB;
constexpr size_t WS_TOKW = 11 * MiB + 256 * 1024;
constexpr size_t WS_POS = 11 * MiB + 512 * 1024;
constexpr size_t WS_WROW = 12 * MiB;
constexpr size_t WS_TILEE = 12 * MiB + 512 * 1024;
constexpr size_t WS_RT = 12 * MiB + 768 * 1024;
constexpr size_t WS_WINT = 16 * MiB;
constexpr size_t WS_WMEMT = 84 * MiB;
constexpr size_t WS_WBDT = 92 * MiB;
constexpr size_t WS_WBMT = 100 * MiB;
constexpr size_t WS_WBCT = 104 * MiB;
constexpr size_t WS_WOUTT = 108 * MiB;
constexpr size_t WS_WRT = 116 * MiB;
constexpr size_t WS_MQK = 120 * MiB;
constexpr size_t WS_U = 120 * MiB;
constexpr size_t WS_XQ = 312 * MiB;
constexpr size_t WS_XP = 312 * MiB;
constexpr size_t WS_VC = 376 * MiB;
constexpr size_t WS_Q = 504 * MiB;
constexpr size_t WS_WQ = 568 * MiB;
constexpr size_t WS_KW = 696 * MiB;
constexpr size_t WS_KWT = 760 * MiB;
constexpr size_t WS_XP2 = 824 * MiB;
constexpr size_t WS_XS = 824 * MiB;
constexpr size_t WS_MLO = 248 * MiB;
constexpr size_t WS_DQ = 120 * MiB, WS_DK = 248 * MiB, WS_DV = 376 * MiB;
constexpr size_t WS_O = 504 * MiB;
constexpr size_t WS_DA = 760 * MiB;
constexpr size_t WS_WGU = 120 * MiB;
constexpr size_t WS_WD = 216 * MiB;
constexpr size_t WS_HBF8 = 952 * MiB;
constexpr size_t WS_GT0 = 264 * MiB, WS_GT1 = 536 * MiB, WS_GT2 = 824 * MiB;
constexpr size_t WS_MERGEDB = 392 * MiB;
constexpr size_t DO_MERGED = 0;
constexpr size_t WS_X1B = 264 * MiB;
constexpr size_t WS_RSS = 1016 * MiB;
constexpr size_t WS_LG = 536 * MiB;
constexpr size_t WS_XSORT = 568 * MiB;
constexpr size_t WS_HD = 856 * MiB;
constexpr size_t WS_YS = 568 * MiB;
constexpr size_t WS_END = 1024 * MiB;
constexpr size_t DO_HBF = 0, DO_HR = 128 * MiB, DO_XA = 192 * MiB;

constexpr int CW_BAR = 4096;
constexpr int CW_AHEAD = 8192;
constexpr int CW_QKMAX = 8256;
constexpr int CW_KMX = 8272;
constexpr int CW_QB2 = 16384;
constexpr int CW_CH = 40960;
constexpr int CW_KT = 32768;
constexpr int KMX_LDS = 131072 + 3072;
constexpr int CW_ND = 16384 + 2048;
constexpr int CW_ECNT = 8320;
constexpr int CW_ECUR = 8384;
constexpr int CW_LAM = 8448;
constexpr int CW_NRT = 8449;

constexpr int RING_BYTES = 131072;
constexpr int MISC_OFF = RING_BYTES + 320;
constexpr int LDS_BYTES = 147456;

#define LDS_WAIT() asm volatile("s_waitcnt lgkmcnt(0)" ::: "memory")
#define VM_WAIT() asm volatile("s_waitcnt vmcnt(0)" ::: "memory")
#define RLX_AGENT __ATOMIC_RELAXED, __HIP_MEMORY_SCOPE_AGENT

__device__ __forceinline__ unsigned cvtpk(float lo, float hi) { unsigned r; asm volatile("s_nop 0\n\tv_cvt_pk_bf16_f32 %0, %1, %2" : "=v"(r) : "v"(lo), "v"(hi)); return r; }
__device__ __forceinline__ unsigned pk4_fp8(float a, float b, float c, float d) { int w = 0; w = __builtin_amdgcn_cvt_pk_fp8_f32(a, b, w, false); w = __builtin_amdgcn_cvt_pk_fp8_f32(c, d, w, true); return (unsigned)w; }
__device__ __forceinline__ float bf2f(unsigned short b) { return __uint_as_float(((unsigned)b) << 16); }
__device__ __forceinline__ float bflo(unsigned w) { return __uint_as_float(w << 16); }
__device__ __forceinline__ float bfhi(unsigned w) { return __uint_as_float(w & 0xffff0000u); }
#define DPP_F(x, ctrl) __builtin_bit_cast(float, __builtin_amdgcn_update_dpp(0, __builtin_bit_cast(int, (x)), (ctrl), 0xF, 0xF, true))
__device__ __forceinline__ float wave_sum(float v) {
    v += DPP_F(v, 0xB1); v += DPP_F(v, 0x4E); v += DPP_F(v, 0x124); v += DPP_F(v, 0x128);
    const int iv = __builtin_bit_cast(int, v);
    return (__builtin_bit_cast(float, __builtin_amdgcn_readlane(iv, 0)) + __builtin_bit_cast(float, __builtin_amdgcn_readlane(iv, 16))) + (__builtin_bit_cast(float, __builtin_amdgcn_readlane(iv, 32)) + __builtin_bit_cast(float, __builtin_amdgcn_readlane(iv, 48)));
}
__device__ __forceinline__ float wave_max(float v) {
    v = fmaxf(v, DPP_F(v, 0xB1)); v = fmaxf(v, DPP_F(v, 0x4E)); v = fmaxf(v, DPP_F(v, 0x124)); v = fmaxf(v, DPP_F(v, 0x128));
    const int iv = __builtin_bit_cast(int, v);
    return fmaxf(fmaxf(__builtin_bit_cast(float, __builtin_amdgcn_readlane(iv, 0)), __builtin_bit_cast(float, __builtin_amdgcn_readlane(iv, 16))), fmaxf(__builtin_bit_cast(float, __builtin_amdgcn_readlane(iv, 32)), __builtin_bit_cast(float, __builtin_amdgcn_readlane(iv, 48))));
}
__device__ __forceinline__ float xsum16(float x) { auto rr = __builtin_amdgcn_permlane16_swap(__float_as_uint(x), __float_as_uint(x), false, false); return __uint_as_float(rr[0]) + __uint_as_float(rr[1]); }
__device__ __forceinline__ float xsum32(float x) { auto rr = __builtin_amdgcn_permlane32_swap(__float_as_uint(x), __float_as_uint(x), false, false); return __uint_as_float(rr[0]) + __uint_as_float(rr[1]); }
__device__ __forceinline__ float xmax16(float x) { auto rr = __builtin_amdgcn_permlane16_swap(__float_as_uint(x), __float_as_uint(x), false, false); return fmaxf(__uint_as_float(rr[0]), __uint_as_float(rr[1])); }
__device__ __forceinline__ float xmax32(float x) { auto rr = __builtin_amdgcn_permlane32_swap(__float_as_uint(x), __float_as_uint(x), false, false); return fmaxf(__uint_as_float(rr[0]), __uint_as_float(rr[1])); }
__device__ __forceinline__ float sigmoidf_(float x) { return __builtin_amdgcn_rcpf(1.0f + __expf(-x)); }

#define XB_TMO      128
#define XB_XCNT(j)  (256  + 64 * (j))
#define XB_XSUB(j)  (1280 + 64 * (j))
#define XB_XGEN(j)  (2304 + 64 * (j))
#define XB_TOP      3328
#define XB_TOPGEN   3392
#define XCD_BAR_WORDS 3456
#define XB_SPIN_CAP (1u << 18)

__device__ __forceinline__ unsigned xb_ld(unsigned* p)              { return __hip_atomic_load(p, __ATOMIC_RELAXED, __HIP_MEMORY_SCOPE_AGENT); }
__device__ __forceinline__ unsigned xb_add(unsigned* p, unsigned v) { return __hip_atomic_fetch_add(p, v, __ATOMIC_RELAXED, __HIP_MEMORY_SCOPE_AGENT); }
__device__ __forceinline__ unsigned xb_xcc_id() { return (unsigned)__builtin_amdgcn_s_getreg((3 << 11) | 20) & 0xFu; }
#define XB_SPIN(cond, bar) do { unsigned _sp = 0; while (cond) { __builtin_amdgcn_s_sleep(1); \
    if ((++_sp & 255u) == 0u) { if (xb_ld(&(bar)[XB_TMO])) break; if (_sp > XB_SPIN_CAP) { atomicAdd(&(bar)[XB_TMO], 1u); break; } } } } while (0)

struct XcdBarrier { unsigned* bar; unsigned x; volatile LAS unsigned* st; };

__device__ __forceinline__ XcdBarrier xcd_barrier_post(unsigned* bar, volatile LAS unsigned* st, const int tid) {
    XcdBarrier b; b.bar = bar; b.x = xb_xcc_id(); b.st = st;
    if (tid == 0) (void)xb_add(&bar[XB_XCNT(b.x)], 1u);
    return b;
}
__device__ __forceinline__ void xcd_barrier_complete(unsigned* bar, unsigned x, unsigned& nloc, unsigned& nx) {
    const unsigned G = gridDim.x * gridDim.y * gridDim.z;
    unsigned sum, cnt, mine, sp = 0u;
    for (;;) {
        sum = 0u; cnt = 0u; mine = 0u;
#pragma unroll
        for (unsigned j = 0; j < 16; ++j) { const unsigned c = xb_ld(&bar[XB_XCNT(j)]); sum += c; cnt += (c > 0u) ? 1u : 0u; mine = (j == x) ? c : mine; }
        if (sum == G) break;
        __builtin_amdgcn_s_sleep(1);
        if ((++sp & 255u) == 0u) { if (xb_ld(&bar[XB_TMO])) break; if (sp > XB_SPIN_CAP) { atomicAdd(&bar[XB_TMO], 1u); break; } }
    }
    nloc = mine > 0u ? mine : 1u; nx = cnt > 0u ? cnt : 1u;
}
__device__ __forceinline__ void xcd_barrier(const XcdBarrier& b, const int tid) {
    asm volatile("s_waitcnt vmcnt(0)" ::: "memory");
    __syncthreads();
    if (tid == 0) {
        unsigned* bar = b.bar;
        __builtin_amdgcn_s_waitcnt(0);
        unsigned nloc = b.st[0], nx = b.st[1];
        if (nloc == 0u) { xcd_barrier_complete(bar, b.x, nloc, nx); b.st[0] = nloc; b.st[1] = nx; }
        const unsigned old = xb_add(&bar[XB_XSUB(b.x)], 1u);
        const unsigned gen = old / nloc;
        if (old + 1u == (gen + 1u) * nloc) {
            __builtin_amdgcn_fence(__ATOMIC_RELEASE, "agent");
            asm volatile("s_waitcnt vmcnt(0)" ::: "memory");
            const unsigned og = xb_add(&bar[XB_TOP], 1u);
            const unsigned tg = og / nx;
            if (og + 1u == (tg + 1u) * nx) xb_add(&bar[XB_TOPGEN], 1u);
            else XB_SPIN(xb_ld(&bar[XB_TOPGEN]) == tg, bar);
            __builtin_amdgcn_fence(__ATOMIC_ACQUIRE, "agent");
            xb_add(&bar[XB_XGEN(b.x)], 1u);
            asm volatile("s_waitcnt vmcnt(0)" ::: "memory");
        } else {
            XB_SPIN(xb_ld(&bar[XB_XGEN(b.x)]) == gen, bar);
            __builtin_amdgcn_fence(__ATOMIC_ACQUIRE, "agent");
            asm volatile("s_waitcnt vmcnt(0)" ::: "memory");
        }
    }
    __syncthreads();
}

namespace pg8 {
constexpr int BM = 256, BK = 64, HALF = 128, HTB = HALF * BK * 2, STAGE_BYTES = 8 * HTB, NXCD = 8, WGM = 8;
__host__ __device__ __forceinline__ int lds_byte(int r, int c) { const int st = (r >> 4) * 2 + (c >> 5), rr = r & 15, cc = c & 31, ob = rr * 64 + cc * 2; return st * 1024 + (ob ^ (((ob >> 9) & 1) << 5)); }
__host__ __device__ __forceinline__ void stage_rc(int b, int& R, int& C) { const int st = b / 1024, sb = b % 1024, swz = sb ^ (((sb >> 9) & 1) << 5); R = (st >> 1) * 16 + swz / 64; C = (st & 1) * 32 + (swz % 64) / 2; }
__host__ __device__ __forceinline__ int perm32(int rho) { const int n = rho >> 4, i = rho & 15; return 8 * (i >> 2) + 4 * n + (i & 3); }

struct Unit { const bf16_t* A; const bf16_t* B; int pm, pn, aux; };

__device__ __forceinline__ void tile_order(int L, int nM, int nN, int& pm, int& pn) {
    const int nwg = nM * nN; int wgid = L;
    { const int q = nwg / NXCD, r = nwg % NXCD, xcd = wgid % NXCD, off = wgid / NXCD; wgid = (xcd < r ? xcd * (q + 1) : r * (q + 1) + (xcd - r) * q) + off; }
    const int nig = WGM * nN, gid = wgid / nig, fm = gid * WGM, gsz = (nM - fm) < WGM ? (nM - fm) : WGM;
    pm = fm + ((wgid % nig) % gsz); pn = (wgid % nig) / gsz;
}

typedef int i32x4 __attribute__((ext_vector_type(4)));
typedef int i32x8 __attribute__((ext_vector_type(8)));
__device__ __forceinline__ i32x8 cat8(const bf16x8 a, const bf16x8 b) { const i32x4 x = __builtin_bit_cast(i32x4, a), y = __builtin_bit_cast(i32x4, b); return __builtin_shufflevector(x, y, 0, 1, 2, 3, 4, 5, 6, 7); }
template <class Epi, class Sched, bool F8 = false>
__device__ __forceinline__ void gemm_phase(LAS unsigned char* lds, const int lda, const int ldb, const int K, const Sched& S, const Epi& E, const int tid) {
    const int wid = __builtin_amdgcn_readfirstlane(tid >> 6), lane = tid & 63, wr = wid >> 2, wc = wid & 3, fr = lane & 15, fq = lane >> 4;
    const int nt = K / BK;
    unsigned voffA[2], voffB[2];
#pragma unroll
    for (int i = 0; i < 2; ++i) { int R, C; stage_rc(tid * 16 + i * 8192, R, C); const int Rb = Epi::PERM ? ((R & ~31) + perm32(R & 31)) : R;
        voffA[i] = (unsigned)(R * lda + C) * 2u; voffB[i] = (unsigned)(Rb * ldb + C) * 2u; }
    const size_t kstep = (size_t)(BK * 2);
    const size_t hstepA = (size_t)HALF * lda * 2, hstepB = (size_t)HALF * ldb * 2;
    const unsigned ldsw = (unsigned)wid * 1024u;
    const int aoff = lds_byte(wr * 64 + fr, fq * 8), boff = lds_byte(wc * 32 + fr, fq * 8);
#define PG8_SA(b, h) (((b) * 2 + (h)) * HTB)
#define PG8_SB(b, h) ((4 + (b) * 2 + (h)) * HTB)
#define PG8_STAGE(bufoff, gbase, voff) do { _Pragma("unroll") for (int _i = 0; _i < 2; ++_i) \
        __builtin_amdgcn_global_load_lds((const unsigned*)((const char*)(gbase) + (voff)[_i]), (LAS unsigned*)(lds + (bufoff) + ldsw + _i * 8192), 16, 0, 0); } while (0)
#define PG8_LDA(dst, b, h) do { _Pragma("unroll") for (int m = 0; m < 4; ++m) { \
        if constexpr (F8) { const i32x4 lo_ = *(const LAS i32x4*)(lds + PG8_SA(b, h) + aoff + m * 2048), hi_ = *(const LAS i32x4*)(lds + PG8_SA(b, h) + aoff + m * 2048 + 1024); dst##8[m] = __builtin_shufflevector(lo_, hi_, 0, 1, 2, 3, 4, 5, 6, 7); } \
        else { _Pragma("unroll") for (int k = 0; k < 2; ++k) dst[m][k] = *(const LAS bf16x8*)(lds + PG8_SA(b, h) + aoff + m * 2048 + k * 1024); } } } while (0)
#define PG8_LDB(dst, b, h) do { _Pragma("unroll") for (int n = 0; n < 2; ++n) { \
        if constexpr (F8) { const i32x4 lo_ = *(const LAS i32x4*)(lds + PG8_SB(b, h) + boff + n * 2048), hi_ = *(const LAS i32x4*)(lds + PG8_SB(b, h) + boff + n * 2048 + 1024); dst##8[n] = __builtin_shufflevector(lo_, hi_, 0, 1, 2, 3, 4, 5, 6, 7); } \
        else { _Pragma("unroll") for (int k = 0; k < 2; ++k) dst[n][k] = *(const LAS bf16x8*)(lds + PG8_SB(b, h) + boff + n * 2048 + k * 1024); } } } while (0)
#define PG8_MMA(ai, bj, At, Bt) do { __builtin_amdgcn_s_setprio(1); _Pragma("unroll") for (int m = 0; m < 4; ++m) _Pragma("unroll") for (int n = 0; n < 2; ++n) { \
        if constexpr (F8) asm volatile("v_mfma_f32_16x16x128_f8f6f4 %0, %1, %2, %0" : "+v"(acc[ai][bj][m][n]) : "v"(Bt##8[n]), "v"(At##8[m])); \
        else { _Pragma("unroll") for (int k = 0; k < 2; ++k) acc[ai][bj][m][n] = __builtin_amdgcn_mfma_f32_16x16x32_bf16(Bt[n][k], At[m][k], acc[ai][bj][m][n], 0, 0, 0); } } \
        __builtin_amdgcn_s_setprio(0); } while (0)
#define PG8_WAIT_V(n) asm volatile("s_waitcnt vmcnt(" #n ")" ::: "memory")
#define PG8_WAIT_L(n) asm volatile("s_waitcnt lgkmcnt(" #n ")" ::: "memory")
#define PG8_BAR __builtin_amdgcn_s_barrier()
#define PG8_SCHED __builtin_amdgcn_sched_barrier(0)
    Unit cur, nxt; int ui = 0;
    if (!S.next(0, cur)) return;
    f32x4 acc[2][2][4][2];
#pragma unroll
    for (int a = 0; a < 2; ++a)
#pragma unroll
        for (int b = 0; b < 2; ++b)
#pragma unroll
            for (int m = 0; m < 4; ++m)
#pragma unroll
                for (int n = 0; n < 2; ++n) acc[a][b][m][n] = (f32x4){0.f, 0.f, 0.f, 0.f};
    bf16x8 At[4][2], B0[2][2], B1[2][2]; i32x8 At8[4], B08[2], B18[2];
    const char* cA = (const char*)cur.A; const char* cB = (const char*)cur.B;
    PG8_STAGE(PG8_SB(0, 0), cB, voffB); PG8_STAGE(PG8_SA(0, 0), cA, voffA); PG8_STAGE(PG8_SB(0, 1), cB + hstepB, voffB); PG8_STAGE(PG8_SA(0, 1), cA + hstepA, voffA);
    if (wr == 1) PG8_BAR;
    PG8_WAIT_V(4); PG8_BAR;
    PG8_STAGE(PG8_SB(1, 0), cB + kstep, voffB); PG8_STAGE(PG8_SA(1, 0), cA + kstep, voffA); PG8_STAGE(PG8_SB(1, 1), cB + hstepB + kstep, voffB);
    PG8_WAIT_V(6); PG8_BAR;
    for (;;) {
        const bool has_next = S.next(ui + 1, nxt);
        const char* nA = has_next ? (const char*)nxt.A : cA; const char* nB = has_next ? (const char*)nxt.B : cB;
#pragma nounroll
        for (int t = 0; t < nt; t += 2) {
            const bool last = (t == nt - 2);
            const char* a1 = cA + (size_t)(t + 1) * kstep;
            const char* a2 = last ? nA : cA + (size_t)(t + 2) * kstep; const char* b2 = last ? nB : cB + (size_t)(t + 2) * kstep;
            const char* a3 = a2 + kstep; const char* b3 = b2 + kstep;
            PG8_LDB(B0, 0, 0); PG8_SCHED; PG8_LDA(At, 0, 0); PG8_STAGE(PG8_SA(1, 1), a1 + hstepA, voffA);
            PG8_WAIT_L(8); PG8_BAR; PG8_WAIT_L(0); PG8_MMA(0, 0, At, B0); PG8_BAR; PG8_SCHED;
            PG8_LDB(B1, 0, 1); PG8_STAGE(PG8_SB(0, 0), b2, voffB);
            PG8_BAR; PG8_WAIT_L(0); PG8_MMA(0, 1, At, B1); PG8_BAR;
            PG8_LDA(At, 0, 1); PG8_STAGE(PG8_SA(0, 0), a2, voffA);
            PG8_BAR; PG8_WAIT_L(0); PG8_MMA(1, 0, At, B0); PG8_BAR; PG8_SCHED;
            PG8_STAGE(PG8_SB(0, 1), b2 + hstepB, voffB);
            PG8_WAIT_V(6); PG8_BAR; PG8_MMA(1, 1, At, B1); PG8_BAR;
            PG8_LDB(B0, 1, 0); PG8_SCHED; PG8_LDA(At, 1, 0); PG8_STAGE(PG8_SA(0, 1), a2 + hstepA, voffA);
            PG8_WAIT_L(8); PG8_BAR; PG8_WAIT_L(0); PG8_MMA(0, 0, At, B0); PG8_BAR; PG8_SCHED;
            PG8_LDB(B1, 1, 1); PG8_STAGE(PG8_SB(1, 0), b3, voffB);
            PG8_BAR; PG8_WAIT_L(0); PG8_MMA(0, 1, At, B1); PG8_BAR;
            PG8_LDA(At, 1, 1); PG8_STAGE(PG8_SA(1, 0), a3, voffA);
            PG8_BAR; PG8_WAIT_L(0); PG8_MMA(1, 0, At, B0); PG8_BAR; PG8_SCHED;
            PG8_STAGE(PG8_SB(1, 1), b3 + hstepB, voffB);
            PG8_WAIT_V(6); PG8_BAR; PG8_MMA(1, 1, At, B1); PG8_BAR;
        }
        if constexpr (F8) asm volatile("s_nop 15\n\ts_nop 15" ::: "memory");
        { int l_e = (int)__builtin_amdgcn_mbcnt_hi(~0u, __builtin_amdgcn_mbcnt_lo(~0u, 0u)); asm volatile("" : "+v"(l_e)); int fr_e = l_e & 15, fq_e = l_e >> 4;
          E(acc, cur, wr, wc, fr_e, fq_e); }
        if (!has_next) break;
#pragma unroll
        for (int a = 0; a < 2; ++a)
#pragma unroll
            for (int b = 0; b < 2; ++b)
#pragma unroll
                for (int m = 0; m < 4; ++m)
#pragma unroll
                    for (int n = 0; n < 2; ++n) acc[a][b][m][n] = (f32x4){0.f, 0.f, 0.f, 0.f};
        cur = nxt; cA = nA; cB = nB; ++ui;
    }
    PG8_WAIT_V(0);
    if (wr == 0) PG8_BAR;
    PG8_BAR;
#undef PG8_SA
#undef PG8_SB
#undef PG8_STAGE
#undef PG8_LDA
#undef PG8_LDB
#undef PG8_MMA
#undef PG8_WAIT_V
#undef PG8_WAIT_L
#undef PG8_BAR
#undef PG8_SCHED
}
}
namespace pg8 {
typedef f32x4 Acc[2][2][4][2];
__device__ __forceinline__ void st_bf16x8(bf16_t* p, f32x4 v0, f32x4 v1) {
    u32x4 w; w.x = cvtpk(v0[0], v0[1]); w.y = cvtpk(v0[2], v0[3]); w.z = cvtpk(v1[0], v1[1]); w.w = cvtpk(v1[2], v1[3]);
    *(u32x4*)p = w;
}
#define EPI_BF16_LOOP(...) \
    _Pragma("unroll") for (int ai = 0; ai < 2; ++ai) \
    _Pragma("unroll") for (int m = 0; m < 4; ++m) { int r = ai * 128 + wr * 64 + m * 16 + fr; asm volatile("" : "+v"(r)); \
    _Pragma("unroll") for (int bj = 0; bj < 2; ++bj) { f32x4 v0 = acc[ai][bj][m][0], v1 = acc[ai][bj][m][1]; const int colh = wc * 32 + 8 * fq; (void)colh; __VA_ARGS__ } }
#define EPI_F32_LOOP(...) \
    _Pragma("unroll") for (int ai = 0; ai < 2; ++ai) \
    _Pragma("unroll") for (int m = 0; m < 4; ++m) { int r = ai * 128 + wr * 64 + m * 16 + fr; asm volatile("" : "+v"(r)); \
    _Pragma("unroll") for (int bj = 0; bj < 2; ++bj) \
    _Pragma("unroll") for (int n = 0; n < 2; ++n) { f32x4 v = acc[ai][bj][m][n]; const int col = bj * 128 + wc * 32 + n * 16 + 4 * fq; (void)col; __VA_ARGS__ } }

struct EpiPA {
    static constexpr bool PERM = true;
    bf16_t *MQK, *MLO, *XQ, *VC; float sc;
    __device__ __forceinline__ void operator()(const Acc& acc, const Unit& u, int wr, int wc, int fr, int fq) const {
        bf16_t* base; size_t ldc;
        if (u.aux == 0) {
            if (u.pn < 8)       { base = MQK + (size_t)u.pm * 256 * 2048 + u.pn * 256; ldc = 2048; }
            else if (u.pn < 12) { base = MLO + (size_t)u.pm * 256 * 1024 + (u.pn - 8) * 256; ldc = 1024; }
            else                { base = XQ + ((size_t)(u.pn - 12) * TT + (size_t)u.pm * 256) * 256; ldc = 256; }
        } else                  { base = VC + ((size_t)(u.pm * 128 + u.pn) * 256) * 512; ldc = 512; }
        EPI_BF16_LOOP( v0 *= sc; v1 *= sc; st_bf16x8(base + (size_t)r * ldc + bj * 128 + colh, v0, v1); )
    }
};
struct EpiMem {
    static constexpr bool PERM = true;
    bf16_t *MK, *MVT;
    __device__ __forceinline__ void operator()(const Acc& acc, const Unit& u, int wr, int wc, int fr, int fq) const {
        bf16_t* base = (u.aux == 0) ? MK + (size_t)(u.pm * 4 + u.pn) * 65536 : MVT + (size_t)(u.pn * 4 + u.pm) * 65536;
        EPI_BF16_LOOP( st_bf16x8(base + (size_t)r * 256 + bj * 128 + colh, v0, v1); )
    }
};
struct EpiPB {
    static constexpr bool PERM = true;
    bf16_t *DQ, *DK, *DV;
    __device__ __forceinline__ void operator()(const Acc& acc, const Unit& u, int wr, int wc, int fr, int fq) const {
        const int which = u.pn >> 3, c0 = (u.pn & 7) * 2;
        bf16_t* buf = DQ + (size_t)which * ((WS_DK - WS_DQ) / 2);
        EPI_BF16_LOOP( st_bf16x8(buf + ((size_t)(c0 + bj) * TT + (size_t)u.pm * 256 + r) * 128 + colh, v0, v1); )
    }
};
struct EpiF32Tile {
    static constexpr bool PERM = false;
    float* C; size_t off_pm, off_pn, off_aux; int ldc;
    __device__ __forceinline__ void operator()(const Acc& acc, const Unit& u, int wr, int wc, int fr, int fq) const {
        float* base = C + (size_t)u.pm * off_pm + (size_t)u.pn * off_pn + (size_t)u.aux * off_aux;
        EPI_F32_LOOP( *(f32x4*)(base + (size_t)r * ldc + col) = v; )
    }
};
struct EpiB16Tile {
    static constexpr bool PERM = true;
    bf16_t* C; size_t off_pm, off_pn, off_aux; int ldc; float sc;
    __device__ __forceinline__ void operator()(const Acc& acc, const Unit& u, int wr, int wc, int fr, int fq) const {
        bf16_t* base = C + (size_t)u.pm * off_pm + (size_t)u.pn * off_pn + (size_t)u.aux * off_aux;
        EPI_BF16_LOOP( v0 *= sc; v1 *= sc; st_bf16x8(base + (size_t)r * ldc + bj * 128 + colh, v0, v1); )
    }
};
constexpr int EPI_TBL_OFF = RING_BYTES + 4096;
#define EPI_XBAR() do { asm volatile("s_waitcnt lgkmcnt(0)" ::: "memory"); __builtin_amdgcn_s_barrier(); asm volatile("" ::: "memory"); } while (0)
struct EpiXSoft {
    static constexpr bool PERM = true;
    bf16_t* XP; LAS float* tbl;
    __device__ __forceinline__ void operator()(const Acc& acc, const Unit& u, int wr, int wc, int fr, int fq) const {
        LAS float* TM = tbl; LAS float* TS = tbl + 1024;
        const int colh = wc * 32 + 8 * fq;
        float mloc[2][4];
#pragma unroll
        for (int ai = 0; ai < 2; ++ai)
#pragma unroll
            for (int m = 0; m < 4; ++m) { const int r = ai * 128 + wr * 64 + m * 16 + fr; float mx = -__builtin_inff();
#pragma unroll
                for (int bj = 0; bj < 2; ++bj)
#pragma unroll
                    for (int n = 0; n < 2; ++n) { const f32x4 v = acc[ai][bj][m][n]; mx = fmaxf(mx, fmaxf(fmaxf(v[0], v[1]), fmaxf(v[2], v[3]))); }
                mx = xmax16(mx); mx = xmax32(mx);
                if (fq == 0) TM[r * 4 + wc] = mx; mloc[ai][m] = mx; }
        EPI_XBAR();
        f32x4 ev[2][4][2][2];
#pragma unroll
        for (int ai = 0; ai < 2; ++ai)
#pragma unroll
            for (int m = 0; m < 4; ++m) { const int r = ai * 128 + wr * 64 + m * 16 + fr;
                const f32x4 t4 = *(const LAS f32x4*)(TM + r * 4); const float mx = fmaxf(fmaxf(t4[0], t4[1]), fmaxf(t4[2], t4[3])) * 0.0625f; float s = 0.f;
#pragma unroll
                for (int bj = 0; bj < 2; ++bj)
#pragma unroll
                    for (int n = 0; n < 2; ++n) { f32x4 v = acc[ai][bj][m][n];
#pragma unroll
                        for (int j = 0; j < 4; ++j) { v[j] = __expf(v[j] * 0.0625f - mx); s += v[j]; }
                        ev[ai][m][bj][n] = v; }
                s = xsum16(s); s = xsum32(s);
                if (fq == 0) TS[r * 4 + wc] = s; }
        EPI_XBAR();
        const size_t t0 = (size_t)u.aux * TT + (size_t)u.pm * 256;
#pragma unroll
        for (int ai = 0; ai < 2; ++ai)
#pragma unroll
            for (int m = 0; m < 4; ++m) { const int r = ai * 128 + wr * 64 + m * 16 + fr;
                const f32x4 t4 = *(const LAS f32x4*)(TS + r * 4); const float inv = 1.0f / ((t4[0] + t4[1]) + (t4[2] + t4[3]));
#pragma unroll
                for (int bj = 0; bj < 2; ++bj) st_bf16x8(XP + (t0 + r) * 256 + bj * 128 + colh, ev[ai][m][bj][0] * inv, ev[ai][m][bj][1] * inv); }
    }
};
struct EpiHNorm {
    static constexpr bool PERM = true;
    bf16_t* HM; const float* HDEN; const bf16_t* MLO; const float* G; LAS float* tbl;
    __device__ __forceinline__ void operator()(const Acc& acc, const Unit& u, int wr, int wc, int fr, int fq) const {
        LAS float* TQ = tbl;
        const size_t t0 = (size_t)u.pm * 256; const int colh = wc * 32 + 8 * fq;
        float inv[2][4];
#pragma unroll
        for (int ai = 0; ai < 2; ++ai)
#pragma unroll
            for (int m = 0; m < 4; ++m) inv[ai][m] = HDEN[(size_t)u.aux * TT + t0 + ai * 128 + wr * 64 + m * 16 + fr];
        asm volatile("" : "+v"(inv[0][0]), "+v"(inv[0][1]), "+v"(inv[0][2]), "+v"(inv[0][3]), "+v"(inv[1][0]), "+v"(inv[1][1]), "+v"(inv[1][2]), "+v"(inv[1][3]));
#pragma unroll
        for (int ai = 0; ai < 2; ++ai)
#pragma unroll
            for (int m = 0; m < 4; ++m) { const int r = ai * 128 + wr * 64 + m * 16 + fr; const float iv = 1.0f / inv[ai][m]; inv[ai][m] = iv; float q = 0.f;
#pragma unroll
                for (int bj = 0; bj < 2; ++bj)
#pragma unroll
                    for (int n = 0; n < 2; ++n) { const f32x4 v = acc[ai][bj][m][n] * iv; q += (v[0] * v[0] + v[1] * v[1]) + (v[2] * v[2] + v[3] * v[3]); }
                q = xsum16(q); q = xsum32(q);
                if (fq == 0) TQ[r * 4 + wc] = q; }
        EPI_XBAR();
        f32x4 gg[2][2];
#pragma unroll
        for (int bj = 0; bj < 2; ++bj) { gg[bj][0] = *(const f32x4*)(G + u.aux * 256 + bj * 128 + colh); gg[bj][1] = *(const f32x4*)(G + u.aux * 256 + bj * 128 + colh + 4); }
#pragma unroll
        for (int ai = 0; ai < 2; ++ai) {
            u32x4 ogv[4][2];
#pragma unroll
            for (int m = 0; m < 4; ++m)
#pragma unroll
                for (int bj = 0; bj < 2; ++bj) ogv[m][bj] = *(const u32x4*)(MLO + (t0 + ai * 128 + wr * 64 + m * 16 + fr) * 1024 + u.aux * 256 + bj * 128 + colh);
#pragma unroll
            for (int m = 0; m < 4; ++m) { const int r = ai * 128 + wr * 64 + m * 16 + fr;
                const f32x4 t4 = *(const LAS f32x4*)(TQ + r * 4); const float rs = rsqrtf(((t4[0] + t4[1]) + (t4[2] + t4[3])) * (1.0f / 256.0f) + EPS) * inv[ai][m];
#pragma unroll
                for (int bj = 0; bj < 2; ++bj) { const size_t o = (t0 + r) * 1024 + u.aux * 256 + bj * 128 + colh; const u32x4 og = ogv[m][bj];
                    const f32x4 g0 = gg[bj][0], g1 = gg[bj][1];
                    f32x4 v0 = acc[ai][bj][m][0] * rs, v1 = acc[ai][bj][m][1] * rs;
                    v0[0] *= sigmoidf_(bflo(og.x)) * g0[0]; v0[1] *= sigmoidf_(bfhi(og.x)) * g0[1]; v0[2] *= sigmoidf_(bflo(og.y)) * g0[2]; v0[3] *= sigmoidf_(bfhi(og.y)) * g0[3];
                    v1[0] *= sigmoidf_(bflo(og.z)) * g1[0]; v1[1] *= sigmoidf_(bfhi(og.z)) * g1[1]; v1[2] *= sigmoidf_(bflo(og.w)) * g1[2]; v1[3] *= sigmoidf_(bfhi(og.w)) * g1[3];
                    st_bf16x8(HM + o, v0, v1); } } }
    }
};
struct EpiW {
    static constexpr bool PERM = true;
    bf16_t* WQ; const float* RS;
    __device__ __forceinline__ void operator()(const Acc& acc, const Unit& u, int wr, int wc, int fr, int fq) const {
        const size_t trow = (size_t)u.aux * TT + (size_t)u.pm * 256;
        const int colh = wc * 32 + 8 * fq;
        float rsv[2][4];
#pragma unroll
        for (int ai = 0; ai < 2; ++ai)
#pragma unroll
            for (int m = 0; m < 4; ++m) rsv[ai][m] = RS[trow + ai * 128 + wr * 64 + m * 16 + fr];
#pragma unroll
        for (int ai = 0; ai < 2; ++ai)
#pragma unroll
            for (int m = 0; m < 4; ++m) { int r = ai * 128 + wr * 64 + m * 16 + fr; asm volatile("" : "+v"(r)); const float rs = rsv[ai][m];
#pragma unroll
                for (int bj = 0; bj < 2; ++bj) { f32x4 v0 = acc[ai][bj][m][0], v1 = acc[ai][bj][m][1]; const int c = bj * 128 + colh; const float fl = (float)(r - c + 1);
#pragma unroll
                    for (int j = 0; j < 4; ++j) { v0[j] = v0[j] * (rs * __saturatef(fl - (float)j)); v1[j] = v1[j] * (rs * __saturatef(fl - (float)(4 + j))); }
                    st_bf16x8(WQ + (trow + r) * 512 + c, v0, v1);
                    } }
    }
};
struct EpiH {
    static constexpr bool PERM = true;
    bf16_t* HR; const float* HDEN;
    __device__ __forceinline__ void operator()(const Acc& acc, const Unit& u, int wr, int wc, int fr, int fq) const {
        const size_t t0 = (size_t)u.pm * 256;
        EPI_BF16_LOOP( const float inv = 1.0f / HDEN[(size_t)u.aux * TT + t0 + r];
            v0 *= inv; v1 *= inv; st_bf16x8(HR + (t0 + r) * 1024 + u.aux * 256 + bj * 128 + colh, v0, v1); )
    }
};
struct EpiXA {
    static constexpr bool PERM = true;
    bf16_t* XA;
    __device__ __forceinline__ void operator()(const Acc& acc, const Unit& u, int wr, int wc, int fr, int fq) const {
        const size_t t0 = (size_t)u.pm * 256;
        EPI_BF16_LOOP( st_bf16x8(XA + (t0 + r) * 1024 + u.aux * 256 + bj * 128 + colh, v0, v1); )
    }
};
struct EpiGate {
    static constexpr bool PERM = true;
    bf16_t* GT; const float* bg; float dsc;
    __device__ __forceinline__ void operator()(const Acc& acc, const Unit& u, int wr, int wc, int fr, int fq) const {
        const size_t t0 = (size_t)u.pm * 256;
        constexpr float L2E = 1.4426950408889634f; const float ns = -dsc * L2E;
        f32x4 bb[2][2];
#pragma unroll
        for (int bj = 0; bj < 2; ++bj) { const int c = u.pn * 256 + bj * 128 + wc * 32 + 8 * fq; bb[bj][0] = *(const f32x4*)(bg + c) * (-L2E); bb[bj][1] = *(const f32x4*)(bg + c + 4) * (-L2E); }
        EPI_BF16_LOOP( const int c = u.pn * 256 + bj * 128 + colh; const f32x4 b0 = bb[bj][0], b1 = bb[bj][1];
            _Pragma("unroll") for (int j = 0; j < 4; ++j) { v0[j] = __builtin_amdgcn_rcpf(1.0f + __builtin_amdgcn_exp2f(fmaf(v0[j], ns, b0[j]))); v1[j] = __builtin_amdgcn_rcpf(1.0f + __builtin_amdgcn_exp2f(fmaf(v1[j], ns, b1[j]))); }
            st_bf16x8(GT + (t0 + r) * 2048 + c, v0, v1); )
    }
};
template <bool FIRST> struct EpiBranch {
    static constexpr bool PERM = true;
    const bf16_t* GT; const bf16_t* MGin; bf16_t* MG; float dsc;
    __device__ __forceinline__ void operator()(const Acc& acc, const Unit& u, int wr, int wc, int fr, int fq) const {
        const size_t t0 = (size_t)u.pm * 256; const int colh = wc * 32 + 8 * fq;
#pragma unroll
        for (int ai = 0; ai < 2; ++ai) {
            int rb = ai * 128 + wr * 64 + fr; asm volatile("" : "+v"(rb));
            const size_t ob = (t0 + rb) * 2048 + u.pn * 256 + colh;
            u32x4 g[4][2], p[4][2];
#pragma unroll
            for (int m = 0; m < 4; ++m)
#pragma unroll
                for (int bj = 0; bj < 2; ++bj) { const size_t o = ob + (size_t)m * 16 * 2048 + bj * 128; g[m][bj] = *(const u32x4*)(GT + o); if (!FIRST) p[m][bj] = *(const u32x4*)(MGin + o); }
#pragma unroll
            for (int m = 0; m < 4; ++m)
#pragma unroll
                for (int bj = 0; bj < 2; ++bj) { const size_t o = ob + (size_t)m * 16 * 2048 + bj * 128; f32x4 v0 = acc[ai][bj][m][0] * dsc, v1 = acc[ai][bj][m][1] * dsc; const u32x4 gg = g[m][bj];
                    v0[0] *= bflo(gg.x); v0[1] *= bfhi(gg.x); v0[2] *= bflo(gg.y); v0[3] *= bfhi(gg.y); v1[0] *= bflo(gg.z); v1[1] *= bfhi(gg.z); v1[2] *= bflo(gg.w); v1[3] *= bfhi(gg.w);
                    if (!FIRST) { const u32x4 pp = p[m][bj];
                        v0[0] += bflo(pp.x); v0[1] += bfhi(pp.x); v0[2] += bflo(pp.y); v0[3] += bfhi(pp.y); v1[0] += bflo(pp.z); v1[1] += bfhi(pp.z); v1[2] += bflo(pp.w); v1[3] += bfhi(pp.w); }
                    st_bf16x8(MG + o, v0, v1); }
        }
    }
};
struct EpiOut {
    static constexpr bool PERM = true;
    const float* X; bf16_t* X1B; float* RSS;
    __device__ __forceinline__ void operator()(const Acc& acc, const Unit& u, int wr, int wc, int fr, int fq) const {
        const size_t t0 = (size_t)u.pm * 256; const int colh = wc * 32 + 8 * fq;
#pragma unroll
        for (int ai = 0; ai < 2; ++ai) {
            int rb = ai * 128 + wr * 64 + fr; asm volatile("" : "+v"(rb));
            const size_t ob = (t0 + rb) * 2048 + u.pn * 256 + colh;
            f32x4 x0[4][2], x1[4][2];
#pragma unroll
            for (int m = 0; m < 4; ++m)
#pragma unroll
                for (int bj = 0; bj < 2; ++bj) { const size_t o = ob + (size_t)m * 16 * 2048 + bj * 128; x0[m][bj] = *(const f32x4*)(X + o); x1[m][bj] = *(const f32x4*)(X + o + 4); }
#pragma unroll
            for (int m = 0; m < 4; ++m) { float ss = 0.f;
#pragma unroll
                for (int bj = 0; bj < 2; ++bj) { const size_t o = ob + (size_t)m * 16 * 2048 + bj * 128;
                    const f32x4 v0 = acc[ai][bj][m][0] + x0[m][bj], v1 = acc[ai][bj][m][1] + x1[m][bj];
                    u32x4 w; w.x = cvtpk(v0[0], v0[1]); w.y = cvtpk(v0[2], v0[3]); w.z = cvtpk(v1[0], v1[1]); w.w = cvtpk(v1[2], v1[3]);
                    *(u32x4*)(X1B + o) = w;
                    ss += ((bflo(w.x) * bflo(w.x) + bfhi(w.x) * bfhi(w.x)) + (bflo(w.y) * bflo(w.y) + bfhi(w.y) * bfhi(w.y))) + ((bflo(w.z) * bflo(w.z) + bfhi(w.z) * bfhi(w.z)) + (bflo(w.w) * bflo(w.w) + bfhi(w.w) * bfhi(w.w))); }
                ss = xsum16(ss); ss = xsum32(ss);
                if (fq == 0) RSS[(t0 + rb + m * 16) * 32 + u.pn * 4 + wc] = ss; }
        }
    }
};
struct EpiGU {
    static constexpr bool PERM = true;
    unsigned char* HD;
    __device__ __forceinline__ void operator()(const Acc& acc, const Unit& u, int wr, int wc, int fr, int fq) const {
        const size_t t0 = (size_t)u.pm * 256; const int colh = wc * 32 + 8 * fq;
#pragma unroll
        for (int ai = 0; ai < 2; ++ai)
#pragma unroll
            for (int m = 0; m < 4; ++m) { int r = ai * 128 + wr * 64 + m * 16 + fr; asm volatile("" : "+v"(r));
                f32x4 g0 = acc[ai][0][m][0], g1 = acc[ai][0][m][1]; const f32x4 u0 = acc[ai][1][m][0], u1 = acc[ai][1][m][1];
#pragma unroll
                for (int j = 0; j < 4; ++j) { const float a0 = g0[j] * (1.0f / 32.0f), a1 = g1[j] * (1.0f / 32.0f); g0[j] = a0 * sigmoidf_(a0) * (u0[j] * 0.25f); g1[j] = a1 * sigmoidf_(a1) * (u1[j] * 0.25f); }
                u32x2 w; w.x = pk4_fp8(g0[0], g0[1], g0[2], g0[3]); w.y = pk4_fp8(g1[0], g1[1], g1[2], g1[3]);
                *(u32x2*)(HD + (t0 + r) * DEXP_P + u.pn * 128 + colh) = w; }
    }
};
struct EpiDown {
    static constexpr bool PERM = true;
    unsigned char* YS; const float* WROW;
    __device__ __forceinline__ void operator()(const Acc& acc, const Unit& u, int wr, int wc, int fr, int fq) const {
        const size_t t0 = (size_t)u.pm * 256;
        float wv[2][4];
#pragma unroll
        for (int ai = 0; ai < 2; ++ai)
#pragma unroll
            for (int m = 0; m < 4; ++m) wv[ai][m] = WROW[t0 + ai * 128 + wr * 64 + m * 16 + fr] * (64.0f / 128.0f);
        EPI_BF16_LOOP( const float w = wv[ai][m]; v0 *= w; v1 *= w;
            u32x2 o; o.x = pk4_fp8(v0[0], v0[1], v0[2], v0[3]); o.y = pk4_fp8(v1[0], v1[1], v1[2], v1[3]); *(u32x2*)(YS + (t0 + r) * 2048 + u.pn * 256 + bj * 128 + colh) = o; )
    }
};

struct SchedDense {
    const bf16_t* A0; const bf16_t* B0; int lda, ldb, nM, nN, G, c;
    __device__ __forceinline__ bool next(int i, Unit& u) const {
        const int L = i * G + c; if (L >= nM * nN) return false;
        tile_order(L, nM, nN, u.pm, u.pn); u.aux = 0;
        u.A = A0 + (size_t)u.pm * 256 * lda; u.B = B0 + (size_t)u.pn * 256 * ldb; return true;
    }
};
struct SchedPA {
    const bf16_t* HBF; const bf16_t* WINT; int G, c;
    __device__ __forceinline__ bool next(int i, Unit& u) const {
        const int L = i * G + c;
        if (L < 1024) { tile_order(L, 128, 8, u.pm, u.pn); u.aux = 0; u.A = HBF + (size_t)u.pm * 256 * 2048; u.B = WINT + (size_t)(6144 + u.pn * 256) * 2048; return true; }
        if (L < 1536) { const int q = L - 1024; u.pm = q & 3; u.pn = q >> 2; u.aux = 1; u.A = WINT + (size_t)(10240 + u.pm * 256) * 2048; u.B = HBF + (size_t)u.pn * 256 * 2048; return true; }
        return false;
    }
};
struct SchedPA8 {
    const bf16_t* H8; const bf16_t* W8; int G, c;
    __device__ __forceinline__ bool next(int i, Unit& u) const {
        const int L = i * G + c; if (L >= 1024) return false;
        int pn; tile_order(L, 128, 8, u.pm, pn); u.pn = pn + 8; u.aux = 0; u.A = H8 + (size_t)u.pm * 256 * 1024; u.B = W8 + (size_t)pn * 256 * 1024; return true;
    }
};
struct SchedMem {
    const bf16_t* MEMN; const bf16_t* WMEMT; int G, c;
    __device__ __forceinline__ bool next(int i, Unit& u) const {
        const int L = i * G + c; if (L >= 16) return false;
        if (L < 8) { u.aux = 0; u.pm = L >> 2; u.pn = L & 3; u.A = MEMN + (size_t)u.pm * 256 * 2048; u.B = WMEMT + (size_t)u.pn * 256 * 2048; }
        else { const int q = L - 8; u.aux = 1; u.pm = q & 3; u.pn = q >> 2; u.A = WMEMT + (size_t)(1024 + u.pm * 256) * 2048; u.B = MEMN + (size_t)u.pn * 256 * 2048; }
        return true;
    }
};
struct SchedHG {
    const bf16_t* A0; const bf16_t* B0; size_t sa_h, sa_g, sb_h, sb_g; int G, c;
    __device__ __forceinline__ bool next(int i, Unit& u) const {
        const int L = i * G + c; if (L >= 512) return false;
        const int hh = L >> 7, g = L & 127; u.aux = hh; u.pm = g; u.pn = 0;
        u.A = A0 + (size_t)hh * sa_h + (size_t)g * sa_g; u.B = B0 + (size_t)hh * sb_h + (size_t)g * sb_g; return true;
    }
};
struct SchedXA {
    const bf16_t* A0; const bf16_t* B0; int G, c;
    __device__ __forceinline__ bool next(int i, Unit& u) const {
        const int L = i * G + c; if (L >= 512) return false;
        const int hh = L >> 7, pm = L & 127; u.aux = hh; u.pm = pm; u.pn = 0;
        u.A = A0 + ((size_t)hh * TT + (size_t)pm * 256) * 256; u.B = B0 + (size_t)((pm >> 6) * 4 + hh) * 65536; return true;
    }
};
struct SchedMoE {
    const bf16_t* A0; const bf16_t* B0; const LAS int* unit_e; int nrt, NT, lda; size_t eb_stride, nb_stride; int G, c;
    __device__ __forceinline__ bool next(int i, Unit& u) const {
        const int L = i * G + c; if (L >= nrt * NT) return false;
        const int rt = L / NT, pn = L - rt * NT; const int e = __builtin_amdgcn_readfirstlane(unit_e[i]);
        u.pm = rt; u.pn = pn; u.aux = e; u.A = A0 + (size_t)rt * 256 * lda; u.B = B0 + (size_t)e * eb_stride + (size_t)pn * nb_stride; return true;
    }
};
}
namespace attn {
constexpr int D = 128;
constexpr float THR = 8.f;
constexpr float SCALE = 0.08838834764831845f;
constexpr int NW = 8, QBLK = 32, KVBLK = 64, QB = NW * QBLK;
constexpr int SHM_V = KVBLK * D * 2, SHM_K = KVBLK * D * 2;
constexpr int LDS_BYTES = 2 * SHM_V + 2 * SHM_K + NW * 64 * 4;
typedef bf16_t bf16;

#define KSWZ(row, colB) ((row) * 256 + ((colB) ^ (((row) & 7) << 4)))
#define SBAR() __builtin_amdgcn_sched_barrier(0)
__device__ __forceinline__ int v_st(int k, int c) { const int kk = (k & ~0xC) | ((k & 4) << 1) | ((k & 8) >> 1); return ((kk >> 3) * 4 + (c >> 5)) * 512 + ((kk & 7) * 32 + (c & 31)) * 2; }
__device__ __forceinline__ int v_rd_base(int lane) { return ((lane & 3) << 3) | (((lane >> 2) & 3) << 6) | (((lane >> 4) & 1) << 5) | (((lane >> 5) & 1) << 8); }
constexpr int v_rd_off(int d0, int ks, int half) { return d0 * 512 + ks * 4096 + half * 2048; }
__device__ __forceinline__ int crow(int r, int hi) { return (r & 3) + 8 * (r >> 2) + 4 * hi; }
__device__ __forceinline__ bf16x8 load8(const bf16* p) { return *reinterpret_cast<const bf16x8*>(p); }

__device__ __forceinline__ void mask_tile(f32x16& p0, f32x16& p1, int dq, unsigned W) {
    const float NEG = -__builtin_inff();
#pragma unroll
    for (int r = 0; r < 16; ++r) {
        const int c = (r & 3) + 8 * (r >> 2);
        if ((unsigned)(dq - c) >= W) p0[r] = NEG;
        if ((unsigned)(dq - c - 32) >= W) p1[r] = NEG;
    }
}
__device__ __forceinline__ void partialSM(f32x16& p0, f32x16& p1, float& m_reg, float& mn, float& alpha) {
    float pmax = p0[0]; for (int r = 1; r < 16; ++r) pmax = fmaxf(pmax, p0[r]); for (int r = 0; r < 16; ++r) pmax = fmaxf(pmax, p1[r]);
    { auto rr = __builtin_amdgcn_permlane32_swap(__float_as_uint(pmax), __float_as_uint(pmax), false, false);
      pmax = fmaxf(__uint_as_float(rr[0]), __uint_as_float(rr[1])); }
    constexpr float C2 = 1.4426950408889634f * SCALE;
    if (__builtin_expect(__all((pmax - m_reg) * SCALE <= THR), 1)) { mn = m_reg; alpha = 1.f; }
    else { mn = fmaxf(m_reg, pmax); alpha = __builtin_amdgcn_exp2f((m_reg - mn) * C2); m_reg = mn; }
    const float mnL = -mn * C2;
    for (int r = 0; r < 16; ++r) p0[r] = fmaf(p0[r], C2, mnL); for (int r = 0; r < 16; ++r) p1[r] = fmaf(p1[r], C2, mnL);
    for (int r = 0; r < 16; ++r) p0[r] = __builtin_amdgcn_exp2f(p0[r]);
}
__device__ __forceinline__ void finishSM(f32x16& p0, f32x16& p1, float alpha, float& l_reg, bf16x8& pa0, bf16x8& pa1, bf16x8& pa2, bf16x8& pa3) {
    for (int r = 0; r < 16; ++r) p1[r] = __builtin_amdgcn_exp2f(p1[r]);
    float ps = 0; for (int r = 0; r < 16; ++r) ps += p0[r]; for (int r = 0; r < 16; ++r) ps += p1[r];
    { auto rr = __builtin_amdgcn_permlane32_swap(__float_as_uint(ps), __float_as_uint(ps), false, false);
      ps = __uint_as_float(rr[0]) + __uint_as_float(rr[1]); }
    l_reg = l_reg * alpha + ps;
#define PK4(P, B_, OUT) do { unsigned a0 = cvtpk(P[B_+0], P[B_+1]), a1 = cvtpk(P[B_+2], P[B_+3]);                          \
        unsigned b0 = cvtpk(P[B_+4], P[B_+5]), b1 = cvtpk(P[B_+6], P[B_+7]);                                             \
        auto r0 = __builtin_amdgcn_permlane32_swap(a0, b0, false, false); auto r1 = __builtin_amdgcn_permlane32_swap(a1, b1, false, false); \
        u32x4 w = {r0[0], r1[0], r0[1], r1[1]}; OUT = *reinterpret_cast<bf16x8*>(&w); } while (0)
    PK4(p0, 0, pa0); PK4(p0, 8, pa1); PK4(p1, 0, pa2); PK4(p1, 8, pa3);
#undef PK4
}
template <int KB>
__device__ __forceinline__ void qkt(f32x16& p0, f32x16& p1, const char* K_lds, int r32, int hi, const bf16x8* qr, float sl, int dq) {
    const float sl8 = 8.f * sl, sl32 = 32.f * sl;
    p0[0] = -sl * (float)dq; p0[1] = p0[0] + sl; p0[2] = p0[1] + sl; p0[3] = p0[2] + sl;
#pragma unroll
    for (int r = 4; r < 16; ++r) p0[r] = p0[r - 4] + sl8;
#pragma unroll
    for (int r = 0; r < 16; ++r) p1[r] = p0[r] + sl32;
    const char* kb[4];
#pragma unroll
    for (int dd = 0; dd < 4; ++dd) kb[dd] = K_lds + KB * SHM_K + KSWZ(r32, (dd * 16 + hi * 8) * 2);
#pragma unroll
    for (int d0 = 0; d0 < 8; ++d0) { const char* a = kb[d0 & 3] + (d0 >> 2) * 128;
        bf16x8 b0_ = *reinterpret_cast<const bf16x8*>(a);
        bf16x8 b1_ = *reinterpret_cast<const bf16x8*>(a + 32 * 256);
        p0 = __builtin_amdgcn_mfma_f32_32x32x16_bf16(b0_, qr[d0], p0, 0, 0, 0);
        p1 = __builtin_amdgcn_mfma_f32_32x32x16_bf16(b1_, qr[d0], p1, 0, 0, 0); }
}
template <int VB>
__device__ __forceinline__ void pv_tile(f32x16* o, int vb0, bf16x8 pa0, bf16x8 pa1, bf16x8 pa2, bf16x8 pa3) {
#define TRRD(dst, off) asm volatile("ds_read_b64_tr_b16 %0, %1 offset:%2" : "=&v"(dst) : "v"(vb0), "i"(off) : "memory")
#define PV_D0(d0) do { s16x4 l0, l1, l2, l3, h0, h1, h2, h3; constexpr int b_ = VB * SHM_V + v_rd_off(d0, 0, 0); \
        TRRD(l0, b_); TRRD(h0, b_ + 2048); TRRD(l1, b_ + 4096); TRRD(h1, b_ + 6144); TRRD(l2, b_ + 8192); TRRD(h2, b_ + 10240); TRRD(l3, b_ + 12288); TRRD(h3, b_ + 14336); \
        asm volatile("s_waitcnt lgkmcnt(0)" ::: "memory"); SBAR();   \
        o[d0] = __builtin_amdgcn_mfma_f32_32x32x16_bf16(pa0, (bf16x8){l0[0], l0[1], l0[2], l0[3], h0[0], h0[1], h0[2], h0[3]}, o[d0], 0, 0, 0);   \
        o[d0] = __builtin_amdgcn_mfma_f32_32x32x16_bf16(pa1, (bf16x8){l1[0], l1[1], l1[2], l1[3], h1[0], h1[1], h1[2], h1[3]}, o[d0], 0, 0, 0);   \
        o[d0] = __builtin_amdgcn_mfma_f32_32x32x16_bf16(pa2, (bf16x8){l2[0], l2[1], l2[2], l2[3], h2[0], h2[1], h2[2], h2[3]}, o[d0], 0, 0, 0);   \
        o[d0] = __builtin_amdgcn_mfma_f32_32x32x16_bf16(pa3, (bf16x8){l3[0], l3[1], l3[2], l3[3], h3[0], h3[1], h3[2], h3[3]}, o[d0], 0, 0, 0); } while (0)
    PV_D0(0); PV_D0(1); PV_D0(2); PV_D0(3);
#undef PV_D0
#undef TRRD
}

struct BlockRef { const bf16* Q; const bf16* K; const bf16* V; bf16* O; int P0; };
struct Seam { bf16x8 qr[8]; bf16x8 st_v0, st_v1, st_k0, st_k1; };
__device__ __forceinline__ int swa_jlo(int P0, int W) { const int lowk = P0 - W + 1; return lowk > 0 ? lowk / KVBLK : 0; }
#define ROW(p, k0, rr) ((p) + (size_t)((k0) + (rr)) * D + sc)
#define VMW() asm volatile("s_waitcnt vmcnt(0)" ::: "memory")
#define VMWN(n) asm volatile("s_waitcnt vmcnt(%0)" :: "i"(n) : "memory")
#define SLOAD_H(Kp, Vp, k0) do { S.st_v0 = load8(ROW(Vp, k0, sr)); S.st_v1 = load8(ROW(Vp, k0, 32 + sr));              \
                         S.st_k0 = load8(ROW(Kp, k0, sr)); S.st_k1 = load8(ROW(Kp, k0, 32 + sr)); } while (0)
#define SWRITE_HK(bf) do { *(bf16x8*)(K_lds + (bf) * SHM_K + kws) = S.st_k0; *(bf16x8*)(K_lds + (bf) * SHM_K + kws + 32 * 256) = S.st_k1; } while (0)
#define SWRITE_HV(bf) do { *(bf16x8*)(V_lds + (bf) * SHM_V + vst0) = S.st_v0; *(bf16x8*)(V_lds + (bf) * SHM_V + vst1) = S.st_v1; } while (0)
#define SWRITE_H(bf) do { SWRITE_HV(bf); SWRITE_HK(bf); } while (0)

__device__ __forceinline__ void causal_swa_prime(const BlockRef& cur, int W, char* lds, Seam& S, const int tid) {
    const int wid = __builtin_amdgcn_readfirstlane(tid >> 6), lane = tid & 63, r32 = lane & 31, hi = lane >> 5;
    const int sr = tid >> 4, sc = (tid & 15) * 8, kws = KSWZ(sr, sc * 2); char* K_lds = lds + 2 * SHM_V;
    const int kb0 = swa_jlo(cur.P0, W) * KVBLK;
    for (int d0 = 0; d0 < 8; ++d0) S.qr[d0] = load8(cur.Q + (size_t)(wid * QBLK + r32) * D + d0 * 16 + hi * 8);
    SLOAD_H(cur.K, cur.V, kb0); VMW(); SWRITE_HK(0);
    __syncthreads();
}
__device__ __forceinline__ void causal_swa_block(const BlockRef& cur, const BlockRef& nxt, int skv, int W, int Wn, float sl, char* lds, Seam& S, const int tid) {
    const int wid = __builtin_amdgcn_readfirstlane(tid >> 6), lane = tid & 63, r32 = lane & 31, hi = lane >> 5;
    const int j_lo = swa_jlo(cur.P0, W);
    int j_hi = (cur.P0 + QB - 1) / KVBLK + 1; if (j_hi > skv / KVBLK) j_hi = skv / KVBLK;
    const int NT = j_hi - j_lo;
    const int kbn = swa_jlo(nxt.P0, Wn) * KVBLK;
    const int qlo = cur.P0 + wid * QBLK, qm = qlo + r32 - 4 * hi;
    char* V_lds = lds; char* K_lds = lds + 2 * SHM_V;
    float* ws = (float*)(lds + 2 * SHM_V + 2 * SHM_K) + wid * 64; float* li_l = ws, * al_l = ws + 32;
    float m_reg = -1e30f, l_reg = 0; f32x16 o[4] = {};
    const int sr = tid >> 4, sc = (tid & 15) * 8, vst0 = v_st(sr, sc), vst1 = v_st(32 + sr, sc), kws = KSWZ(sr, sc * 2);
    const int vb0 = (int)(uintptr_t)V_lds + v_rd_base(lane);
    const bf16* Kh = cur.K; const bf16* Vh = cur.V;
#define RESC(a) do { if (__any((a) < 1.f)) { if (hi == 0) al_l[r32] = (a); asm volatile("s_waitcnt lgkmcnt(0)" ::: "memory");              \
                     for (int d_ = 0; d_ < 4; ++d_) for (int r = 0; r < 16; ++r) o[d_][r] *= al_l[crow(r, hi)]; } } while (0)
#define KBASE(t) ((j_lo + (t)) * KVBLK)
#define MASKT(P0_, P1_, t) do { const int kb_ = KBASE(t); if (kb_ + KVBLK - 1 > qlo || kb_ <= qlo + QBLK - 1 - W) mask_tile(P0_, P1_, qm - kb_, (unsigned)W); } while (0)
    constexpr int NQL = 8;
#define SEAM_K0() do { VMWN(NQL); SWRITE_HK(0); SBAR(); } while (0)
    f32x16 pA0, pA1, pB0, pB1; float mnA, mnB, alA, alB; bf16x8 pa0, pa1, pa2, pa3;
    SWRITE_HV(0); SBAR();
    if (NT > 1) { SLOAD_H(Kh, Vh, KBASE(1)); }
    SBAR(); qkt<0>(pA0, pA1, K_lds, r32, hi, S.qr, sl, qm - KBASE(0));
    MASKT(pA0, pA1, 0); partialSM(pA0, pA1, m_reg, mnA, alA);
    if (NT > 1) { VMW(); SWRITE_H(1); }
    __syncthreads();
#define HALF_STEP(PX0, PX1, mnX, alX, PY0, PY1, alY, t, KB, VB, SB) do {                                                      \
        SBAR(); qkt<KB>(PX0, PX1, K_lds, r32, hi, S.qr, sl, qm - KBASE(t));                                                   \
        finishSM(PY0, PY1, alY, l_reg, pa0, pa1, pa2, pa3); SBAR();                                                           \
        if ((t) + 1 < NT) { SLOAD_H(Kh, Vh, KBASE((t) + 1)); SBAR(); }                                                        \
        pv_tile<VB>(o, vb0, pa0, pa1, pa2, pa3); MASKT(PX0, PX1, (t)); partialSM(PX0, PX1, m_reg, mnX, alX);                  \
        __syncthreads();                                                                                                      \
        if ((t) + 1 < NT) { VMW(); SWRITE_H(SB); }                                                                            \
        RESC(alX); __syncthreads(); } while (0)
    for (int t = 1; t + 1 < NT; t += 2) {
        HALF_STEP(pB0, pB1, mnB, alB, pA0, pA1, alA, t, 1, 0, 0);
        HALF_STEP(pA0, pA1, mnA, alA, pB0, pB1, alB, t + 1, 0, 1, 1);
    }
    const bool even = (NT & 1) == 0;
    if (even) { SBAR(); qkt<1>(pB0, pB1, K_lds, r32, hi, S.qr, sl, qm - KBASE(NT - 1)); SBAR(); }
    SLOAD_H(nxt.K, nxt.V, kbn); SBAR();
#pragma unroll
    for (int d0 = 0; d0 < 8; ++d0) S.qr[d0] = load8(nxt.Q + (size_t)(wid * QBLK + r32) * D + d0 * 16 + hi * 8);
    SBAR();
    finishSM(pA0, pA1, alA, l_reg, pa0, pa1, pa2, pa3); SBAR();
    pv_tile<0>(o, vb0, pa0, pa1, pa2, pa3);
    if (even) { MASKT(pB0, pB1, NT - 1); partialSM(pB0, pB1, m_reg, mnB, alB); __syncthreads(); RESC(alB);
        finishSM(pB0, pB1, alB, l_reg, pa0, pa1, pa2, pa3); SBAR(); pv_tile<1>(o, vb0, pa0, pa1, pa2, pa3); }
    SBAR(); SEAM_K0();
    if (hi == 0) li_l[r32] = l_reg; asm volatile("s_waitcnt lgkmcnt(0)" ::: "memory");
    float rli[16];
#pragma unroll
    for (int r = 0; r < 16; ++r) rli[r] = __builtin_amdgcn_rcpf(li_l[crow(r, hi)]);
    bf16* Ow = cur.O + (size_t)(wid * QBLK) * D;
    int zo = 0; asm volatile("" : "+v"(zo));
    const unsigned ob = (unsigned)(4 * hi * D + r32 + zo);
#pragma unroll
    for (int r = 0; r < 16; ++r) { const unsigned off = ob + (unsigned)(((r & 3) + 8 * (r >> 2)) * D);
#pragma unroll
        for (int d0 = 0; d0 < 4; ++d0) { const float v = o[d0][r] * rli[r];
            const float vn = __shfl_xor(v, 1);
            if ((r32 & 1) == 0) *(unsigned*)(Ow + off + d0 * 32) = cvtpk(v, vn); } }
    __syncthreads();
#undef RESC
#undef KBASE
#undef MASKT
#undef SEAM_K0
#undef HALF_STEP
}
#undef ROW
#undef VMW
#undef VMWN
#undef SLOAD_H
#undef SWRITE_HK
#undef SWRITE_HV
#undef SWRITE_H
}
namespace attn4 {
using attn::bf16; using attn::KVBLK; using attn::QBLK; using attn::SHM_K;
constexpr int QB = 128, D = 128;
constexpr int V_OFF = 0, K_OFF = 65536, PX_OFF = 98304;
constexpr int AL_OFF = RING_BYTES + 1024;
struct Item { const bf16* Q; const bf16* K; const bf16* V0; const bf16* V1; bf16* O; int P0, W; float sl; };

template <int OFF>
__device__ __forceinline__ void pv_half(f32x16* o, int vb0, bf16x8 pa0, bf16x8 pa1, bf16x8 pa2, bf16x8 pa3) {
#define TRRD(dst, off) asm volatile("ds_read_b64_tr_b16 %0, %1 offset:%2" : "=&v"(dst) : "v"(vb0), "i"(off) : "memory")
#define PV_D0(d0) do { s16x4 l0, l1, l2, l3, h0, h1, h2, h3; constexpr int b_ = OFF + attn::v_rd_off(d0, 0, 0); \
        TRRD(l0, b_); TRRD(h0, b_ + 2048); TRRD(l1, b_ + 4096); TRRD(h1, b_ + 6144); TRRD(l2, b_ + 8192); TRRD(h2, b_ + 10240); TRRD(l3, b_ + 12288); TRRD(h3, b_ + 14336); \
        asm volatile("s_waitcnt lgkmcnt(0)" ::: "memory"); SBAR();   \
        o[d0] = __builtin_amdgcn_mfma_f32_32x32x16_bf16(pa0, (bf16x8){l0[0], l0[1], l0[2], l0[3], h0[0], h0[1], h0[2], h0[3]}, o[d0], 0, 0, 0);   \
        o[d0] = __builtin_amdgcn_mfma_f32_32x32x16_bf16(pa1, (bf16x8){l1[0], l1[1], l1[2], l1[3], h1[0], h1[1], h1[2], h1[3]}, o[d0], 0, 0, 0);   \
        o[d0] = __builtin_amdgcn_mfma_f32_32x32x16_bf16(pa2, (bf16x8){l2[0], l2[1], l2[2], l2[3], h2[0], h2[1], h2[2], h2[3]}, o[d0], 0, 0, 0);   \
        o[d0] = __builtin_amdgcn_mfma_f32_32x32x16_bf16(pa3, (bf16x8){l3[0], l3[1], l3[2], l3[3], h3[0], h3[1], h3[2], h3[3]}, o[d0], 0, 0, 0); } while (0)
    PV_D0(0); PV_D0(1); PV_D0(2); PV_D0(3);
#undef PV_D0
#undef TRRD
}

template <int KB>
__device__ __forceinline__ void qkt_b(f32x16& p0, f32x16& p1, const char* K_lds, int r32, int hi, const bf16x8* qr, const f32x16& bias0, const f32x16& bias1) {
    const char* kb[4];
#pragma unroll
    for (int dd = 0; dd < 4; ++dd) kb[dd] = K_lds + KB * SHM_K + KSWZ(r32, (dd * 16 + hi * 8) * 2);
    { const bf16x8 b0_ = *reinterpret_cast<const bf16x8*>(kb[0]), b1_ = *reinterpret_cast<const bf16x8*>(kb[0] + 32 * 256);
      p0 = __builtin_amdgcn_mfma_f32_32x32x16_bf16(b0_, qr[0], bias0, 0, 0, 0); p1 = __builtin_amdgcn_mfma_f32_32x32x16_bf16(b1_, qr[0], bias1, 0, 0, 0); }
#pragma unroll
    for (int d0 = 1; d0 < 8; ++d0) { const char* a = kb[d0 & 3] + (d0 >> 2) * 128;
        const bf16x8 b0_ = *reinterpret_cast<const bf16x8*>(a), b1_ = *reinterpret_cast<const bf16x8*>(a + 32 * 256);
        p0 = __builtin_amdgcn_mfma_f32_32x32x16_bf16(b0_, qr[d0], p0, 0, 0, 0); p1 = __builtin_amdgcn_mfma_f32_32x32x16_bf16(b1_, qr[d0], p1, 0, 0, 0); }
}

__device__ __forceinline__ void item(const Item& it, char* lds, LAS unsigned char* ldsL, const int tid) {
    const int wid = __builtin_amdgcn_readfirstlane(tid >> 6), lane = tid & 63, r32 = lane & 31, hi = lane >> 5, role = wid >> 2, g = wid & 3;
    const int j_lo = attn::swa_jlo(it.P0, it.W);
    const int j_hi = (it.P0 + QB - 1) / KVBLK + 1;
    const int NT = j_hi - j_lo;
    const int W = it.W; const float sl = it.sl;
    const int qlo = it.P0 + g * QBLK, qm = qlo + r32 - 4 * hi;
    const int sr = tid >> 4, sc = (tid & 15) * 8, vst0 = attn::v_st(sr, sc), vst1 = attn::v_st(32 + sr, sc), kws = KSWZ(sr, sc * 2);
    float* AL = (float*)(lds + AL_OFF); int* FLG = (int*)(lds + AL_OFF + 1024); float* LL = (float*)(lds + AL_OFF + 1088);
#define KBASE(t) ((j_lo + (t)) * KVBLK)
    const bf16* gp[6]; int dstA[6], dstB[6];
#pragma unroll
    for (int i = 0; i < 6; ++i) {
        if (i < 2) { const int q = wid * 2 + i, row = 4 * q + (lane >> 4), c = (lane & 15) ^ (row & 7);
            gp[i] = it.K + (size_t)KBASE(0) * D + row * D + c * 8; dstA[i] = K_OFF + 1 * SHM_K + q * 1024; dstB[i] = K_OFF + 0 * SHM_K + q * 1024; }
        else { const int v = wid * 4 + (i - 2), j = v & 15, eh = v >> 4, sidx = 2 * j + (lane >> 5), kk = (sidx >> 2) * 8 + ((lane & 31) >> 2), k = (kk & ~0xC) | ((kk & 4) << 1) | ((kk & 8) >> 1), col = (sidx & 3) * 32 + (lane & 3) * 8;
            gp[i] = (eh ? it.V1 : it.V0) + (size_t)KBASE(0) * D + k * D + col; dstA[i] = V_OFF + 0 * 32768 + eh * 16384 + j * 1024; dstB[i] = V_OFF + 1 * 32768 + eh * 16384 + j * 1024; } }
#define A4_DMA(src, ldsbyte) __builtin_amdgcn_global_load_lds((const unsigned*)(src), (LAS unsigned*)((LAS unsigned char*)ldsL + (ldsbyte)), 16, 0, 0)
#define A4_STAGE(t, PAR) do { const int tk_ = ((t) + 1 < NT ? (t) + 1 : NT - 1), tv_ = ((t) < NT ? (t) : NT - 1); const size_t ok_ = (size_t)tk_ * (KVBLK * D), ov_ = (size_t)tv_ * (KVBLK * D); \
            _Pragma("unroll") for (int i = 0; i < 6; ++i) A4_DMA(gp[i] + (i < 2 ? ok_ : ov_), (PAR) ? dstB[i] : dstA[i]); } while (0)
#define A4_SYNC() do { asm volatile("s_waitcnt vmcnt(0) lgkmcnt(0)" ::: "memory"); __builtin_amdgcn_s_barrier(); asm volatile("" ::: "memory"); } while (0)
#define A4_PROLOGUE() do { A4_DMA(gp[0], dstB[0]); A4_DMA(gp[1], dstB[1]); A4_SYNC(); } while (0)
    char* K_lds = lds + K_OFF;
    if (role == 0) {
        bf16x8 qr[8];
#pragma unroll
        for (int d0 = 0; d0 < 8; ++d0) qr[d0] = attn::load8(it.Q + (size_t)(g * QBLK + r32) * D + d0 * 16 + hi * 8);
        asm volatile("s_waitcnt vmcnt(0)" ::: "memory");
        A4_PROLOGUE();
        float m_reg = -1e30f, l_reg = 0.f;
        f32x16 bias0, bias1;
#pragma unroll
        for (int r = 0; r < 16; ++r) { bias0[r] = sl * (float)((r & 3) + 8 * (r >> 2) + 4 * hi); bias1[r] = bias0[r] + 32.f * sl; }
        const float mstep = 64.f * sl;
#define A2_QK_STEP(t, PAR) do { A4_STAGE(t, PAR); \
            if ((t) < NT) { f32x16 p0, p1; float mn, alpha; bf16x8 pa0, pa1, pa2, pa3; \
                qkt_b<PAR>(p0, p1, K_lds, r32, hi, qr, bias0, bias1); if ((t) > 0) m_reg -= mstep; \
                { const int kb_ = KBASE(t); if (kb_ + KVBLK - 1 > qlo || kb_ <= qlo + QBLK - 1 - W) attn::mask_tile(p0, p1, qm - kb_, (unsigned)W); } \
                attn::partialSM(p0, p1, m_reg, mn, alpha); attn::finishSM(p0, p1, alpha, l_reg, pa0, pa1, pa2, pa3); \
                char* px = lds + PX_OFF + (PAR) * 16384 + g * 4096 + lane * 16; \
                *(bf16x8*)px = pa0; *(bf16x8*)(px + 1024) = pa1; *(bf16x8*)(px + 2048) = pa2; *(bf16x8*)(px + 3072) = pa3; \
                if (hi == 0) AL[(PAR) * 128 + g * 32 + r32] = alpha; \
                const int anyr = __any(alpha < 1.f) ? 1 : 0; if (lane == 0) FLG[(PAR) * 4 + g] = anyr; } \
            A4_SYNC(); } while (0)
        for (int t = 0; t <= NT; t += 2) { A2_QK_STEP(t, 0); if (t + 1 <= NT) A2_QK_STEP(t + 1, 1); }
        if (hi == 0) LL[g * 32 + r32] = l_reg;
        __syncthreads();
        __syncthreads();
#undef A2_QK_STEP
    } else {
        A4_PROLOGUE();
        f32x16 o[8] = {};
        const int vb0 = (int)(uintptr_t)(lds + V_OFF) + attn::v_rd_base(lane);
#define A2_PV_STEP(t, PAR) do { A4_STAGE(t, PAR); \
            if ((t) >= 1) { constexpr int PB = (PAR) ^ 1; \
                const int flag = __builtin_amdgcn_readfirstlane(FLG[PB * 4 + g]); \
                if (flag) { _Pragma("unroll") for (int r = 0; r < 16; ++r) { const float a = AL[PB * 128 + g * 32 + attn::crow(r, hi)]; \
                        _Pragma("unroll") for (int d_ = 0; d_ < 8; ++d_) o[d_][r] *= a; } } \
                const char* px = lds + PX_OFF + PB * 16384 + g * 4096 + lane * 16; \
                const bf16x8 pa0 = *(const bf16x8*)px, pa1 = *(const bf16x8*)(px + 1024), pa2 = *(const bf16x8*)(px + 2048), pa3 = *(const bf16x8*)(px + 3072); \
                pv_half<PB * 32768>(o, vb0, pa0, pa1, pa2, pa3); pv_half<PB * 32768 + 16384>(o + 4, vb0, pa0, pa1, pa2, pa3); } \
            A4_SYNC(); } while (0)
        for (int t = 0; t <= NT; t += 2) { A2_PV_STEP(t, 0); if (t + 1 <= NT) A2_PV_STEP(t + 1, 1); }
        __syncthreads();
        float rli[16];
#pragma unroll
        for (int r = 0; r < 16; ++r) rli[r] = __builtin_amdgcn_rcpf(LL[g * 32 + attn::crow(r, hi)]);
        bf16* Ow = it.O + (size_t)(g * QBLK) * 256;
        int zo = 0; asm volatile("" : "+v"(zo));
        const unsigned ob = (unsigned)(4 * hi * 256 + r32 + zo);
#pragma unroll
        for (int r = 0; r < 16; ++r) { const unsigned off = ob + (unsigned)(((r & 3) + 8 * (r >> 2)) * 256);
#pragma unroll
            for (int d0 = 0; d0 < 8; ++d0) { const float v = o[d0][r] * rli[r];
                const float vn = __builtin_bit_cast(float, __builtin_amdgcn_mov_dpp(__builtin_bit_cast(int, v), 0xB1, 0xF, 0xF, true));
                if ((r32 & 1) == 0) *(unsigned*)(Ow + off + d0 * 32) = cvtpk(v, vn); } }
        __syncthreads();
#undef A2_PV_STEP
    }
#undef KBASE
#undef A4_DMA
#undef A4_STAGE
#undef A4_SYNC
#undef A4_PROLOGUE
}
}
struct Frame {
    LAS unsigned char* lds; unsigned char* lds_g;
    volatile LAS unsigned* MISC;
    unsigned* ctl; unsigned char* ws; unsigned char* dout;
    int tid, lane, wave, G, bid, gw, NGW;
};

__device__ __forceinline__ void tr_item(const float* W, int ldw, int c0, bf16_t* WT, int ldt, int r0, int kb, int nb, LAS float* scr, int lane) {
    const int k0 = 64 * kb, n0 = 32 * nb;
    float ld_[32];
#pragma unroll
    for (int i = 0; i < 32; ++i) ld_[i] = W[(size_t)(k0 + 2 * i + (lane >> 5)) * ldw + c0 + n0 + (lane & 31)];
#pragma unroll
    for (int i = 0; i < 32; ++i) scr[(2 * i + (lane >> 5)) * 33 + (lane & 31)] = ld_[i];
    LDS_WAIT(); asm volatile("" ::: "memory");
    const int c = lane & 7;
#pragma unroll
    for (int j = 0; j < 4; ++j) { const int n = (lane >> 3) + 8 * j; const LAS float* s = scr + (8 * c) * 33 + n;
        u32x4 o; o.x = cvtpk(s[0 * 33], s[1 * 33]); o.y = cvtpk(s[2 * 33], s[3 * 33]); o.z = cvtpk(s[4 * 33], s[5 * 33]); o.w = cvtpk(s[6 * 33], s[7 * 33]);
        *(u32x4*)(WT + (size_t)(r0 + n0 + n) * ldt + k0 + 8 * c) = o; }
    LDS_WAIT(); asm volatile("" ::: "memory");
}
__device__ __forceinline__ void tr_item8(const float* W, int ldw, int c0, unsigned char* WT, int ldt, int r0, int kb, int nb, float sc, LAS float* scr, int lane) {
    const int k0 = 64 * kb, n0 = 32 * nb;
    float ld_[32];
#pragma unroll
    for (int i = 0; i < 32; ++i) ld_[i] = W[(size_t)(k0 + 2 * i + (lane >> 5)) * ldw + c0 + n0 + (lane & 31)];
#pragma unroll
    for (int i = 0; i < 32; ++i) scr[(2 * i + (lane >> 5)) * 33 + (lane & 31)] = ld_[i];
    LDS_WAIT(); asm volatile("" ::: "memory");
    const int c = lane & 7;
#pragma unroll
    for (int j = 0; j < 4; ++j) { const int n = (lane >> 3) + 8 * j; const LAS float* s = scr + (8 * c) * 33 + n;
        u32x2 o; o.x = pk4_fp8(s[0 * 33] * sc, s[1 * 33] * sc, s[2 * 33] * sc, s[3 * 33] * sc); o.y = pk4_fp8(s[4 * 33] * sc, s[5 * 33] * sc, s[6 * 33] * sc, s[7 * 33] * sc);
        *(u32x2*)(WT + (size_t)(r0 + n0 + n) * ldt + k0 + 8 * c) = o; }
    LDS_WAIT(); asm volatile("" ::: "memory");
}
struct TrD { const float* src; size_t ldw2; unsigned char* dst; size_t ldtb; float sc; int f8; };
__device__ __forceinline__ TrD tr_desc(const float* W, int ldw, int c0, void* WT, int ldt, int r0, int kb, int nb, float sc, int f8, int lane) {
    TrD d; d.src = W + (size_t)(64 * kb + (lane >> 5)) * ldw + c0 + 32 * nb + (lane & 31); d.ldw2 = (size_t)2 * ldw;
    d.ldtb = f8 ? (size_t)ldt : (size_t)ldt * 2; d.dst = (unsigned char*)WT + (size_t)(r0 + 32 * nb) * d.ldtb + (f8 ? (size_t)64 * kb : (size_t)128 * kb); d.sc = sc; d.f8 = f8; return d; }
__device__ __forceinline__ void tr_load(const TrD& d, float (&ld)[32]) {
#pragma unroll
    for (int i = 0; i < 32; ++i) ld[i] = d.src[(size_t)i * d.ldw2]; }
__device__ __forceinline__ void tr_flush(const TrD& d, const float (&ld)[32], LAS float* scr, int lane) {
#pragma unroll
    for (int i = 0; i < 32; ++i) scr[(2 * i + (lane >> 5)) * 33 + (lane & 31)] = ld[i];
    LDS_WAIT(); asm volatile("" ::: "memory");
    const int c = lane & 7;
    if (d.f8) {
#pragma unroll
        for (int j = 0; j < 4; ++j) { const int n = (lane >> 3) + 8 * j; const LAS float* s = scr + (8 * c) * 33 + n; const float sc = d.sc;
            u32x2 o; o.x = pk4_fp8(s[0 * 33] * sc, s[1 * 33] * sc, s[2 * 33] * sc, s[3 * 33] * sc); o.y = pk4_fp8(s[4 * 33] * sc, s[5 * 33] * sc, s[6 * 33] * sc, s[7 * 33] * sc);
            *(u32x2*)(d.dst + (size_t)n * d.ldtb + 8 * c) = o; }
    } else {
#pragma unroll
        for (int j = 0; j < 4; ++j) { const int n = (lane >> 3) + 8 * j; const LAS float* s = scr + (8 * c) * 33 + n;
            u32x4 o; o.x = cvtpk(s[0 * 33], s[1 * 33]); o.y = cvtpk(s[2 * 33], s[3 * 33]); o.z = cvtpk(s[4 * 33], s[5 * 33]); o.w = cvtpk(s[6 * 33], s[7 * 33]);
            *(u32x4*)(d.dst + (size_t)n * d.ldtb + 16 * c) = o; }
    }
    LDS_WAIT(); asm volatile("" ::: "memory");
}
template <class Dec>
__device__ __forceinline__ void tr_run(int first, int n_items, int step, const Dec& dec, LAS float* scr, int lane) {
    int it = first; if (it >= n_items) return;
    float la[32], lb[32], lc[32]; TrD da, db, dc;
    da = dec(it); tr_load(da, la);
    { const int i1 = it + step; db = dec(i1 < n_items ? i1 : first); tr_load(db, lb); }
    for (;;) {
        { const int i2 = it + 2 * step; dc = dec(i2 < n_items ? i2 : first); tr_load(dc, lc); }
        tr_flush(da, la, scr, lane);
        it += step; if (it >= n_items) break;
        { const int i2 = it + 2 * step; da = dec(i2 < n_items ? i2 : first); tr_load(da, la); }
        tr_flush(db, lb, scr, lane);
        it += step; if (it >= n_items) break;
        { const int i2 = it + 2 * step; db = dec(i2 < n_items ? i2 : first); tr_load(db, lb); }
        tr_flush(dc, lc, scr, lane);
        it += step; if (it >= n_items) break;
    }
}
__device__ __forceinline__ void rms_row2048(const float* xrow, const float* g, f32x4 (&v)[8], int lane) {
    const f32x4* xr = (const f32x4*)xrow + lane; float ss = 0.f;
#pragma unroll
    for (int j = 0; j < 8; ++j) { v[j] = xr[64 * j]; ss += (v[j].x * v[j].x + v[j].y * v[j].y) + (v[j].z * v[j].z + v[j].w * v[j].w); }
    ss = wave_sum(ss); const float r = rsqrtf(ss * (1.0f / 2048.0f) + EPS);
#pragma unroll
    for (int j = 0; j < 8; ++j) { const f32x4 gg = ((const f32x4*)g)[lane + 64 * j]; v[j] = v[j] * r * gg; }
}
__device__ __forceinline__ void store_row_bf16(bf16_t* orow, const f32x4 (&v)[8], int lane) {
#pragma unroll
    for (int j = 0; j < 8; ++j) { u32x2 w; w.x = cvtpk(v[j].x, v[j].y); w.y = cvtpk(v[j].z, v[j].w); *(u32x2*)(orow + 4 * lane + 256 * j) = w; }
}

__device__ __forceinline__ void p0_prologue(Frame& F, const float* const* in, const int parts = 3) {
    LAS float* scr = (LAS float*)(F.lds + F.wave * 16384);
    const float* w_in = in[3];
    bf16_t* WINT = (bf16_t*)(F.ws + WS_WINT);
    constexpr int I0 = 8192, I1 = 1024, I2 = 1024, I3 = 1024, I4 = 6144, I5 = 2048, I6 = 2048, I7 = 1024, I8 = 1024, I9 = 2048;
    constexpr int NITEMS = I0 + I1 + I2 + I3 + I4 + I5 + I6 + I7 + I8 + I9;
    if (parts & 1) { struct Dec { const float* const* in; const float* w_in; unsigned char* ws; bf16_t* WINT; int lane;
        __device__ __forceinline__ TrD operator()(int it) const { int r = it;
            if (r < I0) return tr_desc(w_in, DIN, 0, WINT, 2048, 0, r / 256, r % 256, 1.f, 0, lane); r -= I0;
            if (r < I1) return tr_desc(w_in, DIN, 9216, WINT + (size_t)8192 * 2048, 2048, 0, r / 32, r % 32, 32.0f, 1, lane); r -= I1;
            if (r < I2) return tr_desc(w_in, DIN, 10248, WINT + (size_t)8192 * 2048, 2048, 1024, r / 32, r % 32, 32.0f, 1, lane); r -= I2;
            if (r < I3) return tr_desc(w_in, DIN, 8192, WINT, 2048, 10240, r / 32, r % 32, 1.f, 0, lane); r -= I3;
            if (r < I4) return tr_desc(w_in, DIN, 11272, WINT + (size_t)11264 * 2048, 2048, 0, r / 192, r % 192, 32.0f, 1, lane); r -= I4;
            if (r < I5) return tr_desc(in[15], 2048, 0, ws + WS_WMEMT, 2048, 0, r / 64, r % 64, 1.f, 0, lane); r -= I5;
            if (r < I6) return tr_desc(in[16], 2048, 0, ws + WS_WBDT, 2048, 0, r / 64, r % 64, 32.0f, 1, lane); r -= I6;
            if (r < I7) return tr_desc(in[17], 2048, 0, ws + WS_WBMT, 1024, 0, r / 64, r % 64, 1.f, 0, lane); r -= I7;
            if (r < I8) return tr_desc(in[18], 2048, 0, ws + WS_WBCT, 1024, 0, r / 64, r % 64, 1.f, 0, lane); r -= I8;
            return tr_desc(in[20], 2048, 0, ws + WS_WOUTT, 2048, 0, r / 64, r % 64, 1.f, 0, lane); } };
      const Dec dec{in, w_in, F.ws, WINT, F.lane};
      tr_run(F.gw, NITEMS, F.NGW, dec, scr, F.lane); }
    if (!(parts & 2)) return;
    { bf16_t* WRT = (bf16_t*)(F.ws + WS_WRT); const float* wrg = in[22]; const float* wre = in[24];
      for (int idx = F.bid * 512 + F.tid; idx < 256 * 2048; idx += F.G * 512) { const int n = idx >> 11, k = idx & 2047;
          const float v = (n < 4 ? wrg[k * 4 + n] : (n < 36 ? wre[k * 32 + (n - 4)] : 0.f)) * in[21][k]; WRT[idx] = (bf16_t)(cvtpk(v, 0.f) & 0xffffu); } }
    __syncthreads();
    LAS float* wg = (LAS float*)F.lds;
    for (int idx = F.tid; idx < 16384; idx += 512) { const int k = idx >> 3, j = idx & 7; wg[j * 2048 + k] = w_in[(size_t)k * DIN + 10240 + j]; }
    __syncthreads();
    const float* x = in[0]; bf16_t* HBF = (bf16_t*)(F.dout + DO_HBF); float* MLG = (float*)(F.ws + WS_MLG);
    f32x4 v[8], gg[8];
#pragma unroll
    for (int j = 0; j < 8; ++j) { v[j] = ((const f32x4*)(x + (size_t)F.gw * 2048))[F.lane + 64 * j]; gg[j] = ((const f32x4*)in[2])[F.lane + 64 * j]; }
    for (int m = F.gw; m < TT; m += F.NGW) {
        f32x4 vn[8];
        { const int mn = m + F.NGW < TT ? m + F.NGW : m;
#pragma unroll
          for (int j = 0; j < 8; ++j) vn[j] = ((const f32x4*)(x + (size_t)mn * 2048))[F.lane + 64 * j]; }
        { float ss = 0.f;
#pragma unroll
          for (int j = 0; j < 8; ++j) ss += (v[j].x * v[j].x + v[j].y * v[j].y) + (v[j].z * v[j].z + v[j].w * v[j].w);
          ss = wave_sum(ss); const float r = rsqrtf(ss * (1.0f / 2048.0f) + EPS);
#pragma unroll
          for (int j = 0; j < 8; ++j) v[j] = v[j] * r * gg[j]; }
        store_row_bf16(HBF + (size_t)m * 2048, v, F.lane);
        { unsigned char* h8 = F.ws + WS_HBF8 + (size_t)m * 2048 + 4 * F.lane;
#pragma unroll
          for (int j = 0; j < 8; ++j) *(unsigned*)(h8 + 256 * j) = pk4_fp8(v[j].x, v[j].y, v[j].z, v[j].w); }
        float res = 0.f;
#pragma unroll
        for (int jj = 0; jj < 8; ++jj) { float a = 0.f;
#pragma unroll
            for (int j = 0; j < 8; ++j) { const f32x4 w = *(const LAS f32x4*)(wg + jj * 2048 + 4 * F.lane + 256 * j); a += (v[j].x * w.x + v[j].y * w.y) + (v[j].z * w.z + v[j].w * w.w); }
            a = wave_sum(a); if (F.lane == jj) res = a; }
        if (F.lane < 8) MLG[(size_t)m * 8 + F.lane] = res;
#pragma unroll
        for (int j = 0; j < 8; ++j) v[j] = vn[j];
    }
    { const float* mem = in[1]; bf16_t* MEMN = (bf16_t*)(F.ws + WS_MEMN);
      for (int m = F.gw; m < NB * MEML; m += F.NGW) { f32x4 v[8]; rms_row2048(mem + (size_t)m * 2048, in[14], v, F.lane); store_row_bf16(MEMN + (size_t)m * 2048, v, F.lane); } }
    if (F.bid == 0 && F.wave == 0) {
        const float* q1 = in[8]; const float* k1 = in[9]; const float* q2 = in[10]; const float* k2 = in[11];
        float d1 = q1[F.lane] * k1[F.lane] + q1[F.lane + 64] * k1[F.lane + 64], d2 = q2[F.lane] * k2[F.lane] + q2[F.lane + 64] * k2[F.lane + 64];
        d1 = wave_sum(d1); d2 = wave_sum(d2);
        if (F.lane == 0) F.ctl[CW_LAM] = __float_as_uint(expf(d1) - expf(d2) + 0.2f);
    }
    __syncthreads();
}

__device__ __forceinline__ void ml0_seq(Frame& F, const float* const* in, int s) {
    const int b = s >> 2, hh = s & 3;
    const float* MLG = (const float*)(F.ws + WS_MLG);
    float* KW = (float*)(F.ws + WS_SCKW); float* RS = (float*)(F.ws + WS_SCRS); float* IT = (float*)(F.ws + WS_SCIT); float* ED = (float*)(F.ws + WS_SCED); float* DEC = (float*)(F.ws + WS_DEC);
    LAS float* sm_bl = (LAS float*)F.lds; LAS float* sm_cm = sm_bl + 64; LAS float* sm_mp = sm_bl + 128; LAS float* sm_R = sm_bl + 192;
    const float big = in[6][hh], bfg = in[7][hh];
    float bl[8][4], gh[8][4], cm[8][4];
#pragma unroll
    for (int rd = 0; rd < 8; ++rd) {
        const int c = rd * 8 + F.wave; const size_t t0 = (size_t)b * SEQ + (size_t)c * 256 + 4 * F.lane;
        float lf[4], ig[4];
#pragma unroll
        for (int i = 0; i < 4; ++i) { const float fg = MLG[(t0 + i) * 8 + 4 + hh] + bfg; lf[i] = fminf(fg, 0.f) - log1pf(__expf(-fabsf(fg))); ig[i] = MLG[(t0 + i) * 8 + hh] + big; }
        float p[4]; p[0] = lf[0]; p[1] = p[0] + lf[1]; p[2] = p[1] + lf[2]; p[3] = p[2] + lf[3];
        float incl = p[3];
#pragma unroll
        for (int o = 1; o < 64; o <<= 1) { const float y = __shfl_up(incl, o); if (F.lane >= o) incl += y; }
        const float excl = incl - p[3];
#pragma unroll
        for (int i = 0; i < 4; ++i) { bl[rd][i] = excl + p[i]; gh[rd][i] = ig[i] - bl[rd][i]; }
        float q[4]; q[0] = gh[rd][0]; q[1] = fmaxf(q[0], gh[rd][1]); q[2] = fmaxf(q[1], gh[rd][2]); q[3] = fmaxf(q[2], gh[rd][3]);
        float im = q[3];
#pragma unroll
        for (int o = 1; o < 64; o <<= 1) { const float y = __shfl_up(im, o); if (F.lane >= o) im = fmaxf(im, y); }
        float em = __shfl_up(im, 1); if (F.lane == 0) em = -__builtin_inff();
#pragma unroll
        for (int i = 0; i < 4; ++i) cm[rd][i] = fmaxf(em, q[i]);
        if (F.lane == 63) { sm_bl[c] = bl[rd][3]; sm_cm[c] = cm[rd][3]; }
    }
    __syncthreads();
    if (F.tid == 0) { float M = 0.f; for (int c = 0; c < 64; ++c) { sm_mp[c] = M; const float R = fmaxf(M, sm_cm[c]); sm_R[c] = R; M = sm_bl[c] + R; } }
    __syncthreads();
#pragma unroll
    for (int rd = 0; rd < 8; ++rd) {
        const int c = rd * 8 + F.wave; const size_t idx = (size_t)hh * TT + (size_t)b * SEQ + (size_t)c * 256 + 4 * F.lane;
        const float Mp = sm_mp[c], R = sm_R[c];
        f32x4 kw, rs, it, ed;
#pragma unroll
        for (int i = 0; i < 4; ++i) { const float Gt = fmaxf(Mp, cm[rd][i]); kw[i] = __expf(gh[rd][i] - R); rs[i] = __expf(R - Gt); it[i] = __expf(Mp - Gt); ed[i] = __expf(-(bl[rd][i] + Gt)); }
        *(f32x4*)(KW + idx) = kw; *(f32x4*)(RS + idx) = rs; *(f32x4*)(IT + idx) = it; *(f32x4*)(ED + idx) = ed;
        if (F.lane == 0) DEC[s * 64 + c] = __expf(Mp - R);
    }
    __syncthreads();
}

__device__ __forceinline__ void unpack8(const u32x4 r, float (&x)[8]) { x[0] = bflo(r.x); x[1] = bfhi(r.x); x[2] = bflo(r.y); x[3] = bfhi(r.y); x[4] = bflo(r.z); x[5] = bfhi(r.z); x[6] = bflo(r.w); x[7] = bfhi(r.w); }
__device__ __forceinline__ void ml1_conv(Frame& F, const float* const* in, const int first, const int nstep) {
    const bf16_t* MQK = (const bf16_t*)(F.ws + WS_MQK);
    bf16_t* Q = (bf16_t*)(F.ws + WS_Q); bf16_t* WQ = (bf16_t*)(F.ws + WS_WQ); bf16_t* KWB = (bf16_t*)(F.ws + WS_KW); bf16_t* KWT = (bf16_t*)(F.ws + WS_KWT);
    const float* KWS = (const float*)(F.ws + WS_SCKW); const float* ITS = (const float*)(F.ws + WS_SCIT); float* KN4 = (float*)(F.ws + WS_KN);
    const float* cw = in[4]; const float* cbp = in[5];
    LAS unsigned char* stg = F.lds + F.wave * 16384;
    const int cl = F.lane & 15, tq = F.lane >> 4;
    for (int id = first; id < 8192; id += nstep) {
        const int g16 = id & 15, sc = id >> 4, kind = g16 >> 3, hh = (g16 >> 1) & 3, dl = (g16 & 1) * 128 + cl * 8, col = g16 * 128 + cl * 8;
        const size_t t0 = (size_t)sc * 64 + tq * 16, tr0 = (size_t)hh * TT + t0;
        const bool st = (t0 & (size_t)(SEQ - 1)) == 0;
        u32x4 xr[19];
#pragma unroll
        for (int i = 0; i < 19; ++i) { const size_t row = (st && i < 3) ? t0 : t0 + i - 3; xr[i] = *(const u32x4*)(MQK + row * 2048 + col); }
        float scl[16];
        { const float* sp = (kind ? KWS : ITS) + tr0;
#pragma unroll
          for (int j = 0; j < 4; ++j) { const f32x4 a = *(const f32x4*)(sp + 4 * j); scl[4 * j] = a.x; scl[4 * j + 1] = a.y; scl[4 * j + 2] = a.z; scl[4 * j + 3] = a.w; } }
        float w[4][8], cb[8], h3[8], h2[8], h1[8], cs[8];
#pragma unroll
        for (int j = 0; j < 4; ++j) { const f32x4 a = *(const f32x4*)(cw + j * 2048 + col), b = *(const f32x4*)(cw + j * 2048 + col + 4);
            w[j][0] = a.x; w[j][1] = a.y; w[j][2] = a.z; w[j][3] = a.w; w[j][4] = b.x; w[j][5] = b.y; w[j][6] = b.z; w[j][7] = b.w; }
        { const f32x4 a = *(const f32x4*)(cbp + col), b = *(const f32x4*)(cbp + col + 4); cb[0] = a.x; cb[1] = a.y; cb[2] = a.z; cb[3] = a.w; cb[4] = b.x; cb[5] = b.y; cb[6] = b.z; cb[7] = b.w; }
        unpack8(xr[0], h3); unpack8(xr[1], h2); unpack8(xr[2], h1);
        if (st) {
#pragma unroll
            for (int c = 0; c < 8; ++c) { h3[c] = 0.f; h2[c] = 0.f; h1[c] = 0.f; } }
#pragma unroll
        for (int c = 0; c < 8; ++c) cs[c] = 0.f;
#pragma unroll
        for (int hf = 0; hf < 2; ++hf) {
#pragma unroll
            for (int i8 = 0; i8 < 8; ++i8) { const int i = hf * 8 + i8;
                float xv[8], sv[8]; unpack8(xr[3 + i], xv);
#pragma unroll
                for (int c = 0; c < 8; ++c) { const float y = w[0][c] * h3[c] + w[1][c] * h2[c] + w[2][c] * h1[c] + w[3][c] * xv[c] + cb[c]; sv[c] = y * sigmoidf_(y); h3[c] = h2[c]; h2[c] = h1[c]; h1[c] = xv[c]; }
                const size_t tr = tr0 + i;
                if (kind == 0) { const float itv = scl[i];
                    u32x4 o; o.x = cvtpk(sv[0], sv[1]); o.y = cvtpk(sv[2], sv[3]); o.z = cvtpk(sv[4], sv[5]); o.w = cvtpk(sv[6], sv[7]); *(u32x4*)(Q + tr * 256 + dl) = o;
                    u32x4 p; p.x = cvtpk(sv[0] * itv, sv[1] * itv); p.y = cvtpk(sv[2] * itv, sv[3] * itv); p.z = cvtpk(sv[4] * itv, sv[5] * itv); p.w = cvtpk(sv[6] * itv, sv[7] * itv); *(u32x4*)(WQ + tr * 512 + 256 + dl) = p;
                } else { const float kwv = scl[i] * 0.0625f;
                    u32x4 o; o.x = cvtpk(sv[0] * kwv, sv[1] * kwv); o.y = cvtpk(sv[2] * kwv, sv[3] * kwv); o.z = cvtpk(sv[4] * kwv, sv[5] * kwv); o.w = cvtpk(sv[6] * kwv, sv[7] * kwv); *(u32x4*)(KWB + tr * 256 + dl) = o;
                    { LAS unsigned char* cp = stg + (cl * 8) * 128 + (((2 * tq + hf) ^ (cl & 7)) << 4) + i8 * 2;
                      *(LAS unsigned short*)(cp + 0 * 128) = (unsigned short)o.x; *(LAS unsigned short*)(cp + 1 * 128) = (unsigned short)(o.x >> 16);
                      *(LAS unsigned short*)(cp + 2 * 128) = (unsigned short)o.y; *(LAS unsigned short*)(cp + 3 * 128) = (unsigned short)(o.y >> 16);
                      *(LAS unsigned short*)(cp + 4 * 128) = (unsigned short)o.z; *(LAS unsigned short*)(cp + 5 * 128) = (unsigned short)(o.z >> 16);
                      *(LAS unsigned short*)(cp + 6 * 128) = (unsigned short)o.w; *(LAS unsigned short*)(cp + 7 * 128) = (unsigned short)(o.w >> 16); }
                    cs[0] += bflo(o.x); cs[1] += bfhi(o.x); cs[2] += bflo(o.y); cs[3] += bfhi(o.y); cs[4] += bflo(o.z); cs[5] += bfhi(o.z); cs[6] += bflo(o.w); cs[7] += bfhi(o.w); }
            }
        }
        if (kind == 1) {
            LDS_WAIT(); asm volatile("" ::: "memory");
            bf16_t* kt = KWT + (((size_t)hh * 128 + (sc >> 2)) * 256 + (g16 & 1) * 128) * 256 + (sc & 3) * 64;
#pragma unroll
            for (int q = 0; q < 16; ++q) { const int r = q * 8 + (F.lane >> 3), k = F.lane & 7;
                const u32x4 v = *(const LAS u32x4*)(stg + r * 128 + ((k ^ (q & 7)) << 4));
                *(u32x4*)(kt + (size_t)r * 256 + k * 8) = v; }
            LDS_WAIT(); asm volatile("" ::: "memory");
#pragma unroll
            for (int c = 0; c < 8; ++c) { cs[c] = xsum16(cs[c]); cs[c] = xsum32(cs[c]); }
            if (tq == 0) { float* kn = KN4 + (((size_t)hh * 128 + (sc >> 2)) * 4 + (sc & 3)) * 256 + dl;
                *(f32x4*)kn = (f32x4){cs[0], cs[1], cs[2], cs[3]}; *(f32x4*)(kn + 4) = (f32x4){cs[4], cs[5], cs[6], cs[7]}; }
        }
    }
}

__device__ __forceinline__ void nscan_seq(Frame& F, int s) {
    if (F.tid < 256) { const int hh = s & 3, b = s >> 2; const float* KN4 = (const float*)(F.ws + WS_KN); const float* DEC = (const float*)(F.ws + WS_DEC); float* NP = (float*)(F.ws + WS_NP);
        float n = 0.f;
        for (int c0 = 0; c0 < 64; c0 += 8) { float kn[8], dc[8];
#pragma unroll
            for (int i = 0; i < 8; ++i) { const float* p = KN4 + ((size_t)hh * 128 + b * 64 + c0 + i) * 1024 + F.tid; kn[i] = (p[0] + p[256]) + (p[512] + p[768]); dc[i] = DEC[s * 64 + c0 + i]; }
#pragma unroll
            for (int i = 0; i < 8; ++i) { NP[((size_t)s * 64 + c0 + i) * 256 + F.tid] = n; n = dc[i] * n + kn[i]; } }
    }
}
__device__ __forceinline__ void xsoftmax(Frame& F) {
    const bf16_t* XS = (const bf16_t*)(F.ws + WS_XS); bf16_t* XP = (bf16_t*)(F.ws + WS_XP);
    const int sub = F.lane >> 5, d8 = (F.lane & 31) * 8;
    for (int row0 = F.gw * 8; row0 < 4 * TT; row0 += F.NGW * 8) {
        u32x4 v[4];
#pragma unroll
        for (int i = 0; i < 4; ++i) v[i] = *(const u32x4*)(XS + (size_t)(row0 + 2 * i + sub) * 256 + d8);
#pragma unroll
        for (int i = 0; i < 4; ++i) { float x[8]; unpack8(v[i], x);
            float m = fmaxf(fmaxf(fmaxf(x[0], x[1]), fmaxf(x[2], x[3])), fmaxf(fmaxf(x[4], x[5]), fmaxf(x[6], x[7])));
#pragma unroll
            for (int o = 1; o < 32; o <<= 1) m = fmaxf(m, __shfl_xor(m, o));
            float s = 0.f;
#pragma unroll
            for (int c = 0; c < 8; ++c) { x[c] = __expf(x[c] - m); s += x[c]; }
#pragma unroll
            for (int o = 1; o < 32; o <<= 1) s += __shfl_xor(s, o);
            const float inv = 1.0f / s;
            u32x4 w; w.x = cvtpk(x[0] * inv, x[1] * inv); w.y = cvtpk(x[2] * inv, x[3] * inv); w.z = cvtpk(x[4] * inv, x[5] * inv); w.w = cvtpk(x[6] * inv, x[7] * inv);
            *(u32x4*)(XP + (size_t)(row0 + 2 * i + sub) * 256 + d8) = w; }
    }
}
__device__ __forceinline__ void cscan(Frame& F) {
    const bf16_t* U = (const bf16_t*)(F.ws + WS_U); bf16_t* VC = (bf16_t*)(F.ws + WS_VC); const float* DEC = (const float*)(F.ws + WS_DEC);
    for (int gid = F.bid * 512 + F.tid; gid < 131072; gid += F.G * 512) {
        const int s = gid >> 14, rem = gid & 16383, dv = rem >> 6, dk4 = (rem & 63) * 4, hh = s & 3, b = s >> 2;
        f32x4 C = {0.f, 0.f, 0.f, 0.f};
        for (int c0 = 0; c0 < 64; c0 += 8) { const size_t g0 = (size_t)hh * 128 + b * 64 + c0;
            f32x4 u[8]; float dc[8];
#pragma unroll
            for (int i = 0; i < 8; ++i) { const u32x2 w = *(const u32x2*)(U + (g0 + i) * 65536 + (size_t)dv * 256 + dk4); u[i] = (f32x4){bflo(w.x), bfhi(w.x), bflo(w.y), bfhi(w.y)}; dc[i] = DEC[s * 64 + c0 + i]; }
#pragma unroll
            for (int i = 0; i < 8; ++i) { u32x2 w; w.x = cvtpk(C.x, C.y); w.y = cvtpk(C.z, C.w); *(u32x2*)(VC + ((g0 + i) * 256 + dv) * 512 + 256 + dk4) = w; C = C * dc[i] + u[i]; } }
    }
}
__device__ __forceinline__ void denpass(Frame& F) {
    const bf16_t* WQ = (const bf16_t*)(F.ws + WS_WQ); const float* NP = (const float*)(F.ws + WS_NP); const float* ED = (const float*)(F.ws + WS_SCED); float* HDEN = (float*)(F.ws + WS_HDEN);
    for (int row0 = F.gw * 4; row0 < 4 * TT; row0 += F.NGW * 4) {
        const int hh = row0 / TT, t = row0 - hh * TT, b = t / SEQ, c = (t - b * SEQ) >> 8;
        u32x4 w[4]; f32x4 n0 = {0.f, 0.f, 0.f, 0.f}, n1 = {0.f, 0.f, 0.f, 0.f};
#pragma unroll
        for (int i = 0; i < 4; ++i) w[i] = *(const u32x4*)(WQ + (size_t)(row0 + i) * 512 + 8 * F.lane);
        if (F.lane >= 32) { const float* np = NP + ((size_t)(b * 4 + hh) * 64 + c) * 256 + 8 * (F.lane - 32); n0 = *(const f32x4*)np; n1 = *(const f32x4*)(np + 4); }
        else { n0 = (f32x4){1.f, 1.f, 1.f, 1.f}; n1 = n0; }
        const float edv = ED[row0 + (F.lane & 3)];
#pragma unroll
        for (int i = 0; i < 4; ++i) {
            const float part = ((bflo(w[i].x) * n0.x + bfhi(w[i].x) * n0.y) + (bflo(w[i].y) * n0.z + bfhi(w[i].y) * n0.w)) + ((bflo(w[i].z) * n1.x + bfhi(w[i].z) * n1.y) + (bflo(w[i].w) * n1.z + bfhi(w[i].w) * n1.w));
            const float den = wave_sum(part);
            if (F.lane == i) HDEN[row0 + i] = fmaxf(fabsf(den), edv); }
    }
}
__device__ __forceinline__ void hmnorm(Frame& F, const float* const* in) {
    bf16_t* HR = (bf16_t*)(F.dout + DO_HR); const bf16_t* MLO = (const bf16_t*)(F.ws + WS_MLO); const float* g = in[13];
    const int sub = F.lane >> 5, d8 = (F.lane & 31) * 8;
    for (int row0 = F.gw * 8; row0 < 4 * TT; row0 += F.NGW * 8) {
        u32x4 xw[4], ow[4];
#pragma unroll
        for (int i = 0; i < 4; ++i) { const int row = row0 + 2 * i + sub; const size_t o = (size_t)(row >> 2) * 1024 + (row & 3) * 256 + d8; xw[i] = *(const u32x4*)(HR + o); ow[i] = *(const u32x4*)(MLO + o); }
#pragma unroll
        for (int i = 0; i < 4; ++i) { const int row = row0 + 2 * i + sub, hh = row & 3; const size_t o = (size_t)(row >> 2) * 1024 + hh * 256 + d8;
            float x[8], og[8]; unpack8(xw[i], x); unpack8(ow[i], og);
            float ss = ((x[0] * x[0] + x[1] * x[1]) + (x[2] * x[2] + x[3] * x[3])) + ((x[4] * x[4] + x[5] * x[5]) + (x[6] * x[6] + x[7] * x[7]));
            ss += __shfl_xor(ss, 1); ss += __shfl_xor(ss, 2); ss += __shfl_xor(ss, 4); ss += __shfl_xor(ss, 8); ss += __shfl_xor(ss, 16);
            const float r = rsqrtf(ss * (1.0f / 256.0f) + EPS);
            const f32x4 g0 = *(const f32x4*)(g + hh * 256 + d8), g1 = *(const f32x4*)(g + hh * 256 + d8 + 4);
            u32x4 w; w.x = cvtpk(sigmoidf_(og[0]) * x[0] * r * g0.x, sigmoidf_(og[1]) * x[1] * r * g0.y); w.y = cvtpk(sigmoidf_(og[2]) * x[2] * r * g0.z, sigmoidf_(og[3]) * x[3] * r * g0.w);
            w.z = cvtpk(sigmoidf_(og[4]) * x[4] * r * g1.x, sigmoidf_(og[5]) * x[5] * r * g1.y); w.w = cvtpk(sigmoidf_(og[6]) * x[6] * r * g1.z, sigmoidf_(og[7]) * x[7] * r * g1.w);
            *(u32x4*)(HR + o) = w; }
    }
}
__device__ __forceinline__ unsigned fkey(float f) { const unsigned u = __float_as_uint(f); return (u & 0x80000000u) ? ~u : (u | 0x80000000u); }
__device__ __forceinline__ float fkey_inv(unsigned k) { return __uint_as_float((k & 0x80000000u) ? (k & 0x7fffffffu) : ~k); }
__device__ __forceinline__ float dot8(const u32x4 a, const u32x4 b) {
    return ((bflo(a.x) * bflo(b.x) + bfhi(a.x) * bfhi(b.x)) + (bflo(a.y) * bflo(b.y) + bfhi(a.y) * bfhi(b.y))) + ((bflo(a.z) * bflo(b.z) + bfhi(a.z) * bfhi(b.z)) + (bflo(a.w) * bflo(b.w) + bfhi(a.w) * bfhi(b.w))); }
__device__ __forceinline__ void normmax(Frame& F) {
    if (F.G != 256) return;
    LAS float* red = (LAS float*)F.lds;
    const bf16_t* DQ = (const bf16_t*)(F.ws + WS_DQ); const bf16_t* DK = (const bf16_t*)(F.ws + WS_DK);
    const int r32 = F.lane & 31, hi = F.lane >> 5, g = F.wave & 3;
    const int tq0 = F.bid * 128 + 32 * g, bstart = ((F.bid * 128) / SEQ) * SEQ;
    const float NEG = -__builtin_inff();
    for (int ci = 0; ci < 8; ++ci) {
        const int c16 = (F.wave >> 2) * 8 + ci;
        const bf16_t* Qc = DQ + (size_t)c16 * TT * 128; const bf16_t* Kc = DK + (size_t)c16 * TT * 128;
        const float slope = exp2f(-(float)((c16 >> 1) + 1));
        bf16x8 qf[8], kf[3][8];
#pragma unroll
        for (int kk = 0; kk < 8; ++kk) qf[kk] = *(const bf16x8*)(Qc + (size_t)(tq0 + r32) * 128 + kk * 16 + hi * 8);
#pragma unroll
        for (int u = 0; u < 3; ++u) { const int ks = tq0 - 32 * (2 - u) >= bstart ? tq0 - 32 * (2 - u) : tq0;
#pragma unroll
            for (int kk = 0; kk < 8; ++kk) kf[u][kk] = *(const bf16x8*)(Kc + (size_t)(ks + r32) * 128 + kk * 16 + hi * 8); }
        float q2 = 0.f, k2 = 0.f;
#pragma unroll
        for (int kk = 0; kk < 8; ++kk) { q2 += dot8(__builtin_bit_cast(u32x4, qf[kk]), __builtin_bit_cast(u32x4, qf[kk])); k2 += dot8(__builtin_bit_cast(u32x4, kf[2][kk]), __builtin_bit_cast(u32x4, kf[2][kk])); }
        q2 = xsum32(q2); k2 = xsum32(k2);
        float vals[3][16]; float m = NEG;
#pragma unroll
        for (int u = 0; u < 3; ++u) { f32x16 acc = {};
#pragma unroll
            for (int kk = 0; kk < 8; ++kk) acc = __builtin_amdgcn_mfma_f32_32x32x16_bf16(kf[u][kk], qf[kk], acc, 0, 0, 0);
            const bool gv = tq0 - 32 * (2 - u) >= bstart;
#pragma unroll
            for (int r = 0; r < 16; ++r) { const int dist = 32 * (2 - u) + r32 - attn::crow(r, hi);
                const float v = (gv && dist >= 0) ? acc[r] * attn::SCALE - slope * (float)dist : NEG; vals[u][r] = v; m = fmaxf(m, v); } }
        const float ms = (m == NEG) ? 0.f : m; float l = 0.f;
#pragma unroll
        for (int u = 0; u < 3; ++u) {
#pragma unroll
            for (int r = 0; r < 16; ++r) l += __expf(vals[u][r] - ms); }
        const float mo = __shfl_xor(m, 32), lo = __shfl_xor(l, 32);
        const float M = fmaxf(m, mo);
        const float L = l * __expf(ms - M) * (m == NEG ? 0.f : 1.f) + lo * ((mo == NEG) ? 0.f : __expf(mo - M));
        float nlb = -(M + __logf(L));
        q2 = wave_max(q2); k2 = wave_max(k2); nlb = wave_max(nlb);
        if (F.lane == 0) { red[F.wave * 48 + c16] = q2; red[F.wave * 48 + 16 + c16] = k2; red[F.wave * 48 + 32 + c16] = nlb; }
    }
    __syncthreads();
    if (F.tid < 48) {
        const int blk = F.bid >> 1, b = (F.bid * 128) / SEQ, kind = F.tid >> 4, c16 = F.tid & 15, w0 = (c16 >> 3) * 4;
        float a = red[w0 * 48 + F.tid];
#pragma unroll
        for (int w = 1; w < 4; ++w) a = fmaxf(a, red[(w0 + w) * 48 + F.tid]);
        if (kind == 0) atomicMax(F.ctl + CW_QB2 + c16 * 128 + blk, __float_as_uint(a));
        else if (kind == 1) F.ctl[CW_KT + (c16 * 2 + b) * 128 + (F.bid - b * (SEQ / 128))] = __float_as_uint(a);
        else atomicMax(F.ctl + CW_ND + c16 * 128 + blk, fkey(a));
    }
    __syncthreads();
}
__device__ __forceinline__ attn4::Item attn_item(Frame& F, int qx, int id) {
    const int b = qx >> 2, m = (qx >> 1) & 1, x = id, h = 7 - (x >> 6), qb = 2 * (63 - (x & 63)) + (qx & 1);
    const bf16_t* DQ = (const bf16_t*)(F.ws + WS_DQ); const bf16_t* DK = (const bf16_t*)(F.ws + WS_DK); const bf16_t* DV = (const bf16_t*)(F.ws + WS_DV); bf16_t* O = (bf16_t*)(F.ws + WS_O);
    attn4::Item it; const size_t srow = (size_t)b * SEQ;
    it.Q = DQ + ((size_t)(h * 2 + m) * TT + srow + (size_t)qb * 128) * 128;
    it.K = DK + ((size_t)(h * 2 + m) * TT + srow) * 128;
    it.V0 = DV + ((size_t)(h * 2 + 0) * TT + srow) * 128;
    it.V1 = DV + ((size_t)(h * 2 + 1) * TT + srow) * 128;
    it.O = O + ((size_t)(h * 2 + m) * TT + srow + (size_t)qb * 128) * 256;
    it.P0 = qb * 128;
    const int c16 = h * 2 + m, blk = b * 64 + (qb >> 1);
    const float q2 = __uint_as_float(F.ctl[CW_QB2 + c16 * 128 + blk]), k2 = ((const LAS float*)(F.lds + KMX_LDS))[c16 * 2 + b], ndg = fkey_inv(F.ctl[CW_ND + c16 * 128 + blk]);
    const float slope = exp2f(-(float)(h + 1));
    const float bnd = sqrtf(q2) * sqrtf(k2) * attn::SCALE + ndg + 18.05f - logf(1.0f - expf(-slope));
    float wf = ceilf(bnd / slope) + 1.0f; if (!(wf < (float)SEQ)) wf = (float)SEQ; if (!(wf >= 1.0f)) wf = 1.0f;
    if (F.G != 256) wf = (float)SEQ;
    it.W = (int)wf; it.sl = slope / attn::SCALE;
    return it;
}
__device__ __forceinline__ int attn_ticket(Frame& F, int rep, int& myq) {
    if (F.tid == 0) { int res = -1;
        for (int k = 0; k < 8; ++k) { const int q = (myq + k) & 7; const unsigned t = atomicAdd(F.ctl + CW_AHEAD + rep * 64 + q * 8, 1u); if (t < 512u) { res = q * 512 + (int)t; break; } }
        F.MISC[0] = (unsigned)res; }
    __syncthreads();
    const int v = __builtin_amdgcn_readfirstlane((int)F.MISC[0]);
    __syncthreads();
    if (v >= 0) myq = v >> 9;
    return v;
}
__device__ __forceinline__ void attn_phase(Frame& F, int rep) {
    const int tid = F.tid; int myq = F.bid & 7;
    { const int ent = F.tid >> 4, sub = F.tid & 15; float m = 0.f;
#pragma unroll
      for (int j = 0; j < 8; ++j) m = fmaxf(m, __uint_as_float(F.ctl[CW_KT + ent * 128 + sub * 8 + j]));
      m = fmaxf(m, __shfl_xor(m, 1)); m = fmaxf(m, __shfl_xor(m, 2)); m = fmaxf(m, __shfl_xor(m, 4)); m = fmaxf(m, __shfl_xor(m, 8));
      if (sub == 0) ((LAS float*)(F.lds + KMX_LDS))[ent] = m;
      __syncthreads(); }
    for (;;) {
        const int id = attn_ticket(F, rep, myq);
        if (id < 0) break;
        const attn4::Item it = attn_item(F, id >> 9, id & 511);
        attn4::item(it, (char*)F.lds_g, F.lds, tid);
    }
    VM_WAIT(); __syncthreads();
}
__device__ __forceinline__ void dacombine(Frame& F, const float* const* in, const bf16_t* O, bf16_t* DA) {
    const float* g = in[12];
    const float lam = __uint_as_float(F.ctl[CW_LAM]);
    const int sub = F.lane >> 5, d8 = (F.lane & 31) * 8;
    const int h = F.gw & 7;
    const f32x4 g0 = *(const f32x4*)(g + h * 256 + d8) * 0.8f, g1 = *(const f32x4*)(g + h * 256 + d8 + 4) * 0.8f;
    const bf16_t* O0 = O + (size_t)(h * 2 + 0) * TT * 256 + d8; const bf16_t* O1 = O + (size_t)(h * 2 + 1) * TT * 256 + d8;
    u32x4 a[4], bq[4];
#define DAC_LOAD(tb_, A_, B_) _Pragma("unroll") for (int i = 0; i < 4; ++i) { const size_t t = (size_t)(tb_) * 8 + 2 * i + sub; A_[i] = *(const u32x4*)(O0 + t * 256); B_[i] = *(const u32x4*)(O1 + t * 256); }
    const int tstep = F.NGW >> 3;
    DAC_LOAD(F.gw >> 3, a, bq);
    for (int tb = F.gw >> 3; tb < TT / 8; tb += tstep) {
        u32x4 an[4], bn[4];
        { const int tn = tb + tstep < TT / 8 ? tb + tstep : tb;
          DAC_LOAD(tn, an, bn); }
#pragma unroll
        for (int i = 0; i < 4; ++i) { const size_t t = (size_t)tb * 8 + 2 * i + sub;
            float x[8], y[8]; unpack8(a[i], x); unpack8(bq[i], y);
#pragma unroll
            for (int c = 0; c < 8; ++c) x[c] -= lam * y[c];
            float ss = ((x[0] * x[0] + x[1] * x[1]) + (x[2] * x[2] + x[3] * x[3])) + ((x[4] * x[4] + x[5] * x[5]) + (x[6] * x[6] + x[7] * x[7]));
            ss += DPP_F(ss, 0xB1); ss += DPP_F(ss, 0x4E); ss += DPP_F(ss, 0x124); ss += DPP_F(ss, 0x128);
            { const int iv = __builtin_bit_cast(int, ss);
              const float h0 = __builtin_bit_cast(float, __builtin_amdgcn_readlane(iv, 0)) + __builtin_bit_cast(float, __builtin_amdgcn_readlane(iv, 16)), h1 = __builtin_bit_cast(float, __builtin_amdgcn_readlane(iv, 32)) + __builtin_bit_cast(float, __builtin_amdgcn_readlane(iv, 48));
              ss = sub ? h1 : h0; }
            const float r = rsqrtf(ss * (1.0f / 256.0f) + EPS);
            u32x2 w; w.x = pk4_fp8(x[0] * r * g0.x, x[1] * r * g0.y, x[2] * r * g0.z, x[3] * r * g0.w); w.y = pk4_fp8(x[4] * r * g1.x, x[5] * r * g1.y, x[6] * r * g1.z, x[7] * r * g1.w);
            *(u32x2*)((unsigned char*)DA + t * 2048 + h * 256 + d8) = w; }
#pragma unroll
        for (int i = 0; i < 4; ++i) { a[i] = an[i]; bq[i] = bn[i]; }
    }
#undef DAC_LOAD
}
#ifndef P9DUP
#define P9DUP 0
#endif
__device__ __forceinline__ void expert_convert(Frame& F, const float* const* in, const int parts = 3) {
    LAS float* scr = (LAS float*)(F.lds + F.wave * 16384);
    unsigned char* WGU = F.ws + WS_WGU; unsigned char* WD = F.ws + WS_WD;
    constexpr int PER = 22528;
    if (parts & 1) { struct Dec { const float* const* in; unsigned char* WGU; unsigned char* WD; int lane;
        __device__ __forceinline__ TrD operator()(int it) const {
            const int kind = it / PER, r = it - kind * PER, e = r / 704, r2 = r - e * 704;
            if (kind < 2) { const int kb = r2 / 22, nb = r2 - kb * 22, pn = nb >> 2;
                return tr_desc((kind == 0 ? in[26] : in[27]) + (size_t)e * 2048 * DEXP, DEXP, 0, WGU, 2048, e * GU_N + pn * 128 + kind * 128, kb, nb, 32.0f, 1, lane); }
            const int kb = r2 >> 6, nb = r2 & 63;
            return tr_desc(in[28] + (size_t)e * DEXP * 2048, 2048, 0, WD + (size_t)e * 2048 * DEXP_P, DEXP_P, 0, kb, nb, 16.0f, 1, lane); } };
      const Dec dec{in, WGU, WD, F.lane};
      for (int rr_ = 0; rr_ < 1 + ((P9DUP >> 1) & 1); ++rr_) tr_run(F.gw, 3 * PER, F.NGW, dec, scr, F.lane);
    const u32x4 z = {0u, 0u, 0u, 0u};
    for (int idx = F.bid * 512 + F.tid; idx < 32 * 2 * 64 * 128; idx += F.G * 512) { const int e = idx >> 14, rem = idx & 16383, blk = rem >> 13, row = (rem >> 7) & 63, c16 = rem & 127;
        *(u32x4*)(WGU + ((size_t)e * GU_N + 1280 + blk * 128 + 64 + row) * 2048 + c16 * 16) = z; }
    for (int idx = F.bid * 512 + F.tid; idx < 32 * 2048 * 4; idx += F.G * 512) { const int en = idx >> 2, j = idx & 3;
        *(u32x4*)(WD + (size_t)en * DEXP_P + DEXP + j * 16) = z; }
    }
    if (parts & 2) { const bf16_t* HBF = (const bf16_t*)(F.dout + DO_HBF); unsigned char* H8 = F.ws + WS_HBF8;
      const size_t stride = (size_t)F.NGW * 64 * 4;
      for (int rr_ = 0; rr_ < 1 + ((P9DUP >> 2) & 1); ++rr_)
      for (size_t g8 = (size_t)(F.gw * 64 + F.lane) * 4; g8 < (size_t)TT * 256; g8 += 4 * stride) {
          u32x4 a[4][4];
#pragma unroll
          for (int j = 0; j < 4; ++j) { const size_t gj = g8 + j * stride < (size_t)TT * 256 ? g8 + j * stride : g8;
#pragma unroll
              for (int i = 0; i < 4; ++i) a[j][i] = *(const u32x4*)(HBF + (gj + i) * 8); }
#pragma unroll
          for (int j = 0; j < 4; ++j) { const size_t gj = g8 + j * stride;
              if (gj < (size_t)TT * 256) { u32x4 o0, o1;
                  o0.x = pk4_fp8(bflo(a[j][0].x), bfhi(a[j][0].x), bflo(a[j][0].y), bfhi(a[j][0].y)); o0.y = pk4_fp8(bflo(a[j][0].z), bfhi(a[j][0].z), bflo(a[j][0].w), bfhi(a[j][0].w));
                  o0.z = pk4_fp8(bflo(a[j][1].x), bfhi(a[j][1].x), bflo(a[j][1].y), bfhi(a[j][1].y)); o0.w = pk4_fp8(bflo(a[j][1].z), bfhi(a[j][1].z), bflo(a[j][1].w), bfhi(a[j][1].w));
                  o1.x = pk4_fp8(bflo(a[j][2].x), bfhi(a[j][2].x), bflo(a[j][2].y), bfhi(a[j][2].y)); o1.y = pk4_fp8(bflo(a[j][2].z), bfhi(a[j][2].z), bflo(a[j][2].w), bfhi(a[j][2].w));
                  o1.z = pk4_fp8(bflo(a[j][3].x), bfhi(a[j][3].x), bflo(a[j][3].y), bfhi(a[j][3].y)); o1.w = pk4_fp8(bflo(a[j][3].z), bfhi(a[j][3].z), bflo(a[j][3].w), bfhi(a[j][3].w));
                  *(u32x4*)(H8 + gj * 8) = o0; *(u32x4*)(H8 + gj * 8 + 16) = o1; } } } }
    __syncthreads();
}
__device__ __forceinline__ void topk_pass(Frame& F, const float* const* in, int tbeg, int tend) {
    const float* LG = (const float*)(F.ws + WS_LG); int* TOKE = (int*)(F.ws + WS_TOKE); float* TOKW = (float*)(F.ws + WS_TOKW); const float* RSS = (const float*)(F.ws + WS_RSS); float* RT = (float*)(F.ws + WS_RT);
    LAS unsigned* hist = (LAS unsigned*)F.lds;
    if (F.tid < 64) hist[F.tid] = 0u;
    __syncthreads();
    const float* brg = in[23]; const float* bre = in[25];
    for (int t = tbeg + F.tid; t < tend; t += 512) {
        const float* lp = LG + (size_t)t * 256;
        float rt; { const f32x4* rs = (const f32x4*)(RSS + (size_t)t * 32); f32x4 a = rs[0];
#pragma unroll
            for (int j = 1; j < 8; ++j) a += rs[j];
            rt = rsqrtf(((a.x + a.y) + (a.z + a.w)) * (1.0f / 2048.0f) + EPS); RT[t] = rt; }
        const f32x4 g4 = *(const f32x4*)lp * rt;
        const float g0 = g4.x + brg[0], g1 = g4.y + brg[1], g2 = g4.z + brg[2], g3 = g4.w + brg[3];
        int grp = 0; float gm = g0; if (g1 > gm) { gm = g1; grp = 1; } if (g2 > gm) { gm = g2; grp = 2; } if (g3 > gm) { gm = g3; grp = 3; }
        const float pg = 1.0f / (expf(g0 - gm) + expf(g1 - gm) + expf(g2 - gm) + expf(g3 - gm));
        const f32x4 ea = *(const f32x4*)(lp + 4 + grp * 8) * rt, eb = *(const f32x4*)(lp + 8 + grp * 8) * rt;
        const f32x4 ba = *(const f32x4*)(bre + grp * 8), bb = *(const f32x4*)(bre + grp * 8 + 4);
        float ev[8] = {ea.x + ba.x, ea.y + ba.y, ea.z + ba.z, ea.w + ba.w, eb.x + bb.x, eb.y + bb.y, eb.z + bb.z, eb.w + bb.w};
        int i1 = 0; float v1 = ev[0];
#pragma unroll
        for (int j = 1; j < 8; ++j) if (ev[j] > v1) { v1 = ev[j]; i1 = j; }
        int i2 = -1; float v2 = -__builtin_inff();
#pragma unroll
        for (int j = 0; j < 8; ++j) if (j != i1 && ev[j] > v2) { v2 = ev[j]; i2 = j; }
        const float ex = expf(v2 - v1), inv = 1.0f / (1.0f + ex);
        const int e1 = grp * 8 + i1, e2 = grp * 8 + i2;
        TOKE[t * 2] = e1; TOKE[t * 2 + 1] = e2; TOKW[t * 2] = inv * pg; TOKW[t * 2 + 1] = ex * inv * pg;
        const int hf = ((t - tbeg) >> 7) & 1;
        __hip_atomic_fetch_add(&hist[hf * 32 + e1], 1u, __ATOMIC_RELAXED, __HIP_MEMORY_SCOPE_WORKGROUP); __hip_atomic_fetch_add(&hist[hf * 32 + e2], 1u, __ATOMIC_RELAXED, __HIP_MEMORY_SCOPE_WORKGROUP);
    }
    __syncthreads();
    if (F.tid < 32 && (hist[F.tid] + hist[32 + F.tid])) atomicAdd(F.ctl + CW_ECNT + F.tid, hist[F.tid] + hist[32 + F.tid]);
    if (F.tid < 64) F.ctl[CW_CH + ((tbeg >> 7) + (F.tid >> 5)) * 32 + (F.tid & 31)] = hist[F.tid];
    __syncthreads();
}
__device__ __forceinline__ void gather_pass(Frame& F, const float* const* in) {
    const int* TOKE = (const int*)(F.ws + WS_TOKE); const float* TOKW = (const float*)(F.ws + WS_TOKW); int* POS = (int*)(F.ws + WS_POS); float* WROW = (float*)(F.ws + WS_WROW); int* TILEE = (int*)(F.ws + WS_TILEE);
    const bf16_t* X1B = (const bf16_t*)(F.ws + WS_X1B); const float* RT = (const float*)(F.ws + WS_RT); unsigned char* XSORT = F.ws + WS_XSORT;
    float gf[32];
#pragma unroll
    for (int j = 0; j < 8; ++j) { const f32x4 g = *(const f32x4*)(in[21] + 32 * F.lane + 4 * j); gf[4 * j] = g.x; gf[4 * j + 1] = g.y; gf[4 * j + 2] = g.z; gf[4 * j + 3] = g.w; }
    LAS unsigned* pstart = (LAS unsigned*)F.lds; LAS unsigned* hist = pstart + 32; LAS unsigned* base = pstart + 64; LAS unsigned* lcur = pstart + 96; LAS int* apos = (LAS int*)(pstart + 128); LAS int* atok = apos + 512;
    LAS unsigned* ecnt = pstart + 2048; LAS unsigned* part = pstart + 2112;
    if (F.tid < 32) ecnt[F.tid] = F.ctl[CW_ECNT + F.tid];
    const bool det = (F.G == 256);
    if (det) { const int e = F.tid & 31, pt = F.tid >> 5; unsigned sum = 0;
#pragma unroll
        for (int j = 0; j < 16; ++j) { const int hq = pt + 16 * j; sum += (hq < F.bid) ? F.ctl[CW_CH + hq * 32 + e] : 0u; }
        part[pt * 32 + e] = sum; }
    __syncthreads();
    if (F.tid == 0) { unsigned acc = 0; for (int e = 0; e < 32; ++e) { pstart[e] = acc; const unsigned c = ecnt[e]; const unsigned pc = (c + 255u) & ~255u;
            if (F.bid == 0) for (unsigned rt = acc >> 8; rt < (acc + pc) >> 8; ++rt) TILEE[rt] = e;
            acc += pc; }
        if (F.bid == 0) F.ctl[CW_NRT] = acc >> 8; }
    if (det && F.tid >= 64 && F.tid < 96) { const int e = F.tid - 64; unsigned sum = 0;
#pragma unroll
        for (int j = 0; j < 16; ++j) sum += part[j * 32 + e];
        part[512 + e] = sum; }
    const int per = (TT + F.G - 1) / F.G;
    const int tbeg = F.bid * per, tend = (tbeg + per < TT) ? tbeg + per : TT;
    for (int ts = tbeg; ts < tend; ts += 256) {
        const int nasg = 2 * ((tend - ts < 256) ? tend - ts : 256);
        if (F.tid < 32) { hist[F.tid] = 0u; lcur[F.tid] = 0u; }
        __syncthreads();
        int e = 0; const int a = F.tid;
        if (a < nasg) { e = TOKE[ts * 2 + a]; __hip_atomic_fetch_add(&hist[e], 1u, __ATOMIC_RELAXED, __HIP_MEMORY_SCOPE_WORKGROUP); }
        __syncthreads();
        if (F.tid < 32) base[F.tid] = pstart[F.tid] + (det ? part[512 + F.tid] : (hist[F.tid] ? atomicAdd(F.ctl + CW_ECUR + F.tid, hist[F.tid]) : 0u));
        __syncthreads();
        if (a < nasg) { const unsigned p = base[e] + __hip_atomic_fetch_add(&lcur[e], 1u, __ATOMIC_RELAXED, __HIP_MEMORY_SCOPE_WORKGROUP); POS[ts * 2 + a] = (int)p; WROW[p] = TOKW[ts * 2 + a]; apos[a] = (int)p; atok[a] = ts + (a >> 1); }
        __syncthreads();
        for (int i = F.wave; i < nasg; i += 8) { const int tok = atok[i]; const u32x4* src = (const u32x4*)(X1B + (size_t)tok * 2048) + 4 * F.lane; u32x4* dst = (u32x4*)(XSORT + (size_t)apos[i] * 2048) + 2 * F.lane;
            u32x4 a[4]; const float rt = RT[tok];
#pragma unroll
            for (int j = 0; j < 4; ++j) a[j] = src[j];
            unsigned o[8];
#pragma unroll
            for (int j = 0; j < 4; ++j) {
                o[2 * j]     = pk4_fp8(bflo(a[j].x) * rt * gf[8 * j],     bfhi(a[j].x) * rt * gf[8 * j + 1], bflo(a[j].y) * rt * gf[8 * j + 2], bfhi(a[j].y) * rt * gf[8 * j + 3]);
                o[2 * j + 1] = pk4_fp8(bflo(a[j].z) * rt * gf[8 * j + 4], bfhi(a[j].z) * rt * gf[8 * j + 5], bflo(a[j].w) * rt * gf[8 * j + 6], bfhi(a[j].w) * rt * gf[8 * j + 7]); }
            u32x4 o0, o1; o0.x = o[0]; o0.y = o[1]; o0.z = o[2]; o0.w = o[3]; o1.x = o[4]; o1.y = o[5]; o1.z = o[6]; o1.w = o[7];
            dst[0] = o0; dst[1] = o1; }
        __syncthreads();
    }
}
__device__ __forceinline__ void unpack8_fp8(const u32x2 w, float (&x)[8]) {
    x[0] = __builtin_amdgcn_cvt_f32_fp8((int)w.x, 0); x[1] = __builtin_amdgcn_cvt_f32_fp8((int)w.x, 1); x[2] = __builtin_amdgcn_cvt_f32_fp8((int)w.x, 2); x[3] = __builtin_amdgcn_cvt_f32_fp8((int)w.x, 3);
    x[4] = __builtin_amdgcn_cvt_f32_fp8((int)w.y, 0); x[5] = __builtin_amdgcn_cvt_f32_fp8((int)w.y, 1); x[6] = __builtin_amdgcn_cvt_f32_fp8((int)w.y, 2); x[7] = __builtin_amdgcn_cvt_f32_fp8((int)w.y, 3); }
__device__ __forceinline__ void final_pass(Frame& F, const float* const* in) {
    const bf16_t* X1B = (const bf16_t*)(F.ws + WS_X1B); float* OUT = (float*)F.dout; const unsigned char* YS = F.ws + WS_YS; const int* POS = (const int*)(F.ws + WS_POS); const float* g = in[29];
    f32x4 gv[4][2];
#pragma unroll
    for (int j = 0; j < 4; ++j) { gv[j][0] = *(const f32x4*)(g + 8 * F.lane + 512 * j); gv[j][1] = *(const f32x4*)(g + 8 * F.lane + 512 * j + 4); }
    for (int m0 = F.gw * 2; m0 < TT; m0 += F.NGW * 2) {
        u32x4 x[2][4]; u32x2 a[2][4], bq[2][4];
#pragma unroll
        for (int rr = 0; rr < 2; ++rr) { const int m = m0 + rr; const int p0 = POS[m * 2], p1 = POS[m * 2 + 1];
#pragma unroll
            for (int j = 0; j < 4; ++j) { const size_t c = 8 * F.lane + 512 * j;
                x[rr][j] = *(const u32x4*)(X1B + (size_t)m * 2048 + c); a[rr][j] = *(const u32x2*)(YS + (size_t)p0 * 2048 + c); bq[rr][j] = *(const u32x2*)(YS + (size_t)p1 * 2048 + c); } }
#pragma unroll
        for (int rr = 0; rr < 2; ++rr) { const int m = m0 + rr; float v[4][8]; float ss = 0.f;
#pragma unroll
            for (int j = 0; j < 4; ++j) { float xa[8], ya[8], yb[8]; unpack8(x[rr][j], xa); unpack8_fp8(a[rr][j], ya); unpack8_fp8(bq[rr][j], yb);
#pragma unroll
                for (int c = 0; c < 8; ++c) { v[j][c] = xa[c] + (ya[c] + yb[c]) * (1.0f / 64.0f); ss += v[j][c] * v[j][c]; } }
            ss = wave_sum(ss); const float r = rsqrtf(ss * (1.0f / 2048.0f) + EPS);
#pragma unroll
            for (int j = 0; j < 4; ++j) { const size_t c = 8 * F.lane + 512 * j; const f32x4 g0 = gv[j][0], g1 = gv[j][1];
                *(f32x4*)(OUT + (size_t)m * 2048 + c) = (f32x4){v[j][0] * r * g0.x, v[j][1] * r * g0.y, v[j][2] * r * g0.z, v[j][3] * r * g0.w};
                *(f32x4*)(OUT + (size_t)m * 2048 + c + 4) = (f32x4){v[j][4] * r * g1.x, v[j][5] * r * g1.y, v[j][6] * r * g1.z, v[j][7] * r * g1.w}; } }
    }
}
constexpr int NPHASE = 20;
struct Args { const float* in[30]; float* out; unsigned char* ws; int ph_lo, ph_hi; };

__device__ __forceinline__ bool fresh_lane(Frame& F) { int l = (int)__builtin_amdgcn_mbcnt_hi(~0u, __builtin_amdgcn_mbcnt_lo(~0u, 0u)); asm volatile("" : "+v"(l)); F.lane = l; F.tid = (F.wave << 6) | l; return true; }
__global__ void __launch_bounds__(512, 2) mk_fwd(Args args) {
    extern __shared__ __attribute__((aligned(16))) unsigned char lds_raw[];
    Frame F;
    F.lds = (LAS unsigned char*)lds_raw; F.lds_g = lds_raw;
    F.MISC = (volatile LAS unsigned*)(F.lds + MISC_OFF);
    F.tid = threadIdx.x; F.lane = F.tid & 63; F.wave = __builtin_amdgcn_readfirstlane(F.tid >> 6);
    F.G = gridDim.x; F.bid = blockIdx.x; F.gw = F.bid * 8 + F.wave; F.NGW = F.G * 8;
    F.ws = args.ws; F.dout = (unsigned char*)args.out; F.ctl = (unsigned*)(args.ws + WS_CTL);
    const float* const* in = args.in;
    for (int u = F.tid; u < (LDS_BYTES - RING_BYTES) / 4; u += 512) ((LAS unsigned*)(F.lds + RING_BYTES))[u] = 0u;
    __syncthreads();
    const int lo = args.ph_lo, hi = args.ph_hi;
    const bool fused = (hi - lo) > 1;
    XcdBarrier bar; bar.bar = F.ctl + CW_BAR; bar.x = 0; bar.st = nullptr;
    if (fused) bar = xcd_barrier_post(F.ctl + CW_BAR, F.MISC + 8, F.tid);
#ifndef ONLY_PHASE
#define ONLY_PHASE -1
#endif
#define IN(k) ((ONLY_PHASE < 0 || ONLY_PHASE == (k)) && lo <= (k) && (k) < hi && fresh_lane(F))
#ifndef DUP_MASK
#define DUP_MASK 0
#endif
#define DUP_BEGIN(k) _Pragma("unroll") for (int rep_ = 0; rep_ < 1 + ((DUP_MASK >> (k)) & 1); ++rep_) { if (rep_) { xcd_barrier(bar, F.tid); fresh_lane(F); }
#define DUP_END }
#define SEAM(k) do { if ((ONLY_PHASE < 0 || ONLY_PHASE == (k) + 1) && lo <= (k) + 1 && (k) + 1 < hi) xcd_barrier(bar, F.tid); } while (0)
    const int G = F.G, c = F.bid;
    bf16_t* const HBF = (bf16_t*)(F.dout + DO_HBF);
    bf16_t* const WINT = (bf16_t*)(F.ws + WS_WINT);
    const bf16_t* const HBF8 = (const bf16_t*)(F.ws + WS_HBF8);
    const bf16_t* const WG8 = (const bf16_t*)(WINT + (size_t)11264 * 2048);

    if (IN(0)) { DUP_BEGIN(0) p0_prologue(F, in); DUP_END SEAM(0); }

    if (IN(1)) { DUP_BEGIN(1)
        if (F.bid >= 16 && F.bid < 24) ml0_seq(F, in, F.bid - 16);
        { pg8::SchedPA S{HBF, WINT, G, c};
          pg8::EpiPA E{(bf16_t*)(F.ws + WS_MQK), (bf16_t*)(F.ws + WS_MLO), (bf16_t*)(F.ws + WS_XQ), (bf16_t*)(F.ws + WS_VC), 1.0f};
          pg8::gemm_phase(F.lds, 2048, 2048, 2048, S, E, F.tid); }
        { pg8::SchedPA8 S{HBF8, (const bf16_t*)(WINT + (size_t)8192 * 2048), G, c};
          pg8::EpiPA E{(bf16_t*)(F.ws + WS_MQK), (bf16_t*)(F.ws + WS_MLO), (bf16_t*)(F.ws + WS_XQ), (bf16_t*)(F.ws + WS_VC), 1.0f / 32.0f};
          pg8::gemm_phase<pg8::EpiPA, pg8::SchedPA8, true>(F.lds, 1024, 1024, 1024, S, E, F.tid); }
        DUP_END SEAM(1);
    }
    if (IN(2)) { DUP_BEGIN(2)
        if (G <= 16 || c < 16) { pg8::SchedMem S{(const bf16_t*)(F.ws + WS_MEMN), (const bf16_t*)(F.ws + WS_WMEMT), G, c};
            pg8::EpiMem E{(bf16_t*)(F.ws + WS_MK), (bf16_t*)(F.ws + WS_MVT)};
            pg8::gemm_phase(F.lds, 2048, 2048, 2048, S, E, F.tid); }
        if (G <= 16 || c >= 16) { const int first = G > 16 ? (c - 16) * 8 + F.wave : F.gw, nstep = G > 16 ? (G - 16) * 8 : F.NGW; ml1_conv(F, in, first, nstep); }
        DUP_END SEAM(2);
    }
    if (IN(3)) { DUP_BEGIN(3)
#ifndef SUB
#define SUB 7
#endif
        if (SUB & 1) { pg8::SchedHG S{(const bf16_t*)(F.ws + WS_Q), (const bf16_t*)(F.ws + WS_KW), (size_t)TT * 256, 65536, (size_t)TT * 256, 65536, G, c};
          pg8::EpiW E{(bf16_t*)(F.ws + WS_WQ), (const float*)(F.ws + WS_SCRS)};
          pg8::gemm_phase(F.lds, 256, 256, 256, S, E, F.tid); }
        if (SUB & 2) { pg8::SchedHG S{(const bf16_t*)(F.ws + WS_VC), (const bf16_t*)(F.ws + WS_KWT), (size_t)128 * 256 * 512, (size_t)256 * 512, (size_t)128 * 65536, 65536, G, c};
          pg8::EpiB16Tile E{(bf16_t*)(F.ws + WS_U), 65536, 0, (size_t)128 * 65536, 256, 1.0f};
          pg8::gemm_phase(F.lds, 512, 256, 256, S, E, F.tid); }
        if (SUB & 4) { pg8::SchedXA S{(const bf16_t*)(F.ws + WS_XQ), (const bf16_t*)(F.ws + WS_MK), G, c};
          pg8::EpiXSoft E{(bf16_t*)(F.ws + WS_XP2), (LAS float*)(F.lds + pg8::EPI_TBL_OFF)};
          pg8::gemm_phase(F.lds, 256, 256, 256, S, E, F.tid); }
        if (F.bid < 8) nscan_seq(F, F.bid);
        DUP_END SEAM(3);
    }
    if (IN(4)) { DUP_BEGIN(4) cscan(F); denpass(F); DUP_END SEAM(4); }
    if (IN(5)) { DUP_BEGIN(5)
        { pg8::SchedHG S{(const bf16_t*)(F.ws + WS_WQ), (const bf16_t*)(F.ws + WS_VC), (size_t)TT * 512, (size_t)256 * 512, (size_t)128 * 256 * 512, (size_t)256 * 512, G, c};
          pg8::EpiHNorm E{(bf16_t*)(F.dout + DO_HR), (const float*)(F.ws + WS_HDEN), (const bf16_t*)(F.ws + WS_MLO), in[13], (LAS float*)(F.lds + pg8::EPI_TBL_OFF)};
          pg8::gemm_phase(F.lds, 512, 512, 512, S, E, F.tid); }
        { pg8::SchedXA S{(const bf16_t*)(F.ws + WS_XP2), (const bf16_t*)(F.ws + WS_MVT), G, c};
          pg8::EpiXA E{(bf16_t*)(F.dout + DO_XA)};
          pg8::gemm_phase(F.lds, 256, 256, 256, S, E, F.tid); }
        DUP_END SEAM(5);
    }
    if (IN(6)) { DUP_BEGIN(6)
        pg8::SchedDense S{HBF, WINT, 2048, 2048, 128, 24, G, c};
        pg8::EpiPB E{(bf16_t*)(F.ws + WS_DQ), (bf16_t*)(F.ws + WS_DK), (bf16_t*)(F.ws + WS_DV)};
        pg8::gemm_phase(F.lds, 2048, 2048, 2048, S, E, F.tid);
        DUP_END SEAM(6);
    }
    if (IN(7)) { DUP_BEGIN(7) normmax(F); DUP_END SEAM(7); }
    if (IN(8)) { DUP_BEGIN(8) attn_phase(F, rep_); DUP_END SEAM(8); }
#ifndef SLEEP_US
#define SLEEP_US 0
#endif
    if (IN(9)) { if (SLEEP_US) { const unsigned long long t0_ = __builtin_amdgcn_s_memrealtime(); while (__builtin_amdgcn_s_memrealtime() - t0_ < (unsigned long long)SLEEP_US * 100ull) __builtin_amdgcn_s_sleep(127); }
        DUP_BEGIN(9) dacombine(F, in, (const bf16_t*)(F.ws + WS_O), (bf16_t*)(F.ws + WS_DA)); if (P9DUP & 1) dacombine(F, in, (const bf16_t*)in[0], (bf16_t*)(F.ws + WS_DV)); expert_convert(F, in, 1);
        { pg8::SchedDense S{HBF8, WG8, 1024, 1024, 128, 8, G, c};
          pg8::EpiGate E{(bf16_t*)(F.ws + WS_GT0), in[19], 1.0f / 32.0f};
          pg8::gemm_phase<pg8::EpiGate, pg8::SchedDense, true>(F.lds, 1024, 1024, 1024, S, E, F.tid); }
        DUP_END SEAM(9); }
    if (IN(11)) { DUP_BEGIN(11)
        { pg8::SchedDense S{(const bf16_t*)(F.ws + WS_DA), (const bf16_t*)(F.ws + WS_WBDT), 1024, 1024, 128, 8, G, c};
          pg8::EpiBranch<true> E{(const bf16_t*)(F.ws + WS_GT0), nullptr, (bf16_t*)(F.dout + DO_MERGED), 1.0f / 32.0f};
          pg8::gemm_phase<pg8::EpiBranch<true>, pg8::SchedDense, true>(F.lds, 1024, 1024, 1024, S, E, F.tid); }
        { pg8::SchedDense S{HBF8, WG8 + (size_t)2048 * 1024, 1024, 1024, 128, 8, G, c};
          pg8::EpiGate E{(bf16_t*)(F.ws + WS_GT1), in[19] + 2048, 1.0f / 32.0f};
          pg8::gemm_phase<pg8::EpiGate, pg8::SchedDense, true>(F.lds, 1024, 1024, 1024, S, E, F.tid); }
        DUP_END if (!fused) SEAM(11);
    }
    if (IN(12)) { DUP_BEGIN(12)
        { pg8::SchedDense S{(const bf16_t*)(F.dout + DO_HR), (const bf16_t*)(F.ws + WS_WBMT), 1024, 1024, 128, 8, G, c};
          pg8::EpiBranch<false> E{(const bf16_t*)(F.ws + WS_GT1), (const bf16_t*)(F.dout + DO_MERGED), (bf16_t*)(F.ws + WS_MERGEDB), 1.0f};
          pg8::gemm_phase(F.lds, 1024, 1024, 1024, S, E, F.tid); }
        { pg8::SchedDense S{HBF8, WG8 + (size_t)4096 * 1024, 1024, 1024, 128, 8, G, c};
          pg8::EpiGate E{(bf16_t*)(F.ws + WS_GT2), in[19] + 4096, 1.0f / 32.0f};
          pg8::gemm_phase<pg8::EpiGate, pg8::SchedDense, true>(F.lds, 1024, 1024, 1024, S, E, F.tid); }
        DUP_END if (!fused) SEAM(12);
    }
    if (IN(13)) { DUP_BEGIN(13)
        pg8::SchedDense S{(const bf16_t*)(F.dout + DO_XA), (const bf16_t*)(F.ws + WS_WBCT), 1024, 1024, 128, 8, G, c};
        pg8::EpiBranch<false> E{(const bf16_t*)(F.ws + WS_GT2), (const bf16_t*)(F.ws + WS_MERGEDB), (bf16_t*)(F.dout + DO_MERGED), 1.0f};
        pg8::gemm_phase(F.lds, 1024, 1024, 1024, S, E, F.tid);
        DUP_END SEAM(13);
    }
    if (IN(14)) { DUP_BEGIN(14)
        pg8::SchedDense S{(const bf16_t*)(F.dout + DO_MERGED), (const bf16_t*)(F.ws + WS_WOUTT), 2048, 2048, 128, 8, G, c};
        pg8::EpiOut E{in[0], (bf16_t*)(F.ws + WS_X1B), (float*)(F.ws + WS_RSS)};
        pg8::gemm_phase(F.lds, 2048, 2048, 2048, S, E, F.tid);
        DUP_END SEAM(14);
    }
    if (IN(15)) { DUP_BEGIN(15)
        pg8::SchedDense S{(const bf16_t*)(F.ws + WS_X1B), (const bf16_t*)(F.ws + WS_WRT), 2048, 2048, 128, 1, G, c};
        pg8::EpiF32Tile E{(float*)(F.ws + WS_LG), 65536, 0, 0, 256};
        pg8::gemm_phase(F.lds, 2048, 2048, 2048, S, E, F.tid);
        VM_WAIT(); __syncthreads();
        for (int L = c; L < 128; L += G) { int pm, pn; pg8::tile_order(L, 128, 1, pm, pn); topk_pass(F, in, pm * 256, pm * 256 + 256); }
        DUP_END SEAM(15);
    }
    if (IN(16)) { DUP_BEGIN(16) gather_pass(F, in); DUP_END SEAM(16); }
    if (IN(17)) { DUP_BEGIN(17)
        const int nrt = (int)__builtin_amdgcn_readfirstlane(F.ctl[CW_NRT]);
        LAS int* ue = (LAS int*)(F.lds + RING_BYTES + 3328);
        if (F.tid < 16) { const int L = F.tid * G + c; ue[F.tid] = (L < nrt * 6) ? ((const int*)(F.ws + WS_TILEE))[L / 6] : 0; }
        __syncthreads();
        pg8::SchedMoE S{(const bf16_t*)(F.ws + WS_XSORT), (const bf16_t*)(F.ws + WS_WGU), ue, nrt, 6, 1024, (size_t)GU_N * 1024, (size_t)256 * 1024, G, c};
        pg8::EpiGU E{F.ws + WS_HD};
        pg8::gemm_phase<pg8::EpiGU, pg8::SchedMoE, true>(F.lds, 1024, 1024, 1024, S, E, F.tid);
        DUP_END SEAM(17);
    }
    if (IN(18)) { DUP_BEGIN(18)
        const int nrt = (int)__builtin_amdgcn_readfirstlane(F.ctl[CW_NRT]);
        LAS int* ue = (LAS int*)(F.lds + RING_BYTES + 3328);
        if (F.tid < 16) { const int L = F.tid * G + c; ue[F.tid] = (L < nrt * 8) ? ((const int*)(F.ws + WS_TILEE))[L / 8] : 0; }
        __syncthreads();
        pg8::SchedMoE S{(const bf16_t*)(F.ws + WS_HD), (const bf16_t*)(F.ws + WS_WD), ue, nrt, 8, DEXP_P / 2, (size_t)2048 * (DEXP_P / 2), (size_t)256 * (DEXP_P / 2), G, c};
        pg8::EpiDown E{F.ws + WS_YS, (const float*)(F.ws + WS_WROW)};
        pg8::gemm_phase<pg8::EpiDown, pg8::SchedMoE, true>(F.lds, DEXP_P / 2, DEXP_P / 2, DEXP_P / 2, S, E, F.tid);
        DUP_END SEAM(18);
    }
    if (IN(19)) { DUP_BEGIN(19) final_pass(F, in); DUP_END }
#ifdef TAIL_PROBE
    if (fused) { xcd_barrier(bar, F.tid); fresh_lane(F);
        if (TAIL_PROBE == 1) dacombine(F, in, (const bf16_t*)(F.ws + WS_O), (bf16_t*)(F.ws + WS_DA));
        if (TAIL_PROBE == 2) expert_convert(F, in, 1);
        if (TAIL_PROBE == 4) ml1_conv(F, in, F.gw, F.NGW);
        if (TAIL_PROBE == 5) cscan(F);
        if (TAIL_PROBE == 6) denpass(F);
        if (TAIL_PROBE == 7) normmax(F);
        if (TAIL_PROBE == 10) p0_prologue(F, in, 1);
    }
#endif
#undef IN
#undef SEAM
}

#ifndef MK_FUSED
#define MK_FUSED 1
#endif
extern "C" void kernel_launch(void* const* d_in, const int* in_sizes, int n_in, void* d_out, int out_size, void* d_ws, size_t ws_size, hipStream_t stream) {
    static int grid = 0;
    if (grid == 0) {
        if (n_in != 30 || out_size != TT * DM || ws_size < WS_END) { fprintf(stderr, "kernel_launch: unexpected shapes (n_in %d out %d ws %zu)\n", n_in, out_size, ws_size); grid = -1; return; }
        int dev = 0, cus = 0, per_cu = 0;
        if (hipGetDevice(&dev) != hipSuccess || hipDeviceGetAttribute(&cus, hipDeviceAttributeMultiprocessorCount, dev) != hipSuccess) { grid = -1; return; }
        if (hipFuncSetAttribute((const void*)mk_fwd, hipFuncAttributeMaxDynamicSharedMemorySize, LDS_BYTES) != hipSuccess) { fprintf(stderr, "kernel_launch: hipFuncSetAttribute failed\n"); grid = -1; return; }
        if (hipOccupancyMaxActiveBlocksPerMultiprocessor(&per_cu, (const void*)mk_fwd, 512, LDS_BYTES) != hipSuccess || per_cu < 1) fprintf(stderr, "kernel_launch: occupancy query says %d\n", per_cu);
        (void)hipGetLastError();
        grid = cus;
    }
    if (grid < 0) return;
    (void)hipMemsetAsync((char*)d_ws + WS_CTL, 0, CTL_ZERO_BYTES, stream);
    Args a{};
    for (int i = 0; i < 30; ++i) a.in[i] = (const float*)d_in[i];
    a.out = (float*)d_out; a.ws = (unsigned char*)d_ws;
#if MK_FUSED
    a.ph_lo = 0; a.ph_hi = NPHASE;
    hipLaunchKernelGGL(mk_fwd, dim3(grid), dim3(512), LDS_BYTES, stream, a);
#else
#ifndef PROBE_DUP
#define PROBE_DUP 0u
#endif
    for (int p = 0; p < NPHASE; ++p) { a.ph_lo = p; a.ph_hi = p + 1; hipLaunchKernelGGL(mk_fwd, dim3(grid), dim3(512), LDS_BYTES, stream, a);
        if ((PROBE_DUP >> p) & 1u) {
            if (p == 8) (void)hipMemsetAsync((char*)d_ws + WS_CTL + CW_AHEAD * 4, 0, 256, stream);
            hipLaunchKernelGGL(mk_fwd, dim3(grid), dim3(512), LDS_BYTES, stream, a); } }
#endif
}
```

```cpp
#include <hip/hip_runtime.h>
#include <hip/hip_bf16.h>
#include <cstdio>
#include <cstdint>

#define LAS __attribute__((address_space(3)))
#define GAS __attribute__((address_space(1)))
typedef unsigned short bf16_t;
typedef short bf16x8 __attribute__((ext_vector_type(8)));
typedef short s16x4 __attribute__((ext_vector_type(4)));
typedef float f32x2 __attribute__((ext_vector_type(2)));
typedef float f32x4 __attribute__((ext_vector_type(4)));
typedef float f32x16 __attribute__((ext_vector_type(16)));
typedef unsigned u32x2 __attribute__((ext_vector_type(2)));
typedef unsigned u32x4 __attribute__((ext_vector_type(4)));

constexpr int NB = 2, SEQ = 16384, TT = NB * SEQ, DM = 2048, MEML = 256;
constexpr int DIN = 17416;
constexpr float EPS = 1e-6f;
constexpr int NEXP = 32, DEXP = 704, DEXP_P = 768, GU_N = 1536;
constexpr int MAX_RT = 288;

constexpr size_t MiB = 1u << 20;
constexpr size_t WS_CTL = 0, CTL_ZERO_BYTES = 1 * MiB;
constexpr size_t WS_MLG = 1 * MiB;
constexpr size_t WS_SCKW = 2 * MiB, WS_SCRS = 2 * MiB + 512 * 1024, WS_SCIT = 3 * MiB, WS_SCED = 3 * MiB + 512 * 1024;
constexpr size_t WS_HDEN = 4 * MiB;
constexpr size_t WS_KN = 13 * MiB;
constexpr size_t WS_NP = 5 * MiB + 512 * 1024;
constexpr size_t WS_DEC = 6 * MiB;
constexpr size_t WS_MEMN = 7 * MiB;
constexpr size_t WS_MK = 9 * MiB;
constexpr size_t WS_MVT = 10 * MiB;
constexpr size_t WS_TOKE = 11 * MiB;
constexpr size_t WS_TOKW = 11 * MiB + 256 * 1024;
constexpr size_t WS_POS = 11 * MiB + 512 * 1024;
constexpr size_t WS_WROW = 12 * MiB;
constexpr size_t WS_TILEE = 12 * MiB + 512 * 1024;
constexpr size_t WS_RT = 12 * MiB + 768 * 1024;
constexpr size_t WS_WINT = 16 * MiB;
constexpr size_t WS_WMEMT = 84 * MiB;
constexpr size_t WS_WBDT = 92 * MiB;
constexpr size_t WS_WBMT = 100 * MiB;
constexpr size_t WS_WBCT = 104 * MiB;
constexpr size_t WS_WOUTT = 108 * MiB;
constexpr size_t WS_WRT = 116 * MiB;
constexpr size_t WS_MQK = 120 * MiB;
constexpr size_t WS_U = 120 * MiB;
constexpr size_t WS_XQ = 312 * MiB;
constexpr size_t WS_XP = 312 * MiB;
constexpr size_t WS_VC = 376 * MiB;
constexpr size_t WS_Q = 504 * MiB;
constexpr size_t WS_WQ = 568 * MiB;
constexpr size_t WS_KW = 696 * MiB;
constexpr size_t WS_KWT = 760 * MiB;
constexpr size_t WS_XP2 = 824 * MiB;
constexpr size_t WS_XS = 824 * MiB;
constexpr size_t WS_MLO = 248 * MiB;
constexpr size_t WS_DQ = 120 * MiB, WS_DK = 248 * MiB, WS_DV = 376 * MiB;
constexpr size_t WS_O = 504 * MiB;
constexpr size_t WS_DA = 760 * MiB;
constexpr size_t WS_WGU = 120 * MiB;
constexpr size_t WS_WD = 216 * MiB;
constexpr size_t WS_HBF8 = 952 * MiB;
constexpr size_t WS_GT0 = 408 * MiB, WS_GT1 = 536 * MiB;
constexpr size_t DO_MERGED = 0;
constexpr size_t WS_X1B = 264 * MiB;
constexpr size_t WS_RSS = 1016 * MiB;
constexpr size_t WS_LG = 536 * MiB;
constexpr size_t WS_XSORT = 568 * MiB;
constexpr size_t WS_HD = 856 * MiB;
constexpr size_t WS_YS = 568 * MiB;
constexpr size_t WS_END = 1024 * MiB;
constexpr size_t DO_HBF = 0, DO_HR = 128 * MiB, DO_XA = 192 * MiB;

constexpr int CW_BAR = 4096;
constexpr int CW_AHEAD = 8192;
constexpr int CW_QKMAX = 8256;
constexpr int CW_KMX = 8272;
constexpr int CW_QB2 = 16384;
constexpr int CW_CH = 40960;
constexpr int CW_KT = 32768;
constexpr int KMX_LDS = 131072 + 3072;
constexpr int CW_ND = 16384 + 2048;
constexpr int CW_ECNT = 8320;
constexpr int CW_ECUR = 8384;
constexpr int CW_LAM = 8448;
constexpr int CW_NRT = 8449;

constexpr int RING_BYTES = 131072;
constexpr int MISC_OFF = RING_BYTES + 320;
constexpr int LDS_BYTES = 147456;

#define LDS_WAIT() asm volatile("s_waitcnt lgkmcnt(0)" ::: "memory")
#define VM_WAIT() asm volatile("s_waitcnt vmcnt(0)" ::: "memory")
#define RLX_AGENT __ATOMIC_RELAXED, __HIP_MEMORY_SCOPE_AGENT

__device__ __forceinline__ unsigned cvtpk(float lo, float hi) { unsigned r; asm volatile("s_nop 0\n\tv_cvt_pk_bf16_f32 %0, %1, %2" : "=v"(r) : "v"(lo), "v"(hi)); return r; }
__device__ __forceinline__ unsigned pk4_fp8(float a, float b, float c, float d) { int w = 0; w = __builtin_amdgcn_cvt_pk_fp8_f32(a, b, w, false); w = __builtin_amdgcn_cvt_pk_fp8_f32(c, d, w, true); return (unsigned)w; }
__device__ __forceinline__ float bf2f(unsigned short b) { return __uint_as_float(((unsigned)b) << 16); }
__device__ __forceinline__ float bflo(unsigned w) { return __uint_as_float(w << 16); }
__device__ __forceinline__ float bfhi(unsigned w) { return __uint_as_float(w & 0xffff0000u); }
#define DPP_F(x, ctrl) __builtin_bit_cast(float, __builtin_amdgcn_update_dpp(0, __builtin_bit_cast(int, (x)), (ctrl), 0xF, 0xF, true))
__device__ __forceinline__ float wave_sum(float v) {
    v += DPP_F(v, 0xB1); v += DPP_F(v, 0x4E); v += DPP_F(v, 0x124); v += DPP_F(v, 0x128);
    const int iv = __builtin_bit_cast(int, v);
    return (__builtin_bit_cast(float, __builtin_amdgcn_readlane(iv, 0)) + __builtin_bit_cast(float, __builtin_amdgcn_readlane(iv, 16))) + (__builtin_bit_cast(float, __builtin_amdgcn_readlane(iv, 32)) + __builtin_bit_cast(float, __builtin_amdgcn_readlane(iv, 48)));
}
__device__ __forceinline__ float wave_max(float v) {
    v = fmaxf(v, DPP_F(v, 0xB1)); v = fmaxf(v, DPP_F(v, 0x4E)); v = fmaxf(v, DPP_F(v, 0x124)); v = fmaxf(v, DPP_F(v, 0x128));
    const int iv = __builtin_bit_cast(int, v);
    return fmaxf(fmaxf(__builtin_bit_cast(float, __builtin_amdgcn_readlane(iv, 0)), __builtin_bit_cast(float, __builtin_amdgcn_readlane(iv, 16))), fmaxf(__builtin_bit_cast(float, __builtin_amdgcn_readlane(iv, 32)), __builtin_bit_cast(float, __builtin_amdgcn_readlane(iv, 48))));
}
__device__ __forceinline__ float xsum16(float x) { auto rr = __builtin_amdgcn_permlane16_swap(__float_as_uint(x), __float_as_uint(x), false, false); return __uint_as_float(rr[0]) + __uint_as_float(rr[1]); }
__device__ __forceinline__ float xsum32(float x) { auto rr = __builtin_amdgcn_permlane32_swap(__float_as_uint(x), __float_as_uint(x), false, false); return __uint_as_float(rr[0]) + __uint_as_float(rr[1]); }
__device__ __forceinline__ float xmax16(float x) { auto rr = __builtin_amdgcn_permlane16_swap(__float_as_uint(x), __float_as_uint(x), false, false); return fmaxf(__uint_as_float(rr[0]), __uint_as_float(rr[1])); }
__device__ __forceinline__ float xmax32(float x) { auto rr = __builtin_amdgcn_permlane32_swap(__float_as_uint(x), __float_as_uint(x), false, false); return fmaxf(__uint_as_float(rr[0]), __uint_as_float(rr[1])); }
__device__ __forceinline__ float sigmoidf_(float x) { return __builtin_amdgcn_rcpf(1.0f + __expf(-x)); }

#define XB_TMO      128
#define XB_XCNT(j)  (256  + 64 * (j))
#define XB_XSUB(j)  (1280 + 64 * (j))
#define XB_XGEN(j)  (2304 + 64 * (j))
#define XB_TOP      3328
#define XB_TOPGEN   3392
#define XCD_BAR_WORDS 3456
#define XB_SPIN_CAP (1u << 18)

__device__ __forceinline__ unsigned xb_ld(unsigned* p)              { return __hip_atomic_load(p, __ATOMIC_RELAXED, __HIP_MEMORY_SCOPE_AGENT); }
__device__ __forceinline__ unsigned xb_add(unsigned* p, unsigned v) { return __hip_atomic_fetch_add(p, v, __ATOMIC_RELAXED, __HIP_MEMORY_SCOPE_AGENT); }
__device__ __forceinline__ unsigned xb_xcc_id() { return (unsigned)__builtin_amdgcn_s_getreg((3 << 11) | 20) & 0xFu; }
#define XB_SPIN(cond, bar) do { unsigned _sp = 0; while (cond) { __builtin_amdgcn_s_sleep(1); \
    if ((++_sp & 255u) == 0u) { if (xb_ld(&(bar)[XB_TMO])) break; if (_sp > XB_SPIN_CAP) { atomicAdd(&(bar)[XB_TMO], 1u); break; } } } } while (0)

struct XcdBarrier { unsigned* bar; unsigned x; volatile LAS unsigned* st; };

__device__ __forceinline__ XcdBarrier xcd_barrier_post(unsigned* bar, volatile LAS unsigned* st, const int tid) {
    XcdBarrier b; b.bar = bar; b.x = xb_xcc_id(); b.st = st;
    if (tid == 0) (void)xb_add(&bar[XB_XCNT(b.x)], 1u);
    return b;
}
__device__ __forceinline__ void xcd_barrier_complete(unsigned* bar, unsigned x, unsigned& nloc, unsigned& nx) {
    const unsigned G = gridDim.x * gridDim.y * gridDim.z;
    unsigned sum, cnt, mine, sp = 0u;
    for (;;) {
        sum = 0u; cnt = 0u; mine = 0u;
#pragma unroll
        for (unsigned j = 0; j < 16; ++j) { const unsigned c = xb_ld(&bar[XB_XCNT(j)]); sum += c; cnt += (c > 0u) ? 1u : 0u; mine = (j == x) ? c : mine; }
        if (sum == G) break;
        __builtin_amdgcn_s_sleep(1);
        if ((++sp & 255u) == 0u) { if (xb_ld(&bar[XB_TMO])) break; if (sp > XB_SPIN_CAP) { atomicAdd(&bar[XB_TMO], 1u); break; } }
    }
    nloc = mine > 0u ? mine : 1u; nx = cnt > 0u ? cnt : 1u;
}
__device__ __forceinline__ void xcd_barrier(const XcdBarrier& b, const int tid) {
    asm volatile("s_waitcnt vmcnt(0)" ::: "memory");
    __syncthreads();
    if (tid == 0) {
        unsigned* bar = b.bar;
        __builtin_amdgcn_s_waitcnt(0);
        unsigned nloc = b.st[0], nx = b.st[1];
        if (nloc == 0u) { xcd_barrier_complete(bar, b.x, nloc, nx); b.st[0] = nloc; b.st[1] = nx; }
        const unsigned old = xb_add(&bar[XB_XSUB(b.x)], 1u);
        const unsigned gen = old / nloc;
        if (old + 1u == (gen + 1u) * nloc) {
            __builtin_amdgcn_fence(__ATOMIC_RELEASE, "agent");
            asm volatile("s_waitcnt vmcnt(0)" ::: "memory");
            const unsigned og = xb_add(&bar[XB_TOP], 1u);
            const unsigned tg = og / nx;
            if (og + 1u == (tg + 1u) * nx) xb_add(&bar[XB_TOPGEN], 1u);
            else XB_SPIN(xb_ld(&bar[XB_TOPGEN]) == tg, bar);
            __builtin_amdgcn_fence(__ATOMIC_ACQUIRE, "agent");
            xb_add(&bar[XB_XGEN(b.x)], 1u);
            asm volatile("s_waitcnt vmcnt(0)" ::: "memory");
        } else {
            XB_SPIN(xb_ld(&bar[XB_XGEN(b.x)]) == gen, bar);
            __builtin_amdgcn_fence(__ATOMIC_ACQUIRE, "agent");
            asm volatile("s_waitcnt vmcnt(0)" ::: "memory");
        }
    }
    __syncthreads();
}

namespace pg8 {
constexpr int BM = 256, BK = 64, HALF = 128, HTB = HALF * BK * 2, STAGE_BYTES = 8 * HTB, NXCD = 8, WGM = 8;
__host__ __device__ __forceinline__ int lds_byte(int r, int c) { const int st = (r >> 4) * 2 + (c >> 5), rr = r & 15, cc = c & 31, ob = rr * 64 + cc * 2; return st * 1024 + (ob ^ (((ob >> 9) & 1) << 5)); }
__host__ __device__ __forceinline__ void stage_rc(int b, int& R, int& C) { const int st = b / 1024, sb = b % 1024, swz = sb ^ (((sb >> 9) & 1) << 5); R = (st >> 1) * 16 + swz / 64; C = (st & 1) * 32 + (swz % 64) / 2; }
__host__ __device__ __forceinline__ int perm32(int rho) { const int n = rho >> 4, i = rho & 15; return 8 * (i >> 2) + 4 * n + (i & 3); }

struct Unit { const bf16_t* A; const bf16_t* B; int pm, pn, aux; };

__device__ __forceinline__ void tile_order(int L, int nM, int nN, int& pm, int& pn) {
    const int nwg = nM * nN; int wgid = L;
    { const int q = nwg / NXCD, r = nwg % NXCD, xcd = wgid % NXCD, off = wgid / NXCD; wgid = (xcd < r ? xcd * (q + 1) : r * (q + 1) + (xcd - r) * q) + off; }
    const int nig = WGM * nN, gid = wgid / nig, fm = gid * WGM, gsz = (nM - fm) < WGM ? (nM - fm) : WGM;
    pm = fm + ((wgid % nig) % gsz); pn = (wgid % nig) / gsz;
}

typedef int i32x4 __attribute__((ext_vector_type(4)));
typedef int i32x8 __attribute__((ext_vector_type(8)));
__device__ __forceinline__ i32x8 cat8(const bf16x8 a, const bf16x8 b) { const i32x4 x = __builtin_bit_cast(i32x4, a), y = __builtin_bit_cast(i32x4, b); return __builtin_shufflevector(x, y, 0, 1, 2, 3, 4, 5, 6, 7); }
template <class Epi, class Sched, bool F8 = false>
__device__ __forceinline__ void gemm_phase(LAS unsigned char* lds, const int lda, const int ldb, const int K, const Sched& S, const Epi& E, const int tid) {
    const int wid = __builtin_amdgcn_readfirstlane(tid >> 6), lane = tid & 63, wr = wid >> 2, wc = wid & 3, fr = lane & 15, fq = lane >> 4;
    const int nt = K / BK;
    unsigned voffA[2], voffB[2];
#pragma unroll
    for (int i = 0; i < 2; ++i) { int R, C; stage_rc(tid * 16 + i * 8192, R, C); const int Rb = Epi::PERM ? ((R & ~31) + perm32(R & 31)) : R;
        voffA[i] = (unsigned)(R * lda + C) * 2u; voffB[i] = (unsigned)(Rb * ldb + C) * 2u; }
    const size_t kstep = (size_t)(BK * 2);
    const size_t hstepA = (size_t)HALF * lda * 2, hstepB = (size_t)HALF * ldb * 2;
    const unsigned ldsw = (unsigned)wid * 1024u;
    const int aoff = lds_byte(wr * 64 + fr, fq * 8), boff = lds_byte(wc * 32 + fr, fq * 8);
#define PG8_SA(b, h) (((b) * 2 + (h)) * HTB)
#define PG8_SB(b, h) ((4 + (b) * 2 + (h)) * HTB)
#define PG8_STAGE(bufoff, gbase, voff) do { _Pragma("unroll") for (int _i = 0; _i < 2; ++_i) \
        __builtin_amdgcn_global_load_lds((const unsigned*)((const char*)(gbase) + (voff)[_i]), (LAS unsigned*)(lds + (bufoff) + ldsw + _i * 8192), 16, 0, 0); } while (0)
#define PG8_LDA(dst, b, h) do { _Pragma("unroll") for (int m = 0; m < 4; ++m) { \
        if constexpr (F8) { const i32x4 lo_ = *(const LAS i32x4*)(lds + PG8_SA(b, h) + aoff + m * 2048), hi_ = *(const LAS i32x4*)(lds + PG8_SA(b, h) + aoff + m * 2048 + 1024); dst##8[m] = __builtin_shufflevector(lo_, hi_, 0, 1, 2, 3, 4, 5, 6, 7); } \
        else { _Pragma("unroll") for (int k = 0; k < 2; ++k) dst[m][k] = *(const LAS bf16x8*)(lds + PG8_SA(b, h) + aoff + m * 2048 + k * 1024); } } } while (0)
#define PG8_LDB(dst, b, h) do { _Pragma("unroll") for (int n = 0; n < 2; ++n) { \
        if constexpr (F8) { const i32x4 lo_ = *(const LAS i32x4*)(lds + PG8_SB(b, h) + boff + n * 2048), hi_ = *(const LAS i32x4*)(lds + PG8_SB(b, h) + boff + n * 2048 + 1024); dst##8[n] = __builtin_shufflevector(lo_, hi_, 0, 1, 2, 3, 4, 5, 6, 7); } \
        else { _Pragma("unroll") for (int k = 0; k < 2; ++k) dst[n][k] = *(const LAS bf16x8*)(lds + PG8_SB(b, h) + boff + n * 2048 + k * 1024); } } } while (0)
#define PG8_MMA(ai, bj, At, Bt) do { __builtin_amdgcn_s_setprio(1); _Pragma("unroll") for (int m = 0; m < 4; ++m) _Pragma("unroll") for (int n = 0; n < 2; ++n) { \
        if constexpr (F8) asm volatile("v_mfma_f32_16x16x128_f8f6f4 %0, %1, %2, %0" : "+v"(acc[ai][bj][m][n]) : "v"(Bt##8[n]), "v"(At##8[m])); \
        else { _Pragma("unroll") for (int k = 0; k < 2; ++k) acc[ai][bj][m][n] = __builtin_amdgcn_mfma_f32_16x16x32_bf16(Bt[n][k], At[m][k], acc[ai][bj][m][n], 0, 0, 0); } } \
        __builtin_amdgcn_s_setprio(0); } while (0)
#define PG8_WAIT_V(n) asm volatile("s_waitcnt vmcnt(" #n ")" ::: "memory")
#define PG8_WAIT_L(n) asm volatile("s_waitcnt lgkmcnt(" #n ")" ::: "memory")
#define PG8_BAR __builtin_amdgcn_s_barrier()
#define PG8_SCHED __builtin_amdgcn_sched_barrier(0)
    Unit cur, nxt; int ui = 0;
    if (!S.next(0, cur)) return;
    f32x4 acc[2][2][4][2];
#pragma unroll
    for (int a = 0; a < 2; ++a)
#pragma unroll
        for (int b = 0; b < 2; ++b)
#pragma unroll
            for (int m = 0; m < 4; ++m)
#pragma unroll
                for (int n = 0; n < 2; ++n) acc[a][b][m][n] = (f32x4){0.f, 0.f, 0.f, 0.f};
    bf16x8 At[4][2], B0[2][2], B1[2][2]; i32x8 At8[4], B08[2], B18[2];
    const char* cA = (const char*)cur.A; const char* cB = (const char*)cur.B;
    PG8_STAGE(PG8_SB(0, 0), cB, voffB); PG8_STAGE(PG8_SA(0, 0), cA, voffA); PG8_STAGE(PG8_SB(0, 1), cB + hstepB, voffB); PG8_STAGE(PG8_SA(0, 1), cA + hstepA, voffA);
    if (wr == 1) PG8_BAR;
    PG8_WAIT_V(4); PG8_BAR;
    PG8_STAGE(PG8_SB(1, 0), cB + kstep, voffB); PG8_STAGE(PG8_SA(1, 0), cA + kstep, voffA); PG8_STAGE(PG8_SB(1, 1), cB + hstepB + kstep, voffB);
    PG8_WAIT_V(6); PG8_BAR;
    for (;;) {
        const bool has_next = S.next(ui + 1, nxt);
        const char* nA = has_next ? (const char*)nxt.A : cA; const char* nB = has_next ? (const char*)nxt.B : cB;
#pragma nounroll
        for (int t = 0; t < nt; t += 2) {
            const bool last = (t == nt - 2);
            const char* a1 = cA + (size_t)(t + 1) * kstep;
            const char* a2 = last ? nA : cA + (size_t)(t + 2) * kstep; const char* b2 = last ? nB : cB + (size_t)(t + 2) * kstep;
            const char* a3 = a2 + kstep; const char* b3 = b2 + kstep;
            PG8_LDB(B0, 0, 0); PG8_SCHED; PG8_LDA(At, 0, 0); PG8_STAGE(PG8_SA(1, 1), a1 + hstepA, voffA);
            PG8_WAIT_L(8); PG8_BAR; PG8_WAIT_L(0); PG8_MMA(0, 0, At, B0); PG8_BAR; PG8_SCHED;
            PG8_LDB(B1, 0, 1); PG8_STAGE(PG8_SB(0, 0), b2, voffB);
            PG8_BAR; PG8_WAIT_L(0); PG8_MMA(0, 1, At, B1); PG8_BAR;
            PG8_LDA(At, 0, 1); PG8_STAGE(PG8_SA(0, 0), a2, voffA);
            PG8_BAR; PG8_WAIT_L(0); PG8_MMA(1, 0, At, B0); PG8_BAR; PG8_SCHED;
            PG8_STAGE(PG8_SB(0, 1), b2 + hstepB, voffB);
            PG8_WAIT_V(6); PG8_BAR; PG8_MMA(1, 1, At, B1); PG8_BAR;
            PG8_LDB(B0, 1, 0); PG8_SCHED; PG8_LDA(At, 1, 0); PG8_STAGE(PG8_SA(0, 1), a2 + hstepA, voffA);
            PG8_WAIT_L(8); PG8_BAR; PG8_WAIT_L(0); PG8_MMA(0, 0, At, B0); PG8_BAR; PG8_SCHED;
            PG8_LDB(B1, 1, 1); PG8_STAGE(PG8_SB(1, 0), b3, voffB);
            PG8_BAR; PG8_WAIT_L(0); PG8_MMA(0, 1, At, B1); PG8_BAR;
            PG8_LDA(At, 1, 1); PG8_STAGE(PG8_SA(1, 0), a3, voffA);
            PG8_BAR; PG8_WAIT_L(0); PG8_MMA(1, 0, At, B0); PG8_BAR; PG8_SCHED;
            PG8_STAGE(PG8_SB(1, 1), b3 + hstepB, voffB);
            PG8_WAIT_V(6); PG8_BAR; PG8_MMA(1, 1, At, B1); PG8_BAR;
        }
        if constexpr (F8) asm volatile("s_nop 15\n\ts_nop 15" ::: "memory");
        { int l_e = (int)__builtin_amdgcn_mbcnt_hi(~0u, __builtin_amdgcn_mbcnt_lo(~0u, 0u)); asm volatile("" : "+v"(l_e)); int fr_e = l_e & 15, fq_e = l_e >> 4;
          E(acc, cur, wr, wc, fr_e, fq_e); }
        if (!has_next) break;
#pragma unroll
        for (int a = 0; a < 2; ++a)
#pragma unroll
            for (int b = 0; b < 2; ++b)
#pragma unroll
                for (int m = 0; m < 4; ++m)
#pragma unroll
                    for (int n = 0; n < 2; ++n) acc[a][b][m][n] = (f32x4){0.f, 0.f, 0.f, 0.f};
        cur = nxt; cA = nA; cB = nB; ++ui;
    }
    PG8_WAIT_V(0);
    if (wr == 0) PG8_BAR;
    PG8_BAR;
#undef PG8_SA
#undef PG8_SB
#undef PG8_STAGE
#undef PG8_LDA
#undef PG8_LDB
#undef PG8_MMA
#undef PG8_WAIT_V
#undef PG8_WAIT_L
#undef PG8_BAR
#undef PG8_SCHED
}
}
namespace pg8 {
typedef f32x4 Acc[2][2][4][2];
__device__ __forceinline__ void st_bf16x8(bf16_t* p, f32x4 v0, f32x4 v1) {
    u32x4 w; w.x = cvtpk(v0[0], v0[1]); w.y = cvtpk(v0[2], v0[3]); w.z = cvtpk(v1[0], v1[1]); w.w = cvtpk(v1[2], v1[3]);
    *(u32x4*)p = w;
}
#define EPI_BF16_LOOP(...) \
    _Pragma("unroll") for (int ai = 0; ai < 2; ++ai) \
    _Pragma("unroll") for (int m = 0; m < 4; ++m) { int r = ai * 128 + wr * 64 + m * 16 + fr; asm volatile("" : "+v"(r)); \
    _Pragma("unroll") for (int bj = 0; bj < 2; ++bj) { f32x4 v0 = acc[ai][bj][m][0], v1 = acc[ai][bj][m][1]; const int colh = wc * 32 + 8 * fq; (void)colh; __VA_ARGS__ } }
#define EPI_F32_LOOP(...) \
    _Pragma("unroll") for (int ai = 0; ai < 2; ++ai) \
    _Pragma("unroll") for (int m = 0; m < 4; ++m) { int r = ai * 128 + wr * 64 + m * 16 + fr; asm volatile("" : "+v"(r)); \
    _Pragma("unroll") for (int bj = 0; bj < 2; ++bj) \
    _Pragma("unroll") for (int n = 0; n < 2; ++n) { f32x4 v = acc[ai][bj][m][n]; const int col = bj * 128 + wc * 32 + n * 16 + 4 * fq; (void)col; __VA_ARGS__ } }

struct EpiPA {
    static constexpr bool PERM = true;
    bf16_t *MQK, *MLO, *XQ, *VC; float sc;
    __device__ __forceinline__ void operator()(const Acc& acc, const Unit& u, int wr, int wc, int fr, int fq) const {
        bf16_t* base; size_t ldc;
        if (u.aux == 0) {
            if (u.pn < 8)       { base = MQK + (size_t)u.pm * 256 * 2048 + u.pn * 256; ldc = 2048; }
            else if (u.pn < 12) { base = MLO + (size_t)u.pm * 256 * 1024 + (u.pn - 8) * 256; ldc = 1024; }
            else                { base = XQ + ((size_t)(u.pn - 12) * TT + (size_t)u.pm * 256) * 256; ldc = 256; }
        } else                  { base = VC + ((size_t)(u.pm * 128 + u.pn) * 256) * 512; ldc = 512; }
        EPI_BF16_LOOP( v0 *= sc; v1 *= sc; st_bf16x8(base + (size_t)r * ldc + bj * 128 + colh, v0, v1); )
    }
};
struct EpiMem {
    static constexpr bool PERM = true;
    bf16_t *MK, *MVT;
    __device__ __forceinline__ void operator()(const Acc& acc, const Unit& u, int wr, int wc, int fr, int fq) const {
        bf16_t* base = (u.aux == 0) ? MK + (size_t)(u.pm * 4 + u.pn) * 65536 : MVT + (size_t)(u.pn * 4 + u.pm) * 65536;
        EPI_BF16_LOOP( st_bf16x8(base + (size_t)r * 256 + bj * 128 + colh, v0, v1); )
    }
};
struct EpiPB {
    static constexpr bool PERM = true;
    bf16_t *DQ, *DK, *DV;
    __device__ __forceinline__ void operator()(const Acc& acc, const Unit& u, int wr, int wc, int fr, int fq) const {
        const int which = u.pn >> 3, c0 = (u.pn & 7) * 2;
        bf16_t* buf = DQ + (size_t)which * ((WS_DK - WS_DQ) / 2);
        EPI_BF16_LOOP( st_bf16x8(buf + ((size_t)(c0 + bj) * TT + (size_t)u.pm * 256 + r) * 128 + colh, v0, v1); )
    }
};
struct EpiF32Tile {
    static constexpr bool PERM = false;
    float* C; size_t off_pm, off_pn, off_aux; int ldc;
    __device__ __forceinline__ void operator()(const Acc& acc, const Unit& u, int wr, int wc, int fr, int fq) const {
        float* base = C + (size_t)u.pm * off_pm + (size_t)u.pn * off_pn + (size_t)u.aux * off_aux;
        EPI_F32_LOOP( *(f32x4*)(base + (size_t)r * ldc + col) = v; )
    }
};
struct EpiB16Tile {
    static constexpr bool PERM = true;
    bf16_t* C; size_t off_pm, off_pn, off_aux; int ldc; float sc;
    __device__ __forceinline__ void operator()(const Acc& acc, const Unit& u, int wr, int wc, int fr, int fq) const {
        bf16_t* base = C + (size_t)u.pm * off_pm + (size_t)u.pn * off_pn + (size_t)u.aux * off_aux;
        EPI_BF16_LOOP( v0 *= sc; v1 *= sc; st_bf16x8(base + (size_t)r * ldc + bj * 128 + colh, v0, v1); )
    }
};
constexpr int EPI_TBL_OFF = RING_BYTES + 4096;
#define EPI_XBAR() do { asm volatile("s_waitcnt lgkmcnt(0)" ::: "memory"); __builtin_amdgcn_s_barrier(); asm volatile("" ::: "memory"); } while (0)
struct EpiXSoft {
    static constexpr bool PERM = true;
    bf16_t* XP; LAS float* tbl;
    __device__ __forceinline__ void operator()(const Acc& acc, const Unit& u, int wr, int wc, int fr, int fq) const {
        LAS float* TM = tbl; LAS float* TS = tbl + 1024;
        const int colh = wc * 32 + 8 * fq;
        float mloc[2][4];
#pragma unroll
        for (int ai = 0; ai < 2; ++ai)
#pragma unroll
            for (int m = 0; m < 4; ++m) { const int r = ai * 128 + wr * 64 + m * 16 + fr; float mx = -__builtin_inff();
#pragma unroll
                for (int bj = 0; bj < 2; ++bj)
#pragma unroll
                    for (int n = 0; n < 2; ++n) { const f32x4 v = acc[ai][bj][m][n]; mx = fmaxf(mx, fmaxf(fmaxf(v[0], v[1]), fmaxf(v[2], v[3]))); }
                mx = xmax16(mx); mx = xmax32(mx);
                if (fq == 0) TM[r * 4 + wc] = mx; mloc[ai][m] = mx; }
        EPI_XBAR();
        f32x4 ev[2][4][2][2];
#pragma unroll
        for (int ai = 0; ai < 2; ++ai)
#pragma unroll
            for (int m = 0; m < 4; ++m) { const int r = ai * 128 + wr * 64 + m * 16 + fr;
                const f32x4 t4 = *(const LAS f32x4*)(TM + r * 4); const float mx = fmaxf(fmaxf(t4[0], t4[1]), fmaxf(t4[2], t4[3])) * 0.0625f; float s = 0.f;
#pragma unroll
                for (int bj = 0; bj < 2; ++bj)
#pragma unroll
                    for (int n = 0; n < 2; ++n) { f32x4 v = acc[ai][bj][m][n];
#pragma unroll
                        for (int j = 0; j < 4; ++j) { v[j] = __expf(v[j] * 0.0625f - mx); s += v[j]; }
                        ev[ai][m][bj][n] = v; }
                s = xsum16(s); s = xsum32(s);
                if (fq == 0) TS[r * 4 + wc] = s; }
        EPI_XBAR();
        const size_t t0 = (size_t)u.aux * TT + (size_t)u.pm * 256;
#pragma unroll
        for (int ai = 0; ai < 2; ++ai)
#pragma unroll
            for (int m = 0; m < 4; ++m) { const int r = ai * 128 + wr * 64 + m * 16 + fr;
                const f32x4 t4 = *(const LAS f32x4*)(TS + r * 4); const float inv = 1.0f / ((t4[0] + t4[1]) + (t4[2] + t4[3]));
#pragma unroll
                for (int bj = 0; bj < 2; ++bj) st_bf16x8(XP + (t0 + r) * 256 + bj * 128 + colh, ev[ai][m][bj][0] * inv, ev[ai][m][bj][1] * inv); }
    }
};
struct EpiHNorm {
    static constexpr bool PERM = true;
    bf16_t* HM; const float* HDEN; const bf16_t* MLO; const float* G; LAS float* tbl;
    __device__ __forceinline__ void operator()(const Acc& acc, const Unit& u, int wr, int wc, int fr, int fq) const {
        LAS float* TQ = tbl;
        const size_t t0 = (size_t)u.pm * 256; const int colh = wc * 32 + 8 * fq;
        float inv[2][4];
#pragma unroll
        for (int ai = 0; ai < 2; ++ai)
#pragma unroll
            for (int m = 0; m < 4; ++m) inv[ai][m] = HDEN[(size_t)u.aux * TT + t0 + ai * 128 + wr * 64 + m * 16 + fr];
        asm volatile("" : "+v"(inv[0][0]), "+v"(inv[0][1]), "+v"(inv[0][2]), "+v"(inv[0][3]), "+v"(inv[1][0]), "+v"(inv[1][1]), "+v"(inv[1][2]), "+v"(inv[1][3]));
#pragma unroll
        for (int ai = 0; ai < 2; ++ai)
#pragma unroll
            for (int m = 0; m < 4; ++m) { const int r = ai * 128 + wr * 64 + m * 16 + fr; const float iv = 1.0f / inv[ai][m]; inv[ai][m] = iv; float q = 0.f;
#pragma unroll
                for (int bj = 0; bj < 2; ++bj)
#pragma unroll
                    for (int n = 0; n < 2; ++n) { const f32x4 v = acc[ai][bj][m][n] * iv; q += (v[0] * v[0] + v[1] * v[1]) + (v[2] * v[2] + v[3] * v[3]); }
                q = xsum16(q); q = xsum32(q);
                if (fq == 0) TQ[r * 4 + wc] = q; }
        EPI_XBAR();
        f32x4 gg[2][2];
#pragma unroll
        for (int bj = 0; bj < 2; ++bj) { gg[bj][0] = *(const f32x4*)(G + u.aux * 256 + bj * 128 + colh); gg[bj][1] = *(const f32x4*)(G + u.aux * 256 + bj * 128 + colh + 4); }
#pragma unroll
        for (int ai = 0; ai < 2; ++ai) {
            u32x4 ogv[4][2];
#pragma unroll
            for (int m = 0; m < 4; ++m)
#pragma unroll
                for (int bj = 0; bj < 2; ++bj) ogv[m][bj] = *(const u32x4*)(MLO + (t0 + ai * 128 + wr * 64 + m * 16 + fr) * 1024 + u.aux * 256 + bj * 128 + colh);
#pragma unroll
            for (int m = 0; m < 4; ++m) { const int r = ai * 128 + wr * 64 + m * 16 + fr;
                const f32x4 t4 = *(const LAS f32x4*)(TQ + r * 4); const float rs = rsqrtf(((t4[0] + t4[1]) + (t4[2] + t4[3])) * (1.0f / 256.0f) + EPS) * inv[ai][m];
#pragma unroll
                for (int bj = 0; bj < 2; ++bj) { const size_t o = (t0 + r) * 1024 + u.aux * 256 + bj * 128 + colh; const u32x4 og = ogv[m][bj];
                    const f32x4 g0 = gg[bj][0], g1 = gg[bj][1];
                    f32x4 v0 = acc[ai][bj][m][0] * rs, v1 = acc[ai][bj][m][1] * rs;
                    v0[0] *= sigmoidf_(bflo(og.x)) * g0[0]; v0[1] *= sigmoidf_(bfhi(og.x)) * g0[1]; v0[2] *= sigmoidf_(bflo(og.y)) * g0[2]; v0[3] *= sigmoidf_(bfhi(og.y)) * g0[3];
                    v1[0] *= sigmoidf_(bflo(og.z)) * g1[0]; v1[1] *= sigmoidf_(bfhi(og.z)) * g1[1]; v1[2] *= sigmoidf_(bflo(og.w)) * g1[2]; v1[3] *= sigmoidf_(bfhi(og.w)) * g1[3];
                    st_bf16x8(HM + o, v0, v1); } } }
    }
};
struct EpiW {
    static constexpr bool PERM = true;
    bf16_t* WQ; const float* RS;
    __device__ __forceinline__ void operator()(const Acc& acc, const Unit& u, int wr, int wc, int fr, int fq) const {
        const size_t trow = (size_t)u.aux * TT + (size_t)u.pm * 256;
        const int colh = wc * 32 + 8 * fq;
        float rsv[2][4];
#pragma unroll
        for (int ai = 0; ai < 2; ++ai)
#pragma unroll
            for (int m = 0; m < 4; ++m) rsv[ai][m] = RS[trow + ai * 128 + wr * 64 + m * 16 + fr];
#pragma unroll
        for (int ai = 0; ai < 2; ++ai)
#pragma unroll
            for (int m = 0; m < 4; ++m) { int r = ai * 128 + wr * 64 + m * 16 + fr; asm volatile("" : "+v"(r)); const float rs = rsv[ai][m];
#pragma unroll
                for (int bj = 0; bj < 2; ++bj) { f32x4 v0 = acc[ai][bj][m][0], v1 = acc[ai][bj][m][1]; const int c = bj * 128 + colh; const float fl = (float)(r - c + 1);
#pragma unroll
                    for (int j = 0; j < 4; ++j) { v0[j] = v0[j] * (rs * __saturatef(fl - (float)j)); v1[j] = v1[j] * (rs * __saturatef(fl - (float)(4 + j))); }
                    st_bf16x8(WQ + (trow + r) * 512 + c, v0, v1);
                    } }
    }
};
struct EpiH {
    static constexpr bool PERM = true;
    bf16_t* HR; const float* HDEN;
    __device__ __forceinline__ void operator()(const Acc& acc, const Unit& u, int wr, int wc, int fr, int fq) const {
        const size_t t0 = (size_t)u.pm * 256;
        EPI_BF16_LOOP( const float inv = 1.0f / HDEN[(size_t)u.aux * TT + t0 + r];
            v0 *= inv; v1 *= inv; st_bf16x8(HR + (t0 + r) * 1024 + u.aux * 256 + bj * 128 + colh, v0, v1); )
    }
};
struct EpiXA {
    static constexpr bool PERM = true;
    bf16_t* XA;
    __device__ __forceinline__ void operator()(const Acc& acc, const Unit& u, int wr, int wc, int fr, int fq) const {
        const size_t t0 = (size_t)u.pm * 256;
        EPI_BF16_LOOP( st_bf16x8(XA + (t0 + r) * 1024 + u.aux * 256 + bj * 128 + colh, v0, v1); )
    }
};
struct EpiGate {
    static constexpr bool PERM = true;
    bf16_t* GT; const float* bg; float dsc;
    __device__ __forceinline__ void operator()(const Acc& acc, const Unit& u, int wr, int wc, int fr, int fq) const {
        const size_t t0 = (size_t)u.pm * 256;
        constexpr float L2E = 1.4426950408889634f; const float ns = -dsc * L2E;
        f32x4 bb[2][2];
#pragma unroll
        for (int bj = 0; bj < 2; ++bj) { const int c = u.pn * 256 + bj * 128 + wc * 32 + 8 * fq; bb[bj][0] = *(const f32x4*)(bg + c) * (-L2E); bb[bj][1] = *(const f32x4*)(bg + c + 4) * (-L2E); }
        EPI_BF16_LOOP( const int c = u.pn * 256 + bj * 128 + colh; const f32x4 b0 = bb[bj][0], b1 = bb[bj][1];
            _Pragma("unroll") for (int j = 0; j < 4; ++j) { v0[j] = __builtin_amdgcn_rcpf(1.0f + __builtin_amdgcn_exp2f(fmaf(v0[j], ns, b0[j]))); v1[j] = __builtin_amdgcn_rcpf(1.0f + __builtin_amdgcn_exp2f(fmaf(v1[j], ns, b1[j]))); }
            st_bf16x8(GT + (t0 + r) * 2048 + c, v0, v1); )
    }
};
template <bool FIRST> struct EpiBranch {
    static constexpr bool PERM = true;
    const bf16_t* GT; bf16_t* MG; float dsc;
    __device__ __forceinline__ void operator()(const Acc& acc, const Unit& u, int wr, int wc, int fr, int fq) const {
        const size_t t0 = (size_t)u.pm * 256; const int colh = wc * 32 + 8 * fq;
#pragma unroll
        for (int ai = 0; ai < 2; ++ai) {
            int rb = ai * 128 + wr * 64 + fr; asm volatile("" : "+v"(rb));
            const size_t ob = (t0 + rb) * 2048 + u.pn * 256 + colh;
            u32x4 g[4][2], p[4][2];
#pragma unroll
            for (int m = 0; m < 4; ++m)
#pragma unroll
                for (int bj = 0; bj < 2; ++bj) { const size_t o = ob + (size_t)m * 16 * 2048 + bj * 128; g[m][bj] = *(const u32x4*)(GT + o); if (!FIRST) p[m][bj] = *(const u32x4*)(MG + o); }
#pragma unroll
            for (int m = 0; m < 4; ++m)
#pragma unroll
                for (int bj = 0; bj < 2; ++bj) { const size_t o = ob + (size_t)m * 16 * 2048 + bj * 128; f32x4 v0 = acc[ai][bj][m][0] * dsc, v1 = acc[ai][bj][m][1] * dsc; const u32x4 gg = g[m][bj];
                    v0[0] *= bflo(gg.x); v0[1] *= bfhi(gg.x); v0[2] *= bflo(gg.y); v0[3] *= bfhi(gg.y); v1[0] *= bflo(gg.z); v1[1] *= bfhi(gg.z); v1[2] *= bflo(gg.w); v1[3] *= bfhi(gg.w);
                    if (!FIRST) { const u32x4 pp = p[m][bj];
                        v0[0] += bflo(pp.x); v0[1] += bfhi(pp.x); v0[2] += bflo(pp.y); v0[3] += bfhi(pp.y); v1[0] += bflo(pp.z); v1[1] += bfhi(pp.z); v1[2] += bflo(pp.w); v1[3] += bfhi(pp.w); }
                    st_bf16x8(MG + o, v0, v1); }
        }
    }
};
struct EpiOut {
    static constexpr bool PERM = true;
    const float* X; bf16_t* X1B; float* RSS;
    __device__ __forceinline__ void operator()(const Acc& acc, const Unit& u, int wr, int wc, int fr, int fq) const {
        const size_t t0 = (size_t)u.pm * 256; const int colh = wc * 32 + 8 * fq;
#pragma unroll
        for (int ai = 0; ai < 2; ++ai) {
            int rb = ai * 128 + wr * 64 + fr; asm volatile("" : "+v"(rb));
            const size_t ob = (t0 + rb) * 2048 + u.pn * 256 + colh;
            f32x4 x0[4][2], x1[4][2];
#pragma unroll
            for (int m = 0; m < 4; ++m)
#pragma unroll
                for (int bj = 0; bj < 2; ++bj) { const size_t o = ob + (size_t)m * 16 * 2048 + bj * 128; x0[m][bj] = *(const f32x4*)(X + o); x1[m][bj] = *(const f32x4*)(X + o + 4); }
#pragma unroll
            for (int m = 0; m < 4; ++m) { float ss = 0.f;
#pragma unroll
                for (int bj = 0; bj < 2; ++bj) { const size_t o = ob + (size_t)m * 16 * 2048 + bj * 128;
                    const f32x4 v0 = acc[ai][bj][m][0] + x0[m][bj], v1 = acc[ai][bj][m][1] + x1[m][bj];
                    u32x4 w; w.x = cvtpk(v0[0], v0[1]); w.y = cvtpk(v0[2], v0[3]); w.z = cvtpk(v1[0], v1[1]); w.w = cvtpk(v1[2], v1[3]);
                    *(u32x4*)(X1B + o) = w;
                    ss += ((bflo(w.x) * bflo(w.x) + bfhi(w.x) * bfhi(w.x)) + (bflo(w.y) * bflo(w.y) + bfhi(w.y) * bfhi(w.y))) + ((bflo(w.z) * bflo(w.z) + bfhi(w.z) * bfhi(w.z)) + (bflo(w.w) * bflo(w.w) + bfhi(w.w) * bfhi(w.w))); }
                ss = xsum16(ss); ss = xsum32(ss);
                if (fq == 0) RSS[(t0 + rb + m * 16) * 32 + u.pn * 4 + wc] = ss; }
        }
    }
};
struct EpiGU {
    static constexpr bool PERM = true;
    unsigned char* HD;
    __device__ __forceinline__ void operator()(const Acc& acc, const Unit& u, int wr, int wc, int fr, int fq) const {
        const size_t t0 = (size_t)u.pm * 256; const int colh = wc * 32 + 8 * fq;
#pragma unroll
        for (int ai = 0; ai < 2; ++ai)
#pragma unroll
            for (int m = 0; m < 4; ++m) { int r = ai * 128 + wr * 64 + m * 16 + fr; asm volatile("" : "+v"(r));
                f32x4 g0 = acc[ai][0][m][0], g1 = acc[ai][0][m][1]; const f32x4 u0 = acc[ai][1][m][0], u1 = acc[ai][1][m][1];
#pragma unroll
                for (int j = 0; j < 4; ++j) { const float a0 = g0[j] * (1.0f / 32.0f), a1 = g1[j] * (1.0f / 32.0f); g0[j] = a0 * sigmoidf_(a0) * (u0[j] * 0.25f); g1[j] = a1 * sigmoidf_(a1) * (u1[j] * 0.25f); }
                u32x2 w; w.x = pk4_fp8(g0[0], g0[1], g0[2], g0[3]); w.y = pk4_fp8(g1[0], g1[1], g1[2], g1[3]);
                *(u32x2*)(HD + (t0 + r) * DEXP_P + u.pn * 128 + colh) = w; }
    }
};
struct EpiDown {
    static constexpr bool PERM = true;
    unsigned char* YS; const float* WROW;
    __device__ __forceinline__ void operator()(const Acc& acc, const Unit& u, int wr, int wc, int fr, int fq) const {
        const size_t t0 = (size_t)u.pm * 256;
        float wv[2][4];
#pragma unroll
        for (int ai = 0; ai < 2; ++ai)
#pragma unroll
            for (int m = 0; m < 4; ++m) wv[ai][m] = WROW[t0 + ai * 128 + wr * 64 + m * 16 + fr] * (64.0f / 128.0f);
        EPI_BF16_LOOP( const float w = wv[ai][m]; v0 *= w; v1 *= w;
            u32x2 o; o.x = pk4_fp8(v0[0], v0[1], v0[2], v0[3]); o.y = pk4_fp8(v1[0], v1[1], v1[2], v1[3]); *(u32x2*)(YS + (t0 + r) * 2048 + u.pn * 256 + bj * 128 + colh) = o; )
    }
};

struct SchedDense {
    const bf16_t* A0; const bf16_t* B0; int lda, ldb, nM, nN, G, c;
    __device__ __forceinline__ bool next(int i, Unit& u) const {
        const int L = i * G + c; if (L >= nM * nN) return false;
        tile_order(L, nM, nN, u.pm, u.pn); u.aux = 0;
        u.A = A0 + (size_t)u.pm * 256 * lda; u.B = B0 + (size_t)u.pn * 256 * ldb; return true;
    }
};
struct SchedPA {
    const bf16_t* HBF; const bf16_t* WINT; int G, c;
    __device__ __forceinline__ bool next(int i, Unit& u) const {
        const int L = i * G + c;
        if (L < 1024) { tile_order(L, 128, 8, u.pm, u.pn); u.aux = 0; u.A = HBF + (size_t)u.pm * 256 * 2048; u.B = WINT + (size_t)(6144 + u.pn * 256) * 2048; return true; }
        if (L < 1536) { const int q = L - 1024; u.pm = q & 3; u.pn = q >> 2; u.aux = 1; u.A = WINT + (size_t)(10240 + u.pm * 256) * 2048; u.B = HBF + (size_t)u.pn * 256 * 2048; return true; }
        return false;
    }
};
struct SchedPA8 {
    const bf16_t* H8; const bf16_t* W8; int G, c;
    __device__ __forceinline__ bool next(int i, Unit& u) const {
        const int L = i * G + c; if (L >= 1024) return false;
        int pn; tile_order(L, 128, 8, u.pm, pn); u.pn = pn + 8; u.aux = 0; u.A = H8 + (size_t)u.pm * 256 * 1024; u.B = W8 + (size_t)pn * 256 * 1024; return true;
    }
};
struct SchedMem {
    const bf16_t* MEMN; const bf16_t* WMEMT; int G, c;
    __device__ __forceinline__ bool next(int i, Unit& u) const {
        const int L = i * G + c; if (L >= 16) return false;
        if (L < 8) { u.aux = 0; u.pm = L >> 2; u.pn = L & 3; u.A = MEMN + (size_t)u.pm * 256 * 2048; u.B = WMEMT + (size_t)u.pn * 256 * 2048; }
        else { const int q = L - 8; u.aux = 1; u.pm = q & 3; u.pn = q >> 2; u.A = WMEMT + (size_t)(1024 + u.pm * 256) * 2048; u.B = MEMN + (size_t)u.pn * 256 * 2048; }
        return true;
    }
};
struct SchedHG {
    const bf16_t* A0; const bf16_t* B0; size_t sa_h, sa_g, sb_h, sb_g; int G, c;
    __device__ __forceinline__ bool next(int i, Unit& u) const {
        const int L = i * G + c; if (L >= 512) return false;
        const int hh = L >> 7, g = L & 127; u.aux = hh; u.pm = g; u.pn = 0;
        u.A = A0 + (size_t)hh * sa_h + (size_t)g * sa_g; u.B = B0 + (size_t)hh * sb_h + (size_t)g * sb_g; return true;
    }
};
struct SchedXA {
    const bf16_t* A0; const bf16_t* B0; int G, c;
    __device__ __forceinline__ bool next(int i, Unit& u) const {
        const int L = i * G + c; if (L >= 512) return false;
        const int hh = L >> 7, pm = L & 127; u.aux = hh; u.pm = pm; u.pn = 0;
        u.A = A0 + ((size_t)hh * TT + (size_t)pm * 256) * 256; u.B = B0 + (size_t)((pm >> 6) * 4 + hh) * 65536; return true;
    }
};
struct SchedMoE {
    const bf16_t* A0; const bf16_t* B0; const LAS int* unit_e; int nrt, NT, lda; size_t eb_stride, nb_stride; int G, c;
    __device__ __forceinline__ bool next(int i, Unit& u) const {
        const int L = i * G + c; if (L >= nrt * NT) return false;
        const int rt = L / NT, pn = L - rt * NT; const int e = __builtin_amdgcn_readfirstlane(unit_e[i]);
        u.pm = rt; u.pn = pn; u.aux = e; u.A = A0 + (size_t)rt * 256 * lda; u.B = B0 + (size_t)e * eb_stride + (size_t)pn * nb_stride; return true;
    }
};
}
namespace attn {
constexpr int D = 128;
constexpr float THR = 8.f;
constexpr float SCALE = 0.08838834764831845f;
constexpr int NW = 8, QBLK = 32, KVBLK = 64, QB = NW * QBLK;
constexpr int SHM_V = KVBLK * D * 2, SHM_K = KVBLK * D * 2;
constexpr int LDS_BYTES = 2 * SHM_V + 2 * SHM_K + NW * 64 * 4;
typedef bf16_t bf16;

#define KSWZ(row, colB) ((row) * 256 + ((colB) ^ (((row) & 7) << 4)))
#define SBAR() __builtin_amdgcn_sched_barrier(0)
__device__ __forceinline__ int v_st(int k, int c) { const int kk = (k & ~0xC) | ((k & 4) << 1) | ((k & 8) >> 1); return ((kk >> 3) * 4 + (c >> 5)) * 512 + ((kk & 7) * 32 + (c & 31)) * 2; }
__device__ __forceinline__ int v_rd_base(int lane) { return ((lane & 3) << 3) | (((lane >> 2) & 3) << 6) | (((lane >> 4) & 1) << 5) | (((lane >> 5) & 1) << 8); }
constexpr int v_rd_off(int d0, int ks, int half) { return d0 * 512 + ks * 4096 + half * 2048; }
__device__ __forceinline__ int crow(int r, int hi) { return (r & 3) + 8 * (r >> 2) + 4 * hi; }
__device__ __forceinline__ bf16x8 load8(const bf16* p) { return *reinterpret_cast<const bf16x8*>(p); }

__device__ __forceinline__ void mask_tile(f32x16& p0, f32x16& p1, int dq, unsigned W) {
    const float NEG = -__builtin_inff();
#pragma unroll
    for (int r = 0; r < 16; ++r) {
        const int c = (r & 3) + 8 * (r >> 2);
        if ((unsigned)(dq - c) >= W) p0[r] = NEG;
        if ((unsigned)(dq - c - 32) >= W) p1[r] = NEG;
    }
}
__device__ __forceinline__ void partialSM(f32x16& p0, f32x16& p1, float& m_reg, float& mn, float& alpha) {
    float pmax = p0[0]; for (int r = 1; r < 16; ++r) pmax = fmaxf(pmax, p0[r]); for (int r = 0; r < 16; ++r) pmax = fmaxf(pmax, p1[r]);
    { auto rr = __builtin_amdgcn_permlane32_swap(__float_as_uint(pmax), __float_as_uint(pmax), false, false);
      pmax = fmaxf(__uint_as_float(rr[0]), __uint_as_float(rr[1])); }
    constexpr float C2 = 1.4426950408889634f * SCALE;
    if (__builtin_expect(__all((pmax - m_reg) * SCALE <= THR), 1)) { mn = m_reg; alpha = 1.f; }
    else { mn = fmaxf(m_reg, pmax); alpha = __builtin_amdgcn_exp2f((m_reg - mn) * C2); m_reg = mn; }
    const float mnL = -mn * C2;
    for (int r = 0; r < 16; ++r) p0[r] = fmaf(p0[r], C2, mnL); for (int r = 0; r < 16; ++r) p1[r] = fmaf(p1[r], C2, mnL);
    for (int r = 0; r < 16; ++r) p0[r] = __builtin_amdgcn_exp2f(p0[r]);
}
__device__ __forceinline__ void finishSM(f32x16& p0, f32x16& p1, float alpha, float& l_reg, bf16x8& pa0, bf16x8& pa1, bf16x8& pa2, bf16x8& pa3) {
    for (int r = 0; r < 16; ++r) p1[r] = __builtin_amdgcn_exp2f(p1[r]);
    float ps = 0; for (int r = 0; r < 16; ++r) ps += p0[r]; for (int r = 0; r < 16; ++r) ps += p1[r];
    { auto rr = __builtin_amdgcn_permlane32_swap(__float_as_uint(ps), __float_as_uint(ps), false, false);
      ps = __uint_as_float(rr[0]) + __uint_as_float(rr[1]); }
    l_reg = l_reg * alpha + ps;
#define PK4(P, B_, OUT) do { unsigned a0 = cvtpk(P[B_+0], P[B_+1]), a1 = cvtpk(P[B_+2], P[B_+3]);                          \
        unsigned b0 = cvtpk(P[B_+4], P[B_+5]), b1 = cvtpk(P[B_+6], P[B_+7]);                                             \
        auto r0 = __builtin_amdgcn_permlane32_swap(a0, b0, false, false); auto r1 = __builtin_amdgcn_permlane32_swap(a1, b1, false, false); \
        u32x4 w = {r0[0], r1[0], r0[1], r1[1]}; OUT = *reinterpret_cast<bf16x8*>(&w); } while (0)
    PK4(p0, 0, pa0); PK4(p0, 8, pa1); PK4(p1, 0, pa2); PK4(p1, 8, pa3);
#undef PK4
}
template <int KB>
__device__ __forceinline__ void qkt(f32x16& p0, f32x16& p1, const char* K_lds, int r32, int hi, const bf16x8* qr, float sl, int dq) {
    const float sl8 = 8.f * sl, sl32 = 32.f * sl;
    p0[0] = -sl * (float)dq; p0[1] = p0[0] + sl; p0[2] = p0[1] + sl; p0[3] = p0[2] + sl;
#pragma unroll
    for (int r = 4; r < 16; ++r) p0[r] = p0[r - 4] + sl8;
#pragma unroll
    for (int r = 0; r < 16; ++r) p1[r] = p0[r] + sl32;
    const char* kb[4];
#pragma unroll
    for (int dd = 0; dd < 4; ++dd) kb[dd] = K_lds + KB * SHM_K + KSWZ(r32, (dd * 16 + hi * 8) * 2);
#pragma unroll
    for (int d0 = 0; d0 < 8; ++d0) { const char* a = kb[d0 & 3] + (d0 >> 2) * 128;
        bf16x8 b0_ = *reinterpret_cast<const bf16x8*>(a);
        bf16x8 b1_ = *reinterpret_cast<const bf16x8*>(a + 32 * 256);
        p0 = __builtin_amdgcn_mfma_f32_32x32x16_bf16(b0_, qr[d0], p0, 0, 0, 0);
        p1 = __builtin_amdgcn_mfma_f32_32x32x16_bf16(b1_, qr[d0], p1, 0, 0, 0); }
}
template <int VB>
__device__ __forceinline__ void pv_tile(f32x16* o, int vb0, bf16x8 pa0, bf16x8 pa1, bf16x8 pa2, bf16x8 pa3) {
#define TRRD(dst, off) asm volatile("ds_read_b64_tr_b16 %0, %1 offset:%2" : "=&v"(dst) : "v"(vb0), "i"(off) : "memory")
#define PV_D0(d0) do { s16x4 l0, l1, l2, l3, h0, h1, h2, h3; constexpr int b_ = VB * SHM_V + v_rd_off(d0, 0, 0); \
        TRRD(l0, b_); TRRD(h0, b_ + 2048); TRRD(l1, b_ + 4096); TRRD(h1, b_ + 6144); TRRD(l2, b_ + 8192); TRRD(h2, b_ + 10240); TRRD(l3, b_ + 12288); TRRD(h3, b_ + 14336); \
        asm volatile("s_waitcnt lgkmcnt(0)" ::: "memory"); SBAR();   \
        o[d0] = __builtin_amdgcn_mfma_f32_32x32x16_bf16(pa0, (bf16x8){l0[0], l0[1], l0[2], l0[3], h0[0], h0[1], h0[2], h0[3]}, o[d0], 0, 0, 0);   \
        o[d0] = __builtin_amdgcn_mfma_f32_32x32x16_bf16(pa1, (bf16x8){l1[0], l1[1], l1[2], l1[3], h1[0], h1[1], h1[2], h1[3]}, o[d0], 0, 0, 0);   \
        o[d0] = __builtin_amdgcn_mfma_f32_32x32x16_bf16(pa2, (bf16x8){l2[0], l2[1], l2[2], l2[3], h2[0], h2[1], h2[2], h2[3]}, o[d0], 0, 0, 0);   \
        o[d0] = __builtin_amdgcn_mfma_f32_32x32x16_bf16(pa3, (bf16x8){l3[0], l3[1], l3[2], l3[3], h3[0], h3[1], h3[2], h3[3]}, o[d0], 0, 0, 0); } while (0)
    PV_D0(0); PV_D0(1); PV_D0(2); PV_D0(3);
#undef PV_D0
#undef TRRD
}

struct BlockRef { const bf16* Q; const bf16* K; const bf16* V; bf16* O; int P0; };
struct Seam { bf16x8 qr[8]; bf16x8 st_v0, st_v1, st_k0, st_k1; };
__device__ __forceinline__ int swa_jlo(int P0, int W) { const int lowk = P0 - W + 1; return lowk > 0 ? lowk / KVBLK : 0; }
#define ROW(p, k0, rr) ((p) + (size_t)((k0) + (rr)) * D + sc)
#define VMW() asm volatile("s_waitcnt vmcnt(0)" ::: "memory")
#define VMWN(n) asm volatile("s_waitcnt vmcnt(%0)" :: "i"(n) : "memory")
#define SLOAD_H(Kp, Vp, k0) do { S.st_v0 = load8(ROW(Vp, k0, sr)); S.st_v1 = load8(ROW(Vp, k0, 32 + sr));              \
                         S.st_k0 = load8(ROW(Kp, k0, sr)); S.st_k1 = load8(ROW(Kp, k0, 32 + sr)); } while (0)
#define SWRITE_HK(bf) do { *(bf16x8*)(K_lds + (bf) * SHM_K + kws) = S.st_k0; *(bf16x8*)(K_lds + (bf) * SHM_K + kws + 32 * 256) = S.st_k1; } while (0)
#define SWRITE_HV(bf) do { *(bf16x8*)(V_lds + (bf) * SHM_V + vst0) = S.st_v0; *(bf16x8*)(V_lds + (bf) * SHM_V + vst1) = S.st_v1; } while (0)
#define SWRITE_H(bf) do { SWRITE_HV(bf); SWRITE_HK(bf); } while (0)

__device__ __forceinline__ void causal_swa_prime(const BlockRef& cur, int W, char* lds, Seam& S, const int tid) {
    const int wid = __builtin_amdgcn_readfirstlane(tid >> 6), lane = tid & 63, r32 = lane & 31, hi = lane >> 5;
    const int sr = tid >> 4, sc = (tid & 15) * 8, kws = KSWZ(sr, sc * 2); char* K_lds = lds + 2 * SHM_V;
    const int kb0 = swa_jlo(cur.P0, W) * KVBLK;
    for (int d0 = 0; d0 < 8; ++d0) S.qr[d0] = load8(cur.Q + (size_t)(wid * QBLK + r32) * D + d0 * 16 + hi * 8);
    SLOAD_H(cur.K, cur.V, kb0); VMW(); SWRITE_HK(0);
    __syncthreads();
}
__device__ __forceinline__ void causal_swa_block(const BlockRef& cur, const BlockRef& nxt, int skv, int W, int Wn, float sl, char* lds, Seam& S, const int tid) {
    const int wid = __builtin_amdgcn_readfirstlane(tid >> 6), lane = tid & 63, r32 = lane & 31, hi = lane >> 5;
    const int j_lo = swa_jlo(cur.P0, W);
    int j_hi = (cur.P0 + QB - 1) / KVBLK + 1; if (j_hi > skv / KVBLK) j_hi = skv / KVBLK;
    const int NT = j_hi - j_lo;
    const int kbn = swa_jlo(nxt.P0, Wn) * KVBLK;
    const int qlo = cur.P0 + wid * QBLK, qm = qlo + r32 - 4 * hi;
    char* V_lds = lds; char* K_lds = lds + 2 * SHM_V;
    float* ws = (float*)(lds + 2 * SHM_V + 2 * SHM_K) + wid * 64; float* li_l = ws, * al_l = ws + 32;
    float m_reg = -1e30f, l_reg = 0; f32x16 o[4] = {};
    const int sr = tid >> 4, sc = (tid & 15) * 8, vst0 = v_st(sr, sc), vst1 = v_st(32 + sr, sc), kws = KSWZ(sr, sc * 2);
    const int vb0 = (int)(uintptr_t)V_lds + v_rd_base(lane);
    const bf16* Kh = cur.K; const bf16* Vh = cur.V;
#define RESC(a) do { if (__any((a) < 1.f)) { if (hi == 0) al_l[r32] = (a); asm volatile("s_waitcnt lgkmcnt(0)" ::: "memory");              \
                     for (int d_ = 0; d_ < 4; ++d_) for (int r = 0; r < 16; ++r) o[d_][r] *= al_l[crow(r, hi)]; } } while (0)
#define KBASE(t) ((j_lo + (t)) * KVBLK)
#define MASKT(P0_, P1_, t) do { const int kb_ = KBASE(t); if (kb_ + KVBLK - 1 > qlo || kb_ <= qlo + QBLK - 1 - W) mask_tile(P0_, P1_, qm - kb_, (unsigned)W); } while (0)
    constexpr int NQL = 8;
#define SEAM_K0() do { VMWN(NQL); SWRITE_HK(0); SBAR(); } while (0)
    f32x16 pA0, pA1, pB0, pB1; float mnA, mnB, alA, alB; bf16x8 pa0, pa1, pa2, pa3;
    SWRITE_HV(0); SBAR();
    if (NT > 1) { SLOAD_H(Kh, Vh, KBASE(1)); }
    SBAR(); qkt<0>(pA0, pA1, K_lds, r32, hi, S.qr, sl, qm - KBASE(0));
    MASKT(pA0, pA1, 0); partialSM(pA0, pA1, m_reg, mnA, alA);
    if (NT > 1) { VMW(); SWRITE_H(1); }
    __syncthreads();
#define HALF_STEP(PX0, PX1, mnX, alX, PY0, PY1, alY, t, KB, VB, SB) do {                                                      \
        SBAR(); qkt<KB>(PX0, PX1, K_lds, r32, hi, S.qr, sl, qm - KBASE(t));                                                   \
        finishSM(PY0, PY1, alY, l_reg, pa0, pa1, pa2, pa3); SBAR();                                                           \
        if ((t) + 1 < NT) { SLOAD_H(Kh, Vh, KBASE((t) + 1)); SBAR(); }                                                        \
        pv_tile<VB>(o, vb0, pa0, pa1, pa2, pa3); MASKT(PX0, PX1, (t)); partialSM(PX0, PX1, m_reg, mnX, alX);                  \
        __syncthreads();                                                                                                      \
        if ((t) + 1 < NT) { VMW(); SWRITE_H(SB); }                                                                            \
        RESC(alX); __syncthreads(); } while (0)
    for (int t = 1; t + 1 < NT; t += 2) {
        HALF_STEP(pB0, pB1, mnB, alB, pA0, pA1, alA, t, 1, 0, 0);
        HALF_STEP(pA0, pA1, mnA, alA, pB0, pB1, alB, t + 1, 0, 1, 1);
    }
    const bool even = (NT & 1) == 0;
    if (even) { SBAR(); qkt<1>(pB0, pB1, K_lds, r32, hi, S.qr, sl, qm - KBASE(NT - 1)); SBAR(); }
    SLOAD_H(nxt.K, nxt.V, kbn); SBAR();
#pragma unroll
    for (int d0 = 0; d0 < 8; ++d0) S.qr[d0] = load8(nxt.Q + (size_t)(wid * QBLK + r32) * D + d0 * 16 + hi * 8);
    SBAR();
    finishSM(pA0, pA1, alA, l_reg, pa0, pa1, pa2, pa3); SBAR();
    pv_tile<0>(o, vb0, pa0, pa1, pa2, pa3);
    if (even) { MASKT(pB0, pB1, NT - 1); partialSM(pB0, pB1, m_reg, mnB, alB); __syncthreads(); RESC(alB);
        finishSM(pB0, pB1, alB, l_reg, pa0, pa1, pa2, pa3); SBAR(); pv_tile<1>(o, vb0, pa0, pa1, pa2, pa3); }
    SBAR(); SEAM_K0();
    if (hi == 0) li_l[r32] = l_reg; asm volatile("s_waitcnt lgkmcnt(0)" ::: "memory");
    float rli[16];
#pragma unroll
    for (int r = 0; r < 16; ++r) rli[r] = __builtin_amdgcn_rcpf(li_l[crow(r, hi)]);
    bf16* Ow = cur.O + (size_t)(wid * QBLK) * D;
    int zo = 0; asm volatile("" : "+v"(zo));
    const unsigned ob = (unsigned)(4 * hi * D + r32 + zo);
#pragma unroll
    for (int r = 0; r < 16; ++r) { const unsigned off = ob + (unsigned)(((r & 3) + 8 * (r >> 2)) * D);
#pragma unroll
        for (int d0 = 0; d0 < 4; ++d0) { const float v = o[d0][r] * rli[r];
            const float vn = __shfl_xor(v, 1);
            if ((r32 & 1) == 0) *(unsigned*)(Ow + off + d0 * 32) = cvtpk(v, vn); } }
    __syncthreads();
#undef RESC
#undef KBASE
#undef MASKT
#undef SEAM_K0
#undef HALF_STEP
}
#undef ROW
#undef VMW
#undef VMWN
#undef SLOAD_H
#undef SWRITE_HK
#undef SWRITE_HV
#undef SWRITE_H
}
namespace attn4 {
using attn::bf16; using attn::KVBLK; using attn::QBLK; using attn::SHM_K;
constexpr int QB = 128, D = 128;
constexpr int V_OFF = 0, K_OFF = 65536, PX_OFF = 98304;
constexpr int AL_OFF = RING_BYTES + 1024;
struct Item { const bf16* Q; const bf16* K; const bf16* V0; const bf16* V1; bf16* O; int P0, W; float sl; int olds; };

template <int OFF>
__device__ __forceinline__ void pv_half(f32x16* o, int vb0, bf16x8 pa0, bf16x8 pa1, bf16x8 pa2, bf16x8 pa3) {
#define TRRD(dst, off) asm volatile("ds_read_b64_tr_b16 %0, %1 offset:%2" : "=&v"(dst) : "v"(vb0), "i"(off) : "memory")
#define PV_D0(d0) do { s16x4 l0, l1, l2, l3, h0, h1, h2, h3; constexpr int b_ = OFF + attn::v_rd_off(d0, 0, 0); \
        TRRD(l0, b_); TRRD(h0, b_ + 2048); TRRD(l1, b_ + 4096); TRRD(h1, b_ + 6144); TRRD(l2, b_ + 8192); TRRD(h2, b_ + 10240); TRRD(l3, b_ + 12288); TRRD(h3, b_ + 14336); \
        asm volatile("s_waitcnt lgkmcnt(0)" ::: "memory"); SBAR();   \
        o[d0] = __builtin_amdgcn_mfma_f32_32x32x16_bf16(pa0, (bf16x8){l0[0], l0[1], l0[2], l0[3], h0[0], h0[1], h0[2], h0[3]}, o[d0], 0, 0, 0);   \
        o[d0] = __builtin_amdgcn_mfma_f32_32x32x16_bf16(pa1, (bf16x8){l1[0], l1[1], l1[2], l1[3], h1[0], h1[1], h1[2], h1[3]}, o[d0], 0, 0, 0);   \
        o[d0] = __builtin_amdgcn_mfma_f32_32x32x16_bf16(pa2, (bf16x8){l2[0], l2[1], l2[2], l2[3], h2[0], h2[1], h2[2], h2[3]}, o[d0], 0, 0, 0);   \
        o[d0] = __builtin_amdgcn_mfma_f32_32x32x16_bf16(pa3, (bf16x8){l3[0], l3[1], l3[2], l3[3], h3[0], h3[1], h3[2], h3[3]}, o[d0], 0, 0, 0); } while (0)
    PV_D0(0); PV_D0(1); PV_D0(2); PV_D0(3);
#undef PV_D0
#undef TRRD
}

template <int KB>
__device__ __forceinline__ void qkt_b(f32x16& p0, f32x16& p1, const char* K_lds, int r32, int hi, const bf16x8* qr, const f32x16& bias0, const f32x16& bias1) {
    const char* kb[4];
#pragma unroll
    for (int dd = 0; dd < 4; ++dd) kb[dd] = K_lds + KB * SHM_K + KSWZ(r32, (dd * 16 + hi * 8) * 2);
    { const bf16x8 b0_ = *reinterpret_cast<const bf16x8*>(kb[0]), b1_ = *reinterpret_cast<const bf16x8*>(kb[0] + 32 * 256);
      p0 = __builtin_amdgcn_mfma_f32_32x32x16_bf16(b0_, qr[0], bias0, 0, 0, 0); p1 = __builtin_amdgcn_mfma_f32_32x32x16_bf16(b1_, qr[0], bias1, 0, 0, 0); }
#pragma unroll
    for (int d0 = 1; d0 < 8; ++d0) { const char* a = kb[d0 & 3] + (d0 >> 2) * 128;
        const bf16x8 b0_ = *reinterpret_cast<const bf16x8*>(a), b1_ = *reinterpret_cast<const bf16x8*>(a + 32 * 256);
        p0 = __builtin_amdgcn_mfma_f32_32x32x16_bf16(b0_, qr[d0], p0, 0, 0, 0); p1 = __builtin_amdgcn_mfma_f32_32x32x16_bf16(b1_, qr[d0], p1, 0, 0, 0); }
}

__device__ __forceinline__ void item(const Item& it, char* lds, LAS unsigned char* ldsL, const int tid) {
    const int wid = __builtin_amdgcn_readfirstlane(tid >> 6), lane = tid & 63, r32 = lane & 31, hi = lane >> 5, role = wid >> 2, g = wid & 3;
    const int j_lo = attn::swa_jlo(it.P0, it.W);
    const int j_hi = (it.P0 + QB - 1) / KVBLK + 1;
    const int NT = j_hi - j_lo;
    const int W = it.W; const float sl = it.sl;
    const int qlo = it.P0 + g * QBLK, qm = qlo + r32 - 4 * hi;
    const int sr = tid >> 4, sc = (tid & 15) * 8, vst0 = attn::v_st(sr, sc), vst1 = attn::v_st(32 + sr, sc), kws = KSWZ(sr, sc * 2);
    float* AL = (float*)(lds + AL_OFF); int* FLG = (int*)(lds + AL_OFF + 1024); float* LL = (float*)(lds + AL_OFF + 1088);
#define KBASE(t) ((j_lo + (t)) * KVBLK)
#define A4_DMA(src, ldsbyte) __builtin_amdgcn_global_load_lds((const unsigned*)(src), (LAS unsigned*)((LAS unsigned char*)ldsL + (ldsbyte)), 16, 0, 0)
#define A4_SYNC() do { asm volatile("s_waitcnt vmcnt(0) lgkmcnt(0)" ::: "memory"); __builtin_amdgcn_s_barrier(); asm volatile("" ::: "memory"); } while (0)
    char* K_lds = lds + K_OFF;
    if (role == 0) {
        bf16x8 qr[8];
#pragma unroll
        for (int d0 = 0; d0 < 8; ++d0) qr[d0] = attn::load8(it.Q + (size_t)(g * QBLK + r32) * D + d0 * 16 + hi * 8);
        const char* const KbQ = (const char*)(it.K + (size_t)KBASE(0) * D) + g * 2048; const int dKq = K_OFF + g * 2048;
        const unsigned qvoK0 = (unsigned)(((lane >> 4) * D + (((lane & 15) ^ ((0 + (lane >> 4)) & 7)) * 8)) * 2), qvoK1 = (unsigned)(((lane >> 4) * D + (((lane & 15) ^ ((4 + (lane >> 4)) & 7)) * 8)) * 2);
        A4_DMA(KbQ + qvoK0, dKq); A4_DMA(KbQ + 1024 + qvoK1, dKq + 1024);
        A4_SYNC();
        float m_reg = -1e30f, l_reg = 0.f;
        f32x16 bias0, bias1;
#pragma unroll
        for (int r = 0; r < 16; ++r) { bias0[r] = sl * (float)((r & 3) + 8 * (r >> 2) + 4 * hi); bias1[r] = bias0[r] + 32.f * sl; }
        const float mstep = 64.f * sl;
#define A2_QK_STEP(t, PAR) do { \
            if ((t) < NT) { f32x16 p0, p1; float mn, alpha; bf16x8 pa0, pa1, pa2, pa3; \
                qkt_b<PAR>(p0, p1, K_lds, r32, hi, qr, bias0, bias1); if ((t) > 0) m_reg -= mstep; \
                { const int tk_ = ((t) + 1 < NT ? (t) + 1 : NT - 1); const char* const bk_ = KbQ + (size_t)tk_ * (KVBLK * D * 2);        \
                  A4_DMA(bk_ + qvoK0, dKq + ((PAR) ? 0 : SHM_K)); A4_DMA(bk_ + 1024 + qvoK1, dKq + ((PAR) ? 0 : SHM_K) + 1024); } \
                { const int kb_ = KBASE(t); if (kb_ + KVBLK - 1 > qlo || kb_ <= qlo + QBLK - 1 - W) attn::mask_tile(p0, p1, qm - kb_, (unsigned)W); } \
                attn::partialSM(p0, p1, m_reg, mn, alpha); attn::finishSM(p0, p1, alpha, l_reg, pa0, pa1, pa2, pa3); \
                char* px = lds + PX_OFF + (PAR) * 16384 + g * 4096 + lane * 16; \
                *(bf16x8*)px = pa0; *(bf16x8*)(px + 1024) = pa1; *(bf16x8*)(px + 2048) = pa2; *(bf16x8*)(px + 3072) = pa3; \
                if (hi == 0) AL[(PAR) * 128 + g * 32 + r32] = alpha; \
                const int anyr = __any(alpha < 1.f) ? 1 : 0; if (lane == 0) FLG[(PAR) * 4 + g] = anyr; } \
            A4_SYNC(); } while (0)
        for (int t = 0; t <= NT; t += 2) { A2_QK_STEP(t, 0); if (t + 1 <= NT) A2_QK_STEP(t + 1, 1); }
        if (hi == 0) LL[g * 32 + r32] = l_reg;
        __syncthreads();
        __syncthreads();
#undef A2_QK_STEP
    } else {
        const char* const KbW = (const char*)(it.K + (size_t)KBASE(0) * D) + 8192 + g * 2048;
        const char* const VbW = (const char*)((g >> 1 ? it.V1 : it.V0) + (size_t)KBASE(0) * D) + (g & 1) * 8192;
        const int dK0 = K_OFF + 8192 + g * 2048, dV0 = V_OFF + (g >> 1) * 16384 + (g & 1) * 8192;
        const unsigned voK0 = (unsigned)(((lane >> 4) * D + (((lane & 15) ^ ((0 + (lane >> 4)) & 7)) * 8)) * 2), voK1 = (unsigned)(((lane >> 4) * D + (((lane & 15) ^ ((4 + (lane >> 4)) & 7)) * 8)) * 2);
        const unsigned voV = (unsigned)((((((lane & 31) >> 4) & 1) * 8 + (((lane & 31) >> 2) & 3)) * D + (lane >> 5) * 32 + (lane & 3) * 8) * 2);
#define A4_VC(i) ((((i) >> 2) * 16 + (((i) >> 1) & 1) * 4) * D * 2 + ((i) & 1) * 128)
#define A4_STAGE_P(t, PAR, K0, K1, V0_, V1_) do { const int tk_ = ((t) + 1 < NT ? (t) + 1 : NT - 1), tv_ = ((t) < NT ? (t) : NT - 1); const char* const bk_ = KbW + (size_t)tk_ * (KVBLK * D * 2); const char* const bv_ = VbW + (size_t)tv_ * (KVBLK * D * 2); \
            _Pragma("unroll") for (int i = (K0); i < (K1); ++i) A4_DMA(bk_ + i * 1024 + ((i & 1) ? voK1 : voK0), dK0 + ((PAR) ? 0 : SHM_K) + i * 1024);        \
            _Pragma("unroll") for (int i = (V0_); i < (V1_); ++i) A4_DMA(bv_ + A4_VC(i) + voV, dV0 + ((PAR) ? 32768 : 0) + i * 1024); } while (0)
#pragma unroll
        for (int i = 0; i < 2; ++i) A4_DMA(KbW + i * 1024 + ((i & 1) ? voK1 : voK0), dK0 + i * 1024);
        A4_SYNC();
        f32x16 o[8] = {};
        const int vb0 = (int)(uintptr_t)(lds + V_OFF) + attn::v_rd_base(lane);
        A4_STAGE_P(0, 0, 0, 2, 0, 8); A4_SYNC();
#define A2_PV_STEP(t, PAR) do { A4_STAGE_P(t, PAR, 0, 2, 0, 3); \
            { constexpr int PB = (PAR) ^ 1; \
                const int flag = __builtin_amdgcn_readfirstlane(FLG[PB * 4 + g]); \
                if (flag) { _Pragma("unroll") for (int r = 0; r < 16; ++r) { const float a = AL[PB * 128 + g * 32 + attn::crow(r, hi)]; \
                        _Pragma("unroll") for (int d_ = 0; d_ < 8; ++d_) o[d_][r] *= a; } } \
                const char* px = lds + PX_OFF + PB * 16384 + g * 4096 + lane * 16; \
                const bf16x8 pa0 = *(const bf16x8*)px, pa1 = *(const bf16x8*)(px + 1024), pa2 = *(const bf16x8*)(px + 2048), pa3 = *(const bf16x8*)(px + 3072); \
                pv_half<PB * 32768>(o, vb0, pa0, pa1, pa2, pa3); A4_STAGE_P(t, PAR, 0, 0, 3, 8); pv_half<PB * 32768 + 16384>(o + 4, vb0, pa0, pa1, pa2, pa3); } \
            A4_SYNC(); } while (0)
        for (int t = 1; t <= NT; t += 2) { A2_PV_STEP(t, 1); if (t + 1 <= NT) A2_PV_STEP(t + 1, 0); }
        __syncthreads();
        float rli[16];
#pragma unroll
        for (int r = 0; r < 16; ++r) rli[r] = __builtin_amdgcn_rcpf(LL[g * 32 + attn::crow(r, hi)]);
        int zo = 0; asm volatile("" : "+v"(zo));
        const unsigned ob = (unsigned)(4 * hi * 256 + r32 + zo);
#define A4_OSTORE(ST_) _Pragma("unroll") for (int r = 0; r < 16; ++r) { const unsigned off = ob + (unsigned)(((r & 3) + 8 * (r >> 2)) * 256); \
            _Pragma("unroll") for (int d0 = 0; d0 < 8; ++d0) { const float v = o[d0][r] * rli[r]; \
                const float vn = __builtin_bit_cast(float, __builtin_amdgcn_mov_dpp(__builtin_bit_cast(int, v), 0xB1, 0xF, 0xF, true));        \
                if ((r32 & 1) == 0) { ST_; } } }
        if (it.olds) { LAS unsigned char* Ol = ldsL + (size_t)(g * QBLK) * 512;
            A4_OSTORE(*(LAS unsigned*)(Ol + (off + d0 * 32) * 2) = cvtpk(v, vn)) }
        else { bf16* Ow = it.O + (size_t)(g * QBLK) * 256;
            A4_OSTORE(*(unsigned*)(Ow + off + d0 * 32) = cvtpk(v, vn)) }
#undef A4_OSTORE
        __syncthreads();
#undef A2_PV_STEP
    }
#undef KBASE
#undef A4_DMA
#undef A4_STAGE_P
#undef A4_VC
#undef A4_SYNC
}
}
struct Frame {
    LAS unsigned char* lds; unsigned char* lds_g;
    volatile LAS unsigned* MISC;
    unsigned* ctl; unsigned char* ws; unsigned char* dout;
    int tid, lane, wave, G, bid, gw, NGW;
    const float* gdiff;
};

__device__ __forceinline__ void tr_item(const float* W, int ldw, int c0, bf16_t* WT, int ldt, int r0, int kb, int nb, LAS float* scr, int lane) {
    const int k0 = 64 * kb, n0 = 32 * nb;
    float ld_[32];
#pragma unroll
    for (int i = 0; i < 32; ++i) ld_[i] = W[(size_t)(k0 + 2 * i + (lane >> 5)) * ldw + c0 + n0 + (lane & 31)];
#pragma unroll
    for (int i = 0; i < 32; ++i) scr[(2 * i + (lane >> 5)) * 33 + (lane & 31)] = ld_[i];
    LDS_WAIT(); asm volatile("" ::: "memory");
    const int c = lane & 7;
#pragma unroll
    for (int j = 0; j < 4; ++j) { const int n = (lane >> 3) + 8 * j; const LAS float* s = scr + (8 * c) * 33 + n;
        u32x4 o; o.x = cvtpk(s[0 * 33], s[1 * 33]); o.y = cvtpk(s[2 * 33], s[3 * 33]); o.z = cvtpk(s[4 * 33], s[5 * 33]); o.w = cvtpk(s[6 * 33], s[7 * 33]);
        *(u32x4*)(WT + (size_t)(r0 + n0 + n) * ldt + k0 + 8 * c) = o; }
    LDS_WAIT(); asm volatile("" ::: "memory");
}
__device__ __forceinline__ void tr_item8(const float* W, int ldw, int c0, unsigned char* WT, int ldt, int r0, int kb, int nb, float sc, LAS float* scr, int lane) {
    const int k0 = 64 * kb, n0 = 32 * nb;
    float ld_[32];
#pragma unroll
    for (int i = 0; i < 32; ++i) ld_[i] = W[(size_t)(k0 + 2 * i + (lane >> 5)) * ldw + c0 + n0 + (lane & 31)];
#pragma unroll
    for (int i = 0; i < 32; ++i) scr[(2 * i + (lane >> 5)) * 33 + (lane & 31)] = ld_[i];
    LDS_WAIT(); asm volatile("" ::: "memory");
    const int c = lane & 7;
#pragma unroll
    for (int j = 0; j < 4; ++j) { const int n = (lane >> 3) + 8 * j; const LAS float* s = scr + (8 * c) * 33 + n;
        u32x2 o; o.x = pk4_fp8(s[0 * 33] * sc, s[1 * 33] * sc, s[2 * 33] * sc, s[3 * 33] * sc); o.y = pk4_fp8(s[4 * 33] * sc, s[5 * 33] * sc, s[6 * 33] * sc, s[7 * 33] * sc);
        *(u32x2*)(WT + (size_t)(r0 + n0 + n) * ldt + k0 + 8 * c) = o; }
    LDS_WAIT(); asm volatile("" ::: "memory");
}
struct TrD { const float* src; size_t ldw2; unsigned char* dst; size_t ldtb; float sc; int f8; };
__device__ __forceinline__ TrD tr_desc(const float* W, int ldw, int c0, void* WT, int ldt, int r0, int kb, int nb, float sc, int f8, int lane) {
    TrD d; d.src = W + (size_t)(64 * kb + (lane >> 5)) * ldw + c0 + 32 * nb + (lane & 31); d.ldw2 = (size_t)2 * ldw;
    d.ldtb = f8 ? (size_t)ldt : (size_t)ldt * 2; d.dst = (unsigned char*)WT + (size_t)(r0 + 32 * nb) * d.ldtb + (f8 ? (size_t)64 * kb : (size_t)128 * kb); d.sc = sc; d.f8 = f8; return d; }
__device__ __forceinline__ void tr_load(const TrD& d, float (&ld)[32]) {
#pragma unroll
    for (int i = 0; i < 32; ++i) ld[i] = d.src[(size_t)i * d.ldw2]; }
__device__ __forceinline__ void tr_flush(const TrD& d, const float (&ld)[32], LAS float* scr, int lane) {
#pragma unroll
    for (int i = 0; i < 32; ++i) scr[(2 * i + (lane >> 5)) * 33 + (lane & 31)] = ld[i];
    LDS_WAIT(); asm volatile("" ::: "memory");
    const int c = lane & 7;
    if (d.f8) {
#pragma unroll
        for (int j = 0; j < 4; ++j) { const int n = (lane >> 3) + 8 * j; const LAS float* s = scr + (8 * c) * 33 + n; const float sc = d.sc;
            u32x2 o; o.x = pk4_fp8(s[0 * 33] * sc, s[1 * 33] * sc, s[2 * 33] * sc, s[3 * 33] * sc); o.y = pk4_fp8(s[4 * 33] * sc, s[5 * 33] * sc, s[6 * 33] * sc, s[7 * 33] * sc);
            *(u32x2*)(d.dst + (size_t)n * d.ldtb + 8 * c) = o; }
    } else {
#pragma unroll
        for (int j = 0; j < 4; ++j) { const int n = (lane >> 3) + 8 * j; const LAS float* s = scr + (8 * c) * 33 + n;
            u32x4 o; o.x = cvtpk(s[0 * 33], s[1 * 33]); o.y = cvtpk(s[2 * 33], s[3 * 33]); o.z = cvtpk(s[4 * 33], s[5 * 33]); o.w = cvtpk(s[6 * 33], s[7 * 33]);
            *(u32x4*)(d.dst + (size_t)n * d.ldtb + 16 * c) = o; }
    }
    LDS_WAIT(); asm volatile("" ::: "memory");
}
template <class Dec>
__device__ __forceinline__ void tr_run(int first, int n_items, int step, const Dec& dec, LAS float* scr, int lane) {
    int it = first; if (it >= n_items) return;
    float la[32], lb[32], lc[32]; TrD da, db, dc;
    da = dec(it); tr_load(da, la);
    { const int i1 = it + step; db = dec(i1 < n_items ? i1 : first); tr_load(db, lb); }
    for (;;) {
        { const int i2 = it + 2 * step; dc = dec(i2 < n_items ? i2 : first); tr_load(dc, lc); }
        tr_flush(da, la, scr, lane);
        it += step; if (it >= n_items) break;
        { const int i2 = it + 2 * step; da = dec(i2 < n_items ? i2 : first); tr_load(da, la); }
        tr_flush(db, lb, scr, lane);
        it += step; if (it >= n_items) break;
        { const int i2 = it + 2 * step; db = dec(i2 < n_items ? i2 : first); tr_load(db, lb); }
        tr_flush(dc, lc, scr, lane);
        it += step; if (it >= n_items) break;
    }
}
__device__ __forceinline__ void rms_row2048(const float* xrow, const float* g, f32x4 (&v)[8], int lane) {
    const f32x4* xr = (const f32x4*)xrow + lane; float ss = 0.f;
#pragma unroll
    for (int j = 0; j < 8; ++j) { v[j] = xr[64 * j]; ss += (v[j].x * v[j].x + v[j].y * v[j].y) + (v[j].z * v[j].z + v[j].w * v[j].w); }
    ss = wave_sum(ss); const float r = rsqrtf(ss * (1.0f / 2048.0f) + EPS);
#pragma unroll
    for (int j = 0; j < 8; ++j) { const f32x4 gg = ((const f32x4*)g)[lane + 64 * j]; v[j] = v[j] * r * gg; }
}
__device__ __forceinline__ void store_row_bf16(bf16_t* orow, const f32x4 (&v)[8], int lane) {
#pragma unroll
    for (int j = 0; j < 8; ++j) { u32x2 w; w.x = cvtpk(v[j].x, v[j].y); w.y = cvtpk(v[j].z, v[j].w); *(u32x2*)(orow + 4 * lane + 256 * j) = w; }
}

__device__ __forceinline__ void p0_prologue(Frame& F, const float* const* in, const int parts = 3) {
    LAS float* scr = (LAS float*)(F.lds + F.wave * 16384);
    const float* w_in = in[3];
    bf16_t* WINT = (bf16_t*)(F.ws + WS_WINT);
    constexpr int I0 = 8192, I1 = 1024, I2 = 1024, I3 = 1024, I4 = 6144, I5 = 2048, I6 = 2048, I7 = 1024, I8 = 1024, I9 = 2048;
    constexpr int NITEMS = I0 + I1 + I2 + I3 + I4 + I5 + I6 + I7 + I8 + I9;
    if (parts & 1) { struct Dec { const float* const* in; const float* w_in; unsigned char* ws; bf16_t* WINT; int lane;
        __device__ __forceinline__ TrD operator()(int it) const { int r = it;
            if (r < I0) return tr_desc(w_in, DIN, 0, WINT, 2048, 0, r / 256, r % 256, 1.f, 0, lane); r -= I0;
            if (r < I1) return tr_desc(w_in, DIN, 9216, WINT + (size_t)8192 * 2048, 2048, 0, r / 32, r % 32, 32.0f, 1, lane); r -= I1;
            if (r < I2) return tr_desc(w_in, DIN, 10248, WINT + (size_t)8192 * 2048, 2048, 1024, r / 32, r % 32, 32.0f, 1, lane); r -= I2;
            if (r < I3) return tr_desc(w_in, DIN, 8192, WINT, 2048, 10240, r / 32, r % 32, 1.f, 0, lane); r -= I3;
            if (r < I4) return tr_desc(w_in, DIN, 11272, WINT + (size_t)11264 * 2048, 2048, 0, r / 192, r % 192, 32.0f, 1, lane); r -= I4;
            if (r < I5) return tr_desc(in[15], 2048, 0, ws + WS_WMEMT, 2048, 0, r / 64, r % 64, 1.f, 0, lane); r -= I5;
            if (r < I6) return tr_desc(in[16], 2048, 0, ws + WS_WBDT, 2048, 0, r / 64, r % 64, 32.0f, 1, lane); r -= I6;
            if (r < I7) return tr_desc(in[17], 2048, 0, ws + WS_WBMT, 1024, 0, r / 64, r % 64, 1.f, 0, lane); r -= I7;
            if (r < I8) return tr_desc(in[18], 2048, 0, ws + WS_WBCT, 1024, 0, r / 64, r % 64, 1.f, 0, lane); r -= I8;
            return tr_desc(in[20], 2048, 0, ws + WS_WOUTT, 2048, 0, r / 64, r % 64, 1.f, 0, lane); } };
      const Dec dec{in, w_in, F.ws, WINT, F.lane};
      tr_run(F.gw, NITEMS, F.NGW, dec, scr, F.lane); }
    if (!(parts & 2)) return;
    { bf16_t* WRT = (bf16_t*)(F.ws + WS_WRT); const float* wrg = in[22]; const float* wre = in[24];
      for (int idx = F.bid * 512 + F.tid; idx < 256 * 2048; idx += F.G * 512) { const int n = idx >> 11, k = idx & 2047;
          const float v = (n < 4 ? wrg[k * 4 + n] : (n < 36 ? wre[k * 32 + (n - 4)] : 0.f)) * in[21][k]; WRT[idx] = (bf16_t)(cvtpk(v, 0.f) & 0xffffu); } }
    __syncthreads();
    LAS float* wg = (LAS float*)F.lds;
    for (int idx = F.tid; idx < 16384; idx += 512) { const int k = idx >> 3, j = idx & 7; wg[j * 2048 + k] = w_in[(size_t)k * DIN + 10240 + j]; }
    __syncthreads();
    const float* x = in[0]; bf16_t* HBF = (bf16_t*)(F.dout + DO_HBF); float* MLG = (float*)(F.ws + WS_MLG);
    f32x4 v[8], gg[8];
#pragma unroll
    for (int j = 0; j < 8; ++j) { v[j] = ((const f32x4*)(x + (size_t)F.gw * 2048))[F.lane + 64 * j]; gg[j] = ((const f32x4*)in[2])[F.lane + 64 * j]; }
    for (int m = F.gw; m < TT; m += F.NGW) {
        f32x4 vn[8];
        { const int mn = m + F.NGW < TT ? m + F.NGW : m;
#pragma unroll
          for (int j = 0; j < 8; ++j) vn[j] = ((const f32x4*)(x + (size_t)mn * 2048))[F.lane + 64 * j]; }
        { float ss = 0.f;
#pragma unroll
          for (int j = 0; j < 8; ++j) ss += (v[j].x * v[j].x + v[j].y * v[j].y) + (v[j].z * v[j].z + v[j].w * v[j].w);
          ss = wave_sum(ss); const float r = rsqrtf(ss * (1.0f / 2048.0f) + EPS);
#pragma unroll
          for (int j = 0; j < 8; ++j) v[j] = v[j] * r * gg[j]; }
        store_row_bf16(HBF + (size_t)m * 2048, v, F.lane);
        { unsigned char* h8 = F.ws + WS_HBF8 + (size_t)m * 2048 + 4 * F.lane;
#pragma unroll
          for (int j = 0; j < 8; ++j) *(unsigned*)(h8 + 256 * j) = pk4_fp8(v[j].x, v[j].y, v[j].z, v[j].w); }
        float res = 0.f;
#pragma unroll
        for (int jj = 0; jj < 8; ++jj) { float a = 0.f;
#pragma unroll
            for (int j = 0; j < 8; ++j) { const f32x4 w = *(const LAS f32x4*)(wg + jj * 2048 + 4 * F.lane + 256 * j); a += (v[j].x * w.x + v[j].y * w.y) + (v[j].z * w.z + v[j].w * w.w); }
            a = wave_sum(a); if (F.lane == jj) res = a; }
        if (F.lane < 8) MLG[(size_t)m * 8 + F.lane] = res;
#pragma unroll
        for (int j = 0; j < 8; ++j) v[j] = vn[j];
    }
    { const float* mem = in[1]; bf16_t* MEMN = (bf16_t*)(F.ws + WS_MEMN);
      for (int m = F.gw; m < NB * MEML; m += F.NGW) { f32x4 v[8]; rms_row2048(mem + (size_t)m * 2048, in[14], v, F.lane); store_row_bf16(MEMN + (size_t)m * 2048, v, F.lane); } }
    if (F.bid == 0 && F.wave == 0) {
        const float* q1 = in[8]; const float* k1 = in[9]; const float* q2 = in[10]; const float* k2 = in[11];
        float d1 = q1[F.lane] * k1[F.lane] + q1[F.lane + 64] * k1[F.lane + 64], d2 = q2[F.lane] * k2[F.lane] + q2[F.lane + 64] * k2[F.lane + 64];
        d1 = wave_sum(d1); d2 = wave_sum(d2);
        if (F.lane == 0) F.ctl[CW_LAM] = __float_as_uint(expf(d1) - expf(d2) + 0.2f);
    }
    __syncthreads();
}

__device__ __forceinline__ void ml0_seq(Frame& F, const float* const* in, int s) {
    const int b = s >> 2, hh = s & 3;
    const float* MLG = (const float*)(F.ws + WS_MLG);
    float* KW = (float*)(F.ws + WS_SCKW); float* RS = (float*)(F.ws + WS_SCRS); float* IT = (float*)(F.ws + WS_SCIT); float* ED = (float*)(F.ws + WS_SCED); float* DEC = (float*)(F.ws + WS_DEC);
    LAS float* sm_bl = (LAS float*)F.lds; LAS float* sm_cm = sm_bl + 64; LAS float* sm_mp = sm_bl + 128; LAS float* sm_R = sm_bl + 192;
    const float big = in[6][hh], bfg = in[7][hh];
    float bl[8][4], gh[8][4], cm[8][4];
#pragma unroll
    for (int rd = 0; rd < 8; ++rd) {
        const int c = rd * 8 + F.wave; const size_t t0 = (size_t)b * SEQ + (size_t)c * 256 + 4 * F.lane;
        float lf[4], ig[4];
#pragma unroll
        for (int i = 0; i < 4; ++i) { const float fg = MLG[(t0 + i) * 8 + 4 + hh] + bfg; lf[i] = fminf(fg, 0.f) - log1pf(__expf(-fabsf(fg))); ig[i] = MLG[(t0 + i) * 8 + hh] + big; }
        float p[4]; p[0] = lf[0]; p[1] = p[0] + lf[1]; p[2] = p[1] + lf[2]; p[3] = p[2] + lf[3];
        float incl = p[3];
#pragma unroll
        for (int o = 1; o < 64; o <<= 1) { const float y = __shfl_up(incl, o); if (F.lane >= o) incl += y; }
        const float excl = incl - p[3];
#pragma unroll
        for (int i = 0; i < 4; ++i) { bl[rd][i] = excl + p[i]; gh[rd][i] = ig[i] - bl[rd][i]; }
        float q[4]; q[0] = gh[rd][0]; q[1] = fmaxf(q[0], gh[rd][1]); q[2] = fmaxf(q[1], gh[rd][2]); q[3] = fmaxf(q[2], gh[rd][3]);
        float im = q[3];
#pragma unroll
        for (int o = 1; o < 64; o <<= 1) { const float y = __shfl_up(im, o); if (F.lane >= o) im = fmaxf(im, y); }
        float em = __shfl_up(im, 1); if (F.lane == 0) em = -__builtin_inff();
#pragma unroll
        for (int i = 0; i < 4; ++i) cm[rd][i] = fmaxf(em, q[i]);
        if (F.lane == 63) { sm_bl[c] = bl[rd][3]; sm_cm[c] = cm[rd][3]; }
    }
    __syncthreads();
    if (F.tid == 0) { float M = 0.f; for (int c = 0; c < 64; ++c) { sm_mp[c] = M; const float R = fmaxf(M, sm_cm[c]); sm_R[c] = R; M = sm_bl[c] + R; } }
    __syncthreads();
#pragma unroll
    for (int rd = 0; rd < 8; ++rd) {
        const int c = rd * 8 + F.wave; const size_t idx = (size_t)hh * TT + (size_t)b * SEQ + (size_t)c * 256 + 4 * F.lane;
        const float Mp = sm_mp[c], R = sm_R[c];
        f32x4 kw, rs, it, ed;
#pragma unroll
        for (int i = 0; i < 4; ++i) { const float Gt = fmaxf(Mp, cm[rd][i]); kw[i] = __expf(gh[rd][i] - R); rs[i] = __expf(R - Gt); it[i] = __expf(Mp - Gt); ed[i] = __expf(-(bl[rd][i] + Gt)); }
        *(f32x4*)(KW + idx) = kw; *(f32x4*)(RS + idx) = rs; *(f32x4*)(IT + idx) = it; *(f32x4*)(ED + idx) = ed;
        if (F.lane == 0) DEC[s * 64 + c] = __expf(Mp - R);
    }
    __syncthreads();
}

__device__ __forceinline__ void unpack8(const u32x4 r, float (&x)[8]) { x[0] = bflo(r.x); x[1] = bfhi(r.x); x[2] = bflo(r.y); x[3] = bfhi(r.y); x[4] = bflo(r.z); x[5] = bfhi(r.z); x[6] = bflo(r.w); x[7] = bfhi(r.w); }
__device__ __forceinline__ void ml1_conv(Frame& F, const float* const* in, const int first, const int nstep) {
    const bf16_t* MQK = (const bf16_t*)(F.ws + WS_MQK);
    bf16_t* Q = (bf16_t*)(F.ws + WS_Q); bf16_t* WQ = (bf16_t*)(F.ws + WS_WQ); bf16_t* KWB = (bf16_t*)(F.ws + WS_KW); bf16_t* KWT = (bf16_t*)(F.ws + WS_KWT);
    const float* KWS = (const float*)(F.ws + WS_SCKW); const float* ITS = (const float*)(F.ws + WS_SCIT); float* KN4 = (float*)(F.ws + WS_KN);
    const float* cw = in[4]; const float* cbp = in[5];
    LAS unsigned char* stg = F.lds + F.wave * 16384;
    const int cl = F.lane & 15, tq = F.lane >> 4;
    for (int id = first; id < 8192; id += nstep) {
        const int g16 = id & 15, sc = id >> 4, kind = g16 >> 3, hh = (g16 >> 1) & 3, dl = (g16 & 1) * 128 + cl * 8, col = g16 * 128 + cl * 8;
        const size_t t0 = (size_t)sc * 64 + tq * 16, tr0 = (size_t)hh * TT + t0;
        const bool st = (t0 & (size_t)(SEQ - 1)) == 0;
        u32x4 xr[19];
#pragma unroll
        for (int i = 0; i < 19; ++i) { const size_t row = (st && i < 3) ? t0 : t0 + i - 3; xr[i] = *(const u32x4*)(MQK + row * 2048 + col); }
        float scl[16];
        { const float* sp = (kind ? KWS : ITS) + tr0;
#pragma unroll
          for (int j = 0; j < 4; ++j) { const f32x4 a = *(const f32x4*)(sp + 4 * j); scl[4 * j] = a.x; scl[4 * j + 1] = a.y; scl[4 * j + 2] = a.z; scl[4 * j + 3] = a.w; } }
        float w[4][8], cb[8], h3[8], h2[8], h1[8], cs[8];
#pragma unroll
        for (int j = 0; j < 4; ++j) { const f32x4 a = *(const f32x4*)(cw + j * 2048 + col), b = *(const f32x4*)(cw + j * 2048 + col + 4);
            w[j][0] = a.x; w[j][1] = a.y; w[j][2] = a.z; w[j][3] = a.w; w[j][4] = b.x; w[j][5] = b.y; w[j][6] = b.z; w[j][7] = b.w; }
        { const f32x4 a = *(const f32x4*)(cbp + col), b = *(const f32x4*)(cbp + col + 4); cb[0] = a.x; cb[1] = a.y; cb[2] = a.z; cb[3] = a.w; cb[4] = b.x; cb[5] = b.y; cb[6] = b.z; cb[7] = b.w; }
        unpack8(xr[0], h3); unpack8(xr[1], h2); unpack8(xr[2], h1);
        if (st) {
#pragma unroll
            for (int c = 0; c < 8; ++c) { h3[c] = 0.f; h2[c] = 0.f; h1[c] = 0.f; } }
#pragma unroll
        for (int c = 0; c < 8; ++c) cs[c] = 0.f;
#pragma unroll
        for (int hf = 0; hf < 2; ++hf) {
#pragma unroll
            for (int i8 = 0; i8 < 8; ++i8) { const int i = hf * 8 + i8;
                float xv[8], sv[8]; unpack8(xr[3 + i], xv);
#pragma unroll
                for (int c = 0; c < 8; ++c) { const float y = w[0][c] * h3[c] + w[1][c] * h2[c] + w[2][c] * h1[c] + w[3][c] * xv[c] + cb[c]; sv[c] = y * sigmoidf_(y); h3[c] = h2[c]; h2[c] = h1[c]; h1[c] = xv[c]; }
                const size_t tr = tr0 + i;
                if (kind == 0) { const float itv = scl[i];
                    u32x4 o; o.x = cvtpk(sv[0], sv[1]); o.y = cvtpk(sv[2], sv[3]); o.z = cvtpk(sv[4], sv[5]); o.w = cvtpk(sv[6], sv[7]); *(u32x4*)(Q + tr * 256 + dl) = o;
                    u32x4 p; p.x = cvtpk(sv[0] * itv, sv[1] * itv); p.y = cvtpk(sv[2] * itv, sv[3] * itv); p.z = cvtpk(sv[4] * itv, sv[5] * itv); p.w = cvtpk(sv[6] * itv, sv[7] * itv); *(u32x4*)(WQ + tr * 512 + 256 + dl) = p;
                } else { const float kwv = scl[i] * 0.0625f;
                    u32x4 o; o.x = cvtpk(sv[0] * kwv, sv[1] * kwv); o.y = cvtpk(sv[2] * kwv, sv[3] * kwv); o.z = cvtpk(sv[4] * kwv, sv[5] * kwv); o.w = cvtpk(sv[6] * kwv, sv[7] * kwv); *(u32x4*)(KWB + tr * 256 + dl) = o;
                    { LAS unsigned char* cp = stg + (cl * 8) * 128 + (((2 * tq + hf) ^ (cl & 7)) << 4) + i8 * 2;
                      *(LAS unsigned short*)(cp + 0 * 128) = (unsigned short)o.x; *(LAS unsigned short*)(cp + 1 * 128) = (unsigned short)(o.x >> 16);
                      *(LAS unsigned short*)(cp + 2 * 128) = (unsigned short)o.y; *(LAS unsigned short*)(cp + 3 * 128) = (unsigned short)(o.y >> 16);
                      *(LAS unsigned short*)(cp + 4 * 128) = (unsigned short)o.z; *(LAS unsigned short*)(cp + 5 * 128) = (unsigned short)(o.z >> 16);
                      *(LAS unsigned short*)(cp + 6 * 128) = (unsigned short)o.w; *(LAS unsigned short*)(cp + 7 * 128) = (unsigned short)(o.w >> 16); }
                    cs[0] += bflo(o.x); cs[1] += bfhi(o.x); cs[2] += bflo(o.y); cs[3] += bfhi(o.y); cs[4] += bflo(o.z); cs[5] += bfhi(o.z); cs[6] += bflo(o.w); cs[7] += bfhi(o.w); }
            }
        }
        if (kind == 1) {
            LDS_WAIT(); asm volatile("" ::: "memory");
            bf16_t* kt = KWT + (((size_t)hh * 128 + (sc >> 2)) * 256 + (g16 & 1) * 128) * 256 + (sc & 3) * 64;
#pragma unroll
            for (int q = 0; q < 16; ++q) { const int r = q * 8 + (F.lane >> 3), k = F.lane & 7;
                const u32x4 v = *(const LAS u32x4*)(stg + r * 128 + ((k ^ (q & 7)) << 4));
                *(u32x4*)(kt + (size_t)r * 256 + k * 8) = v; }
            LDS_WAIT(); asm volatile("" ::: "memory");
#pragma unroll
            for (int c = 0; c < 8; ++c) { cs[c] = xsum16(cs[c]); cs[c] = xsum32(cs[c]); }
            if (tq == 0) { float* kn = KN4 + (((size_t)hh * 128 + (sc >> 2)) * 4 + (sc & 3)) * 256 + dl;
                *(f32x4*)kn = (f32x4){cs[0], cs[1], cs[2], cs[3]}; *(f32x4*)(kn + 4) = (f32x4){cs[4], cs[5], cs[6], cs[7]}; }
        }
    }
}

__device__ __forceinline__ void nscan_seq(Frame& F, int s) {
    if (F.tid < 256) { const int hh = s & 3, b = s >> 2; const float* KN4 = (const float*)(F.ws + WS_KN); const float* DEC = (const float*)(F.ws + WS_DEC); float* NP = (float*)(F.ws + WS_NP);
        float n = 0.f;
        for (int c0 = 0; c0 < 64; c0 += 8) { float kn[8], dc[8];
#pragma unroll
            for (int i = 0; i < 8; ++i) { const float* p = KN4 + ((size_t)hh * 128 + b * 64 + c0 + i) * 1024 + F.tid; kn[i] = (p[0] + p[256]) + (p[512] + p[768]); dc[i] = DEC[s * 64 + c0 + i]; }
#pragma unroll
            for (int i = 0; i < 8; ++i) { NP[((size_t)s * 64 + c0 + i) * 256 + F.tid] = n; n = dc[i] * n + kn[i]; } }
    }
}
__device__ __forceinline__ void xsoftmax(Frame& F) {
    const bf16_t* XS = (const bf16_t*)(F.ws + WS_XS); bf16_t* XP = (bf16_t*)(F.ws + WS_XP);
    const int sub = F.lane >> 5, d8 = (F.lane & 31) * 8;
    for (int row0 = F.gw * 8; row0 < 4 * TT; row0 += F.NGW * 8) {
        u32x4 v[4];
#pragma unroll
        for (int i = 0; i < 4; ++i) v[i] = *(const u32x4*)(XS + (size_t)(row0 + 2 * i + sub) * 256 + d8);
#pragma unroll
        for (int i = 0; i < 4; ++i) { float x[8]; unpack8(v[i], x);
            float m = fmaxf(fmaxf(fmaxf(x[0], x[1]), fmaxf(x[2], x[3])), fmaxf(fmaxf(x[4], x[5]), fmaxf(x[6], x[7])));
#pragma unroll
            for (int o = 1; o < 32; o <<= 1) m = fmaxf(m, __shfl_xor(m, o));
            float s = 0.f;
#pragma unroll
            for (int c = 0; c < 8; ++c) { x[c] = __expf(x[c] - m); s += x[c]; }
#pragma unroll
            for (int o = 1; o < 32; o <<= 1) s += __shfl_xor(s, o);
            const float inv = 1.0f / s;
            u32x4 w; w.x = cvtpk(x[0] * inv, x[1] * inv); w.y = cvtpk(x[2] * inv, x[3] * inv); w.z = cvtpk(x[4] * inv, x[5] * inv); w.w = cvtpk(x[6] * inv, x[7] * inv);
            *(u32x4*)(XP + (size_t)(row0 + 2 * i + sub) * 256 + d8) = w; }
    }
}
__device__ __forceinline__ void cscan(Frame& F) {
    const bf16_t* U = (const bf16_t*)(F.ws + WS_U); bf16_t* VC = (bf16_t*)(F.ws + WS_VC); const float* DEC = (const float*)(F.ws + WS_DEC);
    for (int gid = F.bid * 512 + F.tid; gid < 131072; gid += F.G * 512) {
        const int s = gid >> 14, rem = gid & 16383, dv = rem >> 6, dk4 = (rem & 63) * 4, hh = s & 3, b = s >> 2;
        f32x4 C = {0.f, 0.f, 0.f, 0.f};
        for (int c0 = 0; c0 < 64; c0 += 8) { const size_t g0 = (size_t)hh * 128 + b * 64 + c0;
            f32x4 u[8]; float dc[8];
#pragma unroll
            for (int i = 0; i < 8; ++i) { const u32x2 w = *(const u32x2*)(U + (g0 + i) * 65536 + (size_t)dv * 256 + dk4); u[i] = (f32x4){bflo(w.x), bfhi(w.x), bflo(w.y), bfhi(w.y)}; dc[i] = DEC[s * 64 + c0 + i]; }
#pragma unroll
            for (int i = 0; i < 8; ++i) { u32x2 w; w.x = cvtpk(C.x, C.y); w.y = cvtpk(C.z, C.w); *(u32x2*)(VC + ((g0 + i) * 256 + dv) * 512 + 256 + dk4) = w; C = C * dc[i] + u[i]; } }
    }
}
__device__ __forceinline__ void denpass(Frame& F) {
    const bf16_t* WQ = (const bf16_t*)(F.ws + WS_WQ); const float* NP = (const float*)(F.ws + WS_NP); const float* ED = (const float*)(F.ws + WS_SCED); float* HDEN = (float*)(F.ws + WS_HDEN);
    for (int row0 = F.gw * 4; row0 < 4 * TT; row0 += F.NGW * 4) {
        const int hh = row0 / TT, t = row0 - hh * TT, b = t / SEQ, c = (t - b * SEQ) >> 8;
        u32x4 w[4]; f32x4 n0 = {0.f, 0.f, 0.f, 0.f}, n1 = {0.f, 0.f, 0.f, 0.f};
#pragma unroll
        for (int i = 0; i < 4; ++i) w[i] = *(const u32x4*)(WQ + (size_t)(row0 + i) * 512 + 8 * F.lane);
        if (F.lane >= 32) { const float* np = NP + ((size_t)(b * 4 + hh) * 64 + c) * 256 + 8 * (F.lane - 32); n0 = *(const f32x4*)np; n1 = *(const f32x4*)(np + 4); }
        else { n0 = (f32x4){1.f, 1.f, 1.f, 1.f}; n1 = n0; }
        const float edv = ED[row0 + (F.lane & 3)];
#pragma unroll
        for (int i = 0; i < 4; ++i) {
            const float part = ((bflo(w[i].x) * n0.x + bfhi(w[i].x) * n0.y) + (bflo(w[i].y) * n0.z + bfhi(w[i].y) * n0.w)) + ((bflo(w[i].z) * n1.x + bfhi(w[i].z) * n1.y) + (bflo(w[i].w) * n1.z + bfhi(w[i].w) * n1.w));
            const float den = wave_sum(part);
            if (F.lane == i) HDEN[row0 + i] = fmaxf(fabsf(den), edv); }
    }
}
__device__ __forceinline__ void hmnorm(Frame& F, const float* const* in) {
    bf16_t* HR = (bf16_t*)(F.dout + DO_HR); const bf16_t* MLO = (const bf16_t*)(F.ws + WS_MLO); const float* g = in[13];
    const int sub = F.lane >> 5, d8 = (F.lane & 31) * 8;
    for (int row0 = F.gw * 8; row0 < 4 * TT; row0 += F.NGW * 8) {
        u32x4 xw[4], ow[4];
#pragma unroll
        for (int i = 0; i < 4; ++i) { const int row = row0 + 2 * i + sub; const size_t o = (size_t)(row >> 2) * 1024 + (row & 3) * 256 + d8; xw[i] = *(const u32x4*)(HR + o); ow[i] = *(const u32x4*)(MLO + o); }
#pragma unroll
        for (int i = 0; i < 4; ++i) { const int row = row0 + 2 * i + sub, hh = row & 3; const size_t o = (size_t)(row >> 2) * 1024 + hh * 256 + d8;
            float x[8], og[8]; unpack8(xw[i], x); unpack8(ow[i], og);
            float ss = ((x[0] * x[0] + x[1] * x[1]) + (x[2] * x[2] + x[3] * x[3])) + ((x[4] * x[4] + x[5] * x[5]) + (x[6] * x[6] + x[7] * x[7]));
            ss += __shfl_xor(ss, 1); ss += __shfl_xor(ss, 2); ss += __shfl_xor(ss, 4); ss += __shfl_xor(ss, 8); ss += __shfl_xor(ss, 16);
            const float r = rsqrtf(ss * (1.0f / 256.0f) + EPS);
            const f32x4 g0 = *(const f32x4*)(g + hh * 256 + d8), g1 = *(const f32x4*)(g + hh * 256 + d8 + 4);
            u32x4 w; w.x = cvtpk(sigmoidf_(og[0]) * x[0] * r * g0.x, sigmoidf_(og[1]) * x[1] * r * g0.y); w.y = cvtpk(sigmoidf_(og[2]) * x[2] * r * g0.z, sigmoidf_(og[3]) * x[3] * r * g0.w);
            w.z = cvtpk(sigmoidf_(og[4]) * x[4] * r * g1.x, sigmoidf_(og[5]) * x[5] * r * g1.y); w.w = cvtpk(sigmoidf_(og[6]) * x[6] * r * g1.z, sigmoidf_(og[7]) * x[7] * r * g1.w);
            *(u32x4*)(HR + o) = w; }
    }
}
__device__ __forceinline__ unsigned fkey(float f) { const unsigned u = __float_as_uint(f); return (u & 0x80000000u) ? ~u : (u | 0x80000000u); }
__device__ __forceinline__ float fkey_inv(unsigned k) { return __uint_as_float((k & 0x80000000u) ? (k & 0x7fffffffu) : ~k); }
__device__ __forceinline__ float dot8(const u32x4 a, const u32x4 b) {
    return ((bflo(a.x) * bflo(b.x) + bfhi(a.x) * bfhi(b.x)) + (bflo(a.y) * bflo(b.y) + bfhi(a.y) * bfhi(b.y))) + ((bflo(a.z) * bflo(b.z) + bfhi(a.z) * bfhi(b.z)) + (bflo(a.w) * bflo(b.w) + bfhi(a.w) * bfhi(b.w))); }
__device__ __forceinline__ void normmax(Frame& F) {
    if (F.G != 256) return;
    LAS float* red = (LAS float*)F.lds;
    const bf16_t* DQ = (const bf16_t*)(F.ws + WS_DQ); const bf16_t* DK = (const bf16_t*)(F.ws + WS_DK);
    const int r32 = F.lane & 31, hi = F.lane >> 5, g = F.wave & 3;
    const int tq0 = F.bid * 128 + 32 * g, bstart = ((F.bid * 128) / SEQ) * SEQ;
    const float NEG = -__builtin_inff();
    for (int ci = 0; ci < 8; ++ci) {
        const int c16 = (F.wave >> 2) * 8 + ci;
        const bf16_t* Qc = DQ + (size_t)c16 * TT * 128; const bf16_t* Kc = DK + (size_t)c16 * TT * 128;
        const float slope = exp2f(-(float)((c16 >> 1) + 1));
        bf16x8 qf[8], kf[3][8];
#pragma unroll
        for (int kk = 0; kk < 8; ++kk) qf[kk] = *(const bf16x8*)(Qc + (size_t)(tq0 + r32) * 128 + kk * 16 + hi * 8);
#pragma unroll
        for (int u = 0; u < 3; ++u) { const int ks = tq0 - 32 * (2 - u) >= bstart ? tq0 - 32 * (2 - u) : tq0;
#pragma unroll
            for (int kk = 0; kk < 8; ++kk) kf[u][kk] = *(const bf16x8*)(Kc + (size_t)(ks + r32) * 128 + kk * 16 + hi * 8); }
        float q2 = 0.f, k2 = 0.f;
#pragma unroll
        for (int kk = 0; kk < 8; ++kk) { q2 += dot8(__builtin_bit_cast(u32x4, qf[kk]), __builtin_bit_cast(u32x4, qf[kk])); k2 += dot8(__builtin_bit_cast(u32x4, kf[2][kk]), __builtin_bit_cast(u32x4, kf[2][kk])); }
        q2 = xsum32(q2); k2 = xsum32(k2);
        float vals[3][16]; float m = NEG;
#pragma unroll
        for (int u = 0; u < 3; ++u) { f32x16 acc = {};
#pragma unroll
            for (int kk = 0; kk < 8; ++kk) acc = __builtin_amdgcn_mfma_f32_32x32x16_bf16(kf[u][kk], qf[kk], acc, 0, 0, 0);
            const bool gv = tq0 - 32 * (2 - u) >= bstart;
#pragma unroll
            for (int r = 0; r < 16; ++r) { const int dist = 32 * (2 - u) + r32 - attn::crow(r, hi);
                const float v = (gv && dist >= 0) ? acc[r] * attn::SCALE - slope * (float)dist : NEG; vals[u][r] = v; m = fmaxf(m, v); } }
        const float ms = (m == NEG) ? 0.f : m; float l = 0.f;
#pragma unroll
        for (int u = 0; u < 3; ++u) {
#pragma unroll
            for (int r = 0; r < 16; ++r) l += __expf(vals[u][r] - ms); }
        const float mo = __shfl_xor(m, 32), lo = __shfl_xor(l, 32);
        const float M = fmaxf(m, mo);
        const float L = l * __expf(ms - M) * (m == NEG ? 0.f : 1.f) + lo * ((mo == NEG) ? 0.f : __expf(mo - M));
        float nlb = -(M + __logf(L));
        q2 = wave_max(q2); k2 = wave_max(k2); nlb = wave_max(nlb);
        if (F.lane == 0) { red[F.wave * 48 + c16] = q2; red[F.wave * 48 + 16 + c16] = k2; red[F.wave * 48 + 32 + c16] = nlb; }
    }
    __syncthreads();
    if (F.tid < 48) {
        const int blk = F.bid >> 1, b = (F.bid * 128) / SEQ, kind = F.tid >> 4, c16 = F.tid & 15, w0 = (c16 >> 3) * 4;
        float a = red[w0 * 48 + F.tid];
#pragma unroll
        for (int w = 1; w < 4; ++w) a = fmaxf(a, red[(w0 + w) * 48 + F.tid]);
        if (kind == 0) atomicMax(F.ctl + CW_QB2 + c16 * 128 + blk, __float_as_uint(a));
        else if (kind == 1) F.ctl[CW_KT + (c16 * 2 + b) * 128 + (F.bid - b * (SEQ / 128))] = __float_as_uint(a);
        else atomicMax(F.ctl + CW_ND + c16 * 128 + blk, fkey(a));
    }
    __syncthreads();
}
__device__ __forceinline__ attn4::Item attn_item(Frame& F, int b, int h, int qb, int m) {
    const bf16_t* DQ = (const bf16_t*)(F.ws + WS_DQ); const bf16_t* DK = (const bf16_t*)(F.ws + WS_DK); const bf16_t* DV = (const bf16_t*)(F.ws + WS_DV); bf16_t* O = (bf16_t*)(F.ws + WS_O);
    attn4::Item it; const size_t srow = (size_t)b * SEQ;
    it.Q = DQ + ((size_t)(h * 2 + m) * TT + srow + (size_t)qb * 128) * 128;
    it.K = DK + ((size_t)(h * 2 + m) * TT + srow) * 128;
    it.V0 = DV + ((size_t)(h * 2 + 0) * TT + srow) * 128;
    it.V1 = DV + ((size_t)(h * 2 + 1) * TT + srow) * 128;
    it.O = O + ((size_t)(h * 2 + m) * TT + srow + (size_t)qb * 128) * 256;
    it.P0 = qb * 128; it.olds = 1;
    const int c16 = h * 2 + m, blk = b * 64 + (qb >> 1);
    const float q2 = __uint_as_float(F.ctl[CW_QB2 + c16 * 128 + blk]), k2 = ((const LAS float*)(F.lds + KMX_LDS))[c16 * 2 + b], ndg = fkey_inv(F.ctl[CW_ND + c16 * 128 + blk]);
    const float slope = exp2f(-(float)(h + 1));
    const float bnd = sqrtf(q2) * sqrtf(k2) * attn::SCALE + ndg + 18.05f - logf(1.0f - expf(-slope));
    float wf = ceilf(bnd / slope) + 1.0f; if (!(wf < (float)SEQ)) wf = (float)SEQ; if (!(wf >= 1.0f)) wf = 1.0f;
    if (F.G != 256) wf = (float)SEQ;
    it.W = (int)wf; it.sl = slope / attn::SCALE;
    return it;
}
__device__ __forceinline__ void dacombine_tile(Frame& F, int b, int h, int qb) {
    const bf16_t* O = (const bf16_t*)(F.ws + WS_O); unsigned char* DA = F.ws + WS_DA; const float* g = F.gdiff;
    const float lam = __uint_as_float(F.ctl[CW_LAM]);
    const int sub = F.lane >> 5, d8 = (F.lane & 31) * 8;
    const f32x4 g0 = *(const f32x4*)(g + h * 256 + d8) * 0.8f, g1 = *(const f32x4*)(g + h * 256 + d8 + 4) * 0.8f;
    const size_t t0 = (size_t)b * SEQ + (size_t)qb * 128 + F.wave * 16 + sub;
    const bf16_t* O0 = O + ((size_t)(h * 2 + 0) * TT + t0) * 256 + d8; const LAS bf16_t* O1 = (const LAS bf16_t*)F.lds + (F.wave * 16 + sub) * 256 + d8;
#pragma nounroll
    for (int i4 = 0; i4 < 8; i4 += 4) {
    u32x4 a[4], bq[4];
#pragma unroll
    for (int i = 0; i < 4; ++i) { a[i] = *(const u32x4*)(O0 + (size_t)(i4 + i) * 512); bq[i] = *(const LAS u32x4*)(O1 + (i4 + i) * 512); }
#pragma unroll
    for (int j = 0; j < 4; ++j) { const int i = i4 + j;
        float x[8], y[8]; unpack8(a[j], x); unpack8(bq[j], y);
#pragma unroll
        for (int c = 0; c < 8; ++c) x[c] -= lam * y[c];
        float ss = ((x[0] * x[0] + x[1] * x[1]) + (x[2] * x[2] + x[3] * x[3])) + ((x[4] * x[4] + x[5] * x[5]) + (x[6] * x[6] + x[7] * x[7]));
        ss += DPP_F(ss, 0xB1); ss += DPP_F(ss, 0x4E); ss += DPP_F(ss, 0x124); ss += DPP_F(ss, 0x128);
        { const int iv = __builtin_bit_cast(int, ss);
          const float h0 = __builtin_bit_cast(float, __builtin_amdgcn_readlane(iv, 0)) + __builtin_bit_cast(float, __builtin_amdgcn_readlane(iv, 16)), h1 = __builtin_bit_cast(float, __builtin_amdgcn_readlane(iv, 32)) + __builtin_bit_cast(float, __builtin_amdgcn_readlane(iv, 48));
          ss = sub ? h1 : h0; }
        const float r = rsqrtf(ss * (1.0f / 256.0f) + EPS);
        u32x2 w; w.x = pk4_fp8(x[0] * r * g0.x, x[1] * r * g0.y, x[2] * r * g0.z, x[3] * r * g0.w); w.y = pk4_fp8(x[4] * r * g1.x, x[5] * r * g1.y, x[6] * r * g1.z, x[7] * r * g1.w);
        *(u32x2*)(DA + (t0 + 2 * i) * 2048 + h * 256 + d8) = w; }
    }
}
__device__ __forceinline__ int attn_ticket(Frame& F, int rep, int& myq) {
    if (F.tid == 0) { int res = -1;
        for (int k = 0; k < 8; ++k) { const int q = (myq + k) & 7; const unsigned t = atomicAdd(F.ctl + CW_AHEAD + rep * 64 + q * 8, 1u); if (t < 256u) { res = q * 256 + (int)t; break; } }
        F.MISC[0] = (unsigned)res; }
    __syncthreads();
    const int v = __builtin_amdgcn_readfirstlane((int)F.MISC[0]);
    __syncthreads();
    if (v >= 0) myq = v >> 8;
    return v;
}
__device__ __forceinline__ void attn_phase(Frame& F, int rep) {
    const int tid = F.tid; int myq = F.bid & 7;
    { const int ent = F.tid >> 4, sub = F.tid & 15; float m = 0.f;
#pragma unroll
      for (int j = 0; j < 8; ++j) m = fmaxf(m, __uint_as_float(F.ctl[CW_KT + ent * 128 + sub * 8 + j]));
      m = fmaxf(m, __shfl_xor(m, 1)); m = fmaxf(m, __shfl_xor(m, 2)); m = fmaxf(m, __shfl_xor(m, 4)); m = fmaxf(m, __shfl_xor(m, 8));
      if (sub == 0) ((LAS float*)(F.lds + KMX_LDS))[ent] = m;
      __syncthreads(); }
    for (;;) {
        const int id = attn_ticket(F, rep, myq);
        if (id < 0) break;
#define A_DEC(id_) const int qx = (id_) >> 8, x = (id_) & 255, b = qx >> 2, h = 7 - (2 * (x >> 6) + ((qx >> 1) & 1)), qb = 2 * (63 - (x & 63)) + (qx & 1)
#pragma nounroll
        for (int m = 0; m < 2; ++m) { const int idm = __builtin_amdgcn_readfirstlane((int)F.MISC[0]);
            A_DEC(idm); const attn4::Item it = attn_item(F, b, h, qb, m); attn4::item(it, (char*)F.lds_g, F.lds, tid);
            if (m == 0) {
                bf16_t* Ob = it.O; u32x4 cv[8];
#pragma unroll
                for (int j = 0; j < 8; ++j) cv[j] = *(const LAS u32x4*)(F.lds + (size_t)(tid + 512 * j) * 16);
#pragma unroll
                for (int j = 0; j < 8; ++j) *(u32x4*)(Ob + (size_t)(tid + 512 * j) * 8) = cv[j];
                __syncthreads(); } }
        { const int idc = __builtin_amdgcn_readfirstlane((int)F.MISC[0]); A_DEC(idc);
          dacombine_tile(F, b, h, qb); }
#undef A_DEC
    }
    VM_WAIT(); __syncthreads();
}
__device__ __forceinline__ void dacombine(Frame& F, const float* const* in, const bf16_t* O, bf16_t* DA) {
    const float* g = in[12];
    const float lam = __uint_as_float(F.ctl[CW_LAM]);
    const int sub = F.lane >> 5, d8 = (F.lane & 31) * 8;
    const int h = F.gw & 7;
    const f32x4 g0 = *(const f32x4*)(g + h * 256 + d8) * 0.8f, g1 = *(const f32x4*)(g + h * 256 + d8 + 4) * 0.8f;
    const bf16_t* O0 = O + (size_t)(h * 2 + 0) * TT * 256 + d8; const bf16_t* O1 = O + (size_t)(h * 2 + 1) * TT * 256 + d8;
    u32x4 a[4], bq[4];
#define DAC_LOAD(tb_, A_, B_) _Pragma("unroll") for (int i = 0; i < 4; ++i) { const size_t t = (size_t)(tb_) * 8 + 2 * i + sub; A_[i] = *(const u32x4*)(O0 + t * 256); B_[i] = *(const u32x4*)(O1 + t * 256); }
    const int tstep = F.NGW >> 3;
    DAC_LOAD(F.gw >> 3, a, bq);
    for (int tb = F.gw >> 3; tb < TT / 8; tb += tstep) {
        u32x4 an[4], bn[4];
        { const int tn = tb + tstep < TT / 8 ? tb + tstep : tb;
          DAC_LOAD(tn, an, bn); }
#pragma unroll
        for (int i = 0; i < 4; ++i) { const size_t t = (size_t)tb * 8 + 2 * i + sub;
            float x[8], y[8]; unpack8(a[i], x); unpack8(bq[i], y);
#pragma unroll
            for (int c = 0; c < 8; ++c) x[c] -= lam * y[c];
            float ss = ((x[0] * x[0] + x[1] * x[1]) + (x[2] * x[2] + x[3] * x[3])) + ((x[4] * x[4] + x[5] * x[5]) + (x[6] * x[6] + x[7] * x[7]));
            ss += DPP_F(ss, 0xB1); ss += DPP_F(ss, 0x4E); ss += DPP_F(ss, 0x124); ss += DPP_F(ss, 0x128);
            { const int iv = __builtin_bit_cast(int, ss);
              const float h0 = __builtin_bit_cast(float, __builtin_amdgcn_readlane(iv, 0)) + __builtin_bit_cast(float, __builtin_amdgcn_readlane(iv, 16)), h1 = __builtin_bit_cast(float, __builtin_amdgcn_readlane(iv, 32)) + __builtin_bit_cast(float, __builtin_amdgcn_readlane(iv, 48));
              ss = sub ? h1 : h0; }
            const float r = rsqrtf(ss * (1.0f / 256.0f) + EPS);
            u32x2 w; w.x = pk4_fp8(x[0] * r * g0.x, x[1] * r * g0.y, x[2] * r * g0.z, x[3] * r * g0.w); w.y = pk4_fp8(x[4] * r * g1.x, x[5] * r * g1.y, x[6] * r * g1.z, x[7] * r * g1.w);
            *(u32x2*)((unsigned char*)DA + t * 2048 + h * 256 + d8) = w; }
#pragma unroll
        for (int i = 0; i < 4; ++i) { a[i] = an[i]; bq[i] = bn[i]; }
    }
#undef DAC_LOAD
}
#ifndef P9DUP
#define P9DUP 0
#endif
__device__ __forceinline__ void expert_convert(Frame& F, const float* const* in, const int parts = 3) {
    LAS float* scr = (LAS float*)(F.lds + F.wave * 16384);
    unsigned char* WGU = F.ws + WS_WGU; unsigned char* WD = F.ws + WS_WD;
    constexpr int PER = 22528;
    if (parts & 1) { struct Dec { const float* const* in; unsigned char* WGU; unsigned char* WD; int lane;
        __device__ __forceinline__ TrD operator()(int it) const {
            const int kind = it / PER, r = it - kind * PER, e = r / 704, r2 = r - e * 704;
            if (kind < 2) { const int kb = r2 / 22, nb = r2 - kb * 22, pn = nb >> 2;
                return tr_desc((kind == 0 ? in[26] : in[27]) + (size_t)e * 2048 * DEXP, DEXP, 0, WGU, 2048, e * GU_N + pn * 128 + kind * 128, kb, nb, 32.0f, 1, lane); }
            const int kb = r2 >> 6, nb = r2 & 63;
            return tr_desc(in[28] + (size_t)e * DEXP * 2048, 2048, 0, WD + (size_t)e * 2048 * DEXP_P, DEXP_P, 0, kb, nb, 16.0f, 1, lane); } };
      const Dec dec{in, WGU, WD, F.lane};
      for (int rr_ = 0; rr_ < 1 + ((P9DUP >> 1) & 1); ++rr_) tr_run(F.gw, 3 * PER, F.NGW, dec, scr, F.lane);
    const u32x4 z = {0u, 0u, 0u, 0u};
    for (int idx = F.bid * 512 + F.tid; idx < 32 * 2 * 64 * 128; idx += F.G * 512) { const int e = idx >> 14, rem = idx & 16383, blk = rem >> 13, row = (rem >> 7) & 63, c16 = rem & 127;
        *(u32x4*)(WGU + ((size_t)e * GU_N + 1280 + blk * 128 + 64 + row) * 2048 + c16 * 16) = z; }
    for (int idx = F.bid * 512 + F.tid; idx < 32 * 2048 * 4; idx += F.G * 512) { const int en = idx >> 2, j = idx & 3;
        *(u32x4*)(WD + (size_t)en * DEXP_P + DEXP + j * 16) = z; }
    }
    if (parts & 2) { const bf16_t* HBF = (const bf16_t*)(F.dout + DO_HBF); unsigned char* H8 = F.ws + WS_HBF8;
      const size_t stride = (size_t)F.NGW * 64 * 4;
      for (int rr_ = 0; rr_ < 1 + ((P9DUP >> 2) & 1); ++rr_)
      for (size_t g8 = (size_t)(F.gw * 64 + F.lane) * 4; g8 < (size_t)TT * 256; g8 += 4 * stride) {
          u32x4 a[4][4];
#pragma unroll
          for (int j = 0; j < 4; ++j) { const size_t gj = g8 + j * stride < (size_t)TT * 256 ? g8 + j * stride : g8;
#pragma unroll
              for (int i = 0; i < 4; ++i) a[j][i] = *(const u32x4*)(HBF + (gj + i) * 8); }
#pragma unroll
          for (int j = 0; j < 4; ++j) { const size_t gj = g8 + j * stride;
              if (gj < (size_t)TT * 256) { u32x4 o0, o1;
                  o0.x = pk4_fp8(bflo(a[j][0].x), bfhi(a[j][0].x), bflo(a[j][0].y), bfhi(a[j][0].y)); o0.y = pk4_fp8(bflo(a[j][0].z), bfhi(a[j][0].z), bflo(a[j][0].w), bfhi(a[j][0].w));
                  o0.z = pk4_fp8(bflo(a[j][1].x), bfhi(a[j][1].x), bflo(a[j][1].y), bfhi(a[j][1].y)); o0.w = pk4_fp8(bflo(a[j][1].z), bfhi(a[j][1].z), bflo(a[j][1].w), bfhi(a[j][1].w));
                  o1.x = pk4_fp8(bflo(a[j][2].x), bfhi(a[j][2].x), bflo(a[j][2].y), bfhi(a[j][2].y)); o1.y = pk4_fp8(bflo(a[j][2].z), bfhi(a[j][2].z), bflo(a[j][2].w), bfhi(a[j][2].w));
                  o1.z = pk4_fp8(bflo(a[j][3].x), bfhi(a[j][3].x), bflo(a[j][3].y), bfhi(a[j][3].y)); o1.w = pk4_fp8(bflo(a[j][3].z), bfhi(a[j][3].z), bflo(a[j][3].w), bfhi(a[j][3].w));
                  *(u32x4*)(H8 + gj * 8) = o0; *(u32x4*)(H8 + gj * 8 + 16) = o1; } } } }
    __syncthreads();
}
__device__ __forceinline__ void topk_pass(Frame& F, const float* const* in, int tbeg, int tend) {
    const float* LG = (const float*)(F.ws + WS_LG); int* TOKE = (int*)(F.ws + WS_TOKE); float* TOKW = (float*)(F.ws + WS_TOKW); const float* RSS = (const float*)(F.ws + WS_RSS); float* RT = (float*)(F.ws + WS_RT);
    LAS unsigned* hist = (LAS unsigned*)F.lds;
    if (F.tid < 64) hist[F.tid] = 0u;
    __syncthreads();
    const float* brg = in[23]; const float* bre = in[25];
    for (int t = tbeg + F.tid; t < tend; t += 512) {
        const float* lp = LG + (size_t)t * 256;
        float rt; { const f32x4* rs = (const f32x4*)(RSS + (size_t)t * 32); f32x4 a = rs[0];
#pragma unroll
            for (int j = 1; j < 8; ++j) a += rs[j];
            rt = rsqrtf(((a.x + a.y) + (a.z + a.w)) * (1.0f / 2048.0f) + EPS); RT[t] = rt; }
        const f32x4 g4 = *(const f32x4*)lp * rt;
        const float g0 = g4.x + brg[0], g1 = g4.y + brg[1], g2 = g4.z + brg[2], g3 = g4.w + brg[3];
        int grp = 0; float gm = g0; if (g1 > gm) { gm = g1; grp = 1; } if (g2 > gm) { gm = g2; grp = 2; } if (g3 > gm) { gm = g3; grp = 3; }
        const float pg = 1.0f / (expf(g0 - gm) + expf(g1 - gm) + expf(g2 - gm) + expf(g3 - gm));
        const f32x4 ea = *(const f32x4*)(lp + 4 + grp * 8) * rt, eb = *(const f32x4*)(lp + 8 + grp * 8) * rt;
        const f32x4 ba = *(const f32x4*)(bre + grp * 8), bb = *(const f32x4*)(bre + grp * 8 + 4);
        float ev[8] = {ea.x + ba.x, ea.y + ba.y, ea.z + ba.z, ea.w + ba.w, eb.x + bb.x, eb.y + bb.y, eb.z + bb.z, eb.w + bb.w};
        int i1 = 0; float v1 = ev[0];
#pragma unroll
        for (int j = 1; j < 8; ++j) if (ev[j] > v1) { v1 = ev[j]; i1 = j; }
        int i2 = -1; float v2 = -__builtin_inff();
#pragma unroll
        for (int j = 0; j < 8; ++j) if (j != i1 && ev[j] > v2) { v2 = ev[j]; i2 = j; }
        const float ex = expf(v2 - v1), inv = 1.0f / (1.0f + ex);
        const int e1 = grp * 8 + i1, e2 = grp * 8 + i2;
        TOKE[t * 2] = e1; TOKE[t * 2 + 1] = e2; TOKW[t * 2] = inv * pg; TOKW[t * 2 + 1] = ex * inv * pg;
        const int hf = ((t - tbeg) >> 7) & 1;
        __hip_atomic_fetch_add(&hist[hf * 32 + e1], 1u, __ATOMIC_RELAXED, __HIP_MEMORY_SCOPE_WORKGROUP); __hip_atomic_fetch_add(&hist[hf * 32 + e2], 1u, __ATOMIC_RELAXED, __HIP_MEMORY_SCOPE_WORKGROUP);
    }
    __syncthreads();
    if (F.tid < 32 && (hist[F.tid] + hist[32 + F.tid])) atomicAdd(F.ctl + CW_ECNT + F.tid, hist[F.tid] + hist[32 + F.tid]);
    if (F.tid < 64) F.ctl[CW_CH + ((tbeg >> 7) + (F.tid >> 5)) * 32 + (F.tid & 31)] = hist[F.tid];
    __syncthreads();
}
__device__ __forceinline__ void gather_pass(Frame& F, const float* const* in) {
    const int* TOKE = (const int*)(F.ws + WS_TOKE); const float* TOKW = (const float*)(F.ws + WS_TOKW); int* POS = (int*)(F.ws + WS_POS); float* WROW = (float*)(F.ws + WS_WROW); int* TILEE = (int*)(F.ws + WS_TILEE);
    const bf16_t* X1B = (const bf16_t*)(F.ws + WS_X1B); const float* RT = (const float*)(F.ws + WS_RT); unsigned char* XSORT = F.ws + WS_XSORT;
    float gf[32];
#pragma unroll
    for (int j = 0; j < 8; ++j) { const f32x4 g = *(const f32x4*)(in[21] + 32 * F.lane + 4 * j); gf[4 * j] = g.x; gf[4 * j + 1] = g.y; gf[4 * j + 2] = g.z; gf[4 * j + 3] = g.w; }
    LAS unsigned* pstart = (LAS unsigned*)F.lds; LAS unsigned* hist = pstart + 32; LAS unsigned* base = pstart + 64; LAS unsigned* lcur = pstart + 96; LAS int* apos = (LAS int*)(pstart + 128); LAS int* atok = apos + 512;
    LAS unsigned* ecnt = pstart + 2048; LAS unsigned* part = pstart + 2112;
    if (F.tid < 32) ecnt[F.tid] = F.ctl[CW_ECNT + F.tid];
    const bool det = (F.G == 256);
    if (det) { const int e = F.tid & 31, pt = F.tid >> 5; unsigned sum = 0;
#pragma unroll
        for (int j = 0; j < 16; ++j) { const int hq = pt + 16 * j; sum += (hq < F.bid) ? F.ctl[CW_CH + hq * 32 + e] : 0u; }
        part[pt * 32 + e] = sum; }
    __syncthreads();
    if (F.tid == 0) { unsigned acc = 0; for (int e = 0; e < 32; ++e) { pstart[e] = acc; const unsigned c = ecnt[e]; const unsigned pc = (c + 255u) & ~255u;
            if (F.bid == 0) for (unsigned rt = acc >> 8; rt < (acc + pc) >> 8; ++rt) TILEE[rt] = e;
            acc += pc; }
        if (F.bid == 0) F.ctl[CW_NRT] = acc >> 8; }
    if (det && F.tid >= 64 && F.tid < 96) { const int e = F.tid - 64; unsigned sum = 0;
#pragma unroll
        for (int j = 0; j < 16; ++j) sum += part[j * 32 + e];
        part[512 + e] = sum; }
    const int per = (TT + F.G - 1) / F.G;
    const int tbeg = F.bid * per, tend = (tbeg + per < TT) ? tbeg + per : TT;
    for (int ts = tbeg; ts < tend; ts += 256) {
        const int nasg = 2 * ((tend - ts < 256) ? tend - ts : 256);
        if (F.tid < 32) { hist[F.tid] = 0u; lcur[F.tid] = 0u; }
        __syncthreads();
        int e = 0; const int a = F.tid;
        if (a < nasg) { e = TOKE[ts * 2 + a]; __hip_atomic_fetch_add(&hist[e], 1u, __ATOMIC_RELAXED, __HIP_MEMORY_SCOPE_WORKGROUP); }
        __syncthreads();
        if (F.tid < 32) base[F.tid] = pstart[F.tid] + (det ? part[512 + F.tid] : (hist[F.tid] ? atomicAdd(F.ctl + CW_ECUR + F.tid, hist[F.tid]) : 0u));
        __syncthreads();
        if (a < nasg) { const unsigned p = base[e] + __hip_atomic_fetch_add(&lcur[e], 1u, __ATOMIC_RELAXED, __HIP_MEMORY_SCOPE_WORKGROUP); POS[ts * 2 + a] = (int)p; WROW[p] = TOKW[ts * 2 + a]; apos[a] = (int)p; atok[a] = ts + (a >> 1); }
        __syncthreads();
        for (int i = F.wave; i < nasg; i += 8) { const int tok = atok[i]; const u32x4* src = (const u32x4*)(X1B + (size_t)tok * 2048) + 4 * F.lane; u32x4* dst = (u32x4*)(XSORT + (size_t)apos[i] * 2048) + 2 * F.lane;
            u32x4 a[4]; const float rt = RT[tok];
#pragma unroll
            for (int j = 0; j < 4; ++j) a[j] = src[j];
            unsigned o[8];
#pragma unroll
            for (int j = 0; j < 4; ++j) {
                o[2 * j]     = pk4_fp8(bflo(a[j].x) * rt * gf[8 * j],     bfhi(a[j].x) * rt * gf[8 * j + 1], bflo(a[j].y) * rt * gf[8 * j + 2], bfhi(a[j].y) * rt * gf[8 * j + 3]);
                o[2 * j + 1] = pk4_fp8(bflo(a[j].z) * rt * gf[8 * j + 4], bfhi(a[j].z) * rt * gf[8 * j + 5], bflo(a[j].w) * rt * gf[8 * j + 6], bfhi(a[j].w) * rt * gf[8 * j + 7]); }
            u32x4 o0, o1; o0.x = o[0]; o0.y = o[1]; o0.z = o[2]; o0.w = o[3]; o1.x = o[4]; o1.y = o[5]; o1.z = o[6]; o1.w = o[7];
            dst[0] = o0; dst[1] = o1; }
        __syncthreads();
    }
}
__device__ __forceinline__ void unpack8_fp8(const u32x2 w, float (&x)[8]) {
    x[0] = __builtin_amdgcn_cvt_f32_fp8((int)w.x, 0); x[1] = __builtin_amdgcn_cvt_f32_fp8((int)w.x, 1); x[2] = __builtin_amdgcn_cvt_f32_fp8((int)w.x, 2); x[3] = __builtin_amdgcn_cvt_f32_fp8((int)w.x, 3);
    x[4] = __builtin_amdgcn_cvt_f32_fp8((int)w.y, 0); x[5] = __builtin_amdgcn_cvt_f32_fp8((int)w.y, 1); x[6] = __builtin_amdgcn_cvt_f32_fp8((int)w.y, 2); x[7] = __builtin_amdgcn_cvt_f32_fp8((int)w.y, 3); }
__device__ __forceinline__ void final_pass(Frame& F, const float* const* in) {
    const bf16_t* X1B = (const bf16_t*)(F.ws + WS_X1B); float* OUT = (float*)F.dout; const unsigned char* YS = F.ws + WS_YS; const int* POS = (const int*)(F.ws + WS_POS); const float* g = in[29];
    f32x4 gv[4][2];
#pragma unroll
    for (int j = 0; j < 4; ++j) { gv[j][0] = *(const f32x4*)(g + 8 * F.lane + 512 * j); gv[j][1] = *(const f32x4*)(g + 8 * F.lane + 512 * j + 4); }
    for (int m0 = F.gw * 2; m0 < TT; m0 += F.NGW * 2) {
        u32x4 x[2][4]; u32x2 a[2][4], bq[2][4];
#pragma unroll
        for (int rr = 0; rr < 2; ++rr) { const int m = m0 + rr; const int p0 = POS[m * 2], p1 = POS[m * 2 + 1];
#pragma unroll
            for (int j = 0; j < 4; ++j) { const size_t c = 8 * F.lane + 512 * j;
                x[rr][j] = *(const u32x4*)(X1B + (size_t)m * 2048 + c); a[rr][j] = *(const u32x2*)(YS + (size_t)p0 * 2048 + c); bq[rr][j] = *(const u32x2*)(YS + (size_t)p1 * 2048 + c); } }
#pragma unroll
        for (int rr = 0; rr < 2; ++rr) { const int m = m0 + rr; float v[4][8]; float ss = 0.f;
#pragma unroll
            for (int j = 0; j < 4; ++j) { float xa[8], ya[8], yb[8]; unpack8(x[rr][j], xa); unpack8_fp8(a[rr][j], ya); unpack8_fp8(bq[rr][j], yb);
#pragma unroll
                for (int c = 0; c < 8; ++c) { v[j][c] = xa[c] + (ya[c] + yb[c]) * (1.0f / 64.0f); ss += v[j][c] * v[j][c]; } }
            ss = wave_sum(ss); const float r = rsqrtf(ss * (1.0f / 2048.0f) + EPS);
#pragma unroll
            for (int j = 0; j < 4; ++j) { const size_t c = 8 * F.lane + 512 * j; const f32x4 g0 = gv[j][0], g1 = gv[j][1];
                *(f32x4*)(OUT + (size_t)m * 2048 + c) = (f32x4){v[j][0] * r * g0.x, v[j][1] * r * g0.y, v[j][2] * r * g0.z, v[j][3] * r * g0.w};
                *(f32x4*)(OUT + (size_t)m * 2048 + c + 4) = (f32x4){v[j][4] * r * g1.x, v[j][5] * r * g1.y, v[j][6] * r * g1.z, v[j][7] * r * g1.w}; } }
    }
}
constexpr int NPHASE = 20;
struct Args { const float* in[30]; float* out; unsigned char* ws; int ph_lo, ph_hi; };

__device__ __forceinline__ bool fresh_lane(Frame& F) { int l = (int)__builtin_amdgcn_mbcnt_hi(~0u, __builtin_amdgcn_mbcnt_lo(~0u, 0u)); asm volatile("" : "+v"(l)); F.lane = l; F.tid = (F.wave << 6) | l; return true; }
__global__ void __launch_bounds__(512, 2) mk_fwd(Args args) {
    extern __shared__ __attribute__((aligned(16))) unsigned char lds_raw[];
    Frame F;
    F.lds = (LAS unsigned char*)lds_raw; F.lds_g = lds_raw;
    F.MISC = (volatile LAS unsigned*)(F.lds + MISC_OFF);
    F.tid = threadIdx.x; F.lane = F.tid & 63; F.wave = __builtin_amdgcn_readfirstlane(F.tid >> 6);
    F.G = gridDim.x; F.bid = blockIdx.x; F.gw = F.bid * 8 + F.wave; F.NGW = F.G * 8;
    F.ws = args.ws; F.dout = (unsigned char*)args.out; F.ctl = (unsigned*)(args.ws + WS_CTL);
    const float* const* in = args.in;
    F.gdiff = args.in[12];
    for (int u = F.tid; u < (LDS_BYTES - RING_BYTES) / 4; u += 512) ((LAS unsigned*)(F.lds + RING_BYTES))[u] = 0u;
    __syncthreads();
    const int lo = args.ph_lo, hi = args.ph_hi;
    const bool fused = (hi - lo) > 1;
    XcdBarrier bar; bar.bar = F.ctl + CW_BAR; bar.x = 0; bar.st = nullptr;
    if (fused) bar = xcd_barrier_post(F.ctl + CW_BAR, F.MISC + 8, F.tid);
#ifndef ONLY_PHASE
#define ONLY_PHASE -1
#endif
#define IN(k) ((ONLY_PHASE < 0 || ONLY_PHASE == (k)) && lo <= (k) && (k) < hi && fresh_lane(F))
#ifndef DUP_MASK
#define DUP_MASK 0
#endif
#define DUP_BEGIN(k) _Pragma("unroll") for (int rep_ = 0; rep_ < 1 + ((DUP_MASK >> (k)) & 1); ++rep_) { if (rep_) { xcd_barrier(bar, F.tid); fresh_lane(F); }
#define DUP_END }
#define SEAM(k) do { if ((ONLY_PHASE < 0 || ONLY_PHASE == (k) + 1) && lo <= (k) + 1 && (k) + 1 < hi) xcd_barrier(bar, F.tid); } while (0)
    const int G = F.G, c = F.bid;
    bf16_t* const HBF = (bf16_t*)(F.dout + DO_HBF);
    bf16_t* const WINT = (bf16_t*)(F.ws + WS_WINT);
    const bf16_t* const HBF8 = (const bf16_t*)(F.ws + WS_HBF8);
    const bf16_t* const WG8 = (const bf16_t*)(WINT + (size_t)11264 * 2048);

    if (IN(0)) { DUP_BEGIN(0) p0_prologue(F, in); DUP_END SEAM(0); }

    if (IN(1)) { DUP_BEGIN(1)
        if (F.bid >= 16 && F.bid < 24) ml0_seq(F, in, F.bid - 16);
        { pg8::SchedPA S{HBF, WINT, G, c};
          pg8::EpiPA E{(bf16_t*)(F.ws + WS_MQK), (bf16_t*)(F.ws + WS_MLO), (bf16_t*)(F.ws + WS_XQ), (bf16_t*)(F.ws + WS_VC), 1.0f};
          pg8::gemm_phase(F.lds, 2048, 2048, 2048, S, E, F.tid); }
        { pg8::SchedPA8 S{HBF8, (const bf16_t*)(WINT + (size_t)8192 * 2048), G, c};
          pg8::EpiPA E{(bf16_t*)(F.ws + WS_MQK), (bf16_t*)(F.ws + WS_MLO), (bf16_t*)(F.ws + WS_XQ), (bf16_t*)(F.ws + WS_VC), 1.0f / 32.0f};
          pg8::gemm_phase<pg8::EpiPA, pg8::SchedPA8, true>(F.lds, 1024, 1024, 1024, S, E, F.tid); }
        DUP_END SEAM(1);
    }
    if (IN(2)) { DUP_BEGIN(2)
        if (G <= 16 || c < 16) { pg8::SchedMem S{(const bf16_t*)(F.ws + WS_MEMN), (const bf16_t*)(F.ws + WS_WMEMT), G, c};
            pg8::EpiMem E{(bf16_t*)(F.ws + WS_MK), (bf16_t*)(F.ws + WS_MVT)};
            pg8::gemm_phase(F.lds, 2048, 2048, 2048, S, E, F.tid); }
        if (G <= 16 || c >= 16) { const int first = G > 16 ? (c - 16) * 8 + F.wave : F.gw, nstep = G > 16 ? (G - 16) * 8 : F.NGW; ml1_conv(F, in, first, nstep); }
        DUP_END SEAM(2);
    }
    if (IN(3)) { DUP_BEGIN(3)
#ifndef SUB
#define SUB 7
#endif
        if (SUB & 1) { pg8::SchedHG S{(const bf16_t*)(F.ws + WS_Q), (const bf16_t*)(F.ws + WS_KW), (size_t)TT * 256, 65536, (size_t)TT * 256, 65536, G, c};
          pg8::EpiW E{(bf16_t*)(F.ws + WS_WQ), (const float*)(F.ws + WS_SCRS)};
          pg8::gemm_phase(F.lds, 256, 256, 256, S, E, F.tid); }
        if (SUB & 2) { pg8::SchedHG S{(const bf16_t*)(F.ws + WS_VC), (const bf16_t*)(F.ws + WS_KWT), (size_t)128 * 256 * 512, (size_t)256 * 512, (size_t)128 * 65536, 65536, G, c};
          pg8::EpiB16Tile E{(bf16_t*)(F.ws + WS_U), 65536, 0, (size_t)128 * 65536, 256, 1.0f};
          pg8::gemm_phase(F.lds, 512, 256, 256, S, E, F.tid); }
        if (SUB & 4) { pg8::SchedXA S{(const bf16_t*)(F.ws + WS_XQ), (const bf16_t*)(F.ws + WS_MK), G, c};
          pg8::EpiXSoft E{(bf16_t*)(F.ws + WS_XP2), (LAS float*)(F.lds + pg8::EPI_TBL_OFF)};
          pg8::gemm_phase(F.lds, 256, 256, 256, S, E, F.tid); }
        if (F.bid < 8) nscan_seq(F, F.bid);
        DUP_END SEAM(3);
    }
    if (IN(4)) { DUP_BEGIN(4) cscan(F); denpass(F); DUP_END SEAM(4); }
    if (IN(5)) { DUP_BEGIN(5)
        { pg8::SchedHG S{(const bf16_t*)(F.ws + WS_WQ), (const bf16_t*)(F.ws + WS_VC), (size_t)TT * 512, (size_t)256 * 512, (size_t)128 * 256 * 512, (size_t)256 * 512, G, c};
          pg8::EpiHNorm E{(bf16_t*)(F.dout + DO_HR), (const float*)(F.ws + WS_HDEN), (const bf16_t*)(F.ws + WS_MLO), in[13], (LAS float*)(F.lds + pg8::EPI_TBL_OFF)};
          pg8::gemm_phase(F.lds, 512, 512, 512, S, E, F.tid); }
        { pg8::SchedXA S{(const bf16_t*)(F.ws + WS_XP2), (const bf16_t*)(F.ws + WS_MVT), G, c};
          pg8::EpiXA E{(bf16_t*)(F.dout + DO_XA)};
          pg8::gemm_phase(F.lds, 256, 256, 256, S, E, F.tid); }
        DUP_END SEAM(5);
    }
    if (IN(6)) { DUP_BEGIN(6)
        pg8::SchedDense S{HBF, WINT, 2048, 2048, 128, 24, G, c};
        pg8::EpiPB E{(bf16_t*)(F.ws + WS_DQ), (bf16_t*)(F.ws + WS_DK), (bf16_t*)(F.ws + WS_DV)};
        pg8::gemm_phase(F.lds, 2048, 2048, 2048, S, E, F.tid);
        DUP_END SEAM(6);
    }
    if (IN(7)) { DUP_BEGIN(7) normmax(F); DUP_END SEAM(7); }
    if (IN(8)) { DUP_BEGIN(8) attn_phase(F, rep_); DUP_END SEAM(8); }
#ifndef SLEEP_US
#define SLEEP_US 0
#endif
    if (IN(9)) { if (SLEEP_US) { const unsigned long long t0_ = __builtin_amdgcn_s_memrealtime(); while (__builtin_amdgcn_s_memrealtime() - t0_ < (unsigned long long)SLEEP_US * 100ull) __builtin_amdgcn_s_sleep(127); }
        DUP_BEGIN(9) expert_convert(F, in, 1); DUP_END SEAM(9); }
    if (IN(10)) { DUP_BEGIN(10)
        pg8::SchedDense S{HBF8, WG8, 1024, 1024, 128, 8, G, c};
        pg8::EpiGate E{(bf16_t*)(F.ws + WS_GT0), in[19], 1.0f / 32.0f};
        pg8::gemm_phase<pg8::EpiGate, pg8::SchedDense, true>(F.lds, 1024, 1024, 1024, S, E, F.tid);
        DUP_END SEAM(10);
    }
    if (IN(11)) { DUP_BEGIN(11)
        { pg8::SchedDense S{(const bf16_t*)(F.ws + WS_DA), (const bf16_t*)(F.ws + WS_WBDT), 1024, 1024, 128, 8, G, c};
          pg8::EpiBranch<true> E{(const bf16_t*)(F.ws + WS_GT0), (bf16_t*)(F.dout + DO_MERGED), 1.0f / 32.0f};
          pg8::gemm_phase<pg8::EpiBranch<true>, pg8::SchedDense, true>(F.lds, 1024, 1024, 1024, S, E, F.tid); }
        { pg8::SchedDense S{HBF8, WG8 + (size_t)2048 * 1024, 1024, 1024, 128, 8, G, c};
          pg8::EpiGate E{(bf16_t*)(F.ws + WS_GT1), in[19] + 2048, 1.0f / 32.0f};
          pg8::gemm_phase<pg8::EpiGate, pg8::SchedDense, true>(F.lds, 1024, 1024, 1024, S, E, F.tid); }
        DUP_END SEAM(11);
    }
    if (IN(12)) { DUP_BEGIN(12)
        { pg8::SchedDense S{(const bf16_t*)(F.dout + DO_HR), (const bf16_t*)(F.ws + WS_WBMT), 1024, 1024, 128, 8, G, c};
          pg8::EpiBranch<false> E{(const bf16_t*)(F.ws + WS_GT1), (bf16_t*)(F.dout + DO_MERGED), 1.0f};
          pg8::gemm_phase(F.lds, 1024, 1024, 1024, S, E, F.tid); }
        { pg8::SchedDense S{HBF8, WG8 + (size_t)4096 * 1024, 1024, 1024, 128, 8, G, c};
          pg8::EpiGate E{(bf16_t*)(F.ws + WS_GT0), in[19] + 4096, 1.0f / 32.0f};
          pg8::gemm_phase<pg8::EpiGate, pg8::SchedDense, true>(F.lds, 1024, 1024, 1024, S, E, F.tid); }
        DUP_END SEAM(12);
    }
    if (IN(13)) { DUP_BEGIN(13)
        pg8::SchedDense S{(const bf16_t*)(F.dout + DO_XA), (const bf16_t*)(F.ws + WS_WBCT), 1024, 1024, 128, 8, G, c};
        pg8::EpiBranch<false> E{(const bf16_t*)(F.ws + WS_GT0), (bf16_t*)(F.dout + DO_MERGED), 1.0f};
        pg8::gemm_phase(F.lds, 1024, 1024, 1024, S, E, F.tid);
        DUP_END SEAM(13);
    }
    if (IN(14)) { DUP_BEGIN(14)
        pg8::SchedDense S{(const bf16_t*)(F.dout + DO_MERGED), (const bf16_t*)(F.ws + WS_WOUTT), 2048, 2048, 128, 8, G, c};
        pg8::EpiOut E{in[0], (bf16_t*)(F.ws + WS_X1B), (float*)(F.ws + WS_RSS)};
        pg8::gemm_phase(F.lds, 2048, 2048, 2048, S, E, F.tid);
        DUP_END SEAM(14);
    }
    if (IN(15)) { DUP_BEGIN(15)
        pg8::SchedDense S{(const bf16_t*)(F.ws + WS_X1B), (const bf16_t*)(F.ws + WS_WRT), 2048, 2048, 128, 1, G, c};
        pg8::EpiF32Tile E{(float*)(F.ws + WS_LG), 65536, 0, 0, 256};
        pg8::gemm_phase(F.lds, 2048, 2048, 2048, S, E, F.tid);
        VM_WAIT(); __syncthreads();
        for (int L = c; L < 128; L += G) { int pm, pn; pg8::tile_order(L, 128, 1, pm, pn); topk_pass(F, in, pm * 256, pm * 256 + 256); }
        DUP_END SEAM(15);
    }
    if (IN(16)) { DUP_BEGIN(16) gather_pass(F, in); DUP_END SEAM(16); }
    if (IN(17)) { DUP_BEGIN(17)
        const int nrt = (int)__builtin_amdgcn_readfirstlane(F.ctl[CW_NRT]);
        LAS int* ue = (LAS int*)(F.lds + RING_BYTES + 3328);
        if (F.tid < 16) { const int L = F.tid * G + c; ue[F.tid] = (L < nrt * 6) ? ((const int*)(F.ws + WS_TILEE))[L / 6] : 0; }
        __syncthreads();
        pg8::SchedMoE S{(const bf16_t*)(F.ws + WS_XSORT), (const bf16_t*)(F.ws + WS_WGU), ue, nrt, 6, 1024, (size_t)GU_N * 1024, (size_t)256 * 1024, G, c};
        pg8::EpiGU E{F.ws + WS_HD};
        pg8::gemm_phase<pg8::EpiGU, pg8::SchedMoE, true>(F.lds, 1024, 1024, 1024, S, E, F.tid);
        DUP_END SEAM(17);
    }
    if (IN(18)) { DUP_BEGIN(18)
        const int nrt = (int)__builtin_amdgcn_readfirstlane(F.ctl[CW_NRT]);
        LAS int* ue = (LAS int*)(F.lds + RING_BYTES + 3328);
        if (F.tid < 16) { const int L = F.tid * G + c; ue[F.tid] = (L < nrt * 8) ? ((const int*)(F.ws + WS_TILEE))[L / 8] : 0; }
        __syncthreads();
        pg8::SchedMoE S{(const bf16_t*)(F.ws + WS_HD), (const bf16_t*)(F.ws + WS_WD), ue, nrt, 8, DEXP_P / 2, (size_t)2048 * (DEXP_P / 2), (size_t)256 * (DEXP_P / 2), G, c};
        pg8::EpiDown E{F.ws + WS_YS, (const float*)(F.ws + WS_WROW)};
        pg8::gemm_phase<pg8::EpiDown, pg8::SchedMoE, true>(F.lds, DEXP_P / 2, DEXP_P / 2, DEXP_P / 2, S, E, F.tid);
        DUP_END SEAM(18);
    }
    if (IN(19)) { DUP_BEGIN(19) final_pass(F, in); DUP_END }
#ifdef TAIL_PROBE
    if (fused) { xcd_barrier(bar, F.tid); fresh_lane(F);
        if (TAIL_PROBE == 2) expert_convert(F, in, 1);
        if (TAIL_PROBE == 4) ml1_conv(F, in, F.gw, F.NGW);
        if (TAIL_PROBE == 5) cscan(F);
        if (TAIL_PROBE == 6) denpass(F);
        if (TAIL_PROBE == 7) normmax(F);
        if (TAIL_PROBE == 10) p0_prologue(F, in, 1);
    }
#endif
#undef IN
#undef SEAM
}

#ifndef MK_FUSED
#define MK_FUSED 1
#endif
extern "C" void kernel_launch(void* const* d_in, const int* in_sizes, int n_in, void* d_out, int out_size, void* d_ws, size_t ws_size, hipStream_t stream) {
    static int grid = 0;
    if (grid == 0) {
        if (n_in != 30 || out_size != TT * DM || ws_size < WS_END) { fprintf(stderr, "kernel_launch: unexpected shapes (n_in %d out %d ws %zu)\n", n_in, out_size, ws_size); grid = -1; return; }
        int dev = 0, cus = 0, per_cu = 0;
        if (hipGetDevice(&dev) != hipSuccess || hipDeviceGetAttribute(&cus, hipDeviceAttributeMultiprocessorCount, dev) != hipSuccess) { grid = -1; return; }
        if (hipFuncSetAttribute((const void*)mk_fwd, hipFuncAttributeMaxDynamicSharedMemorySize, LDS_BYTES) != hipSuccess) { fprintf(stderr, "kernel_launch: hipFuncSetAttribute failed\n"); grid = -1; return; }
        if (hipOccupancyMaxActiveBlocksPerMultiprocessor(&per_cu, (const void*)mk_fwd, 512, LDS_BYTES) != hipSuccess || per_cu < 1) fprintf(stderr, "kernel_launch: occupancy query says %d\n", per_cu);
        (void)hipGetLastError();
        grid = cus;
    }
    if (grid < 0) return;
    (void)hipMemsetAsync((char*)d_ws + WS_CTL, 0, CTL_ZERO_BYTES, stream);
    Args a{};
    for (int i = 0; i < 30; ++i) a.in[i] = (const float*)d_in[i];
    a.out = (float*)d_out; a.ws = (unsigned char*)d_ws;
#if MK_FUSED
    a.ph_lo = 0; a.ph_hi = NPHASE;
    hipLaunchKernelGGL(mk_fwd, dim3(grid), dim3(512), LDS_BYTES, stream, a);
#else
#ifndef PROBE_DUP
#define PROBE_DUP 0u
#endif
    for (int p = 0; p < NPHASE; ++p) { a.ph_lo = p; a.ph_hi = p + 1; hipLaunchKernelGGL(mk_fwd, dim3(grid), dim3(512), LDS_BYTES, stream, a);
        if ((PROBE_DUP >> p) & 1u) {
            if (p == 8) (void)hipMemsetAsync((char*)d_ws + WS_CTL + CW_AHEAD * 4, 0, 256, stream);
            hipLaunchKernelGGL(mk_fwd, dim3(grid), dim3(512), LDS_BYTES, stream, a); } }
#endif
}
```
